# Optimizing an MI355X kernel written in HIP

```python
import math
import jax
import jax.numpy as jnp
from jax import lax
import numpy as np

D_MODEL = 2048
BATCH = 32
SEQ = 256
DEPTH = 4
DEC_BATCH = 8
DEC_SEQ = 2048
PAST_LEN = 512

N_MIXERS = 3
N_WIN = (DEPTH + 2) // 3
N_HY = (DEPTH + 1) // 3
N_AX = DEPTH // 3
N_HEADS = 16
N_KV_HEADS = 4
HEAD_DIM = 128
QKV_DIM = (N_HEADS + 2 * N_KV_HEADS) * HEAD_DIM
WINDOW = 128
BLOCK = 128
GRID_W = 64
ROPE_THETA = 10000.0
D_FF = -(-8 * D_MODEL // (3 * 256)) * 256
HY_ORDER = 2
HY_EMB = 33
HY_FILTER_HIDDEN = 64
HY_TARGET = 1e-2
HY_FAST_DECAY = 0.3
HY_SLOW_DECAY = 1.5
HY_MIN_DECAY = math.log(HY_TARGET) / HY_SLOW_DECAY
HY_MAX_DECAY = math.log(HY_TARGET) / HY_FAST_DECAY
EPS = 1e-6
NEG = -1e30

kernel_name = 'hybrid_diffusion_step'


def rmsnorm(x, g):
    xf = x.astype(jnp.float32)
    y = xf * lax.rsqrt(jnp.mean(xf * xf, axis=-1, keepdims=True) + EPS)
    return (y * g.astype(jnp.float32)).astype(x.dtype)


def adaln(cvec, w, b):
    m = jax.nn.silu(cvec) @ w + b
    return jnp.split(m[:, None, :], 6, axis=-1)


def modulate(h, shift, scale):
    return h * (1 + scale) + shift


def swiglu(h, w_gu, w_down):
    g, u = jnp.split(h @ w_gu, 2, axis=-1)
    return (jax.nn.silu(g) * u) @ w_down


def project_qkv(h, wqkv, q_g, k_g):
    B, L, _ = h.shape
    y = h @ wqkv
    nq, nk = N_HEADS * HEAD_DIM, N_KV_HEADS * HEAD_DIM
    q = y[..., :nq].reshape(B, L, N_HEADS, HEAD_DIM)
    k = y[..., nq:nq + nk].reshape(B, L, N_KV_HEADS, HEAD_DIM)
    v = y[..., nq + nk:].reshape(B, L, N_KV_HEADS, HEAD_DIM)
    if q_g is not None:
        q = rmsnorm(q, q_g)
        k = rmsnorm(k, k_g)
    return q, k, v


def axial_rope_tables(L):
    n_rows = L // GRID_W
    row = jnp.repeat(jnp.arange(n_rows, dtype=jnp.float32), GRID_W)
    col = jnp.tile(jnp.arange(GRID_W, dtype=jnp.float32), n_rows)
    half = HEAD_DIM // 2
    inv = ROPE_THETA ** (-jnp.arange(0, half, 2, dtype=jnp.float32) / half)
    ang = jnp.concatenate([row[:, None] * inv, col[:, None] * inv], axis=-1)
    return jnp.cos(ang), jnp.sin(ang)


def apply_axial_rope(x, cos, sin):
    half, quarter = HEAD_DIM // 2, HEAD_DIM // 4
    xf = x.astype(jnp.float32)
    parts = []
    for a in range(2):
        xa = xf[..., a * half:(a + 1) * half]
        x1, x2 = xa[..., :quarter], xa[..., quarter:]
        cs = cos[None, :, None, a * quarter:(a + 1) * quarter]
        sn = sin[None, :, None, a * quarter:(a + 1) * quarter]
        parts += [x1 * cs - x2 * sn, x2 * cs + x1 * sn]
    return jnp.concatenate(parts, axis=-1).astype(x.dtype)


def blocked_attention(q, k_ctx, v_ctx, sink=None, k_lat=None, v_lat=None, window=None):
    B, Lq, H, hd = q.shape
    kvh = k_ctx.shape[2]
    grp = H // kvh
    nb = Lq // BLOCK
    scale = hd ** -0.5
    qb = jnp.moveaxis(q.reshape(B, nb, BLOCK, kvh, grp, hd), 1, 0)
    if k_lat is None:
        k_all, v_all = k_ctx, v_ctx
    elif window is None:
        k_all = jnp.concatenate([k_lat, k_ctx], axis=1)
        v_all = jnp.concatenate([v_lat, v_ctx], axis=1)
    else:
        pad = ((0, 0), (BLOCK, BLOCK), (0, 0), (0, 0))
        k_src, v_src = jnp.pad(k_lat, pad), jnp.pad(v_lat, pad)
        ctx_mask = jnp.ones((BLOCK, k_ctx.shape[1]), dtype=bool)

    def one_block(args):
        b, qblk = args
        if k_lat is not None and window is not None:
            kw = lax.dynamic_slice_in_dim(k_src, b * BLOCK, 3 * BLOCK, axis=1)
            vw = lax.dynamic_slice_in_dim(v_src, b * BLOCK, 3 * BLOCK, axis=1)
            qpos = b * BLOCK + jnp.arange(BLOCK)
            kpos = (b - 1) * BLOCK + jnp.arange(3 * BLOCK)
            m_lat = ((jnp.abs(qpos[:, None] - kpos[None, :]) <= window)
                     & (kpos >= 0)[None, :] & (kpos < Lq)[None, :])
            keys = jnp.concatenate([kw, k_ctx], axis=1)
            vals = jnp.concatenate([vw, v_ctx], axis=1)
            mask = jnp.concatenate([m_lat, ctx_mask], axis=1)
        else:
            keys, vals, mask = k_all, v_all, None
        s = jnp.einsum('bqkgd,bskd->bkgqs', qblk, keys).astype(jnp.float32) * scale
        if mask is not None:
            s = jnp.where(mask, s, NEG)
        if sink is not None:
            sk = sink.astype(jnp.float32).reshape(kvh, grp)[None, :, :, None, None]
            s = jnp.concatenate([s, jnp.broadcast_to(sk, s.shape[:-1] + (1,))], axis=-1)
        p = jax.nn.softmax(s, axis=-1)
        if sink is not None:
            p = p[..., :-1]
        return jnp.einsum('bkgqs,bskd->bqkgd', p.astype(vals.dtype), vals)

    out = lax.map(one_block, (jnp.arange(nb), qb))
    return jnp.moveaxis(out, 0, 1).reshape(B, Lq, H * hd)


def attn_context(h, wqkv, wo, sink, q_g, k_g):
    q, k, v = project_qkv(h, wqkv, q_g, k_g)
    o = blocked_attention(q, k, v, sink=sink)
    return o @ wo, k, v


def attn_latent(h, wqkv, wo, sink, q_g, k_g, k_ctx, v_ctx, window):
    q, k, v = project_qkv(h, wqkv, q_g, k_g)
    cos, sin = axial_rope_tables(h.shape[1])
    q = apply_axial_rope(q, cos, sin)
    k = apply_axial_rope(k, cos, sin)
    o = blocked_attention(q, k_ctx, v_ctx, sink=sink, k_lat=k, v_lat=v, window=window)
    return o @ wo


def short_conv(u, w, b):
    up = jnp.pad(u, ((0, 0), (1, 1), (0, 0)))
    return up[:, :-2] * w[0] + up[:, 1:-1] * w[1] + up[:, 2:] * w[2] + b


def hyena_filters(L, f_w1, f_b1, f_w2, f_b2, f_w3, freq):
    D = f_w3.shape[-1] // (2 * HY_ORDER)
    f32 = jnp.float32
    t = jnp.arange(L, dtype=f32)
    tn = t / max(L - 1, 1)
    bands = (HY_EMB - 1) // 2
    fb = jnp.linspace(1e-4, bands - 1, bands, dtype=f32)
    w = 2.0 * math.pi * t / L
    feats = jnp.concatenate([tn[:, None], jnp.cos(w[:, None] * fb), -jnp.sin(w[:, None] * fb)], axis=-1)
    a = jnp.sin(freq[0].astype(f32) * (feats @ f_w1.astype(f32) + f_b1.astype(f32)))
    a = jnp.sin(freq[1].astype(f32) * (a @ f_w2.astype(f32) + f_b2.astype(f32)))
    hf = (a @ f_w3.astype(f32)).reshape(L, 2, HY_ORDER, D)
    deltas = jnp.abs(jnp.linspace(HY_MIN_DECAY, HY_MAX_DECAY, D, dtype=f32))
    hf = hf * jnp.exp(-tn[:, None] * deltas[None, :])[:, None, None, :]
    fwd, bwd = hf[:, 0], hf[:, 1]
    two = jnp.concatenate([fwd, jnp.zeros((1, HY_ORDER, D), f32), bwd[:0:-1]], axis=0)
    two = two / (jnp.sum(jnp.abs(two), axis=0, keepdims=True) + EPS)
    return jnp.fft.rfft(two, n=2 * L, axis=0)


def long_conv(u, hf, bias):
    L = u.shape[1]
    uf32 = u.astype(jnp.float32)
    uf = jnp.fft.rfft(uf32, n=2 * L, axis=1)
    y = jnp.fft.irfft(uf * hf[None], n=2 * L, axis=1)[:, :L]
    return (y + uf32 * bias.astype(jnp.float32)).astype(u.dtype)


def hyena(h, w_in, conv_w, conv_b, f_w1, f_b1, f_w2, f_b2, f_w3, freq, skip, w_out):
    L = h.shape[1]
    u = short_conv(h @ w_in, conv_w, conv_b)
    v, x1, x2 = jnp.split(u, 3, axis=-1)
    filt = hyena_filters(L, f_w1, f_b1, f_w2, f_b2, f_w3, freq)
    z = x1 * long_conv(v, filt[:, 0], skip[0])
    z = x2 * long_conv(z, filt[:, 1], skip[1])
    return z @ w_out


def setup_inputs(seed: int = 0) -> dict:
    key = jax.random.key(seed)
    ks = iter(jax.random.split(key, 40))
    D = D_MODEL

    def nrm(shape, scale):
        return jax.random.normal(next(ks), shape, jnp.float32) * scale

    kv_win = (DEC_BATCH, N_WIN, PAST_LEN, N_KV_HEADS, HEAD_DIM)
    kv_ax = (DEC_BATCH, N_AX, PAST_LEN, N_KV_HEADS, HEAD_DIM)
    return {
        'x_prompt': nrm((BATCH, SEQ, D), 1.0),
        'x_sample': nrm((DEC_BATCH, DEC_SEQ, D), 1.0),
        'cache_win_k': nrm(kv_win, 1.0),
        'cache_win_v': nrm(kv_win, 1.0),
        'cache_ax_k': nrm(kv_ax, 1.0),
        'cache_ax_v': nrm(kv_ax, 1.0),
        'c': nrm((DEC_BATCH, D), 1.0),
        'c_ctx': nrm((D,), 1.0),
        'norm_mix_g': 1.0 + nrm((DEPTH, D), 0.02),
        'norm_ffn_g': 1.0 + nrm((DEPTH, D), 0.02),
        'mod_w': nrm((DEPTH, D, 6 * D), D ** -0.5),
        'mod_b': nrm((DEPTH, 6 * D), 0.02),
        'win_wqkv': nrm((N_WIN, D, QKV_DIM), D ** -0.5),
        'win_wo': nrm((N_WIN, N_HEADS * HEAD_DIM, D), (N_HEADS * HEAD_DIM) ** -0.5),
        'win_sink': nrm((N_WIN, N_HEADS), 0.5),
        'hy_w_in': nrm((N_HY, D, 3 * D), D ** -0.5),
        'hy_conv_w': nrm((N_HY, 3, 3 * D), 3 ** -0.5),
        'hy_conv_b': nrm((N_HY, 3 * D), 0.02),
        'hy_f_w1': nrm((N_HY, HY_EMB, HY_FILTER_HIDDEN), 1.0),
        'hy_f_b1': nrm((N_HY, HY_FILTER_HIDDEN), 0.1),
        'hy_f_w2': nrm((N_HY, HY_FILTER_HIDDEN, HY_FILTER_HIDDEN), HY_FILTER_HIDDEN ** -0.5),
        'hy_f_b2': nrm((N_HY, HY_FILTER_HIDDEN), 0.1),
        'hy_f_w3': nrm((N_HY, HY_FILTER_HIDDEN, 2 * HY_ORDER * D), HY_FILTER_HIDDEN ** -0.5),
        'hy_freq': 1.0 + nrm((N_HY, 2, HY_FILTER_HIDDEN), 0.02),
        'hy_skip': nrm((N_HY, HY_ORDER, D), 0.1),
        'hy_wo': nrm((N_HY, D, D), D ** -0.5),
        'ax_wqkv': nrm((N_AX, D, QKV_DIM), D ** -0.5),
        'ax_q_g': 1.0 + nrm((N_AX, HEAD_DIM), 0.02),
        'ax_k_g': 1.0 + nrm((N_AX, HEAD_DIM), 0.02),
        'ax_wo': nrm((N_AX, N_HEADS * HEAD_DIM, D), (N_HEADS * HEAD_DIM) ** -0.5),
        'ffn_w_gu': nrm((DEPTH, D, 2 * D_FF), D ** -0.5),
        'ffn_w_down': nrm((DEPTH, D_FF, D), D_FF ** -0.5),
        'final_g': 1.0 + nrm((D,), 0.02),
    }


def reference(x_prompt, x_sample, cache_win_k, cache_win_v, cache_ax_k, cache_ax_v, c, c_ctx,
              norm_mix_g, norm_ffn_g, mod_w, mod_b, win_wqkv, win_wo, win_sink,
              hy_w_in, hy_conv_w, hy_conv_b, hy_f_w1, hy_f_b1, hy_f_w2, hy_f_b2, hy_f_w3, hy_freq, hy_skip, hy_wo,
              ax_wqkv, ax_q_g, ax_k_g, ax_wo, ffn_w_gu, ffn_w_down, final_g):
    ctx, lat = x_prompt, x_sample
    win_k, win_v, ax_k, ax_v = [], [], [], []
    for i in range(DEPTH):
        sh1c, sc1c, g1c, sh2c, sc2c, g2c = adaln(c_ctx[None, :], mod_w[i], mod_b[i])
        sh1l, sc1l, g1l, sh2l, sc2l, g2l = adaln(c, mod_w[i], mod_b[i])
        h_c = modulate(rmsnorm(ctx, norm_mix_g[i]), sh1c, sc1c)
        h_l = modulate(rmsnorm(lat, norm_mix_g[i]), sh1l, sc1l)
        kind, j = i % N_MIXERS, i // N_MIXERS
        if kind == 0:
            o_c, k_c, v_c = attn_context(h_c, win_wqkv[j], win_wo[j], win_sink[j], None, None)
            o_l = attn_latent(h_l, win_wqkv[j], win_wo[j], win_sink[j], None, None,
                              cache_win_k[:, j], cache_win_v[:, j], WINDOW)
            win_k.append(k_c)
            win_v.append(v_c)
        elif kind == 1:
            hp = (hy_w_in[j], hy_conv_w[j], hy_conv_b[j], hy_f_w1[j], hy_f_b1[j], hy_f_w2[j], hy_f_b2[j],
                  hy_f_w3[j], hy_freq[j], hy_skip[j], hy_wo[j])
            o_c = hyena(h_c, *hp)
            o_l = hyena(h_l, *hp)
        else:
            o_c, k_c, v_c = attn_context(h_c, ax_wqkv[j], ax_wo[j], None, ax_q_g[j], ax_k_g[j])
            o_l = attn_latent(h_l, ax_wqkv[j], ax_wo[j], None, ax_q_g[j], ax_k_g[j],
                              cache_ax_k[:, j], cache_ax_v[:, j], None)
            ax_k.append(k_c)
            ax_v.append(v_c)
        ctx = ctx + g1c * o_c
        lat = lat + g1l * o_l
        h_c = modulate(rmsnorm(ctx, norm_ffn_g[i]), sh2c, sc2c)
        h_l = modulate(rmsnorm(lat, norm_ffn_g[i]), sh2l, sc2l)
        ctx = ctx + g2c * swiglu(h_c, ffn_w_gu[i], ffn_w_down[i])
        lat = lat + g2l * swiglu(h_l, ffn_w_gu[i], ffn_w_down[i])
    y_prompt = rmsnorm(ctx, final_g)
    y_sample = rmsnorm(lat, final_g)
    state_win_k = jnp.stack(win_k, axis=1)
    state_win_v = jnp.stack(win_v, axis=1)
    state_ax_k = jnp.stack(ax_k, axis=1)
    state_ax_v = jnp.stack(ax_v, axis=1)
    return (y_prompt, y_sample, state_win_k, state_win_v, state_ax_k, state_ax_v)
```

```cpp
#define MK_PER_PHASE 1
#include <hip/hip_runtime.h>
#include <cstdio>
#include <cstdint>
#include <hip/hip_bf16.h>
#include <cmath>
namespace pg8 {
#define PG8_LAS __attribute__((address_space(3)))
typedef unsigned short bf16_t;
typedef short bf16x8 __attribute__((ext_vector_type(8)));
typedef float f32x4 __attribute__((ext_vector_type(4)));
typedef unsigned u32x4 __attribute__((ext_vector_type(4)));
constexpr int BM = 256, BK = 64, HALF = 128, HTB = HALF * BK * 2  , STAGE_BYTES = 8 * HTB, NXCD = 8, WGM = 8;

__host__ __device__ __forceinline__ int lds_byte(int r, int c) { const int st = (r >> 4) * 2 + (c >> 5), rr = r & 15, cc = c & 31, ob = rr * 64 + cc * 2; return st * 1024 + (ob ^ (((ob >> 9) & 1) << 5)); }
__host__ __device__ __forceinline__ void stage_rc(int b, int& R, int& C) { const int st = b / 1024, sb = b % 1024, swz = sb ^ (((sb >> 9) & 1) << 5); R = (st >> 1) * 16 + swz / 64; C = (st & 1) * 32 + (swz % 64) / 2; }
__host__ __device__ __forceinline__ int perm32(int rho) { const int n = rho >> 4, i = rho & 15; return 8 * (i >> 2) + 4 * n + (i & 3); }

struct Unit { int pm, pn; };
struct Gemm { const bf16_t* A; const bf16_t* Bt; int M, N, K; };

struct StaticOrder {
    int nM, nN, nwg, G, c;
    __host__ __device__ void init(int M, int N, int G_, int c_) { nM = M / BM; nN = N / BM; nwg = nM * nN; G = G_; c = c_; }
    __host__ __device__ bool next(int i, Unit& u) const {
        const long L = (long)i * G + c; if (L >= nwg) return false;
        int wgid = (int)L; { const int q = nwg / NXCD, r = nwg % NXCD, xcd = wgid % NXCD, off = wgid / NXCD; wgid = (xcd < r ? xcd * (q + 1) : r * (q + 1) + (xcd - r) * q) + off; }
        const int nig = WGM * nN, gid = wgid / nig, fm = gid * WGM, gsz = (nM - fm) < WGM ? (nM - fm) : WGM;
        u.pm = fm + ((wgid % nig) % gsz); u.pn = (wgid % nig) / gsz; return true;
    }
    __device__ __forceinline__ void a_ready(const Unit&) const {}
    __device__ __forceinline__ void done(const Unit&) const {}
};

__device__ __forceinline__ unsigned cvt_pk_bf16(float lo, float hi) { unsigned r; asm volatile("v_cvt_pk_bf16_f32 %0, %1, %2" : "=v"(r) : "v"(lo), "v"(hi)); return r; }
typedef float f32x2 __attribute__((ext_vector_type(2)));
struct EpiBf16 {
    static constexpr bool PERM = true, AFTER_DRAIN = false;
    bf16_t* O; int ldc;
    __device__ __forceinline__ void operator()(const f32x4 (&acc)[2][2][4][2], const Unit& u, int wr, int wc, int fr, int fq) const {
        const int row0 = u.pm * BM + wr * 64 + fr; const int col0 = u.pn * BM + wc * 32 + 8 * fq;
#pragma unroll
        for (int ai = 0; ai < 2; ++ai)
#pragma unroll
            for (int m = 0; m < 4; ++m) { bf16_t* rowp = O + (size_t)(row0 + ai * HALF + m * 16) * ldc + col0;
#pragma unroll
                for (int bj = 0; bj < 2; ++bj) { const f32x4 v0 = acc[ai][bj][m][0], v1 = acc[ai][bj][m][1];
                    u32x4 w; w.x = cvt_pk_bf16(v0[0], v0[1]); w.y = cvt_pk_bf16(v0[2], v0[3]); w.z = cvt_pk_bf16(v1[0], v1[1]); w.w = cvt_pk_bf16(v1[2], v1[3]);
                    *(u32x4*)(rowp + bj * HALF) = w; } }
    }
};
struct EpiQKV {
    static constexpr bool PERM = true, AFTER_DRAIN = false;
    bf16_t* O; float* sk; float* sv; int extra;
    __device__ __forceinline__ void operator()(const f32x4 (&acc)[2][2][4][2], const Unit& u, int wr, int wc, int fr, int fq) const {
        const int row0 = u.pm * BM + wr * 64 + fr; const int col0 = u.pn * BM + wc * 32 + 8 * fq;
        float* sb = nullptr; int scol = 0;
        if (u.pm < 32 && u.pn >= 8) { if (u.pn < 10) { sb = sk; scol = col0 - 2048; } else { sb = sv; scol = col0 - 2560; } }
#pragma unroll
        for (int ai = 0; ai < 2; ++ai)
#pragma unroll
            for (int m = 0; m < 4; ++m) { const int row = row0 + ai * HALF + m * 16; bf16_t* rowp = O + (size_t)row * 3072 + col0;
#pragma unroll
                for (int bj = 0; bj < 2; ++bj) { const f32x4 v0 = acc[ai][bj][m][0], v1 = acc[ai][bj][m][1];
                    u32x4 w; w.x = cvt_pk_bf16(v0[0], v0[1]); w.y = cvt_pk_bf16(v0[2], v0[3]); w.z = cvt_pk_bf16(v1[0], v1[1]); w.w = cvt_pk_bf16(v1[2], v1[3]);
                    *(u32x4*)(rowp + bj * HALF) = w;
                    if (sb) { float* sp = sb + (size_t)(row + (row >> 8) * extra) * 512 + scol + bj * HALF; *(f32x4*)sp = v0; *(f32x4*)(sp + 4) = v1; } } }
    }
};
struct EpiResid {
    static constexpr bool PERM = false, AFTER_DRAIN = false;
    const float* xc; const float* xl; float* out; const float* gate;
    __device__ __forceinline__ void operator()(const f32x4 (&acc)[2][2][4][2], const Unit& u, int wr, int wc, int fr, int fq) const {
        const int row0 = u.pm * BM + wr * 64 + fr; const int col0 = u.pn * BM + wc * 32 + 4 * fq;
        const int cv = u.pm < 32 ? 0 : 1 + ((u.pm - 32) >> 3);
        const float* gp = gate + (size_t)cv * (6 * 2048) + col0;
        const float* xin = u.pm < 32 ? xc + (size_t)row0 * 2048 + col0 : xl + (size_t)(row0 - 8192) * 2048 + col0;
        float* op = out + (size_t)row0 * 2048 + col0;
        f32x4 gv[2][2];
#pragma unroll
        for (int bj = 0; bj < 2; ++bj)
#pragma unroll
            for (int n = 0; n < 2; ++n) gv[bj][n] = *(const f32x4*)(gp + bj * HALF + n * 16);
#pragma unroll
        for (int ai = 0; ai < 2; ++ai)
#pragma unroll
            for (int m = 0; m < 4; ++m) { const size_t ro = (size_t)(ai * HALF + m * 16) * 2048;
#pragma unroll
                for (int bj = 0; bj < 2; ++bj)
#pragma unroll
                    for (int n = 0; n < 2; ++n) { const f32x4 x = *(const f32x4*)(xin + ro + bj * HALF + n * 16);
                        *(f32x4*)(op + ro + bj * HALF + n * 16) = x + gv[bj][n] * acc[ai][bj][m][n]; }
                if (m & 1) asm volatile("" ::: "memory"); }
    }
};
struct EpiSwiglu {
    static constexpr bool PERM = true, AFTER_DRAIN = false;
    bf16_t* O;
    __device__ __forceinline__ float sw(float g, float uu) const { return g * __builtin_amdgcn_rcpf(1.0f + __builtin_amdgcn_exp2f(-1.4426950408889634f * g)) * uu; }
    __device__ __forceinline__ void operator()(const f32x4 (&acc)[2][2][4][2], const Unit& u, int wr, int wc, int fr, int fq) const {
        const int row0 = u.pm * BM + wr * 64 + fr; const int col0 = u.pn * HALF + wc * 32 + 8 * fq;
#pragma unroll
        for (int ai = 0; ai < 2; ++ai)
#pragma unroll
            for (int m = 0; m < 4; ++m) { bf16_t* rowp = O + (size_t)(row0 + ai * HALF + m * 16) * 5632 + col0;
                const f32x4 g0 = acc[ai][0][m][0], g1 = acc[ai][0][m][1], u0 = acc[ai][1][m][0], u1 = acc[ai][1][m][1];
                u32x4 w; w.x = cvt_pk_bf16(sw(g0[0], u0[0]), sw(g0[1], u0[1])); w.y = cvt_pk_bf16(sw(g0[2], u0[2]), sw(g0[3], u0[3]));
                w.z = cvt_pk_bf16(sw(g1[0], u1[0]), sw(g1[1], u1[1])); w.w = cvt_pk_bf16(sw(g1[2], u1[2]), sw(g1[3], u1[3]));
                *(u32x4*)rowp = w; }
    }
};

template <class Epi, class Sched, bool ALIGN_EPI = false, bool SP2 = false>
__device__ __forceinline__ void gemm_phase(PG8_LAS unsigned char* lds, const Gemm g, const Sched& S, const Epi& E) {
    int tid_ = threadIdx.x; asm volatile("" : "+v"(tid_));
    const int tid = tid_, wid = __builtin_amdgcn_readfirstlane(tid >> 6), lane = tid & 63, wr = wid >> 2, wc = wid & 3, fr = lane & 15, fq = lane >> 4;
    const int K = g.K, nt = K / BK;
    unsigned voffA[2], voffB[2];
#pragma unroll
    for (int i = 0; i < 2; ++i) { int R, C; stage_rc(tid * 16 + i * 8192, R, C); const int Rb = Epi::PERM ? ((R & ~31) + perm32(R & 31)) : R;
        voffA[i] = (unsigned)(R * K + C) * 2u; voffB[i] = (unsigned)(Rb * K + C) * 2u; }
    const size_t kstep = (size_t)(BK * 2);
    const size_t hstep = (size_t)HALF * K * 2;
    const size_t tstep = 2 * hstep;
    const unsigned ldsw = (unsigned)wid * 1024u;
    const int aoff = lds_byte(wr * 64 + fr, fq * 8), boff = lds_byte(wc * 32 + fr, fq * 8);
#define PG8_SA(b, h) (((b) * 2 + (h)) * HTB)
#define PG8_SB(b, h) ((4 + (b) * 2 + (h)) * HTB)
#define PG8_STAGE(bufoff, gbase, voff) do { _Pragma("unroll") for (int _i = 0; _i < 2; ++_i) \
        __builtin_amdgcn_global_load_lds((const unsigned*)((const char*)(gbase) + (voff)[_i]), (PG8_LAS unsigned*)(lds + (bufoff) + ldsw + _i * 8192), 16, 0, 0); } while (0)
#define PG8_LDA(dst, b, h) do { _Pragma("unroll") for (int m = 0; m < 4; ++m) _Pragma("unroll") for (int k = 0; k < 2; ++k) dst[m][k] = *(const PG8_LAS bf16x8*)(lds + PG8_SA(b, h) + aoff + m * 2048 + k * 1024); } while (0)
#define PG8_LDB(dst, b, h) do { _Pragma("unroll") for (int n = 0; n < 2; ++n) _Pragma("unroll") for (int k = 0; k < 2; ++k) dst[n][k] = *(const PG8_LAS bf16x8*)(lds + PG8_SB(b, h) + boff + n * 2048 + k * 1024); } while (0)
#define PG8_MMA(ai, bj, At, Bt) do { __builtin_amdgcn_s_setprio(1); _Pragma("unroll") for (int m = 0; m < 4; ++m) _Pragma("unroll") for (int n = 0; n < 2; ++n) _Pragma("unroll") for (int k = 0; k < 2; ++k) \
        acc[ai][bj][m][n] = __builtin_amdgcn_mfma_f32_16x16x32_bf16(Bt[n][k], At[m][k], acc[ai][bj][m][n], 0, 0, 0); __builtin_amdgcn_s_setprio(0); } while (0)
#define PG8_WAIT_V(n) asm volatile("s_waitcnt vmcnt(" #n ")" ::: "memory")
#define PG8_WAIT_L(n) asm volatile("s_waitcnt lgkmcnt(" #n ")" ::: "memory")
#define PG8_BAR __builtin_amdgcn_s_barrier()
#define PG8_SCHED __builtin_amdgcn_sched_barrier(0)
    Unit cur, nxt; int ui = 0;
    if (!S.next(0, cur)) return;
    f32x4 acc[2][2][4][2];
#pragma unroll
    for (int a = 0; a < 2; ++a)
#pragma unroll
        for (int b = 0; b < 2; ++b)
#pragma unroll
            for (int m = 0; m < 4; ++m)
#pragma unroll
                for (int n = 0; n < 2; ++n) acc[a][b][m][n] = (f32x4){0.f, 0.f, 0.f, 0.f};
    bf16x8 At[4][2], B0[2][2], B1[2][2];
    const char* cA = (const char*)g.A + (size_t)cur.pm * tstep; const char* cB = (const char*)g.Bt + (size_t)cur.pn * tstep;
    S.a_ready(cur);
    if constexpr (SP2) {
        PG8_STAGE(PG8_SB(0, 0), cB, voffB); PG8_STAGE(PG8_SB(0, 1), cB + hstep, voffB); PG8_STAGE(PG8_SA(0, 0), cA, voffA); PG8_STAGE(PG8_SA(0, 1), cA + hstep, voffA);
        if (wr == 1) PG8_BAR;
        PG8_WAIT_V(2); PG8_BAR;
        PG8_STAGE(PG8_SB(1, 0), cB + kstep, voffB); PG8_STAGE(PG8_SA(1, 0), cA + kstep, voffA); PG8_STAGE(PG8_SB(1, 1), cB + hstep + kstep, voffB);
        PG8_WAIT_V(6); PG8_BAR;
    } else {
        PG8_STAGE(PG8_SB(0, 0), cB, voffB); PG8_STAGE(PG8_SA(0, 0), cA, voffA); PG8_STAGE(PG8_SB(0, 1), cB + hstep, voffB); PG8_STAGE(PG8_SA(0, 1), cA + hstep, voffA);
        if (wr == 1) PG8_BAR;
        PG8_WAIT_V(4); PG8_BAR;
        PG8_STAGE(PG8_SB(1, 0), cB + kstep, voffB); PG8_STAGE(PG8_SA(1, 0), cA + kstep, voffA); PG8_STAGE(PG8_SB(1, 1), cB + hstep + kstep, voffB);
        PG8_WAIT_V(6); PG8_BAR;
    }
    for (;;) {
        const bool has_next = S.next(ui + 1, nxt);
        const char* nA = has_next ? (const char*)g.A + (size_t)nxt.pm * tstep : cA; const char* nB = has_next ? (const char*)g.Bt + (size_t)nxt.pn * tstep : cB;
        for (int t = 0; t < nt; t += 2) {
            const bool last = (t == nt - 2);
            const char* a1 = cA + (size_t)(t + 1) * kstep;
            const char* a2 = last ? nA : cA + (size_t)(t + 2) * kstep; const char* b2 = last ? nB : cB + (size_t)(t + 2) * kstep;
            const char* a3 = a2 + kstep; const char* b3 = b2 + kstep;
            if (last && has_next) S.a_ready(nxt);
            if constexpr (SP2) {
            PG8_LDB(B0, 0, 0); PG8_LDB(B1, 0, 1); PG8_SCHED; PG8_LDA(At, 0, 0); PG8_STAGE(PG8_SA(1, 1), a1 + hstep, voffA);
            PG8_WAIT_V(8); PG8_WAIT_L(0); PG8_BAR; PG8_MMA(0, 0, At, B0); PG8_MMA(0, 1, At, B1); PG8_BAR; PG8_SCHED;
            PG8_LDA(At, 0, 1); PG8_STAGE(PG8_SB(0, 0), b2, voffB); PG8_STAGE(PG8_SB(0, 1), b2 + hstep, voffB); PG8_STAGE(PG8_SA(0, 0), a2, voffA);
            PG8_WAIT_V(8); PG8_WAIT_L(0); PG8_BAR; PG8_MMA(1, 0, At, B0); PG8_MMA(1, 1, At, B1); PG8_BAR; PG8_SCHED;
            PG8_LDB(B0, 1, 0); PG8_LDB(B1, 1, 1); PG8_SCHED; PG8_LDA(At, 1, 0); PG8_STAGE(PG8_SA(0, 1), a2 + hstep, voffA);
            PG8_WAIT_V(8); PG8_WAIT_L(0); PG8_BAR; PG8_MMA(0, 0, At, B0); PG8_MMA(0, 1, At, B1); PG8_BAR; PG8_SCHED;
            PG8_LDA(At, 1, 1); PG8_STAGE(PG8_SB(1, 0), b3, voffB); PG8_STAGE(PG8_SB(1, 1), b3 + hstep, voffB); PG8_STAGE(PG8_SA(1, 0), a3, voffA);
            PG8_WAIT_V(8); PG8_WAIT_L(0); PG8_BAR; PG8_MMA(1, 0, At, B0); PG8_MMA(1, 1, At, B1); PG8_BAR; PG8_SCHED;
            } else {
            PG8_LDB(B0, 0, 0); PG8_SCHED; PG8_LDA(At, 0, 0); PG8_STAGE(PG8_SA(1, 1), a1 + hstep, voffA);
            PG8_WAIT_L(8); PG8_BAR; PG8_WAIT_L(0); PG8_MMA(0, 0, At, B0); PG8_BAR; PG8_SCHED;
            PG8_LDB(B1, 0, 1); PG8_STAGE(PG8_SB(0, 0), b2, voffB);
            PG8_BAR; PG8_WAIT_L(0); PG8_MMA(0, 1, At, B1); PG8_BAR;
            PG8_LDA(At, 0, 1); PG8_STAGE(PG8_SA(0, 0), a2, voffA);
            PG8_BAR; PG8_WAIT_L(0); PG8_MMA(1, 0, At, B0); PG8_BAR; PG8_SCHED;
            PG8_STAGE(PG8_SB(0, 1), b2 + hstep, voffB);
            PG8_WAIT_V(6); PG8_BAR; PG8_MMA(1, 1, At, B1); PG8_BAR;
            PG8_LDB(B0, 1, 0); PG8_SCHED; PG8_LDA(At, 1, 0); PG8_STAGE(PG8_SA(0, 1), a2 + hstep, voffA);
            PG8_WAIT_L(8); PG8_BAR; PG8_WAIT_L(0); PG8_MMA(0, 0, At, B0); PG8_BAR; PG8_SCHED;
            PG8_LDB(B1, 1, 1); PG8_STAGE(PG8_SB(1, 0), b3, voffB);
            PG8_BAR; PG8_WAIT_L(0); PG8_MMA(0, 1, At, B1); PG8_BAR;
            PG8_LDA(At, 1, 1); PG8_STAGE(PG8_SA(1, 0), a3, voffA);
            PG8_BAR; PG8_WAIT_L(0); PG8_MMA(1, 0, At, B0); PG8_BAR; PG8_SCHED;
            PG8_STAGE(PG8_SB(1, 1), b3 + hstep, voffB);
            PG8_WAIT_V(6); PG8_BAR; PG8_MMA(1, 1, At, B1); PG8_BAR;
            }
        }
        if constexpr (ALIGN_EPI) { if (wr == 0) PG8_BAR; }
        if constexpr (!Epi::AFTER_DRAIN) { E(acc, cur, wr, wc, fr, fq); S.done(cur); }
        if (!has_next) break;
#pragma unroll
        for (int a = 0; a < 2; ++a)
#pragma unroll
            for (int b = 0; b < 2; ++b)
#pragma unroll
                for (int m = 0; m < 4; ++m)
#pragma unroll
                    for (int n = 0; n < 2; ++n) acc[a][b][m][n] = (f32x4){0.f, 0.f, 0.f, 0.f};
        cur = nxt; cA = nA; cB = nB; ++ui;
        if constexpr (ALIGN_EPI) { if (wr == 1) PG8_BAR; }
    }
    PG8_WAIT_V(0);
    if constexpr (!ALIGN_EPI) { if (wr == 0) PG8_BAR; }
    PG8_BAR;
    if constexpr (Epi::AFTER_DRAIN) { E.fused(acc, cur, wr, wc, fr, fq, lds, wid, lane); S.done(cur); }
#undef PG8_SA
#undef PG8_SB
#undef PG8_STAGE
#undef PG8_LDA
#undef PG8_LDB
#undef PG8_MMA
#undef PG8_WAIT_V
#undef PG8_WAIT_L
#undef PG8_BAR
#undef PG8_SCHED
}
}

namespace att {
using bf16 = __hip_bfloat16;
constexpr int D = 128, NW = 8, QBLK = 32, KVBLK = 64;
constexpr float SCALE = 0.088388347648318440f;
constexpr float THR = 8.f;
using bf16x8 = __attribute__((ext_vector_type(8))) short;
using s16x4  = __attribute__((ext_vector_type(4))) short;
using f32x16 = __attribute__((ext_vector_type(16))) float;
using u32x4  = __attribute__((ext_vector_type(4))) unsigned;
constexpr size_t SHM_V = KVBLK * D * 2, SHM_K = KVBLK * D * 2, SHM_ATTN = 2 * SHM_V + 2 * SHM_K + NW * 64 * 4;
#define KSWZ(row, colB) ((row) * 256 + ((colB) ^ (((row) & 7) << 4)))
#define SBAR() __builtin_amdgcn_sched_barrier(0)
__device__ __forceinline__ int crow(int r, int hi) { return (r & 3) + 8 * (r >> 2) + 4 * hi; }
__device__ __forceinline__ unsigned cvtpk(float lo, float hi) { unsigned r; asm volatile("v_cvt_pk_bf16_f32 %0, %1, %2" : "=v"(r) : "v"(lo), "v"(hi)); return r; }
__device__ __forceinline__ bf16x8 ld8(const bf16* p) { return *reinterpret_cast<const bf16x8*>(p); }

__device__ __forceinline__ void partialSM(f32x16& p0, f32x16& p1, float& m_reg, float& mn, float& alpha) {
  constexpr float C = SCALE * 1.4426950408889634f;
  float pmax = p0[0]; for (int r = 1; r < 16; ++r) pmax = fmaxf(pmax, p0[r]); for (int r = 0; r < 16; ++r) pmax = fmaxf(pmax, p1[r]);
  { auto rr = __builtin_amdgcn_permlane32_swap(__float_as_uint(pmax), __float_as_uint(pmax), false, false);
    pmax = fmaxf(__uint_as_float(rr[0]), __uint_as_float(rr[1])); }
  if (__builtin_expect(__all(pmax - m_reg <= THR / SCALE), 1)) { mn = m_reg; alpha = 1.f; }
  else { mn = fmaxf(m_reg, pmax); alpha = __builtin_amdgcn_exp2f((m_reg - mn) * C); m_reg = mn; }
  float mnC = -mn * C;
  for (int r = 0; r < 16; ++r) p0[r] = fmaf(p0[r], C, mnC); for (int r = 0; r < 16; ++r) p1[r] = fmaf(p1[r], C, mnC);
  for (int r = 0; r < 16; ++r) p0[r] = __builtin_amdgcn_exp2f(p0[r]);
}
__device__ __forceinline__ void finishSM(f32x16& p0, f32x16& p1, float alpha, float& l_reg, bf16x8& pa0, bf16x8& pa1, bf16x8& pa2, bf16x8& pa3) {
  for (int r = 0; r < 16; ++r) p1[r] = __builtin_amdgcn_exp2f(p1[r]);
  float ps = 0; for (int r = 0; r < 16; ++r) ps += p0[r]; for (int r = 0; r < 16; ++r) ps += p1[r];
  { auto rr = __builtin_amdgcn_permlane32_swap(__float_as_uint(ps), __float_as_uint(ps), false, false);
    ps = __uint_as_float(rr[0]) + __uint_as_float(rr[1]); }
  l_reg = l_reg * alpha + ps;
#define PK4(P, BASE, OUT) do { unsigned a0 = cvtpk(P[BASE + 0], P[BASE + 1]), a1 = cvtpk(P[BASE + 2], P[BASE + 3]);   \
    unsigned b0 = cvtpk(P[BASE + 4], P[BASE + 5]), b1 = cvtpk(P[BASE + 6], P[BASE + 7]);                              \
    auto r0 = __builtin_amdgcn_permlane32_swap(a0, b0, false, false); auto r1 = __builtin_amdgcn_permlane32_swap(a1, b1, false, false); \
    u32x4 w = {r0[0], r1[0], r0[1], r1[1]}; OUT = *reinterpret_cast<bf16x8*>(&w); } while (0)
  PK4(p0, 0, pa0); PK4(p0, 8, pa1); PK4(p1, 0, pa2); PK4(p1, 8, pa3);
#undef PK4
}
__device__ __forceinline__ void qkt(f32x16& p0, f32x16& p1, const bf16* Ks, const bf16x8* qr, int r32, int hi) {
  p0 = f32x16{}; p1 = f32x16{};
  for (int d0 = 0; d0 < 8; ++d0) { int cb = (d0 * 16 + hi * 8) * 2;
    bf16x8 b0 = *reinterpret_cast<const bf16x8*>((const char*)Ks + KSWZ(r32, cb));
    bf16x8 b1 = *reinterpret_cast<const bf16x8*>((const char*)Ks + KSWZ(32 + r32, cb));
    p0 = __builtin_amdgcn_mfma_f32_32x32x16_bf16(b0, qr[d0], p0, 0, 0, 0);
    p1 = __builtin_amdgcn_mfma_f32_32x32x16_bf16(b1, qr[d0], p1, 0, 0, 0); }
}
__device__ __forceinline__ void wmask(f32x16& p0, f32x16& p1, int dq, int hi) {
#pragma unroll
  for (int r = 0; r < 16; ++r) { const int df = dq - crow(r, hi);
    if (df > 128 || df < -128) p0[r] = -1e30f;
    if (df - 32 > 128 || df - 32 < -128) p1[r] = -1e30f; }
}
__device__ __forceinline__ int v_st(int k, int c) { const int kk = (k & ~0xC) | ((k & 4) << 1) | ((k & 8) >> 1); return ((kk >> 3) * 4 + (c >> 5)) * 512 + ((kk & 7) * 32 + (c & 31)) * 2; }
__device__ __forceinline__ int v_rd_base(int lane) { return ((lane & 3) << 3) | (((lane >> 2) & 3) << 6) | (((lane >> 4) & 1) << 5) | (((lane >> 5) & 1) << 8); }
constexpr int v_rd_off(int d0, int ks, int half) { return d0 * 512 + ks * 4096 + half * 2048; }
template <int OFF> __device__ __forceinline__ s16x4 tr_read(int vb) {
  s16x4 r; asm volatile("ds_read_b64_tr_b16 %0, %1 offset:%2" : "=&v"(r) : "v"(vb), "i"(OFF) : "memory"); return r;
}
template <int D0> __device__ __forceinline__ void pv_one(f32x16& od, int vb, bf16x8 pa0, bf16x8 pa1, bf16x8 pa2, bf16x8 pa3) {
  const s16x4 l0 = tr_read<v_rd_off(D0, 0, 0)>(vb), h0 = tr_read<v_rd_off(D0, 0, 1)>(vb), l1 = tr_read<v_rd_off(D0, 1, 0)>(vb), h1 = tr_read<v_rd_off(D0, 1, 1)>(vb);
  const s16x4 l2 = tr_read<v_rd_off(D0, 2, 0)>(vb), h2 = tr_read<v_rd_off(D0, 2, 1)>(vb), l3 = tr_read<v_rd_off(D0, 3, 0)>(vb), h3 = tr_read<v_rd_off(D0, 3, 1)>(vb);
  asm volatile("s_waitcnt lgkmcnt(0)" ::: "memory"); SBAR();
#define PK(L, H) (bf16x8){L[0], L[1], L[2], L[3], H[0], H[1], H[2], H[3]}
  od = __builtin_amdgcn_mfma_f32_32x32x16_bf16(pa0, PK(l0, h0), od, 0, 0, 0);
  od = __builtin_amdgcn_mfma_f32_32x32x16_bf16(pa1, PK(l1, h1), od, 0, 0, 0);
  od = __builtin_amdgcn_mfma_f32_32x32x16_bf16(pa2, PK(l2, h2), od, 0, 0, 0);
  od = __builtin_amdgcn_mfma_f32_32x32x16_bf16(pa3, PK(l3, h3), od, 0, 0, 0);
#undef PK
}
__device__ __forceinline__ void pv_d0(f32x16* o, int vb, bf16x8 pa0, bf16x8 pa1, bf16x8 pa2, bf16x8 pa3) {
  pv_one<0>(o[0], vb, pa0, pa1, pa2, pa3); pv_one<1>(o[1], vb, pa0, pa1, pa2, pa3); pv_one<2>(o[2], vb, pa0, pa1, pa2, pa3); pv_one<3>(o[3], vb, pa0, pa1, pa2, pa3);
}

struct Unit {
  const bf16* Q; int ldq;
  const bf16* KA; const bf16* VA; int ldA; int nA;
  const bf16* KB; const bf16* VB; int ldB;
  int NT;
  int win;
  int dq0;
  int has_sink; float sink;
  bf16* O; int ldo;
};

__device__ __forceinline__ void attn_unit(const Unit& U, char* lds) {
  int tid_ = threadIdx.x; asm volatile("" : "+v"(tid_));
  const int tid = tid_, wid = tid >> 6, lane = tid & 63, r32 = lane & 31, hi = lane >> 5;
  bf16* V_lds = (bf16*)lds; bf16* K_lds = (bf16*)(lds + 2 * SHM_V);
  float* ws = (float*)(lds + 2 * SHM_V + 2 * SHM_K) + wid * 64; float* li_l = ws; float* al_l = ws + 32;
  float m_reg = -1e30f, l_reg = 0; f32x16 o[4] = {}; bf16x8 qr[8];
  const bf16* Qw = U.Q + (long)(wid * QBLK + r32) * U.ldq + hi * 8;
#pragma unroll
  for (int d0 = 0; d0 < 8; ++d0) qr[d0] = ld8(Qw + d0 * 16);
  const int sr = tid >> 4, sc = (tid & 15) * 8, vst0 = v_st(sr, sc), vst1 = v_st(32 + sr, sc);
  const int vb0 = (int)(uintptr_t)V_lds + v_rd_base(lane);
  const int nA = U.nA, NT = U.NT;
  const int dqw = U.dq0 + wid * QBLK + r32;
  struct { bf16x8 vs0, vs1, ks0, ks1; } sr_[1];
#define SLOAD(i, jt) do { const int jj_ = (jt); const bf16 *kp_, *vp_; long ld_; \
    if (jj_ < nA) { ld_ = U.ldA; kp_ = U.KA + (long)jj_ * 64 * ld_; vp_ = U.VA + (long)jj_ * 64 * ld_; } \
    else { ld_ = U.ldB; kp_ = U.KB + (long)(jj_ - nA) * 64 * ld_; vp_ = U.VB + (long)(jj_ - nA) * 64 * ld_; } \
    sr_[i].vs0 = ld8(vp_ + (long)sr * ld_ + sc); sr_[i].vs1 = ld8(vp_ + (long)(32 + sr) * ld_ + sc); \
    sr_[i].ks0 = ld8(kp_ + (long)sr * ld_ + sc); sr_[i].ks1 = ld8(kp_ + (long)(32 + sr) * ld_ + sc); } while (0)
#define SWRITE(b, i) do { *(bf16x8*)((char*)V_lds + (b) * SHM_V + vst0) = sr_[i].vs0;          \
    *(bf16x8*)((char*)V_lds + (b) * SHM_V + vst1) = sr_[i].vs1; int kc = sc * 2;               \
    *(bf16x8*)((char*)K_lds + (b) * SHM_K + KSWZ(sr, kc)) = sr_[i].ks0;                       \
    *(bf16x8*)((char*)K_lds + (b) * SHM_K + KSWZ(32 + sr, kc)) = sr_[i].ks1; } while (0)
#define RESC(a) do { if (__any((a) < 1.f)) { if (hi == 0) al_l[r32] = (a); asm volatile("s_waitcnt lgkmcnt(0)" ::: "memory"); \
    for (int d = 0; d < 4; ++d) for (int r = 0; r < 16; ++r) o[d][r] *= al_l[crow(r, hi)]; } } while (0)
#define MASK(P0, P1, jt) do { if (U.win && (jt) >= nA) { const int dq_ = dqw - ((jt) - nA) * 64; \
    if (__any(dq_ > 128 || dq_ - 63 < -128)) wmask(P0, P1, dq_, hi); } } while (0)
  f32x16 p0, p1; float mn, al; bf16x8 pa0, pa1, pa2, pa3;
  SLOAD(0, 0); asm volatile("s_waitcnt vmcnt(0)" ::: "memory"); SWRITE(0, 0); SLOAD(0, 1); __syncthreads();
#pragma unroll 1
  for (int j = 0; j < NT; ++j) {
    const int b = j & 1;
    qkt(p0, p1, (const bf16*)((const char*)K_lds + b * SHM_K), qr, r32, hi); MASK(p0, p1, j);
    partialSM(p0, p1, m_reg, mn, al);
    RESC(al);
    finishSM(p0, p1, al, l_reg, pa0, pa1, pa2, pa3); SBAR();
    pv_d0(o, vb0 + b * (int)SHM_V, pa0, pa1, pa2, pa3);
    if (j + 1 < NT) { asm volatile("s_waitcnt vmcnt(0)" ::: "memory"); SWRITE(b ^ 1, 0); if (j + 2 < NT) SLOAD(0, j + 2); }
    __syncthreads();
  }
  if (U.has_sink) { constexpr float C = SCALE * 1.4426950408889634f; l_reg += __builtin_amdgcn_exp2f(fminf(U.sink * 1.4426950408889634f - m_reg * C, 120.f)); }
  if (hi == 0) li_l[r32] = l_reg; asm volatile("s_waitcnt lgkmcnt(0)" ::: "memory");
  float rli[16];
#pragma unroll
  for (int r = 0; r < 16; ++r) rli[r] = __builtin_amdgcn_rcpf(li_l[crow(r, hi)]);
  bf16* Ow = U.O + (long)(wid * QBLK) * U.ldo;
#pragma unroll
  for (int r = 0; r < 16; ++r) { int orow = crow(r, hi);
    for (int d0 = 0; d0 < 4; ++d0) { const float v = o[d0][r] * rli[r]; const unsigned pk = cvtpk(v, v);
      *(unsigned short*)(Ow + (long)orow * U.ldo + d0 * 32 + r32) = (unsigned short)(pk & 0xffffu); } }
#undef SLOAD
#undef SWRITE
#undef RESC
#undef MASK
}
}

constexpr int DM = 2048, NCTX = 8192, NLAT = 16384, NTOK = 24576, QKVD = 3072, DFF = 5632, NGU = 11264, DEPTH = 4;
constexpr int NWAVES = 8;
constexpr size_t MiB = 1u << 20;
constexpr size_t OUT_YP = 0, OUT_YS = (size_t)NCTX * DM, OUT_WK = (size_t)NTOK * DM, OUT_WV = OUT_WK + (size_t)32 * 2 * 256 * 512,
                 OUT_AK = OUT_WV + (size_t)32 * 2 * 256 * 512, OUT_AV = OUT_AK + (size_t)32 * 256 * 512, OUT_END = OUT_AV + (size_t)32 * 256 * 512;
constexpr size_t WS_CTL = 0, CTL_ZERO_BYTES = 1 * MiB;
constexpr size_t WS_MODP = 1 * MiB;
constexpr size_t WS_MODF = 16 * MiB;
constexpr size_t WS_A2 = 18 * MiB;
constexpr size_t WS_NP = 19 * MiB;
constexpr size_t WS_CKV = 20 * MiB;
constexpr size_t WS_CWK = WS_CKV, WS_CWV = WS_CKV + 8 * MiB, WS_CAK = WS_CKV + 16 * MiB, WS_CAV = WS_CKV + 20 * MiB;
constexpr size_t WS_FT = 44 * MiB;
constexpr size_t WS_FT_CTX = WS_FT + 32 * MiB;
constexpr size_t WS_W = 80 * MiB;
constexpr size_t W_QKV = (size_t)QKVD * DM * 2, W_SQ = (size_t)DM * DM * 2, W_IN = (size_t)6144 * DM * 2, W_GU = (size_t)NGU * DM * 2, W_DN = (size_t)DM * DFF * 2;
constexpr size_t WS_WQKV0 = WS_W, WS_WQKV1 = WS_WQKV0 + W_QKV, WS_WQKVA = WS_WQKV1 + W_QKV, WS_WO0 = WS_WQKVA + W_QKV, WS_WO1 = WS_WO0 + W_SQ, WS_WOA = WS_WO1 + W_SQ,
                 WS_WHO = WS_WOA + W_SQ, WS_WHI = WS_WHO + W_SQ, WS_WGU = WS_WHI + W_IN, WS_WDN = WS_WGU + 4 * W_GU, WS_WEND = WS_WDN + 4 * W_DN;
constexpr size_t WS_H = 448 * MiB;
constexpr size_t WS_BIG = 544 * MiB;
constexpr size_t WS_ZT = WS_BIG + 288 * MiB;
constexpr size_t WS_END = WS_BIG + 384 * MiB;
static_assert(WS_WEND <= WS_H && WS_FT_CTX + 4 * MiB <= WS_W && WS_CAV + 4 * MiB <= WS_FT, "ws map");
static_assert(WS_MODP + (size_t)4 * 8 * 9 * 12288 * 4 <= WS_MODF && WS_MODF + (size_t)4 * 9 * 6 * 2048 * 4 <= WS_A2 && WS_A2 + (size_t)2304 * 64 * 4 <= WS_NP && WS_NP + (size_t)18 * 8192 * 4 <= WS_CKV, "small buffers");
constexpr int CW_TMO = 0;
constexpr int CW_BAR = 4096;
constexpr int RING_BYTES = 131072;
constexpr int LDSCTL_OFF = RING_BYTES, MISC_OFF = LDSCTL_OFF + 320;
constexpr int LDS_BYTES = 147456;

#define GAS __attribute__((address_space(1)))
#define LAS __attribute__((address_space(3)))
typedef unsigned short bf16;
typedef unsigned v4u __attribute__((ext_vector_type(4)));
typedef unsigned v2u __attribute__((ext_vector_type(2)));
typedef float f32x4 __attribute__((ext_vector_type(4)));
typedef short bf16x8 __attribute__((ext_vector_type(8)));
typedef short bf16x4 __attribute__((ext_vector_type(4)));
typedef GAS unsigned gu32;
#define RLX_AGENT __ATOMIC_RELAXED, __HIP_MEMORY_SCOPE_AGENT
#define LDS_WAIT() asm volatile("s_waitcnt lgkmcnt(0)" ::: "memory")
#define VM_WAIT() asm volatile("s_waitcnt vmcnt(0)" ::: "memory")
__device__ __forceinline__ unsigned f2bf(float f) { unsigned u = __builtin_bit_cast(unsigned, f); return (u + 0x7fffu + ((u >> 16) & 1u)) >> 16; }
__device__ __forceinline__ unsigned pk2(float lo, float hi) { return f2bf(lo) | (f2bf(hi) << 16); }
__device__ __forceinline__ float bf2f(unsigned short b) { return __builtin_bit_cast(float, (unsigned)b << 16); }
__device__ __forceinline__ float bflo(unsigned w) { return __builtin_bit_cast(float, w << 16); }
__device__ __forceinline__ float bfhi(unsigned w) { return __builtin_bit_cast(float, w & 0xffff0000u); }
__device__ __forceinline__ float wave_sum(float v) {
#pragma unroll
    for (int o = 1; o < 64; o <<= 1) v += __shfl_xor(v, o);
    return v;
}
#define XB_TMO      128
#define XB_XCNT(j)  (256  + 64 * (j))
#define XB_XSUB(j)  (1280 + 64 * (j))
#define XB_XGEN(j)  (2304 + 64 * (j))
#define XB_TOP      3328
#define XB_TOPGEN   3392
#define XCD_BAR_WORDS 3456
#define XB_SPIN_CAP (1u << 18)

__device__ __forceinline__ unsigned xb_ld(unsigned* p)              { return __hip_atomic_load(p, __ATOMIC_RELAXED, __HIP_MEMORY_SCOPE_AGENT); }
__device__ __forceinline__ unsigned xb_add(unsigned* p, unsigned v) { return __hip_atomic_fetch_add(p, v, __ATOMIC_RELAXED, __HIP_MEMORY_SCOPE_AGENT); }
__device__ __forceinline__ unsigned xb_xcc_id() { return (unsigned)__builtin_amdgcn_s_getreg((3 << 11) | 20) & 0xFu; }
#define XB_SPIN(cond, bar) do { unsigned _sp = 0; while (cond) { __builtin_amdgcn_s_sleep(1); \
    if ((++_sp & 255u) == 0u) { if (xb_ld(&(bar)[XB_TMO])) break; if (_sp > XB_SPIN_CAP) { atomicAdd(&(bar)[XB_TMO], 1u); break; } } } } while (0)

struct XcdBarrier {
    unsigned* bar; unsigned x;
    volatile LAS unsigned* st;
};

__device__ __forceinline__ XcdBarrier xcd_barrier_post(unsigned* bar, volatile LAS unsigned* st) {
    XcdBarrier b; b.bar = bar; b.x = xb_xcc_id(); b.st = st;
    if (threadIdx.x == 0) (void)xb_add(&bar[XB_XCNT(b.x)], 1u);
    return b;
}
__device__ __forceinline__ void xcd_barrier_complete(unsigned* bar, unsigned x, unsigned& nloc, unsigned& nx) {
    const unsigned G = gridDim.x * gridDim.y * gridDim.z;
    unsigned sum, cnt, mine, sp = 0u;
    for (;;) {
        sum = 0u; cnt = 0u; mine = 0u;
#pragma unroll
        for (unsigned j = 0; j < 16; ++j) { const unsigned c = xb_ld(&bar[XB_XCNT(j)]); sum += c; cnt += (c > 0u) ? 1u : 0u; mine = (j == x) ? c : mine; }
        if (sum == G) break;
        __builtin_amdgcn_s_sleep(1);
        if ((++sp & 255u) == 0u) { if (xb_ld(&bar[XB_TMO])) break; if (sp > XB_SPIN_CAP) { atomicAdd(&bar[XB_TMO], 1u); break; } }
    }
    nloc = mine > 0u ? mine : 1u; nx = cnt > 0u ? cnt : 1u;
}

__device__ __forceinline__ void xcd_barrier(const XcdBarrier& b) {
    asm volatile("s_waitcnt vmcnt(0)" ::: "memory");
    __syncthreads();
    if (threadIdx.x == 0) {
        unsigned* bar = b.bar;
        __builtin_amdgcn_s_waitcnt(0);
        unsigned nloc = b.st[0], nx = b.st[1];
        if (nloc == 0u) { xcd_barrier_complete(bar, b.x, nloc, nx); b.st[0] = nloc; b.st[1] = nx; }
        const unsigned old = xb_add(&bar[XB_XSUB(b.x)], 1u);
        const unsigned gen = old / nloc;
        if (old + 1u == (gen + 1u) * nloc) {
            __builtin_amdgcn_fence(__ATOMIC_RELEASE, "agent");
            asm volatile("s_waitcnt vmcnt(0)" ::: "memory");
            const unsigned og = xb_add(&bar[XB_TOP], 1u);
            const unsigned tg = og / nx;
            if (og + 1u == (tg + 1u) * nx) xb_add(&bar[XB_TOPGEN], 1u);
            else XB_SPIN(xb_ld(&bar[XB_TOPGEN]) == tg, bar);
            __builtin_amdgcn_fence(__ATOMIC_ACQUIRE, "agent");
            xb_add(&bar[XB_XGEN(b.x)], 1u);
            asm volatile("s_waitcnt vmcnt(0)" ::: "memory");
        } else {
            XB_SPIN(xb_ld(&bar[XB_XGEN(b.x)]) == gen, bar);
            __builtin_amdgcn_fence(__ATOMIC_ACQUIRE, "agent");
            asm volatile("s_waitcnt vmcnt(0)" ::: "memory");
        }
    }
    __syncthreads();
}

__device__ __forceinline__ void transpose_item(const float* W, int K, int N, bf16* WT, int k0, int n0, int drow0, LAS float* scr, int lane) {
#pragma unroll 8
    for (int i = 0; i < 32; ++i) { const int kk = 2 * i + (lane >> 5); scr[kk * 33 + (lane & 31)] = W[(size_t)(k0 + kk) * N + n0 + (lane & 31)]; }
    LDS_WAIT(); asm volatile("" ::: "memory");
    const int c = lane & 7;
#pragma unroll
    for (int j = 0; j < 4; ++j) { const int n = (lane >> 3) + 8 * j; const LAS float* s = scr + (8 * c) * 33 + n;
        v4u o; o.x = pk2(s[0 * 33], s[1 * 33]); o.y = pk2(s[2 * 33], s[3 * 33]); o.z = pk2(s[4 * 33], s[5 * 33]); o.w = pk2(s[6 * 33], s[7 * 33]);
        *(GAS v4u*)(WT + (size_t)(drow0 + n) * K + k0 + 8 * c) = o; }
    LDS_WAIT(); asm volatile("" ::: "memory");
}
constexpr int IT_QKV = (DM / 64) * (QKVD / 32), IT_SQ = (DM / 64) * (DM / 32), IT_IN = (DM / 64) * (6144 / 32), IT_GU = (DM / 64) * (NGU / 32), IT_DN = (DFF / 64) * (DM / 32);
constexpr int IT_TOTAL = 3 * IT_QKV + 4 * IT_SQ + IT_IN + 4 * IT_GU + 4 * IT_DN;

struct Args { const float* in[33]; float* out; unsigned char* ws; int ph_lo, ph_hi; };

__device__ __forceinline__ void weight_item(const Args& A, int it, LAS float* scr, int lane) {
    unsigned char* ws = A.ws;
    const float* src; bf16* dst; int K = DM, N; bool gu = false; int r = it;
    if (r < 3 * IT_QKV) { const int m = r / IT_QKV; r -= m * IT_QKV; N = QKVD;
        src = (m < 2) ? A.in[12] + (size_t)m * DM * QKVD : A.in[26]; dst = (bf16*)(ws + WS_WQKV0 + (size_t)m * W_QKV); }
    else if ((r -= 3 * IT_QKV) < 4 * IT_SQ) { const int m = r / IT_SQ; r -= m * IT_SQ; N = DM;
        src = (m < 2) ? A.in[13] + (size_t)m * DM * DM : (m == 2 ? A.in[29] : A.in[25]); dst = (bf16*)(ws + WS_WO0 + (size_t)m * W_SQ); }
    else if ((r -= 4 * IT_SQ) < IT_IN) { N = 6144; src = A.in[15]; dst = (bf16*)(ws + WS_WHI); }
    else if ((r -= IT_IN) < 4 * IT_GU) { const int m = r / IT_GU; r -= m * IT_GU; N = NGU; gu = true;
        src = A.in[30] + (size_t)m * DM * NGU; dst = (bf16*)(ws + WS_WGU + (size_t)m * W_GU); }
    else { r -= 4 * IT_GU; const int m = r / IT_DN; r -= m * IT_DN; N = DM; K = DFF;
        src = A.in[31] + (size_t)m * DFF * DM; dst = (bf16*)(ws + WS_WDN + (size_t)m * W_DN); }
    const int nblk = N / 32, kb = r / nblk, nb = r % nblk, k0 = 64 * kb, n0 = 32 * nb;
    int drow0 = n0;
    if (gu) { const int isu = n0 >= DFF ? 1 : 0; const int j = n0 - isu * DFF; drow0 = (j >> 7) * 256 + isu * 128 + (j & 127); }
    transpose_item(src, K, N, dst, k0, n0, drow0, scr, lane);
}

__device__ __forceinline__ void adaln_partial_unit(const Args& A, int u, LAS float* scr, int lane) {
    const int layer = u / 384, kc = (u / 48) % 8, cg = u % 48;
    const float* cctx = A.in[7]; const float* cin = A.in[6];
    for (int idx = lane; idx < 9 * 256; idx += 64) { const int c = idx >> 8, kk = idx & 255, k = kc * 256 + kk;
        const float v = (c == 0) ? cctx[k] : cin[(size_t)(c - 1) * DM + k]; scr[idx] = v / (1.0f + expf(-v)); }
    LDS_WAIT(); asm volatile("" ::: "memory");
    f32x4 acc[9];
#pragma unroll
    for (int c = 0; c < 9; ++c) acc[c] = (f32x4){0.f, 0.f, 0.f, 0.f};
    const float* wp = A.in[10] + (size_t)layer * DM * 12288 + (size_t)(kc * 256) * 12288 + cg * 256 + lane * 4;
#pragma unroll 8
    for (int kk = 0; kk < 256; ++kk) { const f32x4 w = *(const GAS f32x4*)(wp + (size_t)kk * 12288);
#pragma unroll
        for (int c = 0; c < 9; ++c) acc[c] += scr[c * 256 + kk] * w; }
    float* mp = (float*)(A.ws + WS_MODP) + (size_t)((layer * 8 + kc) * 9) * 12288 + cg * 256 + lane * 4;
#pragma unroll
    for (int c = 0; c < 9; ++c) *(f32x4*)(mp + (size_t)c * 12288) = acc[c];
    LDS_WAIT(); asm volatile("" ::: "memory");
}

__device__ __forceinline__ void filter_a2_row(const Args& A, int rr, int lane) {
    const int L = rr < 2048 ? 2048 : 256, t = rr < 2048 ? rr : rr - 2048;
    const float tn = (float)t / (float)(L - 1), w = 6.283185307179586f * (float)t / (float)L;
    float feat = 0.f;
    if (lane == 0) feat = tn;
    else if (lane <= 16) feat = cosf(w * (1e-4f + (float)(lane - 1) * ((15.0f - 1e-4f) / 15.0f)));
    else if (lane <= 32) feat = -sinf(w * (1e-4f + (float)(lane - 17) * ((15.0f - 1e-4f) / 15.0f)));
    const float* w1 = A.in[18]; const float* b1 = A.in[19]; const float* w2 = A.in[20]; const float* b2 = A.in[21]; const float* fq = A.in[23];
    float s = b1[lane];
    for (int f = 0; f < 33; ++f) s += __shfl(feat, f) * w1[f * 64 + lane];
    const float a1 = sinf(fq[lane] * s);
    float s2 = b2[lane];
    for (int k = 0; k < 64; ++k) s2 += __shfl(a1, k) * w2[k * 64 + lane];
    ((float*)(A.ws + WS_A2))[(size_t)rr * 64 + lane] = sinf(fq[64 + lane] * s2);
}

__device__ __forceinline__ void filter_hf_unit(const Args& A, int u, LAS float* scr, int lane) {
    const int variant = u < 2048 ? 0 : 1; const int uu = variant ? u - 2048 : u; const int tch = uu >> 7, cgp = uu & 127;
    const int L = variant ? 256 : 2048; const int col = cgp * 64 + lane, side = col >> 12, order = (col >> 11) & 1, d = col & 2047;
    const float* w3 = A.in[22];
    float w3r[64];
#pragma unroll
    for (int k = 0; k < 64; ++k) w3r[k] = w3[(size_t)k * 8192 + col];
    constexpr float MIND = -3.0701134573253944f, MAXD = -15.350567286626972f;
    const float delta = fabsf(MIND + (MAXD - MIND) * ((float)d / 2047.0f));
    const float* a2 = (const float*)(A.ws + WS_A2) + (size_t)(variant ? 2048 : 0) * 64;
    bf16* ft = (bf16*)(A.ws + (variant ? WS_FT_CTX : WS_FT)) + ((size_t)(order * 2048 + d) * 2 + side) * L;
    const float rl1 = 1.0f / (float)(L - 1);
    float asum = 0.f;
#pragma unroll 1
    for (int half = 0; half < 2; ++half) {
        const int tb = tch * 128 + half * 64;
        { const GAS f32x4* src = (const GAS f32x4*)(a2 + (size_t)(tb + lane) * 64);
#pragma unroll
          for (int q = 0; q < 16; ++q) *(LAS f32x4*)(scr + lane * 64 + q * 4) = src[q]; }
        LDS_WAIT(); asm volatile("" ::: "memory");
#pragma unroll 1
        for (int tt = 0; tt < 64; tt += 2) {
            float s0 = 0.f, s1 = 0.f;
#pragma unroll
            for (int q = 0; q < 16; ++q) { const f32x4 x0 = *(const LAS f32x4*)(scr + tt * 64 + q * 4), x1 = *(const LAS f32x4*)(scr + (tt + 1) * 64 + q * 4);
                s0 += x0.x * w3r[4 * q] + x0.y * w3r[4 * q + 1] + x0.z * w3r[4 * q + 2] + x0.w * w3r[4 * q + 3];
                s1 += x1.x * w3r[4 * q] + x1.y * w3r[4 * q + 1] + x1.z * w3r[4 * q + 2] + x1.w * w3r[4 * q + 3]; }
            const int t = tb + tt;
            s0 *= expf(-((float)t * rl1) * delta); s1 *= expf(-((float)(t + 1) * rl1) * delta);
            if (!(side == 1 && t == 0)) asum += fabsf(s0);
            asum += fabsf(s1);
            *(GAS unsigned*)(ft + t) = pk2(s0, s1);
        }
        LDS_WAIT(); asm volatile("" ::: "memory");
    }
    ((float*)(A.ws + WS_NP))[(size_t)(variant ? 16 + tch : tch) * 8192 + col] = asum;
}

__device__ __forceinline__ void norm_row(const float* xrow, const float* Ac, const float* Sc, bf16* orow, int lane) {
    const GAS f32x4* xr = (const GAS f32x4*)xrow + lane;
    f32x4 v[8]; float s = 0.f;
#pragma unroll
    for (int j = 0; j < 8; ++j) { v[j] = xr[64 * j]; s += (v[j].x * v[j].x + v[j].y * v[j].y) + (v[j].z * v[j].z + v[j].w * v[j].w); }
    const float rstd = 1.0f / sqrtf(wave_sum(s) * (1.0f / DM) + 1e-6f);
    GAS v2u* o8 = (GAS v2u*)orow + lane;
#pragma unroll
    for (int j = 0; j < 8; ++j) { const f32x4 a = *((const GAS f32x4*)Ac + lane + 64 * j), b = *((const GAS f32x4*)Sc + lane + 64 * j);
        const f32x4 y = v[j] * rstd * a + b; v2u w; w.x = pk2(y.x, y.y); w.y = pk2(y.z, y.w); o8[64 * j] = w; }
}
__device__ __forceinline__ void final_norm_row(float* xrow, const float* g, int lane) {
    GAS f32x4* xr = (GAS f32x4*)xrow + lane;
    f32x4 v[8]; float s = 0.f;
#pragma unroll
    for (int j = 0; j < 8; ++j) { v[j] = xr[64 * j]; s += (v[j].x * v[j].x + v[j].y * v[j].y) + (v[j].z * v[j].z + v[j].w * v[j].w); }
    const float rstd = 1.0f / sqrtf(wave_sum(s) * (1.0f / DM) + 1e-6f);
#pragma unroll
    for (int j = 0; j < 8; ++j) { const f32x4 a = *((const GAS f32x4*)g + lane + 64 * j); xr[64 * j] = v[j] * rstd * a; }
}

__device__ __forceinline__ void qkpost_row(bf16* qkv_row, int row, bool is_ax, const float* qg, const float* kg, float* state_k, int lane) {
    const bool is_lat = row >= NCTX;
    const int hsub = lane >> 4, a = (lane >> 3) & 1, i0 = (lane & 7) * 4;
    float cs[4], sn[4];
    if (is_lat) { const int t = (row - NCTX) & 2047; const float pos = (float)(a == 0 ? (t >> 6) : (t & 63));
#pragma unroll
        for (int e = 0; e < 4; ++e) { const float inv = expf(-(float)(i0 + e) * (9.210340371976184f / 32.0f)); sn[e] = sinf(pos * inv); cs[e] = cosf(pos * inv); } }
#pragma unroll
    for (int grp = 0; grp < 5; ++grp) {
        const int head = 4 * grp + hsub;
        bf16* base = qkv_row + head * 128 + a * 64 + i0;
        const v2u r1 = *(const GAS v2u*)base, r2 = *(const GAS v2u*)(base + 32);
        float x1[4] = {bflo(r1.x), bfhi(r1.x), bflo(r1.y), bfhi(r1.y)}, x2[4] = {bflo(r2.x), bfhi(r2.x), bflo(r2.y), bfhi(r2.y)};
        if (is_ax) {
            float ss = 0.f;
#pragma unroll
            for (int e = 0; e < 4; ++e) ss += x1[e] * x1[e] + x2[e] * x2[e];
            ss += __shfl_xor(ss, 1); ss += __shfl_xor(ss, 2); ss += __shfl_xor(ss, 4); ss += __shfl_xor(ss, 8);
            const float rstd = 1.0f / sqrtf(ss * (1.0f / 128.0f) + 1e-6f);
            const float* G = (head < 16 ? qg : kg) + a * 64 + i0;
#pragma unroll
            for (int e = 0; e < 4; ++e) { x1[e] = x1[e] * rstd * G[e]; x2[e] = x2[e] * rstd * G[32 + e]; }
        }
        if (is_lat) {
#pragma unroll
            for (int e = 0; e < 4; ++e) { const float y1 = x1[e] * cs[e] - x2[e] * sn[e], y2 = x2[e] * cs[e] + x1[e] * sn[e]; x1[e] = y1; x2[e] = y2; }
        }
        if (is_ax || is_lat) { v2u w1, w2; w1.x = pk2(x1[0], x1[1]); w1.y = pk2(x1[2], x1[3]); w2.x = pk2(x2[0], x2[1]); w2.y = pk2(x2[2], x2[3]);
            *(GAS v2u*)base = w1; *(GAS v2u*)(base + 32) = w2; }
        if (is_ax && !is_lat && head >= 16) { float* sp = state_k + (size_t)row * 512 + (head - 16) * 128 + a * 64 + i0;
            *(GAS f32x4*)sp = (f32x4){x1[0], x1[1], x1[2], x1[3]}; *(GAS f32x4*)(sp + 32) = (f32x4){x2[0], x2[1], x2[2], x2[3]}; }
    }
}

namespace hy {
constexpr int CPY_STRIDE = 8480;
constexpr int U_OFF = 8 * CPY_STRIDE;
constexpr int U_BYTES = 6144;
static_assert(U_OFF + 8 * U_BYTES <= RING_BYTES, "hyena LDS map");

__device__ __forceinline__ void build_copies(LAS unsigned char* lds, const bf16* ft, int L, int tid) {
    if (tid < 264) { const int c = tid / 33, e = tid % 33; const int qq = (e < 17 - c) ? e : 2 * L + 16 - c + (e - (17 - c));
        *(LAS unsigned short*)(lds + c * CPY_STRIDE + qq * 2) = 0; }
    if (tid < 2 * L / 8) { const int side = tid / (L / 8), t8 = (tid % (L / 8)) * 8;
        const v4u raw = *(const GAS v4u*)(ft + (size_t)side * L + t8);
        const unsigned wds[4] = {raw.x, raw.y, raw.z, raw.w};
#pragma unroll
        for (int e = 0; e < 8; ++e) { const int t = t8 + e; const unsigned short val = (unsigned short)((e & 1) ? (wds[e >> 1] >> 16) : (wds[e >> 1] & 0xffffu));
            if (!(side == 1 && t == 0)) { const int p = side == 0 ? L - t : L + t;
#pragma unroll
                for (int c = 0; c < 8; ++c) *(LAS unsigned short*)(lds + c * CPY_STRIDE + (p + 16 - c) * 2) = val; } } }
}
__device__ __forceinline__ void fill_u(LAS unsigned char* ub, const bf16* urow, int L, float w0, float w1, float w2, float bb, int lane) {
    { const int e0 = lane < 32 ? lane * 8 : L + 256 + (lane - 32) * 8; *(LAS v4u*)(ub + e0 * 2) = (v4u){0u, 0u, 0u, 0u}; }
    for (int q = lane; q < L / 8; q += 64) { const int s0 = 8 * q;
        const v4u raw = *(const GAS v4u*)(urow + s0);
        const float prev = s0 > 0 ? bf2f(urow[s0 - 1]) : 0.f, next = s0 + 8 < L ? bf2f(urow[s0 + 8]) : 0.f;
        const float x[10] = {prev, bflo(raw.x), bfhi(raw.x), bflo(raw.y), bfhi(raw.y), bflo(raw.z), bfhi(raw.z), bflo(raw.w), bfhi(raw.w), next};
        float y[8];
#pragma unroll
        for (int j = 0; j < 8; ++j) y[j] = w0 * x[j] + w1 * x[j + 1] + w2 * x[j + 2] + bb;
        v4u o; o.x = pk2(y[0], y[1]); o.y = pk2(y[2], y[3]); o.z = pk2(y[4], y[5]); o.w = pk2(y[6], y[7]);
        *(LAS v4u*)(ub + (256 + s0) * 2) = o; }
}
template <int NT>
__device__ __forceinline__ void toeplitz(const LAS unsigned char* cpy, const LAS unsigned char* ub, f32x4 (&acc)[NT], int lane) {
    constexpr int L = 256 * NT;
    const int i = lane & 15, g = lane >> 4, c = (-i) & 7;
    const LAS unsigned char* ap = cpy + c * CPY_STRIDE + 2 * (L + 8 * g + 16 - i - c);
    const LAS unsigned char* bp = ub + 2 * (256 + 8 * g + 16 * i);
#pragma unroll 1
    for (int db = -(L / 32 - 1); db <= L / 32; ++db) {
        const int delta = 32 * db;
        const bf16x8 a = *(const LAS bf16x8*)(ap - 2 * delta);
#pragma unroll
        for (int k = 0; k < NT; ++k) { const int S = 256 * k - delta;
            if (S >= -256 && S <= L - 32) { const bf16x8 b = *(const LAS bf16x8*)(bp + 2 * S);
                acc[k] = __builtin_amdgcn_mfma_f32_16x16x32_bf16(a, b, acc[k], 0, 0, 0); } }
    }
}
template <int NT>
__device__ __forceinline__ void gate(const f32x4 (&acc)[NT], LAS unsigned char* ub, const bf16* xg, float cw0, float cw1, float cw2, float cb, float invn, float skip, int lane, bool last, bf16* zt) {
    constexpr int L = 256 * NT;
    const int sg = lane & 15, g = lane >> 4;
#pragma unroll
    for (int k = 0; k < NT; ++k) { const int t0 = 256 * k + 16 * sg + 4 * g;
        const v2u ur = *(const LAS v2u*)(ub + (256 + t0) * 2);
        const v2u xr = *(const GAS v2u*)(xg + t0);
        const float prev = t0 > 0 ? bf2f(xg[t0 - 1]) : 0.f, next = t0 + 4 < L ? bf2f(xg[t0 + 4]) : 0.f;
        const float x[6] = {prev, bflo(xr.x), bfhi(xr.x), bflo(xr.y), bfhi(xr.y), next};
        const float uu[4] = {bflo(ur.x), bfhi(ur.x), bflo(ur.y), bfhi(ur.y)};
        float z[4];
#pragma unroll
        for (int r = 0; r < 4; ++r) { const float xc = cw0 * x[r] + cw1 * x[r + 1] + cw2 * x[r + 2] + cb; z[r] = xc * (acc[k][r] * invn + skip * uu[r]); }
        v2u o; o.x = pk2(z[0], z[1]); o.y = pk2(z[2], z[3]);
        if (last) *(GAS v2u*)(zt + t0) = o; else *(LAS v2u*)(ub + (256 + t0) * 2) = o; }
}
}

constexpr int NPHASE = 35;
#ifndef PHMASK
#define PHMASK 0xFFFF
#endif
#define PHON(b) ((PHMASK >> (b)) & 1)
#ifndef MK_PER_PHASE
#define MK_PER_PHASE 0
#endif


template <class T> __device__ __forceinline__ T* launder(T* p) { asm volatile("" : "+s"(p)); return p; }
#define ENV_IDS int tid_ = threadIdx.x; asm volatile("" : "+v"(tid_)); const int tid = tid_, lane = tid & 63, wave = __builtin_amdgcn_readfirstlane(tid >> 6); const int G = gridDim.x, bx = blockIdx.x; \
    const int vcu = (G % 8 == 0) ? (bx % 8) * (G / 8) + bx / 8 : bx; const int gw = vcu * NWAVES + wave, NGW = G * NWAVES; (void)tid; (void)lane; (void)gw; (void)NGW; (void)bx;
#define ENV_PTRS unsigned char* ws = launder(A.ws); float* out = launder(A.out); (void)out; (void)ws;

__device__ __forceinline__ void ph_prologue_a(const Args& A, LAS unsigned char* L) {
    ENV_IDS ENV_PTRS
    LAS float* wscr = (LAS float*)(L + wave * 16384);
    for (int it = gw; it < IT_TOTAL; it += NGW) weight_item(A, it, wscr, lane);
    { const size_t NCH = (size_t)2 * 524288 + 2 * 262144;
      for (size_t ch = (size_t)gw * 64 + lane; ch < NCH; ch += (size_t)NGW * 64) {
          int ten; size_t off; unsigned char* dstb;
          if (ch < 524288) { ten = 0; off = ch * 8; dstb = ws + WS_CWK; } else if (ch < 1048576) { ten = 1; off = (ch - 524288) * 8; dstb = ws + WS_CWV; }
          else if (ch < 1310720) { ten = 2; off = (ch - 1048576) * 8; dstb = ws + WS_CAK; } else { ten = 3; off = (ch - 1310720) * 8; dstb = ws + WS_CAV; }
          const float* src = A.in[2 + ten] + off; const f32x4 a = *(const GAS f32x4*)src, b = *(const GAS f32x4*)(src + 4);
          v4u o; o.x = pk2(a.x, a.y); o.y = pk2(a.z, a.w); o.z = pk2(b.x, b.y); o.w = pk2(b.z, b.w);
          *(GAS v4u*)((bf16*)dstb + off) = o; } }
    for (int u = gw; u < 1536; u += NGW) adaln_partial_unit(A, __builtin_amdgcn_readfirstlane(u), wscr, lane);
    for (int rr = gw; rr < 2304; rr += NGW) filter_a2_row(A, __builtin_amdgcn_readfirstlane(rr), lane);
}
__device__ __forceinline__ void ph_prologue_b(const Args& A, LAS unsigned char* L) {
    ENV_IDS ENV_PTRS
    LAS float* wscr = (LAS float*)(L + wave * 16384);
    float* MODF = (float*)(ws + WS_MODF);
    for (int e = gw * 64 + lane; e < DEPTH * 9 * DM; e += NGW * 64) { const int layer = e / (9 * DM), c = (e / DM) % 9, col = e % DM;
        float m[6];
#pragma unroll
        for (int q = 0; q < 6; ++q) { float s = A.in[11][(size_t)layer * 12288 + q * DM + col];
#pragma unroll
            for (int kc = 0; kc < 8; ++kc) s += ((const float*)(ws + WS_MODP))[(size_t)((layer * 8 + kc) * 9 + c) * 12288 + q * DM + col];
            m[q] = s; }
        float* mf = MODF + (size_t)((layer * 9 + c) * 6) * DM + col;
        mf[0 * DM] = A.in[8][layer * DM + col] * (1.0f + m[1]); mf[1 * DM] = m[0]; mf[2 * DM] = m[2];
        mf[3 * DM] = A.in[9][layer * DM + col] * (1.0f + m[4]); mf[4 * DM] = m[3]; mf[5 * DM] = m[5]; }
    for (int u = gw; u < 2304; u += NGW) filter_hf_unit(A, __builtin_amdgcn_readfirstlane(u), wscr, lane);
}
__device__ __forceinline__ void ph_norm(const Args& A, int layer, int which) {
    ENV_IDS ENV_PTRS
    const float* modf = (const float*)(ws + WS_MODF) + (size_t)layer * 9 * 6 * DM; bf16* HB = (bf16*)(ws + WS_H);
    const float* xc = (layer == 0 && which == 0) ? A.in[0] : out; const float* xl = (layer == 0 && which == 0) ? A.in[1] : out + (size_t)NCTX * DM;
    for (int row = gw; row < NTOK; row += NGW) { const int cv = row < NCTX ? 0 : 1 + ((row - NCTX) >> 11);
        const float* xr = row < NCTX ? xc + (size_t)row * DM : xl + (size_t)(row - NCTX) * DM;
        norm_row(xr, modf + (size_t)(cv * 6 + 3 * which) * DM, modf + (size_t)(cv * 6 + 3 * which + 1) * DM, HB + (size_t)row * DM, lane); }
}
__device__ __forceinline__ void ph_qkv(const Args& A, int layer, LAS unsigned char* L) {
    ENV_PTRS
    const int G = gridDim.x, bx = blockIdx.x; const bool is_ax = (layer % 3) == 2; const int jx = layer / 3;
    const bf16* W = (const bf16*)(ws + (is_ax ? WS_WQKVA : (jx == 0 ? WS_WQKV0 : WS_WQKV1)));
    pg8::Gemm g{(const bf16*)(ws + WS_H), W, NTOK, QKVD, DM}; pg8::StaticOrder S; S.init(NTOK, QKVD, G, bx);
    pg8::EpiQKV E{(bf16*)(ws + WS_BIG), is_ax ? nullptr : out + OUT_WK + (size_t)jx * 256 * 512, is_ax ? out + OUT_AV : out + OUT_WV + (size_t)jx * 256 * 512, is_ax ? 0 : 256};
    pg8::gemm_phase<pg8::EpiQKV, pg8::StaticOrder, true, true>(L, g, S, E);
}
__device__ __forceinline__ void ph_qkpost(const Args& A, int layer) {
    ENV_IDS ENV_PTRS
    const bool is_ax = (layer % 3) == 2; bf16* QKVB = (bf16*)(ws + WS_BIG);
    for (int row = (is_ax ? 0 : NCTX) + gw; row < NTOK; row += NGW)
        qkpost_row(QKVB + (size_t)row * QKVD, row, is_ax, A.in[27], A.in[28], out + OUT_AK, lane);
}
__device__ __forceinline__ void ph_attn(const Args& A, int layer, char* lds) {
    ENV_PTRS
    const int G = gridDim.x, bx = blockIdx.x; const bool is_ax = (layer % 3) == 2; const int jx = layer / 3;
    const att::bf16* QK = (const att::bf16*)(ws + WS_BIG); att::bf16* OB = (att::bf16*)(ws + WS_H);
    const att::bf16* CK = (const att::bf16*)(ws + (is_ax ? WS_CAK : WS_CWK));
    const att::bf16* CV = (const att::bf16*)(ws + (is_ax ? WS_CAV : WS_CWV));
    const int ncl = is_ax ? 1 : 2;
#pragma unroll 1
    for (int u = bx; u < 1536; u += G) {
        att::Unit U;
        if (u < 1024) { const int b = u >> 7, qb = (u >> 4) & 7, h = u & 15, kvh = h >> 2;
            const size_t r0 = (size_t)NCTX + (size_t)b * 2048 + (size_t)qb * 256;
            U.Q = QK + r0 * QKVD + h * 128; U.ldq = QKVD;
            const size_t coff = ((size_t)(b * ncl + (is_ax ? 0 : jx)) * 512) * 512 + kvh * 128;
            U.KA = CK + coff; U.VA = CV + coff; U.ldA = 512; U.nA = 8;
            const int klo = is_ax ? 0 : (qb * 256 - 128 < 0 ? 0 : qb * 256 - 128), khi = is_ax ? 2048 : (qb * 256 + 384 > 2048 ? 2048 : qb * 256 + 384);
            const size_t kr0 = (size_t)NCTX + (size_t)b * 2048 + klo;
            U.KB = QK + kr0 * QKVD + 2048 + kvh * 128; U.VB = QK + kr0 * QKVD + 2560 + kvh * 128; U.ldB = QKVD;
            U.NT = 8 + (khi - klo) / 64; U.win = is_ax ? 0 : 1; U.dq0 = qb * 256 - klo;
            U.O = OB + r0 * DM + h * 128; U.ldo = DM;
            U.has_sink = is_ax ? 0 : 1; U.sink = is_ax ? 0.f : A.in[14][jx * 16 + h];
        } else { const int uc = u - 1024, b = uc >> 4, h = uc & 15, kvh = h >> 2; const size_t r0 = (size_t)b * 256;
            U.Q = QK + r0 * QKVD + h * 128; U.ldq = QKVD;
            U.KA = QK + r0 * QKVD + 2048 + kvh * 128; U.VA = QK + r0 * QKVD + 2560 + kvh * 128; U.ldA = QKVD; U.nA = 4;
            U.KB = U.KA; U.VB = U.VA; U.ldB = QKVD; U.NT = 4; U.win = 0; U.dq0 = 0;
            U.O = OB + r0 * DM + h * 128; U.ldo = DM;
            U.has_sink = is_ax ? 0 : 1; U.sink = is_ax ? 0.f : A.in[14][jx * 16 + h];
        }
        att::attn_unit(U, lds);
    }
}
__device__ __forceinline__ void ph_hyin(const Args& A, LAS unsigned char* L) {
    ENV_PTRS
    const int G = gridDim.x, bx = blockIdx.x;
    pg8::Gemm g{(const bf16*)(ws + WS_WHI), (const bf16*)(ws + WS_H), 6144, NTOK, DM}; pg8::StaticOrder S; S.init(6144, NTOK, G, bx);
    pg8::EpiBf16 E{(bf16*)(ws + WS_BIG), NTOK};
    pg8::gemm_phase<pg8::EpiBf16, pg8::StaticOrder, true, true>(L, g, S, E);
}
__device__ __forceinline__ void ph_hyconv(const Args& A, LAS unsigned char* L) {
    ENV_IDS ENV_PTRS
    const bf16* UT = (const bf16*)(ws + WS_BIG); bf16* ZT = (bf16*)(ws + WS_ZT);
    const float* cw = A.in[16]; const float* cbv = A.in[17]; const float* skp = A.in[24]; const float* NP = (const float*)(ws + WS_NP);
    LAS unsigned char* ub = L + hy::U_OFF + wave * hy::U_BYTES;
#pragma unroll 1
    for (int d = bx; d < DM; d += G) {
        float w0[3], w1[3], w2[3], cb[3];
#pragma unroll
        for (int p = 0; p < 3; ++p) { const int ch = p * DM + d; w0[p] = cw[ch]; w1[p] = cw[6144 + ch]; w2[p] = cw[2 * 6144 + ch]; cb[p] = cbv[ch]; }
        float invn[2][2];
#pragma unroll
        for (int o = 0; o < 2; ++o) { float sl = 0.f, sc = 0.f;
            for (int ch = 0; ch < 16; ++ch) sl += NP[(size_t)ch * 8192 + o * 2048 + d] + NP[(size_t)ch * 8192 + 4096 + o * 2048 + d];
            for (int ch = 16; ch < 18; ++ch) sc += NP[(size_t)ch * 8192 + o * 2048 + d] + NP[(size_t)ch * 8192 + 4096 + o * 2048 + d];
            invn[0][o] = 1.0f / (sl + 1e-6f); invn[1][o] = 1.0f / (sc + 1e-6f); }
        const float sk0 = skp[d], sk1 = skp[DM + d];
        const bf16* ftl = (const bf16*)(ws + WS_FT) + (size_t)d * 2 * 2048; const bf16* ftc = (const bf16*)(ws + WS_FT_CTX) + (size_t)d * 2 * 256;
        { const size_t sb = (size_t)NCTX + (size_t)wave * 2048;
          hy::fill_u(ub, UT + (size_t)d * NTOK + sb, 2048, w0[0], w1[0], w2[0], cb[0], lane);
          __syncthreads(); hy::build_copies(L, ftl, 2048, tid); __syncthreads();
          f32x4 acc[8];
#pragma unroll
          for (int k = 0; k < 8; ++k) acc[k] = (f32x4){0.f, 0.f, 0.f, 0.f};
          hy::toeplitz<8>(L, ub, acc, lane);
          hy::gate<8>(acc, ub, UT + (size_t)(DM + d) * NTOK + sb, w0[1], w1[1], w2[1], cb[1], invn[0][0], sk0, lane, false, nullptr);
          __syncthreads(); hy::build_copies(L, ftl + (size_t)2048 * 2 * 2048, 2048, tid); __syncthreads();
#pragma unroll
          for (int k = 0; k < 8; ++k) acc[k] = (f32x4){0.f, 0.f, 0.f, 0.f};
          hy::toeplitz<8>(L, ub, acc, lane);
          hy::gate<8>(acc, ub, UT + (size_t)(2 * DM + d) * NTOK + sb, w0[2], w1[2], w2[2], cb[2], invn[0][1], sk1, lane, true, ZT + (size_t)d * NTOK + sb); }
        { for (int q = 0; q < 4; ++q) hy::fill_u(ub + q * 1536, UT + (size_t)d * NTOK + (size_t)(wave * 4 + q) * 256, 256, w0[0], w1[0], w2[0], cb[0], lane);
          __syncthreads(); hy::build_copies(L, ftc, 256, tid); __syncthreads();
#pragma unroll 1
          for (int q = 0; q < 4; ++q) { const size_t sb = (size_t)(wave * 4 + q) * 256; f32x4 acc[1]; acc[0] = (f32x4){0.f, 0.f, 0.f, 0.f};
              hy::toeplitz<1>(L, ub + q * 1536, acc, lane);
              hy::gate<1>(acc, ub + q * 1536, UT + (size_t)(DM + d) * NTOK + sb, w0[1], w1[1], w2[1], cb[1], invn[1][0], sk0, lane, false, nullptr); }
          __syncthreads(); hy::build_copies(L, ftc + (size_t)2048 * 2 * 256, 256, tid); __syncthreads();
#pragma unroll 1
          for (int q = 0; q < 4; ++q) { const size_t sb = (size_t)(wave * 4 + q) * 256; f32x4 acc[1]; acc[0] = (f32x4){0.f, 0.f, 0.f, 0.f};
              hy::toeplitz<1>(L, ub + q * 1536, acc, lane);
              hy::gate<1>(acc, ub + q * 1536, UT + (size_t)(2 * DM + d) * NTOK + sb, w0[2], w1[2], w2[2], cb[2], invn[1][1], sk1, lane, true, ZT + (size_t)d * NTOK + sb); } }
    }
    __syncthreads();
}
__device__ __forceinline__ void ph_hytr(const Args& A, LAS unsigned char* L) {
    ENV_IDS ENV_PTRS
    const bf16* ZT = (const bf16*)(ws + WS_ZT); bf16* HB = (bf16*)(ws + WS_H);
    LAS unsigned char* scr = L + wave * 16384;
    for (int tile = gw; tile < 32 * 384; tile += NGW) { const int d0 = (tile & 31) * 64, r0 = (tile >> 5) * 64;
#pragma unroll
        for (int j = 0; j < 8; ++j) { const int idx = j * 64 + lane, dl = idx >> 3, ch = idx & 7;
            *(LAS v4u*)(scr + dl * 144 + ch * 16) = *(const GAS v4u*)(ZT + (size_t)(d0 + dl) * NTOK + r0 + ch * 8); }
        LDS_WAIT(); asm volatile("" ::: "memory");
#pragma unroll
        for (int j = 0; j < 8; ++j) { unsigned e[8];
#pragma unroll
            for (int q = 0; q < 8; ++q) e[q] = *(const LAS unsigned short*)(scr + (j * 8 + q) * 144 + lane * 2);
            v4u o; o.x = e[0] | (e[1] << 16); o.y = e[2] | (e[3] << 16); o.z = e[4] | (e[5] << 16); o.w = e[6] | (e[7] << 16);
            *(GAS v4u*)(HB + (size_t)(r0 + lane) * DM + d0 + j * 8) = o; }
        LDS_WAIT(); asm volatile("" ::: "memory"); }
}
__device__ __forceinline__ void ph_mixout(const Args& A, int layer, LAS unsigned char* L) {
    ENV_PTRS
    const int G = gridDim.x, bx = blockIdx.x; const int kind = layer % 3, jx = layer / 3;
    const float* modf = (const float*)(ws + WS_MODF) + (size_t)layer * 9 * 6 * DM;
    const float* xc = layer == 0 ? A.in[0] : out; const float* xl = layer == 0 ? A.in[1] : out + (size_t)NCTX * DM;
    const bf16* W = (const bf16*)(ws + (kind == 1 ? WS_WHO : (kind == 2 ? WS_WOA : (jx == 0 ? WS_WO0 : WS_WO1))));
    pg8::Gemm g{(const bf16*)(ws + WS_H), W, NTOK, DM, DM}; pg8::StaticOrder S; S.init(NTOK, DM, G, bx);
    pg8::EpiResid E{xc, xl, out, modf + 2 * DM};
    pg8::gemm_phase<pg8::EpiResid, pg8::StaticOrder, true, true>(L, g, S, E);
}
__device__ __forceinline__ void ph_gu(const Args& A, int layer, LAS unsigned char* L) {
    ENV_PTRS
    const int G = gridDim.x, bx = blockIdx.x;
    pg8::Gemm g{(const bf16*)(ws + WS_H), (const bf16*)(ws + WS_WGU + (size_t)layer * W_GU), NTOK, NGU, DM}; pg8::StaticOrder S; S.init(NTOK, NGU, G, bx);
    pg8::EpiSwiglu E{(bf16*)(ws + WS_BIG)};
    pg8::gemm_phase<pg8::EpiSwiglu, pg8::StaticOrder, true, true>(L, g, S, E);
}
__device__ __forceinline__ void ph_down(const Args& A, int layer, LAS unsigned char* L) {
    ENV_PTRS
    const int G = gridDim.x, bx = blockIdx.x;
    const float* modf = (const float*)(ws + WS_MODF) + (size_t)layer * 9 * 6 * DM;
    pg8::Gemm g{(const bf16*)(ws + WS_BIG), (const bf16*)(ws + WS_WDN + (size_t)layer * W_DN), NTOK, DM, DFF}; pg8::StaticOrder S; S.init(NTOK, DM, G, bx);
    pg8::EpiResid E{out, out + (size_t)NCTX * DM, out, modf + 5 * DM};
    pg8::gemm_phase<pg8::EpiResid, pg8::StaticOrder, true, true>(L, g, S, E);
}
__device__ __forceinline__ void ph_final(const Args& A) {
    ENV_IDS ENV_PTRS
    for (int row = gw; row < NTOK; row += NGW) final_norm_row(out + (size_t)row * DM, A.in[32], lane);
}

__global__ void __launch_bounds__(NWAVES * 64, 2) hybrid_fwd(Args A) {
    extern __shared__ __attribute__((aligned(16))) unsigned char lds[];
    LAS unsigned char* L = (LAS unsigned char*)lds;
    for (int u = threadIdx.x; u < (LDS_BYTES - LDSCTL_OFF) / 4; u += NWAVES * 64) ((LAS unsigned*)(L + LDSCTL_OFF))[u] = 0u;
    __syncthreads();
    XcdBarrier bar; bar.bar = (unsigned*)(A.ws + WS_CTL) + CW_BAR; bar.x = 0; bar.st = nullptr;
    if (!MK_PER_PHASE) bar = xcd_barrier_post((unsigned*)(A.ws + WS_CTL) + CW_BAR, (volatile LAS unsigned*)(L + MISC_OFF) + 8);
    const int lo = A.ph_lo, hi = A.ph_hi;
#define IN(k) (lo <= (k) && (k) < hi)
#define SEAM(k) do { if (IN(k) && IN((k) + 1)) xcd_barrier(bar); } while (0)
    if (PHON(0) && IN(0)) ph_prologue_a(A, L);
    SEAM(0);
    if (PHON(1) && IN(1)) ph_prologue_b(A, L);
    SEAM(1);
#pragma unroll 1
    for (int layer = 0; layer < DEPTH; ++layer) {
        const int pb = 2 + 8 * layer;
        if (PHON(2) && IN(pb + 0)) ph_norm(A, layer, 0);
        SEAM(pb + 0);
        if ((layer % 3) != 1) {
            if (PHON(3) && IN(pb + 1)) ph_qkv(A, layer, L);
            SEAM(pb + 1);
            if (PHON(4) && IN(pb + 2)) ph_qkpost(A, layer);
            SEAM(pb + 2);
            if (PHON(5) && IN(pb + 3)) ph_attn(A, layer, (char*)lds);
            SEAM(pb + 3);
        } else {
            if (PHON(6) && IN(pb + 1)) ph_hyin(A, L);
            SEAM(pb + 1);
            if (PHON(7) && IN(pb + 2)) ph_hyconv(A, L);
            SEAM(pb + 2);
            if (PHON(8) && IN(pb + 3)) ph_hytr(A, L);
            SEAM(pb + 3);
        }
        if (PHON(9) && IN(pb + 4)) ph_mixout(A, layer, L);
        SEAM(pb + 4);
        if (PHON(10) && IN(pb + 5)) ph_norm(A, layer, 1);
        SEAM(pb + 5);
        if (PHON(11) && IN(pb + 6)) ph_gu(A, layer, L);
        SEAM(pb + 6);
        if (PHON(12) && IN(pb + 7)) ph_down(A, layer, L);
        SEAM(pb + 7);
    }
    if (PHON(13) && IN(34)) ph_final(A);
#undef IN
#undef SEAM
}

extern "C" void kernel_launch(void* const* d_in, const int* in_sizes, int n_in, void* d_out, int out_size, void* d_ws, size_t ws_size, hipStream_t stream) {
    static int grid = 0;
    if (grid == 0) {
        if (n_in != 33 || (size_t)out_size != OUT_END || ws_size < WS_END) { fprintf(stderr, "kernel_launch: unexpected shapes: n_in %d out %d ws %zu (need %zu)\n", n_in, out_size, ws_size, (size_t)WS_END); grid = -1; return; }
        int dev = 0, cus = 0, per_cu = 0;
        if (hipGetDevice(&dev) != hipSuccess || hipDeviceGetAttribute(&cus, hipDeviceAttributeMultiprocessorCount, dev) != hipSuccess) { grid = -1; return; }
        if (hipFuncSetAttribute((const void*)hybrid_fwd, hipFuncAttributeMaxDynamicSharedMemorySize, LDS_BYTES) != hipSuccess) { fprintf(stderr, "kernel_launch: hipFuncSetAttribute failed\n"); grid = -1; return; }
        if (hipOccupancyMaxActiveBlocksPerMultiprocessor(&per_cu, (const void*)hybrid_fwd, NWAVES * 64, LDS_BYTES) != hipSuccess || per_cu < 1)
            fprintf(stderr, "kernel_launch: occupancy query reports %d workgroups per CU\n", per_cu);
        (void)hipGetLastError();
        grid = cus;
    }
    if (grid < 0) return;
    if (hipMemsetAsync((char*)d_ws + WS_CTL, 0, CTL_ZERO_BYTES, stream) != hipSuccess) { fprintf(stderr, "kernel_launch: memset failed\n"); return; }
    Args a{};
    for (int i = 0; i < 33; ++i) a.in[i] = (const float*)d_in[i];
    a.out = (float*)d_out; a.ws = (unsigned char*)d_ws;
#if MK_PER_PHASE
    for (int ph = 0; ph < NPHASE; ++ph) { a.ph_lo = ph; a.ph_hi = ph + 1; hipLaunchKernelGGL(hybrid_fwd, dim3(grid), dim3(NWAVES * 64), LDS_BYTES, stream, a); }
#else
    a.ph_lo = 0; a.ph_hi = NPHASE; hipLaunchKernelGGL(hybrid_fwd, dim3(grid), dim3(NWAVES * 64), LDS_BYTES, stream, a);
#endif
    const hipError_t le = hipPeekAtLastError();
    if (le != hipSuccess) fprintf(stderr, "kernel_launch: launch failed: %s\n", hipGetErrorName(le));
}
```

```cpp
#include <hip/hip_runtime.h>
#include <cstdio>
#include <cstdint>
#include <hip/hip_bf16.h>
#include <cmath>
namespace pg8 {
#define PG8_LAS __attribute__((address_space(3)))
typedef unsigned short bf16_t;
typedef short bf16x8 __attribute__((ext_vector_type(8)));
typedef float f32x4 __attribute__((ext_vector_type(4)));
typedef unsigned u32x4 __attribute__((ext_vector_type(4)));
constexpr int BM = 256, BK = 64, HALF = 128, HTB = HALF * BK * 2  , STAGE_BYTES = 8 * HTB, NXCD = 8, WGM = 8;

__host__ __device__ __forceinline__ int lds_byte(int r, int c) { const int st = (r >> 4) * 2 + (c >> 5), rr = r & 15, cc = c & 31, ob = rr * 64 + cc * 2; return st * 1024 + (ob ^ (((ob >> 9) & 1) << 5)); }
__host__ __device__ __forceinline__ void stage_rc(int b, int& R, int& C) { const int st = b / 1024, sb = b % 1024, swz = sb ^ (((sb >> 9) & 1) << 5); R = (st >> 1) * 16 + swz / 64; C = (st & 1) * 32 + (swz % 64) / 2; }
__host__ __device__ __forceinline__ int perm32(int rho) { const int n = rho >> 4, i = rho & 15; return 8 * (i >> 2) + 4 * n + (i & 3); }

struct Unit { int pm, pn; };
struct Gemm { const bf16_t* A; const bf16_t* Bt; int M, N, K; };

struct StaticOrder {
    int nM, nN, nwg, G, c;
    __host__ __device__ void init(int M, int N, int G_, int c_) { nM = M / BM; nN = N / BM; nwg = nM * nN; G = G_; c = c_; }
    __host__ __device__ bool next(int i, Unit& u) const {
        const long L = (long)i * G + c; if (L >= nwg) return false;
        int wgid = (int)L; { const int q = nwg / NXCD, r = nwg % NXCD, xcd = wgid % NXCD, off = wgid / NXCD; wgid = (xcd < r ? xcd * (q + 1) : r * (q + 1) + (xcd - r) * q) + off; }
        const int nig = WGM * nN, gid = wgid / nig, fm = gid * WGM, gsz = (nM - fm) < WGM ? (nM - fm) : WGM;
        u.pm = fm + ((wgid % nig) % gsz); u.pn = (wgid % nig) / gsz; return true;
    }
    __device__ __forceinline__ void a_ready(const Unit&) const {}
    __device__ __forceinline__ void done(const Unit&) const {}
};

__device__ __forceinline__ unsigned cvt_pk_bf16(float lo, float hi) { unsigned r; asm volatile("v_cvt_pk_bf16_f32 %0, %1, %2" : "=v"(r) : "v"(lo), "v"(hi)); return r; }
typedef float f32x2 __attribute__((ext_vector_type(2)));
struct EpiBf16 {
    static constexpr bool PERM = true, AFTER_DRAIN = false;
    bf16_t* O; int ldc;
    __device__ __forceinline__ void operator()(const f32x4 (&acc)[2][2][4][2], const Unit& u, int wr, int wc, int fr, int fq) const {
        const int row0 = u.pm * BM + wr * 64 + fr; const int col0 = u.pn * BM + wc * 32 + 8 * fq;
#pragma unroll
        for (int ai = 0; ai < 2; ++ai)
#pragma unroll
            for (int m = 0; m < 4; ++m) { bf16_t* rowp = O + (size_t)(row0 + ai * HALF + m * 16) * ldc + col0;
#pragma unroll
                for (int bj = 0; bj < 2; ++bj) { const f32x4 v0 = acc[ai][bj][m][0], v1 = acc[ai][bj][m][1];
                    u32x4 w; w.x = cvt_pk_bf16(v0[0], v0[1]); w.y = cvt_pk_bf16(v0[2], v0[3]); w.z = cvt_pk_bf16(v1[0], v1[1]); w.w = cvt_pk_bf16(v1[2], v1[3]);
                    *(u32x4*)(rowp + bj * HALF) = w; } }
    }
};
struct EpiQKV {
    static constexpr bool PERM = true, AFTER_DRAIN = false;
    bf16_t* O; float* sk; float* sv; int extra;
    __device__ __forceinline__ void operator()(const f32x4 (&acc)[2][2][4][2], const Unit& u, int wr, int wc, int fr, int fq) const {
        const int row0 = u.pm * BM + wr * 64 + fr; const int col0 = u.pn * BM + wc * 32 + 8 * fq;
        float* sb = nullptr; int scol = 0;
        if (u.pm < 32 && u.pn >= 8) { if (u.pn < 10) { sb = sk; scol = col0 - 2048; } else { sb = sv; scol = col0 - 2560; } }
#pragma unroll
        for (int ai = 0; ai < 2; ++ai)
#pragma unroll
            for (int m = 0; m < 4; ++m) { const int row = row0 + ai * HALF + m * 16; bf16_t* rowp = O + (size_t)row * 3072 + col0;
#pragma unroll
                for (int bj = 0; bj < 2; ++bj) { const f32x4 v0 = acc[ai][bj][m][0], v1 = acc[ai][bj][m][1];
                    u32x4 w; w.x = cvt_pk_bf16(v0[0], v0[1]); w.y = cvt_pk_bf16(v0[2], v0[3]); w.z = cvt_pk_bf16(v1[0], v1[1]); w.w = cvt_pk_bf16(v1[2], v1[3]);
                    *(u32x4*)(rowp + bj * HALF) = w;
                    if (sb) { float* sp = sb + (size_t)(row + (row >> 8) * extra) * 512 + scol + bj * HALF; *(f32x4*)sp = v0; *(f32x4*)(sp + 4) = v1; } } }
    }
};
struct EpiResid {
    static constexpr bool PERM = false, AFTER_DRAIN = false;
    const float* xc; const float* xl; float* out; const float* gate;
    __device__ __forceinline__ void operator()(const f32x4 (&acc)[2][2][4][2], const Unit& u, int wr, int wc, int fr, int fq) const {
        const int row0 = u.pm * BM + wr * 64 + fr; const int col0 = u.pn * BM + wc * 32 + 4 * fq;
        const int cv = u.pm < 32 ? 0 : 1 + ((u.pm - 32) >> 3);
        const float* gp = gate + (size_t)cv * (6 * 2048) + col0;
        const float* xin = u.pm < 32 ? xc + (size_t)row0 * 2048 + col0 : xl + (size_t)(row0 - 8192) * 2048 + col0;
        float* op = out + (size_t)row0 * 2048 + col0;
        f32x4 gv[2][2];
#pragma unroll
        for (int bj = 0; bj < 2; ++bj)
#pragma unroll
            for (int n = 0; n < 2; ++n) gv[bj][n] = *(const f32x4*)(gp + bj * HALF + n * 16);
#pragma unroll
        for (int ai = 0; ai < 2; ++ai)
#pragma unroll
            for (int m = 0; m < 4; ++m) { const size_t ro = (size_t)(ai * HALF + m * 16) * 2048;
#pragma unroll
                for (int bj = 0; bj < 2; ++bj)
#pragma unroll
                    for (int n = 0; n < 2; ++n) { const f32x4 x = *(const f32x4*)(xin + ro + bj * HALF + n * 16);
                        *(f32x4*)(op + ro + bj * HALF + n * 16) = x + gv[bj][n] * acc[ai][bj][m][n]; }
                if (m & 1) asm volatile("" ::: "memory"); }
    }
};
struct EpiSwiglu {
    static constexpr bool PERM = true, AFTER_DRAIN = false;
    bf16_t* O;
    __device__ __forceinline__ float sw(float g, float uu) const { return g * __builtin_amdgcn_rcpf(1.0f + __builtin_amdgcn_exp2f(-1.4426950408889634f * g)) * uu; }
    __device__ __forceinline__ void operator()(const f32x4 (&acc)[2][2][4][2], const Unit& u, int wr, int wc, int fr, int fq) const {
        const int row0 = u.pm * BM + wr * 64 + fr; const int col0 = u.pn * HALF + wc * 32 + 8 * fq;
#pragma unroll
        for (int ai = 0; ai < 2; ++ai)
#pragma unroll
            for (int m = 0; m < 4; ++m) { bf16_t* rowp = O + (size_t)(row0 + ai * HALF + m * 16) * 5632 + col0;
                const f32x4 g0 = acc[ai][0][m][0], g1 = acc[ai][0][m][1], u0 = acc[ai][1][m][0], u1 = acc[ai][1][m][1];
                u32x4 w; w.x = cvt_pk_bf16(sw(g0[0], u0[0]), sw(g0[1], u0[1])); w.y = cvt_pk_bf16(sw(g0[2], u0[2]), sw(g0[3], u0[3]));
                w.z = cvt_pk_bf16(sw(g1[0], u1[0]), sw(g1[1], u1[1])); w.w = cvt_pk_bf16(sw(g1[2], u1[2]), sw(g1[3], u1[3]));
                *(u32x4*)rowp = w; }
    }
};

template <class Epi, class Sched, bool ALIGN_EPI = false, bool SP2 = false>
__device__ __forceinline__ void gemm_phase(PG8_LAS unsigned char* lds, const Gemm g, const Sched& S, const Epi& E) {
    int tid_ = threadIdx.x; asm volatile("" : "+v"(tid_));
    const int tid = tid_, wid = __builtin_amdgcn_readfirstlane(tid >> 6), lane = tid & 63, wr = wid >> 2, wc = wid & 3, fr = lane & 15, fq = lane >> 4;
    const int K = g.K, nt = K / BK;
    unsigned voffA[2], voffB[2];
#pragma unroll
    for (int i = 0; i < 2; ++i) { int R, C; stage_rc(tid * 16 + i * 8192, R, C); const int Rb = Epi::PERM ? ((R & ~31) + perm32(R & 31)) : R;
        voffA[i] = (unsigned)(R * K + C) * 2u; voffB[i] = (unsigned)(Rb * K + C) * 2u; }
    const size_t kstep = (size_t)(BK * 2);
    const size_t hstep = (size_t)HALF * K * 2;
    const size_t tstep = 2 * hstep;
    const unsigned ldsw = (unsigned)wid * 1024u;
    const int aoff = lds_byte(wr * 64 + fr, fq * 8), boff = lds_byte(wc * 32 + fr, fq * 8);
#define PG8_SA(b, h) (((b) * 2 + (h)) * HTB)
#define PG8_SB(b, h) ((4 + (b) * 2 + (h)) * HTB)
#define PG8_STAGE(bufoff, gbase, voff) do { _Pragma("unroll") for (int _i = 0; _i < 2; ++_i) \
        __builtin_amdgcn_global_load_lds((const unsigned*)((const char*)(gbase) + (voff)[_i]), (PG8_LAS unsigned*)(lds + (bufoff) + ldsw + _i * 8192), 16, 0, 0); } while (0)
#define PG8_LDA(dst, b, h) do { _Pragma("unroll") for (int m = 0; m < 4; ++m) _Pragma("unroll") for (int k = 0; k < 2; ++k) dst[m][k] = *(const PG8_LAS bf16x8*)(lds + PG8_SA(b, h) + aoff + m * 2048 + k * 1024); } while (0)
#define PG8_LDB(dst, b, h) do { _Pragma("unroll") for (int n = 0; n < 2; ++n) _Pragma("unroll") for (int k = 0; k < 2; ++k) dst[n][k] = *(const PG8_LAS bf16x8*)(lds + PG8_SB(b, h) + boff + n * 2048 + k * 1024); } while (0)
#define PG8_MMA(ai, bj, At, Bt) do { __builtin_amdgcn_s_setprio(1); _Pragma("unroll") for (int m = 0; m < 4; ++m) _Pragma("unroll") for (int n = 0; n < 2; ++n) _Pragma("unroll") for (int k = 0; k < 2; ++k) \
        acc[ai][bj][m][n] = __builtin_amdgcn_mfma_f32_16x16x32_bf16(Bt[n][k], At[m][k], acc[ai][bj][m][n], 0, 0, 0); __builtin_amdgcn_s_setprio(0); } while (0)
#define PG8_WAIT_V(n) asm volatile("s_waitcnt vmcnt(" #n ")" ::: "memory")
#define PG8_WAIT_L(n) asm volatile("s_waitcnt lgkmcnt(" #n ")" ::: "memory")
#define PG8_BAR __builtin_amdgcn_s_barrier()
#define PG8_SCHED __builtin_amdgcn_sched_barrier(0)
    Unit cur, nxt; int ui = 0;
    if (!S.next(0, cur)) return;
    f32x4 acc[2][2][4][2];
#pragma unroll
    for (int a = 0; a < 2; ++a)
#pragma unroll
        for (int b = 0; b < 2; ++b)
#pragma unroll
            for (int m = 0; m < 4; ++m)
#pragma unroll
                for (int n = 0; n < 2; ++n) acc[a][b][m][n] = (f32x4){0.f, 0.f, 0.f, 0.f};
    bf16x8 At[4][2], B0[2][2], B1[2][2];
    const char* cA = (const char*)g.A + (size_t)cur.pm * tstep; const char* cB = (const char*)g.Bt + (size_t)cur.pn * tstep;
    S.a_ready(cur);
    if constexpr (SP2) {
        PG8_STAGE(PG8_SB(0, 0), cB, voffB); PG8_STAGE(PG8_SB(0, 1), cB + hstep, voffB); PG8_STAGE(PG8_SA(0, 0), cA, voffA); PG8_STAGE(PG8_SA(0, 1), cA + hstep, voffA);
        if (wr == 1) PG8_BAR;
        PG8_WAIT_V(2); PG8_BAR;
        PG8_STAGE(PG8_SB(1, 0), cB + kstep, voffB); PG8_STAGE(PG8_SA(1, 0), cA + kstep, voffA); PG8_STAGE(PG8_SB(1, 1), cB + hstep + kstep, voffB);
        PG8_WAIT_V(6); PG8_BAR;
    } else {
        PG8_STAGE(PG8_SB(0, 0), cB, voffB); PG8_STAGE(PG8_SA(0, 0), cA, voffA); PG8_STAGE(PG8_SB(0, 1), cB + hstep, voffB); PG8_STAGE(PG8_SA(0, 1), cA + hstep, voffA);
        if (wr == 1) PG8_BAR;
        PG8_WAIT_V(4); PG8_BAR;
        PG8_STAGE(PG8_SB(1, 0), cB + kstep, voffB); PG8_STAGE(PG8_SA(1, 0), cA + kstep, voffA); PG8_STAGE(PG8_SB(1, 1), cB + hstep + kstep, voffB);
        PG8_WAIT_V(6); PG8_BAR;
    }
    for (;;) {
        const bool has_next = S.next(ui + 1, nxt);
        const char* nA = has_next ? (const char*)g.A + (size_t)nxt.pm * tstep : cA; const char* nB = has_next ? (const char*)g.Bt + (size_t)nxt.pn * tstep : cB;
        for (int t = 0; t < nt; t += 2) {
            const bool last = (t == nt - 2);
            const char* a1 = cA + (size_t)(t + 1) * kstep;
            const char* a2 = last ? nA : cA + (size_t)(t + 2) * kstep; const char* b2 = last ? nB : cB + (size_t)(t + 2) * kstep;
            const char* a3 = a2 + kstep; const char* b3 = b2 + kstep;
            if (last && has_next) S.a_ready(nxt);
            if constexpr (SP2) {
            PG8_LDB(B0, 0, 0); PG8_LDB(B1, 0, 1); PG8_SCHED; PG8_LDA(At, 0, 0); PG8_STAGE(PG8_SA(1, 1), a1 + hstep, voffA);
            PG8_WAIT_V(8); PG8_WAIT_L(0); PG8_BAR; PG8_MMA(0, 0, At, B0); PG8_MMA(0, 1, At, B1); PG8_BAR; PG8_SCHED;
            PG8_LDA(At, 0, 1); PG8_STAGE(PG8_SB(0, 0), b2, voffB); PG8_STAGE(PG8_SB(0, 1), b2 + hstep, voffB); PG8_STAGE(PG8_SA(0, 0), a2, voffA);
            PG8_WAIT_V(8); PG8_WAIT_L(0); PG8_BAR; PG8_MMA(1, 0, At, B0); PG8_MMA(1, 1, At, B1); PG8_BAR; PG8_SCHED;
            PG8_LDB(B0, 1, 0); PG8_LDB(B1, 1, 1); PG8_SCHED; PG8_LDA(At, 1, 0); PG8_STAGE(PG8_SA(0, 1), a2 + hstep, voffA);
            PG8_WAIT_V(8); PG8_WAIT_L(0); PG8_BAR; PG8_MMA(0, 0, At, B0); PG8_MMA(0, 1, At, B1); PG8_BAR; PG8_SCHED;
            PG8_LDA(At, 1, 1); PG8_STAGE(PG8_SB(1, 0), b3, voffB); PG8_STAGE(PG8_SB(1, 1), b3 + hstep, voffB); PG8_STAGE(PG8_SA(1, 0), a3, voffA);
            PG8_WAIT_V(8); PG8_WAIT_L(0); PG8_BAR; PG8_MMA(1, 0, At, B0); PG8_MMA(1, 1, At, B1); PG8_BAR; PG8_SCHED;
            } else {
            PG8_LDB(B0, 0, 0); PG8_SCHED; PG8_LDA(At, 0, 0); PG8_STAGE(PG8_SA(1, 1), a1 + hstep, voffA);
            PG8_WAIT_L(8); PG8_BAR; PG8_WAIT_L(0); PG8_MMA(0, 0, At, B0); PG8_BAR; PG8_SCHED;
            PG8_LDB(B1, 0, 1); PG8_STAGE(PG8_SB(0, 0), b2, voffB);
            PG8_BAR; PG8_WAIT_L(0); PG8_MMA(0, 1, At, B1); PG8_BAR;
            PG8_LDA(At, 0, 1); PG8_STAGE(PG8_SA(0, 0), a2, voffA);
            PG8_BAR; PG8_WAIT_L(0); PG8_MMA(1, 0, At, B0); PG8_BAR; PG8_SCHED;
            PG8_STAGE(PG8_SB(0, 1), b2 + hstep, voffB);
            PG8_WAIT_V(6); PG8_BAR; PG8_MMA(1, 1, At, B1); PG8_BAR;
            PG8_LDB(B0, 1, 0); PG8_SCHED; PG8_LDA(At, 1, 0); PG8_STAGE(PG8_SA(0, 1), a2 + hstep, voffA);
            PG8_WAIT_L(8); PG8_BAR; PG8_WAIT_L(0); PG8_MMA(0, 0, At, B0); PG8_BAR; PG8_SCHED;
            PG8_LDB(B1, 1, 1); PG8_STAGE(PG8_SB(1, 0), b3, voffB);
            PG8_BAR; PG8_WAIT_L(0); PG8_MMA(0, 1, At, B1); PG8_BAR;
            PG8_LDA(At, 1, 1); PG8_STAGE(PG8_SA(1, 0), a3, voffA);
            PG8_BAR; PG8_WAIT_L(0); PG8_MMA(1, 0, At, B0); PG8_BAR; PG8_SCHED;
            PG8_STAGE(PG8_SB(1, 1), b3 + hstep, voffB);
            PG8_WAIT_V(6); PG8_BAR; PG8_MMA(1, 1, At, B1); PG8_BAR;
            }
        }
        if constexpr (ALIGN_EPI) { if (wr == 0) PG8_BAR; }
        if constexpr (!Epi::AFTER_DRAIN) { E(acc, cur, wr, wc, fr, fq); S.done(cur); }
        if (!has_next) break;
#pragma unroll
        for (int a = 0; a < 2; ++a)
#pragma unroll
            for (int b = 0; b < 2; ++b)
#pragma unroll
                for (int m = 0; m < 4; ++m)
#pragma unroll
                    for (int n = 0; n < 2; ++n) acc[a][b][m][n] = (f32x4){0.f, 0.f, 0.f, 0.f};
        cur = nxt; cA = nA; cB = nB; ++ui;
        if constexpr (ALIGN_EPI) { if (wr == 1) PG8_BAR; }
    }
    PG8_WAIT_V(0);
    if constexpr (!ALIGN_EPI) { if (wr == 0) PG8_BAR; }
    PG8_BAR;
    if constexpr (Epi::AFTER_DRAIN) { E.fused(acc, cur, wr, wc, fr, fq, lds, wid, lane); S.done(cur); }
#undef PG8_SA
#undef PG8_SB
#undef PG8_STAGE
#undef PG8_LDA
#undef PG8_LDB
#undef PG8_MMA
#undef PG8_WAIT_V
#undef PG8_WAIT_L
#undef PG8_BAR
#undef PG8_SCHED
}
}

namespace att {
using bf16 = __hip_bfloat16;
constexpr int D = 128, NW = 8, QBLK = 32, KVBLK = 64;
constexpr float SCALE = 0.088388347648318440f;
constexpr float THR = 8.f;
using bf16x8 = __attribute__((ext_vector_type(8))) short;
using s16x4  = __attribute__((ext_vector_type(4))) short;
using f32x16 = __attribute__((ext_vector_type(16))) float;
using u32x4  = __attribute__((ext_vector_type(4))) unsigned;
constexpr size_t SHM_V = KVBLK * D * 2, SHM_K = KVBLK * D * 2, SHM_ATTN = 2 * SHM_V + 2 * SHM_K + NW * 64 * 4;
#define KSWZ(row, colB) ((row) * 256 + ((colB) ^ (((row) & 7) << 4)))
#define SBAR() __builtin_amdgcn_sched_barrier(0)
__device__ __forceinline__ int crow(int r, int hi) { return (r & 3) + 8 * (r >> 2) + 4 * hi; }
__device__ __forceinline__ unsigned cvtpk(float lo, float hi) { unsigned r; asm volatile("v_cvt_pk_bf16_f32 %0, %1, %2" : "=v"(r) : "v"(lo), "v"(hi)); return r; }
__device__ __forceinline__ bf16x8 ld8(const bf16* p) { return *reinterpret_cast<const bf16x8*>(p); }

__device__ __forceinline__ void partialSM(f32x16& p0, f32x16& p1, float& m_reg, float& mn, float& alpha) {
  constexpr float C = SCALE * 1.4426950408889634f;
  float pmax = p0[0]; for (int r = 1; r < 16; ++r) pmax = fmaxf(pmax, p0[r]); for (int r = 0; r < 16; ++r) pmax = fmaxf(pmax, p1[r]);
  { auto rr = __builtin_amdgcn_permlane32_swap(__float_as_uint(pmax), __float_as_uint(pmax), false, false);
    pmax = fmaxf(__uint_as_float(rr[0]), __uint_as_float(rr[1])); }
  if (__builtin_expect(__all(pmax - m_reg <= THR / SCALE), 1)) { mn = m_reg; alpha = 1.f; }
  else { mn = fmaxf(m_reg, pmax); alpha = __builtin_amdgcn_exp2f((m_reg - mn) * C); m_reg = mn; }
  float mnC = -mn * C;
  for (int r = 0; r < 16; ++r) p0[r] = fmaf(p0[r], C, mnC); for (int r = 0; r < 16; ++r) p1[r] = fmaf(p1[r], C, mnC);
  for (int r = 0; r < 16; ++r) p0[r] = __builtin_amdgcn_exp2f(p0[r]);
}
__device__ __forceinline__ void finishSM(f32x16& p0, f32x16& p1, float alpha, float& l_reg, bf16x8& pa0, bf16x8& pa1, bf16x8& pa2, bf16x8& pa3) {
  for (int r = 0; r < 16; ++r) p1[r] = __builtin_amdgcn_exp2f(p1[r]);
  float ps = 0; for (int r = 0; r < 16; ++r) ps += p0[r]; for (int r = 0; r < 16; ++r) ps += p1[r];
  { auto rr = __builtin_amdgcn_permlane32_swap(__float_as_uint(ps), __float_as_uint(ps), false, false);
    ps = __uint_as_float(rr[0]) + __uint_as_float(rr[1]); }
  l_reg = l_reg * alpha + ps;
#define PK4(P, BASE, OUT) do { unsigned a0 = cvtpk(P[BASE + 0], P[BASE + 1]), a1 = cvtpk(P[BASE + 2], P[BASE + 3]);   \
    unsigned b0 = cvtpk(P[BASE + 4], P[BASE + 5]), b1 = cvtpk(P[BASE + 6], P[BASE + 7]);                              \
    auto r0 = __builtin_amdgcn_permlane32_swap(a0, b0, false, false); auto r1 = __builtin_amdgcn_permlane32_swap(a1, b1, false, false); \
    u32x4 w = {r0[0], r1[0], r0[1], r1[1]}; OUT = *reinterpret_cast<bf16x8*>(&w); } while (0)
  PK4(p0, 0, pa0); PK4(p0, 8, pa1); PK4(p1, 0, pa2); PK4(p1, 8, pa3);
#undef PK4
}
__device__ __forceinline__ void qkt(f32x16& p0, f32x16& p1, const bf16* Ks, const bf16x8* qr, int r32, int hi) {
  p0 = f32x16{}; p1 = f32x16{};
  for (int d0 = 0; d0 < 8; ++d0) { int cb = (d0 * 16 + hi * 8) * 2;
    bf16x8 b0 = *reinterpret_cast<const bf16x8*>((const char*)Ks + KSWZ(r32, cb));
    bf16x8 b1 = *reinterpret_cast<const bf16x8*>((const char*)Ks + KSWZ(32 + r32, cb));
    p0 = __builtin_amdgcn_mfma_f32_32x32x16_bf16(b0, qr[d0], p0, 0, 0, 0);
    p1 = __builtin_amdgcn_mfma_f32_32x32x16_bf16(b1, qr[d0], p1, 0, 0, 0); }
}
__device__ __forceinline__ void wmask(f32x16& p0, f32x16& p1, int dq, int hi) {
#pragma unroll
  for (int r = 0; r < 16; ++r) { const int df = dq - crow(r, hi);
    if (df > 128 || df < -128) p0[r] = -1e30f;
    if (df - 32 > 128 || df - 32 < -128) p1[r] = -1e30f; }
}
__device__ __forceinline__ int v_st(int k, int c) { const int kk = (k & ~0xC) | ((k & 4) << 1) | ((k & 8) >> 1); return ((kk >> 3) * 4 + (c >> 5)) * 512 + ((kk & 7) * 32 + (c & 31)) * 2; }
__device__ __forceinline__ int v_rd_base(int lane) { return ((lane & 3) << 3) | (((lane >> 2) & 3) << 6) | (((lane >> 4) & 1) << 5) | (((lane >> 5) & 1) << 8); }
constexpr int v_rd_off(int d0, int ks, int half) { return d0 * 512 + ks * 4096 + half * 2048; }
template <int OFF> __device__ __forceinline__ s16x4 tr_read(int vb) {
  s16x4 r; asm volatile("ds_read_b64_tr_b16 %0, %1 offset:%2" : "=&v"(r) : "v"(vb), "i"(OFF) : "memory"); return r;
}
template <int D0> __device__ __forceinline__ void pv_one(f32x16& od, int vb, bf16x8 pa0, bf16x8 pa1, bf16x8 pa2, bf16x8 pa3) {
  const s16x4 l0 = tr_read<v_rd_off(D0, 0, 0)>(vb), h0 = tr_read<v_rd_off(D0, 0, 1)>(vb), l1 = tr_read<v_rd_off(D0, 1, 0)>(vb), h1 = tr_read<v_rd_off(D0, 1, 1)>(vb);
  const s16x4 l2 = tr_read<v_rd_off(D0, 2, 0)>(vb), h2 = tr_read<v_rd_off(D0, 2, 1)>(vb), l3 = tr_read<v_rd_off(D0, 3, 0)>(vb), h3 = tr_read<v_rd_off(D0, 3, 1)>(vb);
  asm volatile("s_waitcnt lgkmcnt(0)" ::: "memory"); SBAR();
#define PK(L, H) (bf16x8){L[0], L[1], L[2], L[3], H[0], H[1], H[2], H[3]}
  od = __builtin_amdgcn_mfma_f32_32x32x16_bf16(pa0, PK(l0, h0), od, 0, 0, 0);
  od = __builtin_amdgcn_mfma_f32_32x32x16_bf16(pa1, PK(l1, h1), od, 0, 0, 0);
  od = __builtin_amdgcn_mfma_f32_32x32x16_bf16(pa2, PK(l2, h2), od, 0, 0, 0);
  od = __builtin_amdgcn_mfma_f32_32x32x16_bf16(pa3, PK(l3, h3), od, 0, 0, 0);
#undef PK
}
__device__ __forceinline__ void pv_d0(f32x16* o, int vb, bf16x8 pa0, bf16x8 pa1, bf16x8 pa2, bf16x8 pa3) {
  pv_one<0>(o[0], vb, pa0, pa1, pa2, pa3); pv_one<1>(o[1], vb, pa0, pa1, pa2, pa3); pv_one<2>(o[2], vb, pa0, pa1, pa2, pa3); pv_one<3>(o[3], vb, pa0, pa1, pa2, pa3);
}

struct Unit {
  const bf16* Q; int ldq;
  const bf16* KA; const bf16* VA; int ldA; int nA;
  const bf16* KB; const bf16* VB; int ldB;
  int NT;
  int win;
  int dq0;
  int has_sink; float sink;
  bf16* O; int ldo;
};

__device__ __forceinline__ void attn_unit(const Unit& U, char* lds) {
  int tid_ = threadIdx.x; asm volatile("" : "+v"(tid_));
  const int tid = tid_, wid = tid >> 6, lane = tid & 63, r32 = lane & 31, hi = lane >> 5;
  bf16* V_lds = (bf16*)lds; bf16* K_lds = (bf16*)(lds + 2 * SHM_V);
  float* ws = (float*)(lds + 2 * SHM_V + 2 * SHM_K) + wid * 64; float* li_l = ws; float* al_l = ws + 32;
  float m_reg = -1e30f, l_reg = 0; f32x16 o[4] = {}; bf16x8 qr[8];
  const bf16* Qw = U.Q + (long)(wid * QBLK + r32) * U.ldq + hi * 8;
#pragma unroll
  for (int d0 = 0; d0 < 8; ++d0) qr[d0] = ld8(Qw + d0 * 16);
  const int sr = tid >> 4, sc = (tid & 15) * 8, vst0 = v_st(sr, sc), vst1 = v_st(32 + sr, sc);
  const int vb0 = (int)(uintptr_t)V_lds + v_rd_base(lane);
  const int nA = U.nA, NT = U.NT;
  const int dqw = U.dq0 + wid * QBLK + r32;
  struct { bf16x8 vs0, vs1, ks0, ks1; } sr_[1];
#define SLOAD(i, jt) do { const int jj_ = (jt); const bf16 *kp_, *vp_; long ld_; \
    if (jj_ < nA) { ld_ = U.ldA; kp_ = U.KA + (long)jj_ * 64 * ld_; vp_ = U.VA + (long)jj_ * 64 * ld_; } \
    else { ld_ = U.ldB; kp_ = U.KB + (long)(jj_ - nA) * 64 * ld_; vp_ = U.VB + (long)(jj_ - nA) * 64 * ld_; } \
    sr_[i].vs0 = ld8(vp_ + (long)sr * ld_ + sc); sr_[i].vs1 = ld8(vp_ + (long)(32 + sr) * ld_ + sc); \
    sr_[i].ks0 = ld8(kp_ + (long)sr * ld_ + sc); sr_[i].ks1 = ld8(kp_ + (long)(32 + sr) * ld_ + sc); } while (0)
#define SWRITE(b, i) do { *(bf16x8*)((char*)V_lds + (b) * SHM_V + vst0) = sr_[i].vs0;          \
    *(bf16x8*)((char*)V_lds + (b) * SHM_V + vst1) = sr_[i].vs1; int kc = sc * 2;               \
    *(bf16x8*)((char*)K_lds + (b) * SHM_K + KSWZ(sr, kc)) = sr_[i].ks0;                       \
    *(bf16x8*)((char*)K_lds + (b) * SHM_K + KSWZ(32 + sr, kc)) = sr_[i].ks1; } while (0)
#define RESC(a) do { if (__any((a) < 1.f)) { if (hi == 0) al_l[r32] = (a); asm volatile("s_waitcnt lgkmcnt(0)" ::: "memory"); \
    for (int d = 0; d < 4; ++d) for (int r = 0; r < 16; ++r) o[d][r] *= al_l[crow(r, hi)]; } } while (0)
#define MASK(P0, P1, jt) do { if (U.win && (jt) >= nA) { const int dq_ = dqw - ((jt) - nA) * 64; \
    if (__any(dq_ > 128 || dq_ - 63 < -128)) wmask(P0, P1, dq_, hi); } } while (0)
  f32x16 p0, p1; float mn, al; bf16x8 pa0, pa1, pa2, pa3;
  SLOAD(0, 0); asm volatile("s_waitcnt vmcnt(0)" ::: "memory"); SWRITE(0, 0); SLOAD(0, 1); __syncthreads();
#pragma unroll 1
  for (int j = 0; j < NT; ++j) {
    const int b = j & 1;
    qkt(p0, p1, (const bf16*)((const char*)K_lds + b * SHM_K), qr, r32, hi); MASK(p0, p1, j);
    partialSM(p0, p1, m_reg, mn, al);
    RESC(al);
    finishSM(p0, p1, al, l_reg, pa0, pa1, pa2, pa3); SBAR();
    pv_d0(o, vb0 + b * (int)SHM_V, pa0, pa1, pa2, pa3);
    if (j + 1 < NT) { asm volatile("s_waitcnt vmcnt(0)" ::: "memory"); SWRITE(b ^ 1, 0); if (j + 2 < NT) SLOAD(0, j + 2); }
    __syncthreads();
  }
  if (U.has_sink) { constexpr float C = SCALE * 1.4426950408889634f; l_reg += __builtin_amdgcn_exp2f(fminf(U.sink * 1.4426950408889634f - m_reg * C, 120.f)); }
  if (hi == 0) li_l[r32] = l_reg; asm volatile("s_waitcnt lgkmcnt(0)" ::: "memory");
  float rli[16];
#pragma unroll
  for (int r = 0; r < 16; ++r) rli[r] = __builtin_amdgcn_rcpf(li_l[crow(r, hi)]);
  bf16* Ow = U.O + (long)(wid * QBLK) * U.ldo;
#pragma unroll
  for (int r = 0; r < 16; ++r) { int orow = crow(r, hi);
    for (int d0 = 0; d0 < 4; ++d0) { const float v = o[d0][r] * rli[r]; const unsigned pk = cvtpk(v, v);
      *(unsigned short*)(Ow + (long)orow * U.ldo + d0 * 32 + r32) = (unsigned short)(pk & 0xffffu); } }
#undef SLOAD
#undef SWRITE
#undef RESC
#undef MASK
}
}

constexpr int DM = 2048, NCTX = 8192, NLAT = 16384, NTOK = 24576, QKVD = 3072, DFF = 5632, NGU = 11264, DEPTH = 4;
constexpr int NWAVES = 8;
constexpr size_t MiB = 1u << 20;
constexpr size_t OUT_YP = 0, OUT_YS = (size_t)NCTX * DM, OUT_WK = (size_t)NTOK * DM, OUT_WV = OUT_WK + (size_t)32 * 2 * 256 * 512,
                 OUT_AK = OUT_WV + (size_t)32 * 2 * 256 * 512, OUT_AV = OUT_AK + (size_t)32 * 256 * 512, OUT_END = OUT_AV + (size_t)32 * 256 * 512;
constexpr size_t WS_CTL = 0, CTL_ZERO_BYTES = 1 * MiB;
constexpr size_t WS_MODP = 1 * MiB;
constexpr size_t WS_MODF = 16 * MiB;
constexpr size_t WS_A2 = 18 * MiB;
constexpr size_t WS_NP = 19 * MiB;
constexpr size_t WS_CKV = 20 * MiB;
constexpr size_t WS_CWK = WS_CKV, WS_CWV = WS_CKV + 8 * MiB, WS_CAK = WS_CKV + 16 * MiB, WS_CAV = WS_CKV + 20 * MiB;
constexpr size_t WS_FT = 44 * MiB;
constexpr size_t WS_FT_CTX = WS_FT + 32 * MiB;
constexpr size_t WS_W = 80 * MiB;
constexpr size_t W_QKV = (size_t)QKVD * DM * 2, W_SQ = (size_t)DM * DM * 2, W_IN = (size_t)6144 * DM * 2, W_GU = (size_t)NGU * DM * 2, W_DN = (size_t)DM * DFF * 2;
constexpr size_t WS_WQKV0 = WS_W, WS_WQKV1 = WS_WQKV0 + W_QKV, WS_WQKVA = WS_WQKV1 + W_QKV, WS_WO0 = WS_WQKVA + W_QKV, WS_WO1 = WS_WO0 + W_SQ, WS_WOA = WS_WO1 + W_SQ,
                 WS_WHO = WS_WOA + W_SQ, WS_WHI = WS_WHO + W_SQ, WS_WGU = WS_WHI + W_IN, WS_WDN = WS_WGU + 4 * W_GU, WS_WEND = WS_WDN + 4 * W_DN;
constexpr size_t WS_H = 448 * MiB;
constexpr size_t WS_BIG = 544 * MiB;
constexpr size_t WS_ZT = WS_BIG + 288 * MiB;
constexpr size_t WS_END = WS_BIG + 384 * MiB;
static_assert(WS_WEND <= WS_H && WS_FT_CTX + 4 * MiB <= WS_W && WS_CAV + 4 * MiB <= WS_FT, "ws map");
static_assert(WS_MODP + (size_t)4 * 8 * 9 * 12288 * 4 <= WS_MODF && WS_MODF + (size_t)4 * 9 * 6 * 2048 * 4 <= WS_A2 && WS_A2 + (size_t)2304 * 64 * 4 <= WS_NP && WS_NP + (size_t)18 * 8192 * 4 <= WS_CKV, "small buffers");
constexpr int CW_TMO = 0;
constexpr int CW_BAR = 4096;
constexpr int RING_BYTES = 131072;
constexpr int LDSCTL_OFF = RING_BYTES, MISC_OFF = LDSCTL_OFF + 320;
constexpr int LDS_BYTES = 147456;

#define GAS __attribute__((address_space(1)))
#define LAS __attribute__((address_space(3)))
typedef unsigned short bf16;
typedef unsigned v4u __attribute__((ext_vector_type(4)));
typedef unsigned v2u __attribute__((ext_vector_type(2)));
typedef float f32x4 __attribute__((ext_vector_type(4)));
typedef short bf16x8 __attribute__((ext_vector_type(8)));
typedef short bf16x4 __attribute__((ext_vector_type(4)));
typedef GAS unsigned gu32;
#define RLX_AGENT __ATOMIC_RELAXED, __HIP_MEMORY_SCOPE_AGENT
#define LDS_WAIT() asm volatile("s_waitcnt lgkmcnt(0)" ::: "memory")
#define VM_WAIT() asm volatile("s_waitcnt vmcnt(0)" ::: "memory")
__device__ __forceinline__ unsigned f2bf(float f) { unsigned u = __builtin_bit_cast(unsigned, f); return (u + 0x7fffu + ((u >> 16) & 1u)) >> 16; }
__device__ __forceinline__ unsigned pk2(float lo, float hi) { return f2bf(lo) | (f2bf(hi) << 16); }
__device__ __forceinline__ float bf2f(unsigned short b) { return __builtin_bit_cast(float, (unsigned)b << 16); }
__device__ __forceinline__ float bflo(unsigned w) { return __builtin_bit_cast(float, w << 16); }
__device__ __forceinline__ float bfhi(unsigned w) { return __builtin_bit_cast(float, w & 0xffff0000u); }
__device__ __forceinline__ float wave_sum(float v) {
#pragma unroll
    for (int o = 1; o < 64; o <<= 1) v += __shfl_xor(v, o);
    return v;
}
#define XB_TMO      128
#define XB_XCNT(j)  (256  + 64 * (j))
#define XB_XSUB(j)  (1280 + 64 * (j))
#define XB_XGEN(j)  (2304 + 64 * (j))
#define XB_TOP      3328
#define XB_TOPGEN   3392
#define XCD_BAR_WORDS 3456
#define XB_SPIN_CAP (1u << 18)

__device__ __forceinline__ unsigned xb_ld(unsigned* p)              { return __hip_atomic_load(p, __ATOMIC_RELAXED, __HIP_MEMORY_SCOPE_AGENT); }
__device__ __forceinline__ unsigned xb_add(unsigned* p, unsigned v) { return __hip_atomic_fetch_add(p, v, __ATOMIC_RELAXED, __HIP_MEMORY_SCOPE_AGENT); }
__device__ __forceinline__ unsigned xb_xcc_id() { return (unsigned)__builtin_amdgcn_s_getreg((3 << 11) | 20) & 0xFu; }
#define XB_SPIN(cond, bar) do { unsigned _sp = 0; while (cond) { __builtin_amdgcn_s_sleep(1); \
    if ((++_sp & 255u) == 0u) { if (xb_ld(&(bar)[XB_TMO])) break; if (_sp > XB_SPIN_CAP) { atomicAdd(&(bar)[XB_TMO], 1u); break; } } } } while (0)

struct XcdBarrier {
    unsigned* bar; unsigned x;
    volatile LAS unsigned* st;
};

__device__ __forceinline__ XcdBarrier xcd_barrier_post(unsigned* bar, volatile LAS unsigned* st) {
    XcdBarrier b; b.bar = bar; b.x = xb_xcc_id(); b.st = st;
    if (threadIdx.x == 0) (void)xb_add(&bar[XB_XCNT(b.x)], 1u);
    return b;
}
__device__ __forceinline__ void xcd_barrier_complete(unsigned* bar, unsigned x, unsigned& nloc, unsigned& nx) {
    const unsigned G = gridDim.x * gridDim.y * gridDim.z;
    unsigned sum, cnt, mine, sp = 0u;
    for (;;) {
        sum = 0u; cnt = 0u; mine = 0u;
#pragma unroll
        for (unsigned j = 0; j < 16; ++j) { const unsigned c = xb_ld(&bar[XB_XCNT(j)]); sum += c; cnt += (c > 0u) ? 1u : 0u; mine = (j == x) ? c : mine; }
        if (sum == G) break;
        __builtin_amdgcn_s_sleep(1);
        if ((++sp & 255u) == 0u) { if (xb_ld(&bar[XB_TMO])) break; if (sp > XB_SPIN_CAP) { atomicAdd(&bar[XB_TMO], 1u); break; } }
    }
    nloc = mine > 0u ? mine : 1u; nx = cnt > 0u ? cnt : 1u;
}

__device__ __forceinline__ void xcd_barrier(const XcdBarrier& b) {
    asm volatile("s_waitcnt vmcnt(0)" ::: "memory");
    __syncthreads();
    if (threadIdx.x == 0) {
        unsigned* bar = b.bar;
        __builtin_amdgcn_s_waitcnt(0);
        unsigned nloc = b.st[0], nx = b.st[1];
        if (nloc == 0u) { xcd_barrier_complete(bar, b.x, nloc, nx); b.st[0] = nloc; b.st[1] = nx; }
        const unsigned old = xb_add(&bar[XB_XSUB(b.x)], 1u);
        const unsigned gen = old / nloc;
        if (old + 1u == (gen + 1u) * nloc) {
            __builtin_amdgcn_fence(__ATOMIC_RELEASE, "agent");
            asm volatile("s_waitcnt vmcnt(0)" ::: "memory");
            const unsigned og = xb_add(&bar[XB_TOP], 1u);
            const unsigned tg = og / nx;
            if (og + 1u == (tg + 1u) * nx) xb_add(&bar[XB_TOPGEN], 1u);
            else XB_SPIN(xb_ld(&bar[XB_TOPGEN]) == tg, bar);
            __builtin_amdgcn_fence(__ATOMIC_ACQUIRE, "agent");
            xb_add(&bar[XB_XGEN(b.x)], 1u);
            asm volatile("s_waitcnt vmcnt(0)" ::: "memory");
        } else {
            XB_SPIN(xb_ld(&bar[XB_XGEN(b.x)]) == gen, bar);
            __builtin_amdgcn_fence(__ATOMIC_ACQUIRE, "agent");
            asm volatile("s_waitcnt vmcnt(0)" ::: "memory");
        }
    }
    __syncthreads();
}

__device__ __forceinline__ void transpose_item(const float* W, int K, int N, bf16* WT, int k0, int n0, int drow0, LAS float* scr, int lane) {
#pragma unroll 8
    for (int i = 0; i < 32; ++i) { const int kk = 2 * i + (lane >> 5); scr[kk * 33 + (lane & 31)] = W[(size_t)(k0 + kk) * N + n0 + (lane & 31)]; }
    LDS_WAIT(); asm volatile("" ::: "memory");
    const int c = lane & 7;
#pragma unroll
    for (int j = 0; j < 4; ++j) { const int n = (lane >> 3) + 8 * j; const LAS float* s = scr + (8 * c) * 33 + n;
        v4u o; o.x = pk2(s[0 * 33], s[1 * 33]); o.y = pk2(s[2 * 33], s[3 * 33]); o.z = pk2(s[4 * 33], s[5 * 33]); o.w = pk2(s[6 * 33], s[7 * 33]);
        *(GAS v4u*)(WT + (size_t)(drow0 + n) * K + k0 + 8 * c) = o; }
    LDS_WAIT(); asm volatile("" ::: "memory");
}
constexpr int IT_QKV = (DM / 64) * (QKVD / 32), IT_SQ = (DM / 64) * (DM / 32), IT_IN = (DM / 64) * (6144 / 32), IT_GU = (DM / 64) * (NGU / 32), IT_DN = (DFF / 64) * (DM / 32);
constexpr int IT_TOTAL = 3 * IT_QKV + 4 * IT_SQ + IT_IN + 4 * IT_GU + 4 * IT_DN;

struct Args { const float* in[33]; float* out; unsigned char* ws; int ph_lo, ph_hi; };

__device__ __forceinline__ void weight_item(const Args& A, int it, LAS float* scr, int lane) {
    unsigned char* ws = A.ws;
    const float* src; bf16* dst; int K = DM, N; bool gu = false; int r = it;
    if (r < 3 * IT_QKV) { const int m = r / IT_QKV; r -= m * IT_QKV; N = QKVD;
        src = (m < 2) ? A.in[12] + (size_t)m * DM * QKVD : A.in[26]; dst = (bf16*)(ws + WS_WQKV0 + (size_t)m * W_QKV); }
    else if ((r -= 3 * IT_QKV) < 4 * IT_SQ) { const int m = r / IT_SQ; r -= m * IT_SQ; N = DM;
        src = (m < 2) ? A.in[13] + (size_t)m * DM * DM : (m == 2 ? A.in[29] : A.in[25]); dst = (bf16*)(ws + WS_WO0 + (size_t)m * W_SQ); }
    else if ((r -= 4 * IT_SQ) < IT_IN) { N = 6144; src = A.in[15]; dst = (bf16*)(ws + WS_WHI); }
    else if ((r -= IT_IN) < 4 * IT_GU) { const int m = r / IT_GU; r -= m * IT_GU; N = NGU; gu = true;
        src = A.in[30] + (size_t)m * DM * NGU; dst = (bf16*)(ws + WS_WGU + (size_t)m * W_GU); }
    else { r -= 4 * IT_GU; const int m = r / IT_DN; r -= m * IT_DN; N = DM; K = DFF;
        src = A.in[31] + (size_t)m * DFF * DM; dst = (bf16*)(ws + WS_WDN + (size_t)m * W_DN); }
    const int nblk = N / 32, kb = r / nblk, nb = r % nblk, k0 = 64 * kb, n0 = 32 * nb;
    int drow0 = n0;
    if (gu) { const int isu = n0 >= DFF ? 1 : 0; const int j = n0 - isu * DFF; drow0 = (j >> 7) * 256 + isu * 128 + (j & 127); }
    transpose_item(src, K, N, dst, k0, n0, drow0, scr, lane);
}

__device__ __forceinline__ void adaln_partial_unit(const Args& A, int u, LAS float* scr, int lane) {
    const int layer = u / 384, kc = (u / 48) % 8, cg = u % 48;
    const float* cctx = A.in[7]; const float* cin = A.in[6];
    for (int idx = lane; idx < 9 * 256; idx += 64) { const int c = idx >> 8, kk = idx & 255, k = kc * 256 + kk;
        const float v = (c == 0) ? cctx[k] : cin[(size_t)(c - 1) * DM + k]; scr[idx] = v / (1.0f + expf(-v)); }
    LDS_WAIT(); asm volatile("" ::: "memory");
    f32x4 acc[9];
#pragma unroll
    for (int c = 0; c < 9; ++c) acc[c] = (f32x4){0.f, 0.f, 0.f, 0.f};
    const float* wp = A.in[10] + (size_t)layer * DM * 12288 + (size_t)(kc * 256) * 12288 + cg * 256 + lane * 4;
#pragma unroll 8
    for (int kk = 0; kk < 256; ++kk) { const f32x4 w = *(const GAS f32x4*)(wp + (size_t)kk * 12288);
#pragma unroll
        for (int c = 0; c < 9; ++c) acc[c] += scr[c * 256 + kk] * w; }
    float* mp = (float*)(A.ws + WS_MODP) + (size_t)((layer * 8 + kc) * 9) * 12288 + cg * 256 + lane * 4;
#pragma unroll
    for (int c = 0; c < 9; ++c) *(f32x4*)(mp + (size_t)c * 12288) = acc[c];
    LDS_WAIT(); asm volatile("" ::: "memory");
}

__device__ __forceinline__ void filter_a2_row(const Args& A, int rr, int lane) {
    const int L = rr < 2048 ? 2048 : 256, t = rr < 2048 ? rr : rr - 2048;
    const float tn = (float)t / (float)(L - 1), w = 6.283185307179586f * (float)t / (float)L;
    float feat = 0.f;
    if (lane == 0) feat = tn;
    else if (lane <= 16) feat = cosf(w * (1e-4f + (float)(lane - 1) * ((15.0f - 1e-4f) / 15.0f)));
    else if (lane <= 32) feat = -sinf(w * (1e-4f + (float)(lane - 17) * ((15.0f - 1e-4f) / 15.0f)));
    const float* w1 = A.in[18]; const float* b1 = A.in[19]; const float* w2 = A.in[20]; const float* b2 = A.in[21]; const float* fq = A.in[23];
    float s = b1[lane];
    for (int f = 0; f < 33; ++f) s += __shfl(feat, f) * w1[f * 64 + lane];
    const float a1 = sinf(fq[lane] * s);
    float s2 = b2[lane];
    for (int k = 0; k < 64; ++k) s2 += __shfl(a1, k) * w2[k * 64 + lane];
    ((float*)(A.ws + WS_A2))[(size_t)rr * 64 + lane] = sinf(fq[64 + lane] * s2);
}

__device__ __forceinline__ void filter_hf_unit(const Args& A, int u, LAS float* scr, int lane) {
    const int variant = u < 2048 ? 0 : 1; const int uu = variant ? u - 2048 : u; const int tch = uu >> 7, cgp = uu & 127;
    const int L = variant ? 256 : 2048; const int col = cgp * 64 + lane, side = col >> 12, order = (col >> 11) & 1, d = col & 2047;
    const float* w3 = A.in[22];
    float w3r[64];
#pragma unroll
    for (int k = 0; k < 64; ++k) w3r[k] = w3[(size_t)k * 8192 + col];
    constexpr float MIND = -3.0701134573253944f, MAXD = -15.350567286626972f;
    const float delta = fabsf(MIND + (MAXD - MIND) * ((float)d / 2047.0f));
    const float* a2 = (const float*)(A.ws + WS_A2) + (size_t)(variant ? 2048 : 0) * 64;
    bf16* ft = (bf16*)(A.ws + (variant ? WS_FT_CTX : WS_FT)) + ((size_t)(order * 2048 + d) * 2 + side) * L;
    const float rl1 = 1.0f / (float)(L - 1);
    float asum = 0.f;
#pragma unroll 1
    for (int half = 0; half < 2; ++half) {
        const int tb = tch * 128 + half * 64;
        { const GAS f32x4* src = (const GAS f32x4*)(a2 + (size_t)(tb + lane) * 64);
#pragma unroll
          for (int q = 0; q < 16; ++q) *(LAS f32x4*)(scr + lane * 64 + q * 4) = src[q]; }
        LDS_WAIT(); asm volatile("" ::: "memory");
#pragma unroll 1
        for (int tt = 0; tt < 64; tt += 2) {
            float s0 = 0.f, s1 = 0.f;
#pragma unroll
            for (int q = 0; q < 16; ++q) { const f32x4 x0 = *(const LAS f32x4*)(scr + tt * 64 + q * 4), x1 = *(const LAS f32x4*)(scr + (tt + 1) * 64 + q * 4);
                s0 += x0.x * w3r[4 * q] + x0.y * w3r[4 * q + 1] + x0.z * w3r[4 * q + 2] + x0.w * w3r[4 * q + 3];
                s1 += x1.x * w3r[4 * q] + x1.y * w3r[4 * q + 1] + x1.z * w3r[4 * q + 2] + x1.w * w3r[4 * q + 3]; }
            const int t = tb + tt;
            s0 *= expf(-((float)t * rl1) * delta); s1 *= expf(-((float)(t + 1) * rl1) * delta);
            if (!(side == 1 && t == 0)) asum += fabsf(s0);
            asum += fabsf(s1);
            *(GAS unsigned*)(ft + t) = pk2(s0, s1);
        }
        LDS_WAIT(); asm volatile("" ::: "memory");
    }
    ((float*)(A.ws + WS_NP))[(size_t)(variant ? 16 + tch : tch) * 8192 + col] = asum;
}

__device__ __forceinline__ void norm_row(const float* xrow, const float* Ac, const float* Sc, bf16* orow, int lane) {
    const GAS f32x4* xr = (const GAS f32x4*)xrow + lane;
    f32x4 v[8]; float s = 0.f;
#pragma unroll
    for (int j = 0; j < 8; ++j) { v[j] = xr[64 * j]; s += (v[j].x * v[j].x + v[j].y * v[j].y) + (v[j].z * v[j].z + v[j].w * v[j].w); }
    const float rstd = 1.0f / sqrtf(wave_sum(s) * (1.0f / DM) + 1e-6f);
    GAS v2u* o8 = (GAS v2u*)orow + lane;
#pragma unroll
    for (int j = 0; j < 8; ++j) { const f32x4 a = *((const GAS f32x4*)Ac + lane + 64 * j), b = *((const GAS f32x4*)Sc + lane + 64 * j);
        const f32x4 y = v[j] * rstd * a + b; v2u w; w.x = pk2(y.x, y.y); w.y = pk2(y.z, y.w); o8[64 * j] = w; }
}
__device__ __forceinline__ void final_norm_row(float* xrow, const float* g, int lane) {
    GAS f32x4* xr = (GAS f32x4*)xrow + lane;
    f32x4 v[8]; float s = 0.f;
#pragma unroll
    for (int j = 0; j < 8; ++j) { v[j] = xr[64 * j]; s += (v[j].x * v[j].x + v[j].y * v[j].y) + (v[j].z * v[j].z + v[j].w * v[j].w); }
    const float rstd = 1.0f / sqrtf(wave_sum(s) * (1.0f / DM) + 1e-6f);
#pragma unroll
    for (int j = 0; j < 8; ++j) { const f32x4 a = *((const GAS f32x4*)g + lane + 64 * j); xr[64 * j] = v[j] * rstd * a; }
}

__device__ __forceinline__ void qkpost_row(bf16* qkv_row, int row, bool is_ax, const float* qg, const float* kg, float* state_k, int lane) {
    const bool is_lat = row >= NCTX;
    const int hsub = lane >> 4, a = (lane >> 3) & 1, i0 = (lane & 7) * 4;
    float cs[4], sn[4];
    if (is_lat) { const int t = (row - NCTX) & 2047; const float pos = (float)(a == 0 ? (t >> 6) : (t & 63));
#pragma unroll
        for (int e = 0; e < 4; ++e) { const float inv = expf(-(float)(i0 + e) * (9.210340371976184f / 32.0f)); sn[e] = sinf(pos * inv); cs[e] = cosf(pos * inv); } }
#pragma unroll
    for (int grp = 0; grp < 5; ++grp) {
        const int head = 4 * grp + hsub;
        bf16* base = qkv_row + head * 128 + a * 64 + i0;
        const v2u r1 = *(const GAS v2u*)base, r2 = *(const GAS v2u*)(base + 32);
        float x1[4] = {bflo(r1.x), bfhi(r1.x), bflo(r1.y), bfhi(r1.y)}, x2[4] = {bflo(r2.x), bfhi(r2.x), bflo(r2.y), bfhi(r2.y)};
        if (is_ax) {
            float ss = 0.f;
#pragma unroll
            for (int e = 0; e < 4; ++e) ss += x1[e] * x1[e] + x2[e] * x2[e];
            ss += __shfl_xor(ss, 1); ss += __shfl_xor(ss, 2); ss += __shfl_xor(ss, 4); ss += __shfl_xor(ss, 8);
            const float rstd = 1.0f / sqrtf(ss * (1.0f / 128.0f) + 1e-6f);
            const float* G = (head < 16 ? qg : kg) + a * 64 + i0;
#pragma unroll
            for (int e = 0; e < 4; ++e) { x1[e] = x1[e] * rstd * G[e]; x2[e] = x2[e] * rstd * G[32 + e]; }
        }
        if (is_lat) {
#pragma unroll
            for (int e = 0; e < 4; ++e) { const float y1 = x1[e] * cs[e] - x2[e] * sn[e], y2 = x2[e] * cs[e] + x1[e] * sn[e]; x1[e] = y1; x2[e] = y2; }
        }
        if (is_ax || is_lat) { v2u w1, w2; w1.x = pk2(x1[0], x1[1]); w1.y = pk2(x1[2], x1[3]); w2.x = pk2(x2[0], x2[1]); w2.y = pk2(x2[2], x2[3]);
            *(GAS v2u*)base = w1; *(GAS v2u*)(base + 32) = w2; }
        if (is_ax && !is_lat && head >= 16) { float* sp = state_k + (size_t)row * 512 + (head - 16) * 128 + a * 64 + i0;
            *(GAS f32x4*)sp = (f32x4){x1[0], x1[1], x1[2], x1[3]}; *(GAS f32x4*)(sp + 32) = (f32x4){x2[0], x2[1], x2[2], x2[3]}; }
    }
}

namespace hy {
constexpr int CPY_STRIDE = 8480;
constexpr int U_OFF = 8 * CPY_STRIDE;
constexpr int U_BYTES = 6144;
static_assert(U_OFF + 8 * U_BYTES <= RING_BYTES, "hyena LDS map");

__device__ __forceinline__ void build_copies(LAS unsigned char* lds, const bf16* ft, int L, int tid) {
    if (tid < 264) { const int c = tid / 33, e = tid % 33; const int qq = (e < 17 - c) ? e : 2 * L + 16 - c + (e - (17 - c));
        *(LAS unsigned short*)(lds + c * CPY_STRIDE + qq * 2) = 0; }
    if (tid < 2 * L / 8) { const int side = tid / (L / 8), t8 = (tid % (L / 8)) * 8;
        const v4u raw = *(const GAS v4u*)(ft + (size_t)side * L + t8);
        const unsigned wds[4] = {raw.x, raw.y, raw.z, raw.w};
#pragma unroll
        for (int e = 0; e < 8; ++e) { const int t = t8 + e; const unsigned short val = (unsigned short)((e & 1) ? (wds[e >> 1] >> 16) : (wds[e >> 1] & 0xffffu));
            if (!(side == 1 && t == 0)) { const int p = side == 0 ? L - t : L + t;
#pragma unroll
                for (int c = 0; c < 8; ++c) *(LAS unsigned short*)(lds + c * CPY_STRIDE + (p + 16 - c) * 2) = val; } } }
}
__device__ __forceinline__ void fill_u(LAS unsigned char* ub, const bf16* urow, int L, float w0, float w1, float w2, float bb, int lane) {
    { const int e0 = lane < 32 ? lane * 8 : L + 256 + (lane - 32) * 8; *(LAS v4u*)(ub + e0 * 2) = (v4u){0u, 0u, 0u, 0u}; }
    for (int q = lane; q < L / 8; q += 64) { const int s0 = 8 * q;
        const v4u raw = *(const GAS v4u*)(urow + s0);
        const float prev = s0 > 0 ? bf2f(urow[s0 - 1]) : 0.f, next = s0 + 8 < L ? bf2f(urow[s0 + 8]) : 0.f;
        const float x[10] = {prev, bflo(raw.x), bfhi(raw.x), bflo(raw.y), bfhi(raw.y), bflo(raw.z), bfhi(raw.z), bflo(raw.w), bfhi(raw.w), next};
        float y[8];
#pragma unroll
        for (int j = 0; j < 8; ++j) y[j] = w0 * x[j] + w1 * x[j + 1] + w2 * x[j + 2] + bb;
        v4u o; o.x = pk2(y[0], y[1]); o.y = pk2(y[2], y[3]); o.z = pk2(y[4], y[5]); o.w = pk2(y[6], y[7]);
        *(LAS v4u*)(ub + (256 + s0) * 2) = o; }
}
template <int NT>
__device__ __forceinline__ void toeplitz(const LAS unsigned char* cpy, const LAS unsigned char* ub, f32x4 (&acc)[NT], int lane) {
    constexpr int L = 256 * NT;
    const int i = lane & 15, g = lane >> 4, c = (-i) & 7;
    const LAS unsigned char* ap = cpy + c * CPY_STRIDE + 2 * (L + 8 * g + 16 - i - c);
    const LAS unsigned char* bp = ub + 2 * (256 + 8 * g + 16 * i);
#pragma unroll 1
    for (int db = -(L / 32 - 1); db <= L / 32; ++db) {
        const int delta = 32 * db;
        const bf16x8 a = *(const LAS bf16x8*)(ap - 2 * delta);
#pragma unroll
        for (int k = 0; k < NT; ++k) { const int S = 256 * k - delta;
            if (S >= -256 && S <= L - 32) { const bf16x8 b = *(const LAS bf16x8*)(bp + 2 * S);
                acc[k] = __builtin_amdgcn_mfma_f32_16x16x32_bf16(a, b, acc[k], 0, 0, 0); } }
    }
}
template <int NT>
__device__ __forceinline__ void gate(const f32x4 (&acc)[NT], LAS unsigned char* ub, const bf16* xg, float cw0, float cw1, float cw2, float cb, float invn, float skip, int lane, bool last, bf16* zt) {
    constexpr int L = 256 * NT;
    const int sg = lane & 15, g = lane >> 4;
#pragma unroll
    for (int k = 0; k < NT; ++k) { const int t0 = 256 * k + 16 * sg + 4 * g;
        const v2u ur = *(const LAS v2u*)(ub + (256 + t0) * 2);
        const v2u xr = *(const GAS v2u*)(xg + t0);
        const float prev = t0 > 0 ? bf2f(xg[t0 - 1]) : 0.f, next = t0 + 4 < L ? bf2f(xg[t0 + 4]) : 0.f;
        const float x[6] = {prev, bflo(xr.x), bfhi(xr.x), bflo(xr.y), bfhi(xr.y), next};
        const float uu[4] = {bflo(ur.x), bfhi(ur.x), bflo(ur.y), bfhi(ur.y)};
        float z[4];
#pragma unroll
        for (int r = 0; r < 4; ++r) { const float xc = cw0 * x[r] + cw1 * x[r + 1] + cw2 * x[r + 2] + cb; z[r] = xc * (acc[k][r] * invn + skip * uu[r]); }
        v2u o; o.x = pk2(z[0], z[1]); o.y = pk2(z[2], z[3]);
        if (last) *(GAS v2u*)(zt + t0) = o; else *(LAS v2u*)(ub + (256 + t0) * 2) = o; }
}
}

constexpr int NPHASE = 35;
#ifndef PHMASK
#define PHMASK 0xFFFF
#endif
#define PHON(b) ((PHMASK >> (b)) & 1)
#ifndef MK_PER_PHASE
#define MK_PER_PHASE 0
#endif


template <class T> __device__ __forceinline__ T* launder(T* p) { asm volatile("" : "+s"(p)); return p; }
#define ENV_IDS int tid_ = threadIdx.x; asm volatile("" : "+v"(tid_)); const int tid = tid_, lane = tid & 63, wave = __builtin_amdgcn_readfirstlane(tid >> 6); const int G = gridDim.x, bx = blockIdx.x; \
    const int vcu = (G % 8 == 0) ? (bx % 8) * (G / 8) + bx / 8 : bx; const int gw = vcu * NWAVES + wave, NGW = G * NWAVES; (void)tid; (void)lane; (void)gw; (void)NGW; (void)bx;
#define ENV_PTRS unsigned char* ws = launder(A.ws); float* out = launder(A.out); (void)out; (void)ws;

__device__ __forceinline__ void ph_prologue_a(const Args& A, LAS unsigned char* L) {
    ENV_IDS ENV_PTRS
    LAS float* wscr = (LAS float*)(L + wave * 16384);
    for (int it = gw; it < IT_TOTAL; it += NGW) weight_item(A, it, wscr, lane);
    { const size_t NCH = (size_t)2 * 524288 + 2 * 262144;
      for (size_t ch = (size_t)gw * 64 + lane; ch < NCH; ch += (size_t)NGW * 64) {
          int ten; size_t off; unsigned char* dstb;
          if (ch < 524288) { ten = 0; off = ch * 8; dstb = ws + WS_CWK; } else if (ch < 1048576) { ten = 1; off = (ch - 524288) * 8; dstb = ws + WS_CWV; }
          else if (ch < 1310720) { ten = 2; off = (ch - 1048576) * 8; dstb = ws + WS_CAK; } else { ten = 3; off = (ch - 1310720) * 8; dstb = ws + WS_CAV; }
          const float* src = A.in[2 + ten] + off; const f32x4 a = *(const GAS f32x4*)src, b = *(const GAS f32x4*)(src + 4);
          v4u o; o.x = pk2(a.x, a.y); o.y = pk2(a.z, a.w); o.z = pk2(b.x, b.y); o.w = pk2(b.z, b.w);
          *(GAS v4u*)((bf16*)dstb + off) = o; } }
    for (int u = gw; u < 1536; u += NGW) adaln_partial_unit(A, __builtin_amdgcn_readfirstlane(u), wscr, lane);
    for (int rr = gw; rr < 2304; rr += NGW) filter_a2_row(A, __builtin_amdgcn_readfirstlane(rr), lane);
}
__device__ __forceinline__ void ph_prologue_b(const Args& A, LAS unsigned char* L) {
    ENV_IDS ENV_PTRS
    LAS float* wscr = (LAS float*)(L + wave * 16384);
    float* MODF = (float*)(ws + WS_MODF);
    for (int e = gw * 64 + lane; e < DEPTH * 9 * DM; e += NGW * 64) { const int layer = e / (9 * DM), c = (e / DM) % 9, col = e % DM;
        float m[6];
#pragma unroll
        for (int q = 0; q < 6; ++q) { float s = A.in[11][(size_t)layer * 12288 + q * DM + col];
#pragma unroll
            for (int kc = 0; kc < 8; ++kc) s += ((const float*)(ws + WS_MODP))[(size_t)((layer * 8 + kc) * 9 + c) * 12288 + q * DM + col];
            m[q] = s; }
        float* mf = MODF + (size_t)((layer * 9 + c) * 6) * DM + col;
        mf[0 * DM] = A.in[8][layer * DM + col] * (1.0f + m[1]); mf[1 * DM] = m[0]; mf[2 * DM] = m[2];
        mf[3 * DM] = A.in[9][layer * DM + col] * (1.0f + m[4]); mf[4 * DM] = m[3]; mf[5 * DM] = m[5]; }
    for (int u = gw; u < 2304; u += NGW) filter_hf_unit(A, __builtin_amdgcn_readfirstlane(u), wscr, lane);
}
__device__ __forceinline__ void ph_norm(const Args& A, int layer, int which) {
    ENV_IDS ENV_PTRS
    const float* modf = (const float*)(ws + WS_MODF) + (size_t)layer * 9 * 6 * DM; bf16* HB = (bf16*)(ws + WS_H);
    const float* xc = (layer == 0 && which == 0) ? A.in[0] : out; const float* xl = (layer == 0 && which == 0) ? A.in[1] : out + (size_t)NCTX * DM;
    for (int row = gw; row < NTOK; row += NGW) { const int cv = row < NCTX ? 0 : 1 + ((row - NCTX) >> 11);
        const float* xr = row < NCTX ? xc + (size_t)row * DM : xl + (size_t)(row - NCTX) * DM;
        norm_row(xr, modf + (size_t)(cv * 6 + 3 * which) * DM, modf + (size_t)(cv * 6 + 3 * which + 1) * DM, HB + (size_t)row * DM, lane); }
}
__device__ __forceinline__ void ph_qkv(const Args& A, int layer, LAS unsigned char* L) {
    ENV_PTRS
    const int G = gridDim.x, bx = blockIdx.x; const bool is_ax = (layer % 3) == 2; const int jx = layer / 3;
    const bf16* W = (const bf16*)(ws + (is_ax ? WS_WQKVA : (jx == 0 ? WS_WQKV0 : WS_WQKV1)));
    pg8::Gemm g{(const bf16*)(ws + WS_H), W, NTOK, QKVD, DM}; pg8::StaticOrder S; S.init(NTOK, QKVD, G, bx);
    pg8::EpiQKV E{(bf16*)(ws + WS_BIG), is_ax ? nullptr : out + OUT_WK + (size_t)jx * 256 * 512, is_ax ? out + OUT_AV : out + OUT_WV + (size_t)jx * 256 * 512, is_ax ? 0 : 256};
    pg8::gemm_phase<pg8::EpiQKV, pg8::StaticOrder, true, true>(L, g, S, E);
}
__device__ __forceinline__ void ph_qkpost(const Args& A, int layer) {
    ENV_IDS ENV_PTRS
    const bool is_ax = (layer % 3) == 2; bf16* QKVB = (bf16*)(ws + WS_BIG);
    for (int row = (is_ax ? 0 : NCTX) + gw; row < NTOK; row += NGW)
        qkpost_row(QKVB + (size_t)row * QKVD, row, is_ax, A.in[27], A.in[28], out + OUT_AK, lane);
}
__device__ __forceinline__ void ph_attn(const Args& A, int layer, char* lds) {
    ENV_PTRS
    const int G = gridDim.x, bx = blockIdx.x; const bool is_ax = (layer % 3) == 2; const int jx = layer / 3;
    const att::bf16* QK = (const att::bf16*)(ws + WS_BIG); att::bf16* OB = (att::bf16*)(ws + WS_H);
    const att::bf16* CK = (const att::bf16*)(ws + (is_ax ? WS_CAK : WS_CWK));
    const att::bf16* CV = (const att::bf16*)(ws + (is_ax ? WS_CAV : WS_CWV));
    const int ncl = is_ax ? 1 : 2;
#pragma unroll 1
    for (int u = bx; u < 1536; u += G) {
        att::Unit U;
        if (u < 1024) { const int b = u >> 7, qb = (u >> 4) & 7, h = u & 15, kvh = h >> 2;
            const size_t r0 = (size_t)NCTX + (size_t)b * 2048 + (size_t)qb * 256;
            U.Q = QK + r0 * QKVD + h * 128; U.ldq = QKVD;
            const size_t coff = ((size_t)(b * ncl + (is_ax ? 0 : jx)) * 512) * 512 + kvh * 128;
            U.KA = CK + coff; U.VA = CV + coff; U.ldA = 512; U.nA = 8;
            const int klo = is_ax ? 0 : (qb * 256 - 128 < 0 ? 0 : qb * 256 - 128), khi = is_ax ? 2048 : (qb * 256 + 384 > 2048 ? 2048 : qb * 256 + 384);
            const size_t kr0 = (size_t)NCTX + (size_t)b * 2048 + klo;
            U.KB = QK + kr0 * QKVD + 2048 + kvh * 128; U.VB = QK + kr0 * QKVD + 2560 + kvh * 128; U.ldB = QKVD;
            U.NT = 8 + (khi - klo) / 64; U.win = is_ax ? 0 : 1; U.dq0 = qb * 256 - klo;
            U.O = OB + r0 * DM + h * 128; U.ldo = DM;
            U.has_sink = is_ax ? 0 : 1; U.sink = is_ax ? 0.f : A.in[14][jx * 16 + h];
        } else { const int uc = u - 1024, b = uc >> 4, h = uc & 15, kvh = h >> 2; const size_t r0 = (size_t)b * 256;
            U.Q = QK + r0 * QKVD + h * 128; U.ldq = QKVD;
            U.KA = QK + r0 * QKVD + 2048 + kvh * 128; U.VA = QK + r0 * QKVD + 2560 + kvh * 128; U.ldA = QKVD; U.nA = 4;
            U.KB = U.KA; U.VB = U.VA; U.ldB = QKVD; U.NT = 4; U.win = 0; U.dq0 = 0;
            U.O = OB + r0 * DM + h * 128; U.ldo = DM;
            U.has_sink = is_ax ? 0 : 1; U.sink = is_ax ? 0.f : A.in[14][jx * 16 + h];
        }
        att::attn_unit(U, lds);
    }
}
__device__ __forceinline__ void ph_hyin(const Args& A, LAS unsigned char* L) {
    ENV_PTRS
    const int G = gridDim.x, bx = blockIdx.x;
    pg8::Gemm g{(const bf16*)(ws + WS_WHI), (const bf16*)(ws + WS_H), 6144, NTOK, DM}; pg8::StaticOrder S; S.init(6144, NTOK, G, bx);
    pg8::EpiBf16 E{(bf16*)(ws + WS_BIG), NTOK};
    pg8::gemm_phase<pg8::EpiBf16, pg8::StaticOrder, true, true>(L, g, S, E);
}
__device__ __forceinline__ void ph_hyconv(const Args& A, LAS unsigned char* L) {
    ENV_IDS ENV_PTRS
    const bf16* UT = (const bf16*)(ws + WS_BIG); bf16* ZT = (bf16*)(ws + WS_ZT);
    const float* cw = A.in[16]; const float* cbv = A.in[17]; const float* skp = A.in[24]; const float* NP = (const float*)(ws + WS_NP);
    LAS unsigned char* ub = L + hy::U_OFF + wave * hy::U_BYTES;
#pragma unroll 1
    for (int d = bx; d < DM; d += G) {
        float w0[3], w1[3], w2[3], cb[3];
#pragma unroll
        for (int p = 0; p < 3; ++p) { const int ch = p * DM + d; w0[p] = cw[ch]; w1[p] = cw[6144 + ch]; w2[p] = cw[2 * 6144 + ch]; cb[p] = cbv[ch]; }
        float invn[2][2];
#pragma unroll
        for (int o = 0; o < 2; ++o) { float sl = 0.f, sc = 0.f;
            for (int ch = 0; ch < 16; ++ch) sl += NP[(size_t)ch * 8192 + o * 2048 + d] + NP[(size_t)ch * 8192 + 4096 + o * 2048 + d];
            for (int ch = 16; ch < 18; ++ch) sc += NP[(size_t)ch * 8192 + o * 2048 + d] + NP[(size_t)ch * 8192 + 4096 + o * 2048 + d];
            invn[0][o] = 1.0f / (sl + 1e-6f); invn[1][o] = 1.0f / (sc + 1e-6f); }
        const float sk0 = skp[d], sk1 = skp[DM + d];
        const bf16* ftl = (const bf16*)(ws + WS_FT) + (size_t)d * 2 * 2048; const bf16* ftc = (const bf16*)(ws + WS_FT_CTX) + (size_t)d * 2 * 256;
        { const size_t sb = (size_t)NCTX + (size_t)wave * 2048;
          hy::fill_u(ub, UT + (size_t)d * NTOK + sb, 2048, w0[0], w1[0], w2[0], cb[0], lane);
          __syncthreads(); hy::build_copies(L, ftl, 2048, tid); __syncthreads();
          f32x4 acc[8];
#pragma unroll
          for (int k = 0; k < 8; ++k) acc[k] = (f32x4){0.f, 0.f, 0.f, 0.f};
          hy::toeplitz<8>(L, ub, acc, lane);
          hy::gate<8>(acc, ub, UT + (size_t)(DM + d) * NTOK + sb, w0[1], w1[1], w2[1], cb[1], invn[0][0], sk0, lane, false, nullptr);
          __syncthreads(); hy::build_copies(L, ftl + (size_t)2048 * 2 * 2048, 2048, tid); __syncthreads();
#pragma unroll
          for (int k = 0; k < 8; ++k) acc[k] = (f32x4){0.f, 0.f, 0.f, 0.f};
          hy::toeplitz<8>(L, ub, acc, lane);
          hy::gate<8>(acc, ub, UT + (size_t)(2 * DM + d) * NTOK + sb, w0[2], w1[2], w2[2], cb[2], invn[0][1], sk1, lane, true, ZT + (size_t)d * NTOK + sb); }
        { for (int q = 0; q < 4; ++q) hy::fill_u(ub + q * 1536, UT + (size_t)d * NTOK + (size_t)(wave * 4 + q) * 256, 256, w0[0], w1[0], w2[0], cb[0], lane);
          __syncthreads(); hy::build_copies(L, ftc, 256, tid); __syncthreads();
#pragma unroll 1
          for (int q = 0; q < 4; ++q) { const size_t sb = (size_t)(wave * 4 + q) * 256; f32x4 acc[1]; acc[0] = (f32x4){0.f, 0.f, 0.f, 0.f};
              hy::toeplitz<1>(L, ub + q * 1536, acc, lane);
              hy::gate<1>(acc, ub + q * 1536, UT + (size_t)(DM + d) * NTOK + sb, w0[1], w1[1], w2[1], cb[1], invn[1][0], sk0, lane, false, nullptr); }
          __syncthreads(); hy::build_copies(L, ftc + (size_t)2048 * 2 * 256, 256, tid); __syncthreads();
#pragma unroll 1
          for (int q = 0; q < 4; ++q) { const size_t sb = (size_t)(wave * 4 + q) * 256; f32x4 acc[1]; acc[0] = (f32x4){0.f, 0.f, 0.f, 0.f};
              hy::toeplitz<1>(L, ub + q * 1536, acc, lane);
              hy::gate<1>(acc, ub + q * 1536, UT + (size_t)(2 * DM + d) * NTOK + sb, w0[2], w1[2], w2[2], cb[2], invn[1][1], sk1, lane, true, ZT + (size_t)d * NTOK + sb); } }
    }
    __syncthreads();
}
__device__ __forceinline__ void ph_hytr(const Args& A, LAS unsigned char* L) {
    ENV_IDS ENV_PTRS
    const bf16* ZT = (const bf16*)(ws + WS_ZT); bf16* HB = (bf16*)(ws + WS_H);
    LAS unsigned char* scr = L + wave * 16384;
    for (int tile = gw; tile < 32 * 384; tile += NGW) { const int d0 = (tile & 31) * 64, r0 = (tile >> 5) * 64;
#pragma unroll
        for (int j = 0; j < 8; ++j) { const int idx = j * 64 + lane, dl = idx >> 3, ch = idx & 7;
            *(LAS v4u*)(scr + dl * 144 + ch * 16) = *(const GAS v4u*)(ZT + (size_t)(d0 + dl) * NTOK + r0 + ch * 8); }
        LDS_WAIT(); asm volatile("" ::: "memory");
#pragma unroll
        for (int j = 0; j < 8; ++j) { unsigned e[8];
#pragma unroll
            for (int q = 0; q < 8; ++q) e[q] = *(const LAS unsigned short*)(scr + (j * 8 + q) * 144 + lane * 2);
            v4u o; o.x = e[0] | (e[1] << 16); o.y = e[2] | (e[3] << 16); o.z = e[4] | (e[5] << 16); o.w = e[6] | (e[7] << 16);
            *(GAS v4u*)(HB + (size_t)(r0 + lane) * DM + d0 + j * 8) = o; }
        LDS_WAIT(); asm volatile("" ::: "memory"); }
}
__device__ __forceinline__ void ph_mixout(const Args& A, int layer, LAS unsigned char* L) {
    ENV_PTRS
    const int G = gridDim.x, bx = blockIdx.x; const int kind = layer % 3, jx = layer / 3;
    const float* modf = (const float*)(ws + WS_MODF) + (size_t)layer * 9 * 6 * DM;
    const float* xc = layer == 0 ? A.in[0] : out; const float* xl = layer == 0 ? A.in[1] : out + (size_t)NCTX * DM;
    const bf16* W = (const bf16*)(ws + (kind == 1 ? WS_WHO : (kind == 2 ? WS_WOA : (jx == 0 ? WS_WO0 : WS_WO1))));
    pg8::Gemm g{(const bf16*)(ws + WS_H), W, NTOK, DM, DM}; pg8::StaticOrder S; S.init(NTOK, DM, G, bx);
    pg8::EpiResid E{xc, xl, out, modf + 2 * DM};
    pg8::gemm_phase<pg8::EpiResid, pg8::StaticOrder, true, true>(L, g, S, E);
}
__device__ __forceinline__ void ph_gu(const Args& A, int layer, LAS unsigned char* L) {
    ENV_PTRS
    const int G = gridDim.x, bx = blockIdx.x;
    pg8::Gemm g{(const bf16*)(ws + WS_H), (const bf16*)(ws + WS_WGU + (size_t)layer * W_GU), NTOK, NGU, DM}; pg8::StaticOrder S; S.init(NTOK, NGU, G, bx);
    pg8::EpiSwiglu E{(bf16*)(ws + WS_BIG)};
    pg8::gemm_phase<pg8::EpiSwiglu, pg8::StaticOrder, true, true>(L, g, S, E);
}
__device__ __forceinline__ void ph_down(const Args& A, int layer, LAS unsigned char* L) {
    ENV_PTRS
    const int G = gridDim.x, bx = blockIdx.x;
    const float* modf = (const float*)(ws + WS_MODF) + (size_t)layer * 9 * 6 * DM;
    pg8::Gemm g{(const bf16*)(ws + WS_BIG), (const bf16*)(ws + WS_WDN + (size_t)layer * W_DN), NTOK, DM, DFF}; pg8::StaticOrder S; S.init(NTOK, DM, G, bx);
    pg8::EpiResid E{out, out + (size_t)NCTX * DM, out, modf + 5 * DM};
    pg8::gemm_phase<pg8::EpiResid, pg8::StaticOrder, true, true>(L, g, S, E);
}
__device__ __forceinline__ void ph_final(const Args& A) {
    ENV_IDS ENV_PTRS
    for (int row = gw; row < NTOK; row += NGW) final_norm_row(out + (size_t)row * DM, A.in[32], lane);
}

__global__ void __launch_bounds__(NWAVES * 64, 2) hybrid_fwd(Args A) {
    extern __shared__ __attribute__((aligned(16))) unsigned char lds[];
    LAS unsigned char* L = (LAS unsigned char*)lds;
    for (int u = threadIdx.x; u < (LDS_BYTES - LDSCTL_OFF) / 4; u += NWAVES * 64) ((LAS unsigned*)(L + LDSCTL_OFF))[u] = 0u;
    __syncthreads();
    XcdBarrier bar; bar.bar = (unsigned*)(A.ws + WS_CTL) + CW_BAR; bar.x = 0; bar.st = nullptr;
    if (!MK_PER_PHASE) bar = xcd_barrier_post((unsigned*)(A.ws + WS_CTL) + CW_BAR, (volatile LAS unsigned*)(L + MISC_OFF) + 8);
    const int lo = A.ph_lo, hi = A.ph_hi;
#define IN(k) (lo <= (k) && (k) < hi)
#define SEAM(k) do { if (IN(k) && IN((k) + 1)) xcd_barrier(bar); } while (0)
    if (PHON(0) && IN(0)) ph_prologue_a(A, L);
    SEAM(0);
    if (PHON(1) && IN(1)) ph_prologue_b(A, L);
    SEAM(1);
#pragma unroll 1
    for (int layer = 0; layer < DEPTH; ++layer) {
        const int pb = 2 + 8 * layer;
        if (PHON(2) && IN(pb + 0)) ph_norm(A, layer, 0);
        SEAM(pb + 0);
        if ((layer % 3) != 1) {
            if (PHON(3) && IN(pb + 1)) ph_qkv(A, layer, L);
            SEAM(pb + 1);
            if (PHON(4) && IN(pb + 2)) ph_qkpost(A, layer);
            SEAM(pb + 2);
            if (PHON(5) && IN(pb + 3)) ph_attn(A, layer, (char*)lds);
            SEAM(pb + 3);
        } else {
            if (PHON(6) && IN(pb + 1)) ph_hyin(A, L);
            SEAM(pb + 1);
            if (PHON(7) && IN(pb + 2)) ph_hyconv(A, L);
            SEAM(pb + 2);
            if (PHON(8) && IN(pb + 3)) ph_hytr(A, L);
            SEAM(pb + 3);
        }
        if (PHON(9) && IN(pb + 4)) ph_mixout(A, layer, L);
        SEAM(pb + 4);
        if (PHON(10) && IN(pb + 5)) ph_norm(A, layer, 1);
        SEAM(pb + 5);
        if (PHON(11) && IN(pb + 6)) ph_gu(A, layer, L);
        SEAM(pb + 6);
        if (PHON(12) && IN(pb + 7)) ph_down(A, layer, L);
        SEAM(pb + 7);
    }
    if (PHON(13) && IN(34)) ph_final(A);
#undef IN
#undef SEAM
}

extern "C" void kernel_launch(void* const* d_in, const int* in_sizes, int n_in, void* d_out, int out_size, void* d_ws, size_t ws_size, hipStream_t stream) {
    static int grid = 0;
    if (grid == 0) {
        if (n_in != 33 || (size_t)out_size != OUT_END || ws_size < WS_END) { fprintf(stderr, "kernel_launch: unexpected shapes: n_in %d out %d ws %zu (need %zu)\n", n_in, out_size, ws_size, (size_t)WS_END); grid = -1; return; }
        int dev = 0, cus = 0, per_cu = 0;
        if (hipGetDevice(&dev) != hipSuccess || hipDeviceGetAttribute(&cus, hipDeviceAttributeMultiprocessorCount, dev) != hipSuccess) { grid = -1; return; }
        if (hipFuncSetAttribute((const void*)hybrid_fwd, hipFuncAttributeMaxDynamicSharedMemorySize, LDS_BYTES) != hipSuccess) { fprintf(stderr, "kernel_launch: hipFuncSetAttribute failed\n"); grid = -1; return; }
        if (hipOccupancyMaxActiveBlocksPerMultiprocessor(&per_cu, (const void*)hybrid_fwd, NWAVES * 64, LDS_BYTES) != hipSuccess || per_cu < 1)
            fprintf(stderr, "kernel_launch: occupancy query reports %d workgroups per CU\n", per_cu);
        (void)hipGetLastError();
        grid = cus;
    }
    if (grid < 0) return;
    if (hipMemsetAsync((char*)d_ws + WS_CTL, 0, CTL_ZERO_BYTES, stream) != hipSuccess) { fprintf(stderr, "kernel_launch: memset failed\n"); return; }
    Args a{};
    for (int i = 0; i < 33; ++i) a.in[i] = (const float*)d_in[i];
    a.out = (float*)d_out; a.ws = (unsigned char*)d_ws;
#if MK_PER_PHASE
    for (int ph = 0; ph < NPHASE; ++ph) { a.ph_lo = ph; a.ph_hi = ph + 1; hipLaunchKernelGGL(hybrid_fwd, dim3(grid), dim3(NWAVES * 64), LDS_BYTES, stream, a); }
#else
    a.ph_lo = 0; a.ph_hi = NPHASE; hipLaunchKernelGGL(hybrid_fwd, dim3(grid), dim3(NWAVES * 64), LDS_BYTES, stream, a);
#endif
    const hipError_t le = hipPeekAtLastError();
    if (le != hipSuccess) fprintf(stderr, "kernel_launch: launch failed: %s\n", hipGetErrorName(le));
}
```

```cpp
#include <hip/hip_runtime.h>
#include <cstdio>
#include <cstdint>
#include <hip/hip_bf16.h>
#include <cmath>
namespace pg8 {
#define PG8_LAS __attribute__((address_space(3)))
typedef unsigned short bf16_t;
typedef short bf16x8 __attribute__((ext_vector_type(8)));
typedef float f32x4 __attribute__((ext_vector_type(4)));
typedef unsigned u32x4 __attribute__((ext_vector_type(4)));
constexpr int BM = 256, BK = 64, HALF = 128, HTB = HALF * BK * 2  , STAGE_BYTES = 8 * HTB, NXCD = 8, WGM = 8;

__host__ __device__ __forceinline__ int lds_byte(int r, int c) { const int st = (r >> 4) * 2 + (c >> 5), rr = r & 15, cc = c & 31, ob = rr * 64 + cc * 2; return st * 1024 + (ob ^ (((ob >> 9) & 1) << 5)); }
__host__ __device__ __forceinline__ void stage_rc(int b, int& R, int& C) { const int st = b / 1024, sb = b % 1024, swz = sb ^ (((sb >> 9) & 1) << 5); R = (st >> 1) * 16 + swz / 64; C = (st & 1) * 32 + (swz % 64) / 2; }
__host__ __device__ __forceinline__ int perm32(int rho) { const int n = rho >> 4, i = rho & 15; return 8 * (i >> 2) + 4 * n + (i & 3); }

struct Unit { int pm, pn; };
struct Gemm { const bf16_t* A; const bf16_t* Bt; int M, N, K; };

struct StaticOrder {
    int nM, nN, nwg, G, c;
    __host__ __device__ void init(int M, int N, int G_, int c_) { nM = M / BM; nN = N / BM; nwg = nM * nN; G = G_; c = c_; }
    __host__ __device__ bool next(int i, Unit& u) const {
        const long L = (long)i * G + c; if (L >= nwg) return false;
        int wgid = (int)L; { const int q = nwg / NXCD, r = nwg % NXCD, xcd = wgid % NXCD, off = wgid / NXCD; wgid = (xcd < r ? xcd * (q + 1) : r * (q + 1) + (xcd - r) * q) + off; }
        const int nig = WGM * nN, gid = wgid / nig, fm = gid * WGM, gsz = (nM - fm) < WGM ? (nM - fm) : WGM;
        u.pm = fm + ((wgid % nig) % gsz); u.pn = (wgid % nig) / gsz; return true;
    }
    __device__ __forceinline__ void a_ready(const Unit&) const {}
    __device__ __forceinline__ void done(const Unit&) const {}
};

__device__ __forceinline__ unsigned cvt_pk_bf16(float lo, float hi) { unsigned r; asm volatile("v_cvt_pk_bf16_f32 %0, %1, %2" : "=v"(r) : "v"(lo), "v"(hi)); return r; }
typedef float f32x2 __attribute__((ext_vector_type(2)));
struct EpiBf16 {
    static constexpr bool PERM = true, AFTER_DRAIN = false;
    bf16_t* O; int ldc;
    __device__ __forceinline__ void operator()(const f32x4 (&acc)[2][2][4][2], const Unit& u, int wr, int wc, int fr, int fq) const {
        const int row0 = u.pm * BM + wr * 64 + fr; const int col0 = u.pn * BM + wc * 32 + 8 * fq;
#pragma unroll
        for (int ai = 0; ai < 2; ++ai)
#pragma unroll
            for (int m = 0; m < 4; ++m) { bf16_t* rowp = O + (size_t)(row0 + ai * HALF + m * 16) * ldc + col0;
#pragma unroll
                for (int bj = 0; bj < 2; ++bj) { const f32x4 v0 = acc[ai][bj][m][0], v1 = acc[ai][bj][m][1];
                    u32x4 w; w.x = cvt_pk_bf16(v0[0], v0[1]); w.y = cvt_pk_bf16(v0[2], v0[3]); w.z = cvt_pk_bf16(v1[0], v1[1]); w.w = cvt_pk_bf16(v1[2], v1[3]);
                    *(u32x4*)(rowp + bj * HALF) = w; } }
    }
};
struct EpiQKV {
    static constexpr bool PERM = true, AFTER_DRAIN = false;
    bf16_t* O; float* sk; float* sv; int extra;
    __device__ __forceinline__ void operator()(const f32x4 (&acc)[2][2][4][2], const Unit& u, int wr, int wc, int fr, int fq) const {
        const int row0 = u.pm * BM + wr * 64 + fr; const int col0 = u.pn * BM + wc * 32 + 8 * fq;
        float* sb = nullptr; int scol = 0;
        if (u.pm < 32 && u.pn >= 8) { if (u.pn < 10) { sb = sk; scol = col0 - 2048; } else { sb = sv; scol = col0 - 2560; } }
#pragma unroll
        for (int ai = 0; ai < 2; ++ai)
#pragma unroll
            for (int m = 0; m < 4; ++m) { const int row = row0 + ai * HALF + m * 16; bf16_t* rowp = O + (size_t)row * 3072 + col0;
#pragma unroll
                for (int bj = 0; bj < 2; ++bj) { const f32x4 v0 = acc[ai][bj][m][0], v1 = acc[ai][bj][m][1];
                    u32x4 w; w.x = cvt_pk_bf16(v0[0], v0[1]); w.y = cvt_pk_bf16(v0[2], v0[3]); w.z = cvt_pk_bf16(v1[0], v1[1]); w.w = cvt_pk_bf16(v1[2], v1[3]);
                    *(u32x4*)(rowp + bj * HALF) = w;
                    if (sb) { float* sp = sb + (size_t)(row + (row >> 8) * extra) * 512 + scol + bj * HALF; *(f32x4*)sp = v0; *(f32x4*)(sp + 4) = v1; } } }
    }
};
struct EpiResid {
    static constexpr bool PERM = false, AFTER_DRAIN = false;
    const float* xc; const float* xl; float* out; const float* gate;
    __device__ __forceinline__ void operator()(const f32x4 (&acc)[2][2][4][2], const Unit& u, int wr, int wc, int fr, int fq) const {
        const int row0 = u.pm * BM + wr * 64 + fr; const int col0 = u.pn * BM + wc * 32 + 4 * fq;
        const int cv = u.pm < 32 ? 0 : 1 + ((u.pm - 32) >> 3);
        const float* gp = gate + (size_t)cv * (6 * 2048) + col0;
        const float* xin = u.pm < 32 ? xc + (size_t)row0 * 2048 + col0 : xl + (size_t)(row0 - 8192) * 2048 + col0;
        float* op = out + (size_t)row0 * 2048 + col0;
        f32x4 gv[2][2];
#pragma unroll
        for (int bj = 0; bj < 2; ++bj)
#pragma unroll
            for (int n = 0; n < 2; ++n) gv[bj][n] = *(const f32x4*)(gp + bj * HALF + n * 16);
#pragma unroll
        for (int ai = 0; ai < 2; ++ai)
#pragma unroll
            for (int m = 0; m < 4; ++m) { const size_t ro = (size_t)(ai * HALF + m * 16) * 2048;
#pragma unroll
                for (int bj = 0; bj < 2; ++bj)
#pragma unroll
                    for (int n = 0; n < 2; ++n) { const f32x4 x = *(const f32x4*)(xin + ro + bj * HALF + n * 16);
                        *(f32x4*)(op + ro + bj * HALF + n * 16) = x + gv[bj][n] * acc[ai][bj][m][n]; }
                if (m & 1) asm volatile("" ::: "memory"); }
    }
};
struct EpiSwiglu {
    static constexpr bool PERM = true, AFTER_DRAIN = false;
    bf16_t* O;
    __device__ __forceinline__ float sw(float g, float uu) const { return g * __builtin_amdgcn_rcpf(1.0f + __builtin_amdgcn_exp2f(-1.4426950408889634f * g)) * uu; }
    __device__ __forceinline__ void operator()(const f32x4 (&acc)[2][2][4][2], const Unit& u, int wr, int wc, int fr, int fq) const {
        const int row0 = u.pm * BM + wr * 64 + fr; const int col0 = u.pn * HALF + wc * 32 + 8 * fq;
#pragma unroll
        for (int ai = 0; ai < 2; ++ai)
#pragma unroll
            for (int m = 0; m < 4; ++m) { bf16_t* rowp = O + (size_t)(row0 + ai * HALF + m * 16) * 5632 + col0;
                const f32x4 g0 = acc[ai][0][m][0], g1 = acc[ai][0][m][1], u0 = acc[ai][1][m][0], u1 = acc[ai][1][m][1];
                u32x4 w; w.x = cvt_pk_bf16(sw(g0[0], u0[0]), sw(g0[1], u0[1])); w.y = cvt_pk_bf16(sw(g0[2], u0[2]), sw(g0[3], u0[3]));
                w.z = cvt_pk_bf16(sw(g1[0], u1[0]), sw(g1[1], u1[1])); w.w = cvt_pk_bf16(sw(g1[2], u1[2]), sw(g1[3], u1[3]));
                *(u32x4*)rowp = w; }
    }
};

template <class Epi, class Sched, bool ALIGN_EPI = false, bool SP2 = false>
__device__ __forceinline__ void gemm_phase(PG8_LAS unsigned char* lds, const Gemm g, const Sched& S, const Epi& E) {
    int tid_ = threadIdx.x; asm volatile("" : "+v"(tid_));
    const int tid = tid_, wid = __builtin_amdgcn_readfirstlane(tid >> 6), lane = tid & 63, wr = wid >> 2, wc = wid & 3, fr = lane & 15, fq = lane >> 4;
    const int K = g.K, nt = K / BK;
    unsigned voffA[2], voffB[2];
#pragma unroll
    for (int i = 0; i < 2; ++i) { int R, C; stage_rc(tid * 16 + i * 8192, R, C); const int Rb = Epi::PERM ? ((R & ~31) + perm32(R & 31)) : R;
        voffA[i] = (unsigned)(R * K + C) * 2u; voffB[i] = (unsigned)(Rb * K + C) * 2u; }
    const size_t kstep = (size_t)(BK * 2);
    const size_t hstep = (size_t)HALF * K * 2;
    const size_t tstep = 2 * hstep;
    const unsigned ldsw = (unsigned)wid * 1024u;
    const int aoff = lds_byte(wr * 64 + fr, fq * 8), boff = lds_byte(wc * 32 + fr, fq * 8);
#define PG8_SA(b, h) (((b) * 2 + (h)) * HTB)
#define PG8_SB(b, h) ((4 + (b) * 2 + (h)) * HTB)
#define PG8_STAGE(bufoff, gbase, voff) do { _Pragma("unroll") for (int _i = 0; _i < 2; ++_i) \
        __builtin_amdgcn_global_load_lds((const unsigned*)((const char*)(gbase) + (voff)[_i]), (PG8_LAS unsigned*)(lds + (bufoff) + ldsw + _i * 8192), 16, 0, 0); } while (0)
#define PG8_LDA(dst, b, h) do { _Pragma("unroll") for (int m = 0; m < 4; ++m) _Pragma("unroll") for (int k = 0; k < 2; ++k) dst[m][k] = *(const PG8_LAS bf16x8*)(lds + PG8_SA(b, h) + aoff + m * 2048 + k * 1024); } while (0)
#define PG8_LDB(dst, b, h) do { _Pragma("unroll") for (int n = 0; n < 2; ++n) _Pragma("unroll") for (int k = 0; k < 2; ++k) dst[n][k] = *(const PG8_LAS bf16x8*)(lds + PG8_SB(b, h) + boff + n * 2048 + k * 1024); } while (0)
#define PG8_MMA(ai, bj, At, Bt) do { __builtin_amdgcn_s_setprio(1); _Pragma("unroll") for (int m = 0; m < 4; ++m) _Pragma("unroll") for (int n = 0; n < 2; ++n) _Pragma("unroll") for (int k = 0; k < 2; ++k) \
        acc[ai][bj][m][n] = __builtin_amdgcn_mfma_f32_16x16x32_bf16(Bt[n][k], At[m][k], acc[ai][bj][m][n], 0, 0, 0); __builtin_amdgcn_s_setprio(0); } while (0)
#define PG8_WAIT_V(n) asm volatile("s_waitcnt vmcnt(" #n ")" ::: "memory")
#define PG8_WAIT_L(n) asm volatile("s_waitcnt lgkmcnt(" #n ")" ::: "memory")
#define PG8_BAR __builtin_amdgcn_s_barrier()
#define PG8_SCHED __builtin_amdgcn_sched_barrier(0)
    Unit cur, nxt; int ui = 0;
    if (!S.next(0, cur)) return;
    f32x4 acc[2][2][4][2];
#pragma unroll
    for (int a = 0; a < 2; ++a)
#pragma unroll
        for (int b = 0; b < 2; ++b)
#pragma unroll
            for (int m = 0; m < 4; ++m)
#pragma unroll
                for (int n = 0; n < 2; ++n) acc[a][b][m][n] = (f32x4){0.f, 0.f, 0.f, 0.f};
    bf16x8 At[4][2], B0[2][2], B1[2][2];
    const char* cA = (const char*)g.A + (size_t)cur.pm * tstep; const char* cB = (const char*)g.Bt + (size_t)cur.pn * tstep;
    S.a_ready(cur);
    if constexpr (SP2) {
        PG8_STAGE(PG8_SB(0, 0), cB, voffB); PG8_STAGE(PG8_SB(0, 1), cB + hstep, voffB); PG8_STAGE(PG8_SA(0, 0), cA, voffA); PG8_STAGE(PG8_SA(0, 1), cA + hstep, voffA);
        if (wr == 1) PG8_BAR;
        PG8_WAIT_V(2); PG8_BAR;
        PG8_STAGE(PG8_SB(1, 0), cB + kstep, voffB); PG8_STAGE(PG8_SA(1, 0), cA + kstep, voffA); PG8_STAGE(PG8_SB(1, 1), cB + hstep + kstep, voffB);
        PG8_WAIT_V(6); PG8_BAR;
    } else {
        PG8_STAGE(PG8_SB(0, 0), cB, voffB); PG8_STAGE(PG8_SA(0, 0), cA, voffA); PG8_STAGE(PG8_SB(0, 1), cB + hstep, voffB); PG8_STAGE(PG8_SA(0, 1), cA + hstep, voffA);
        if (wr == 1) PG8_BAR;
        PG8_WAIT_V(4); PG8_BAR;
        PG8_STAGE(PG8_SB(1, 0), cB + kstep, voffB); PG8_STAGE(PG8_SA(1, 0), cA + kstep, voffA); PG8_STAGE(PG8_SB(1, 1), cB + hstep + kstep, voffB);
        PG8_WAIT_V(6); PG8_BAR;
    }
    for (;;) {
        const bool has_next = S.next(ui + 1, nxt);
        const char* nA = has_next ? (const char*)g.A + (size_t)nxt.pm * tstep : cA; const char* nB = has_next ? (const char*)g.Bt + (size_t)nxt.pn * tstep : cB;
        for (int t = 0; t < nt; t += 2) {
            const bool last = (t == nt - 2);
            const char* a1 = cA + (size_t)(t + 1) * kstep;
            const char* a2 = last ? nA : cA + (size_t)(t + 2) * kstep; const char* b2 = last ? nB : cB + (size_t)(t + 2) * kstep;
            const char* a3 = a2 + kstep; const char* b3 = b2 + kstep;
            if (last && has_next) S.a_ready(nxt);
            if constexpr (SP2) {
            PG8_LDB(B0, 0, 0); PG8_LDB(B1, 0, 1); PG8_SCHED; PG8_LDA(At, 0, 0); PG8_STAGE(PG8_SA(1, 1), a1 + hstep, voffA);
            PG8_WAIT_V(8); PG8_WAIT_L(0); PG8_BAR; PG8_MMA(0, 0, At, B0); PG8_MMA(0, 1, At, B1); PG8_BAR; PG8_SCHED;
            PG8_LDA(At, 0, 1); PG8_STAGE(PG8_SB(0, 0), b2, voffB); PG8_STAGE(PG8_SB(0, 1), b2 + hstep, voffB); PG8_STAGE(PG8_SA(0, 0), a2, voffA);
            PG8_WAIT_V(8); PG8_WAIT_L(0); PG8_BAR; PG8_MMA(1, 0, At, B0); PG8_MMA(1, 1, At, B1); PG8_BAR; PG8_SCHED;
            PG8_LDB(B0, 1, 0); PG8_LDB(B1, 1, 1); PG8_SCHED; PG8_LDA(At, 1, 0); PG8_STAGE(PG8_SA(0, 1), a2 + hstep, voffA);
            PG8_WAIT_V(8); PG8_WAIT_L(0); PG8_BAR; PG8_MMA(0, 0, At, B0); PG8_MMA(0, 1, At, B1); PG8_BAR; PG8_SCHED;
            PG8_LDA(At, 1, 1); PG8_STAGE(PG8_SB(1, 0), b3, voffB); PG8_STAGE(PG8_SB(1, 1), b3 + hstep, voffB); PG8_STAGE(PG8_SA(1, 0), a3, voffA);
            PG8_WAIT_V(8); PG8_WAIT_L(0); PG8_BAR; PG8_MMA(1, 0, At, B0); PG8_MMA(1, 1, At, B1); PG8_BAR; PG8_SCHED;
            } else {
            PG8_LDB(B0, 0, 0); PG8_SCHED; PG8_LDA(At, 0, 0); PG8_STAGE(PG8_SA(1, 1), a1 + hstep, voffA);
            PG8_WAIT_L(8); PG8_BAR; PG8_WAIT_L(0); PG8_MMA(0, 0, At, B0); PG8_BAR; PG8_SCHED;
            PG8_LDB(B1, 0, 1); PG8_STAGE(PG8_SB(0, 0), b2, voffB);
            PG8_BAR; PG8_WAIT_L(0); PG8_MMA(0, 1, At, B1); PG8_BAR;
            PG8_LDA(At, 0, 1); PG8_STAGE(PG8_SA(0, 0), a2, voffA);
            PG8_BAR; PG8_WAIT_L(0); PG8_MMA(1, 0, At, B0); PG8_BAR; PG8_SCHED;
            PG8_STAGE(PG8_SB(0, 1), b2 + hstep, voffB);
            PG8_WAIT_V(6); PG8_BAR; PG8_MMA(1, 1, At, B1); PG8_BAR;
            PG8_LDB(B0, 1, 0); PG8_SCHED; PG8_LDA(At, 1, 0); PG8_STAGE(PG8_SA(0, 1), a2 + hstep, voffA);
            PG8_WAIT_L(8); PG8_BAR; PG8_WAIT_L(0); PG8_MMA(0, 0, At, B0); PG8_BAR; PG8_SCHED;
            PG8_LDB(B1, 1, 1); PG8_STAGE(PG8_SB(1, 0), b3, voffB);
            PG8_BAR; PG8_WAIT_L(0); PG8_MMA(0, 1, At, B1); PG8_BAR;
            PG8_LDA(At, 1, 1); PG8_STAGE(PG8_SA(1, 0), a3, voffA);
            PG8_BAR; PG8_WAIT_L(0); PG8_MMA(1, 0, At, B0); PG8_BAR; PG8_SCHED;
            PG8_STAGE(PG8_SB(1, 1), b3 + hstep, voffB);
            PG8_WAIT_V(6); PG8_BAR; PG8_MMA(1, 1, At, B1); PG8_BAR;
            }
        }
        if constexpr (ALIGN_EPI) { if (wr == 0) PG8_BAR; }
        if constexpr (!Epi::AFTER_DRAIN) { E(acc, cur, wr, wc, fr, fq); S.done(cur); }
        if (!has_next) break;
#pragma unroll
        for (int a = 0; a < 2; ++a)
#pragma unroll
            for (int b = 0; b < 2; ++b)
#pragma unroll
                for (int m = 0; m < 4; ++m)
#pragma unroll
                    for (int n = 0; n < 2; ++n) acc[a][b][m][n] = (f32x4){0.f, 0.f, 0.f, 0.f};
        cur = nxt; cA = nA; cB = nB; ++ui;
        if constexpr (ALIGN_EPI) { if (wr == 1) PG8_BAR; }
    }
    PG8_WAIT_V(0);
    if constexpr (!ALIGN_EPI) { if (wr == 0) PG8_BAR; }
    PG8_BAR;
    if constexpr (Epi::AFTER_DRAIN) { E.fused(acc, cur, wr, wc, fr, fq, lds, wid, lane); S.done(cur); }
#undef PG8_SA
#undef PG8_SB
#undef PG8_STAGE
#undef PG8_LDA
#undef PG8_LDB
#undef PG8_MMA
#undef PG8_WAIT_V
#undef PG8_WAIT_L
#undef PG8_BAR
#undef PG8_SCHED
}
}

namespace att {
using bf16 = __hip_bfloat16;
constexpr int D = 128, NW = 8, QBLK = 32, KVBLK = 64;
constexpr float SCALE = 0.088388347648318440f;
constexpr float THR = 8.f;
using bf16x8 = __attribute__((ext_vector_type(8))) short;
using s16x4  = __attribute__((ext_vector_type(4))) short;
using f32x16 = __attribute__((ext_vector_type(16))) float;
using u32x4  = __attribute__((ext_vector_type(4))) unsigned;
constexpr size_t SHM_V = KVBLK * D * 2, SHM_K = KVBLK * D * 2, SHM_ATTN = 2 * SHM_V + 2 * SHM_K + NW * 64 * 4;
#define KSWZ(row, colB) ((row) * 256 + ((colB) ^ (((row) & 7) << 4)))
#define SBAR() __builtin_amdgcn_sched_barrier(0)
__device__ __forceinline__ int crow(int r, int hi) { return (r & 3) + 8 * (r >> 2) + 4 * hi; }
__device__ __forceinline__ unsigned cvtpk(float lo, float hi) { unsigned r; asm volatile("v_cvt_pk_bf16_f32 %0, %1, %2" : "=v"(r) : "v"(lo), "v"(hi)); return r; }
__device__ __forceinline__ bf16x8 ld8(const bf16* p) { return *reinterpret_cast<const bf16x8*>(p); }

__device__ __forceinline__ void partialSM(f32x16& p0, f32x16& p1, float& m_reg, float& mn, float& alpha) {
  constexpr float C = SCALE * 1.4426950408889634f;
  float pmax = p0[0]; for (int r = 1; r < 16; ++r) pmax = fmaxf(pmax, p0[r]); for (int r = 0; r < 16; ++r) pmax = fmaxf(pmax, p1[r]);
  { auto rr = __builtin_amdgcn_permlane32_swap(__float_as_uint(pmax), __float_as_uint(pmax), false, false);
    pmax = fmaxf(__uint_as_float(rr[0]), __uint_as_float(rr[1])); }
  if (__builtin_expect(__all(pmax - m_reg <= THR / SCALE), 1)) { mn = m_reg; alpha = 1.f; }
  else { mn = fmaxf(m_reg, pmax); alpha = __builtin_amdgcn_exp2f((m_reg - mn) * C); m_reg = mn; }
  float mnC = -mn * C;
  for (int r = 0; r < 16; ++r) p0[r] = fmaf(p0[r], C, mnC); for (int r = 0; r < 16; ++r) p1[r] = fmaf(p1[r], C, mnC);
  for (int r = 0; r < 16; ++r) p0[r] = __builtin_amdgcn_exp2f(p0[r]);
}
__device__ __forceinline__ void finishSM(f32x16& p0, f32x16& p1, float alpha, float& l_reg, bf16x8& pa0, bf16x8& pa1, bf16x8& pa2, bf16x8& pa3) {
  for (int r = 0; r < 16; ++r) p1[r] = __builtin_amdgcn_exp2f(p1[r]);
  float ps = 0; for (int r = 0; r < 16; ++r) ps += p0[r]; for (int r = 0; r < 16; ++r) ps += p1[r];
  { auto rr = __builtin_amdgcn_permlane32_swap(__float_as_uint(ps), __float_as_uint(ps), false, false);
    ps = __uint_as_float(rr[0]) + __uint_as_float(rr[1]); }
  l_reg = l_reg * alpha + ps;
#define PK4(P, BASE, OUT) do { unsigned a0 = cvtpk(P[BASE + 0], P[BASE + 1]), a1 = cvtpk(P[BASE + 2], P[BASE + 3]);   \
    unsigned b0 = cvtpk(P[BASE + 4], P[BASE + 5]), b1 = cvtpk(P[BASE + 6], P[BASE + 7]);                              \
    auto r0 = __builtin_amdgcn_permlane32_swap(a0, b0, false, false); auto r1 = __builtin_amdgcn_permlane32_swap(a1, b1, false, false); \
    u32x4 w = {r0[0], r1[0], r0[1], r1[1]}; OUT = *reinterpret_cast<bf16x8*>(&w); } while (0)
  PK4(p0, 0, pa0); PK4(p0, 8, pa1); PK4(p1, 0, pa2); PK4(p1, 8, pa3);
#undef PK4
}
__device__ __forceinline__ void qkt(f32x16& p0, f32x16& p1, const bf16* Ks, const bf16x8* qr, int r32, int hi) {
  p0 = f32x16{}; p1 = f32x16{};
  for (int d0 = 0; d0 < 8; ++d0) { int cb = (d0 * 16 + hi * 8) * 2;
    bf16x8 b0 = *reinterpret_cast<const bf16x8*>((const char*)Ks + KSWZ(r32, cb));
    bf16x8 b1 = *reinterpret_cast<const bf16x8*>((const char*)Ks + KSWZ(32 + r32, cb));
    p0 = __builtin_amdgcn_mfma_f32_32x32x16_bf16(b0, qr[d0], p0, 0, 0, 0);
    p1 = __builtin_amdgcn_mfma_f32_32x32x16_bf16(b1, qr[d0], p1, 0, 0, 0); }
}
__device__ __forceinline__ void wmask(f32x16& p0, f32x16& p1, int dq, int hi) {
#pragma unroll
  for (int r = 0; r < 16; ++r) { const int df = dq - crow(r, hi);
    if (df > 128 || df < -128) p0[r] = -1e30f;
    if (df - 32 > 128 || df - 32 < -128) p1[r] = -1e30f; }
}
__device__ __forceinline__ int v_st(int k, int c) { const int kk = (k & ~0xC) | ((k & 4) << 1) | ((k & 8) >> 1); return ((kk >> 3) * 4 + (c >> 5)) * 512 + ((kk & 7) * 32 + (c & 31)) * 2; }
__device__ __forceinline__ int v_rd_base(int lane) { return ((lane & 3) << 3) | (((lane >> 2) & 3) << 6) | (((lane >> 4) & 1) << 5) | (((lane >> 5) & 1) << 8); }
constexpr int v_rd_off(int d0, int ks, int half) { return d0 * 512 + ks * 4096 + half * 2048; }
template <int OFF> __device__ __forceinline__ s16x4 tr_read(int vb) {
  s16x4 r; asm volatile("ds_read_b64_tr_b16 %0, %1 offset:%2" : "=&v"(r) : "v"(vb), "i"(OFF) : "memory"); return r;
}
template <int D0> __device__ __forceinline__ void pv_one(f32x16& od, int vb, bf16x8 pa0, bf16x8 pa1, bf16x8 pa2, bf16x8 pa3) {
  const s16x4 l0 = tr_read<v_rd_off(D0, 0, 0)>(vb), h0 = tr_read<v_rd_off(D0, 0, 1)>(vb), l1 = tr_read<v_rd_off(D0, 1, 0)>(vb), h1 = tr_read<v_rd_off(D0, 1, 1)>(vb);
  const s16x4 l2 = tr_read<v_rd_off(D0, 2, 0)>(vb), h2 = tr_read<v_rd_off(D0, 2, 1)>(vb), l3 = tr_read<v_rd_off(D0, 3, 0)>(vb), h3 = tr_read<v_rd_off(D0, 3, 1)>(vb);
  asm volatile("s_waitcnt lgkmcnt(0)" ::: "memory"); SBAR();
#define PK(L, H) (bf16x8){L[0], L[1], L[2], L[3], H[0], H[1], H[2], H[3]}
  od = __builtin_amdgcn_mfma_f32_32x32x16_bf16(pa0, PK(l0, h0), od, 0, 0, 0);
  od = __builtin_amdgcn_mfma_f32_32x32x16_bf16(pa1, PK(l1, h1), od, 0, 0, 0);
  od = __builtin_amdgcn_mfma_f32_32x32x16_bf16(pa2, PK(l2, h2), od, 0, 0, 0);
  od = __builtin_amdgcn_mfma_f32_32x32x16_bf16(pa3, PK(l3, h3), od, 0, 0, 0);
#undef PK
}
__device__ __forceinline__ void pv_d0(f32x16* o, int vb, bf16x8 pa0, bf16x8 pa1, bf16x8 pa2, bf16x8 pa3) {
  pv_one<0>(o[0], vb, pa0, pa1, pa2, pa3); pv_one<1>(o[1], vb, pa0, pa1, pa2, pa3); pv_one<2>(o[2], vb, pa0, pa1, pa2, pa3); pv_one<3>(o[3], vb, pa0, pa1, pa2, pa3);
}

struct Unit {
  const bf16* Q; int ldq;
  const bf16* KA; const bf16* VA; int ldA; int nA;
  const bf16* KB; const bf16* VB; int ldB;
  int NT;
  int win;
  int dq0;
  int has_sink; float sink;
  bf16* O; int ldo;
};

__device__ __forceinline__ void attn_unit(const Unit& U, char* lds) {
  int tid_ = threadIdx.x; asm volatile("" : "+v"(tid_));
  const int tid = tid_, wid = tid >> 6, lane = tid & 63, r32 = lane & 31, hi = lane >> 5;
  bf16* V_lds = (bf16*)lds; bf16* K_lds = (bf16*)(lds + 2 * SHM_V);
  float* ws = (float*)(lds + 2 * SHM_V + 2 * SHM_K) + wid * 64; float* li_l = ws; float* al_l = ws + 32;
  float m_reg = -1e30f, l_reg = 0; f32x16 o[4] = {}; bf16x8 qr[8];
  const bf16* Qw = U.Q + (long)(wid * QBLK + r32) * U.ldq + hi * 8;
#pragma unroll
  for (int d0 = 0; d0 < 8; ++d0) qr[d0] = ld8(Qw + d0 * 16);
  const int sr = tid >> 4, sc = (tid & 15) * 8, vst0 = v_st(sr, sc), vst1 = v_st(32 + sr, sc);
  const int vb0 = (int)(uintptr_t)V_lds + v_rd_base(lane);
  const int nA = U.nA, NT = U.NT;
  const int dqw = U.dq0 + wid * QBLK + r32;
  struct { bf16x8 vs0, vs1, ks0, ks1; } sr_[1];
#define SLOAD(i, jt) do { const int jj_ = (jt); const bf16 *kp_, *vp_; long ld_; \
    if (jj_ < nA) { ld_ = U.ldA; kp_ = U.KA + (long)jj_ * 64 * ld_; vp_ = U.VA + (long)jj_ * 64 * ld_; } \
    else { ld_ = U.ldB; kp_ = U.KB + (long)(jj_ - nA) * 64 * ld_; vp_ = U.VB + (long)(jj_ - nA) * 64 * ld_; } \
    sr_[i].vs0 = ld8(vp_ + (long)sr * ld_ + sc); sr_[i].vs1 = ld8(vp_ + (long)(32 + sr) * ld_ + sc); \
    sr_[i].ks0 = ld8(kp_ + (long)sr * ld_ + sc); sr_[i].ks1 = ld8(kp_ + (long)(32 + sr) * ld_ + sc); } while (0)
#define SWRITE(b, i) do { *(bf16x8*)((char*)V_lds + (b) * SHM_V + vst0) = sr_[i].vs0;          \
    *(bf16x8*)((char*)V_lds + (b) * SHM_V + vst1) = sr_[i].vs1; int kc = sc * 2;               \
    *(bf16x8*)((char*)K_lds + (b) * SHM_K + KSWZ(sr, kc)) = sr_[i].ks0;                       \
    *(bf16x8*)((char*)K_lds + (b) * SHM_K + KSWZ(32 + sr, kc)) = sr_[i].ks1; } while (0)
#define RESC(a) do { if (__any((a) < 1.f)) { if (hi == 0) al_l[r32] = (a); asm volatile("s_waitcnt lgkmcnt(0)" ::: "memory"); \
    for (int d = 0; d < 4; ++d) for (int r = 0; r < 16; ++r) o[d][r] *= al_l[crow(r, hi)]; } } while (0)
#define MASK(P0, P1, jt) do { if (U.win && (jt) >= nA) { const int dq_ = dqw - ((jt) - nA) * 64; \
    if (__any(dq_ > 128 || dq_ - 63 < -128)) wmask(P0, P1, dq_, hi); } } while (0)
  f32x16 p0, p1; float mn, al; bf16x8 pa0, pa1, pa2, pa3;
  SLOAD(0, 0); asm volatile("s_waitcnt vmcnt(0)" ::: "memory"); SWRITE(0, 0); SLOAD(0, 1); __syncthreads();
#pragma unroll 1
  for (int j = 0; j < NT; ++j) {
    const int b = j & 1;
    qkt(p0, p1, (const bf16*)((const char*)K_lds + b * SHM_K), qr, r32, hi); MASK(p0, p1, j);
    partialSM(p0, p1, m_reg, mn, al);
    RESC(al);
    finishSM(p0, p1, al, l_reg, pa0, pa1, pa2, pa3); SBAR();
    pv_d0(o, vb0 + b * (int)SHM_V, pa0, pa1, pa2, pa3);
    if (j + 1 < NT) { asm volatile("s_waitcnt vmcnt(0)" ::: "memory"); SWRITE(b ^ 1, 0); if (j + 2 < NT) SLOAD(0, j + 2); }
    __syncthreads();
  }
  if (U.has_sink) { constexpr float C = SCALE * 1.4426950408889634f; l_reg += __builtin_amdgcn_exp2f(fminf(U.sink * 1.4426950408889634f - m_reg * C, 120.f)); }
  if (hi == 0) li_l[r32] = l_reg; asm volatile("s_waitcnt lgkmcnt(0)" ::: "memory");
  float rli[16];
#pragma unroll
  for (int r = 0; r < 16; ++r) rli[r] = __builtin_amdgcn_rcpf(li_l[crow(r, hi)]);
  bf16* Ow = U.O + (long)(wid * QBLK) * U.ldo;
#pragma unroll
  for (int r = 0; r < 16; ++r) { int orow = crow(r, hi);
    for (int d0 = 0; d0 < 4; ++d0) { const float v = o[d0][r] * rli[r]; const unsigned pk = cvtpk(v, v);
      *(unsigned short*)(Ow + (long)orow * U.ldo + d0 * 32 + r32) = (unsigned short)(pk & 0xffffu); } }
#undef SLOAD
#undef SWRITE
#undef RESC
#undef MASK
}
}

constexpr int DM = 2048, NCTX = 8192, NLAT = 16384, NTOK = 24576, QKVD = 3072, DFF = 5632, NGU = 11264, DEPTH = 4;
constexpr int NWAVES = 8;
constexpr size_t MiB = 1u << 20;
constexpr size_t OUT_YP = 0, OUT_YS = (size_t)NCTX * DM, OUT_WK = (size_t)NTOK * DM, OUT_WV = OUT_WK + (size_t)32 * 2 * 256 * 512,
                 OUT_AK = OUT_WV + (size_t)32 * 2 * 256 * 512, OUT_AV = OUT_AK + (size_t)32 * 256 * 512, OUT_END = OUT_AV + (size_t)32 * 256 * 512;
constexpr size_t WS_CTL = 0, CTL_ZERO_BYTES = 1 * MiB;
constexpr size_t WS_MODP = 1 * MiB;
constexpr size_t WS_MODF = 16 * MiB;
constexpr size_t WS_A2 = 18 * MiB;
constexpr size_t WS_NP = 19 * MiB;
constexpr size_t WS_CKV = 20 * MiB;
constexpr size_t WS_CWK = WS_CKV, WS_CWV = WS_CKV + 8 * MiB, WS_CAK = WS_CKV + 16 * MiB, WS_CAV = WS_CKV + 20 * MiB;
constexpr size_t WS_FT = 44 * MiB;
constexpr size_t WS_FT_CTX = WS_FT + 32 * MiB;
constexpr size_t WS_W = 80 * MiB;
constexpr size_t W_QKV = (size_t)QKVD * DM * 2, W_SQ = (size_t)DM * DM * 2, W_IN = (size_t)6144 * DM * 2, W_GU = (size_t)NGU * DM * 2, W_DN = (size_t)DM * DFF * 2;
constexpr size_t WS_WQKV0 = WS_W, WS_WQKV1 = WS_WQKV0 + W_QKV, WS_WQKVA = WS_WQKV1 + W_QKV, WS_WO0 = WS_WQKVA + W_QKV, WS_WO1 = WS_WO0 + W_SQ, WS_WOA = WS_WO1 + W_SQ,
                 WS_WHO = WS_WOA + W_SQ, WS_WHI = WS_WHO + W_SQ, WS_WGU = WS_WHI + W_IN, WS_WDN = WS_WGU + 4 * W_GU, WS_WEND = WS_WDN + 4 * W_DN;
constexpr size_t WS_H = 448 * MiB;
constexpr size_t WS_BIG = 544 * MiB;
constexpr size_t WS_ZT = WS_BIG + 288 * MiB;
constexpr size_t WS_END = WS_BIG + 384 * MiB;
static_assert(WS_WEND <= WS_H && WS_FT_CTX + 4 * MiB <= WS_W && WS_CAV + 4 * MiB <= WS_FT, "ws map");
static_assert(WS_MODP + (size_t)4 * 8 * 9 * 12288 * 4 <= WS_MODF && WS_MODF + (size_t)4 * 9 * 6 * 2048 * 4 <= WS_A2 && WS_A2 + (size_t)2304 * 64 * 4 <= WS_NP && WS_NP + (size_t)18 * 8192 * 4 <= WS_CKV, "small buffers");
constexpr int CW_TMO = 0;
constexpr int CW_BAR = 4096;
constexpr int RING_BYTES = 131072;
constexpr int LDSCTL_OFF = RING_BYTES, MISC_OFF = LDSCTL_OFF + 320;
constexpr int LDS_BYTES = 147456;

#define GAS __attribute__((address_space(1)))
#define LAS __attribute__((address_space(3)))
typedef unsigned short bf16;
typedef unsigned v4u __attribute__((ext_vector_type(4)));
typedef unsigned v2u __attribute__((ext_vector_type(2)));
typedef float f32x4 __attribute__((ext_vector_type(4)));
typedef short bf16x8 __attribute__((ext_vector_type(8)));
typedef short bf16x4 __attribute__((ext_vector_type(4)));
typedef GAS unsigned gu32;
#define RLX_AGENT __ATOMIC_RELAXED, __HIP_MEMORY_SCOPE_AGENT
#define LDS_WAIT() asm volatile("s_waitcnt lgkmcnt(0)" ::: "memory")
#define VM_WAIT() asm volatile("s_waitcnt vmcnt(0)" ::: "memory")
__device__ __forceinline__ unsigned f2bf(float f) { unsigned u = __builtin_bit_cast(unsigned, f); return (u + 0x7fffu + ((u >> 16) & 1u)) >> 16; }
__device__ __forceinline__ unsigned pk2(float lo, float hi) { return f2bf(lo) | (f2bf(hi) << 16); }
__device__ __forceinline__ float bf2f(unsigned short b) { return __builtin_bit_cast(float, (unsigned)b << 16); }
__device__ __forceinline__ float bflo(unsigned w) { return __builtin_bit_cast(float, w << 16); }
__device__ __forceinline__ float bfhi(unsigned w) { return __builtin_bit_cast(float, w & 0xffff0000u); }
__device__ __forceinline__ float wave_sum(float v) {
#pragma unroll
    for (int o = 1; o < 64; o <<= 1) v += __shfl_xor(v, o);
    return v;
}
#define XB_TMO      128
#define XB_XCNT(j)  (256  + 64 * (j))
#define XB_XSUB(j)  (1280 + 64 * (j))
#define XB_XGEN(j)  (2304 + 64 * (j))
#define XB_TOP      3328
#define XB_TOPGEN   3392
#define XCD_BAR_WORDS 3456
#define XB_SPIN_CAP (1u << 18)

__device__ __forceinline__ unsigned xb_ld(unsigned* p)              { return __hip_atomic_load(p, __ATOMIC_RELAXED, __HIP_MEMORY_SCOPE_AGENT); }
__device__ __forceinline__ unsigned xb_add(unsigned* p, unsigned v) { return __hip_atomic_fetch_add(p, v, __ATOMIC_RELAXED, __HIP_MEMORY_SCOPE_AGENT); }
__device__ __forceinline__ unsigned xb_xcc_id() { return (unsigned)__builtin_amdgcn_s_getreg((3 << 11) | 20) & 0xFu; }
#define XB_SPIN(cond, bar) do { unsigned _sp = 0; while (cond) { __builtin_amdgcn_s_sleep(1); \
    if ((++_sp & 255u) == 0u) { if (xb_ld(&(bar)[XB_TMO])) break; if (_sp > XB_SPIN_CAP) { atomicAdd(&(bar)[XB_TMO], 1u); break; } } } } while (0)

struct XcdBarrier {
    unsigned* bar; unsigned x;
    volatile LAS unsigned* st;
};

__device__ __forceinline__ XcdBarrier xcd_barrier_post(unsigned* bar, volatile LAS unsigned* st) {
    XcdBarrier b; b.bar = bar; b.x = xb_xcc_id(); b.st = st;
    if (threadIdx.x == 0) (void)xb_add(&bar[XB_XCNT(b.x)], 1u);
    return b;
}
__device__ __forceinline__ void xcd_barrier_complete(unsigned* bar, unsigned x, unsigned& nloc, unsigned& nx) {
    const unsigned G = gridDim.x * gridDim.y * gridDim.z;
    unsigned sum, cnt, mine, sp = 0u;
    for (;;) {
        sum = 0u; cnt = 0u; mine = 0u;
#pragma unroll
        for (unsigned j = 0; j < 16; ++j) { const unsigned c = xb_ld(&bar[XB_XCNT(j)]); sum += c; cnt += (c > 0u) ? 1u : 0u; mine = (j == x) ? c : mine; }
        if (sum == G) break;
        __builtin_amdgcn_s_sleep(1);
        if ((++sp & 255u) == 0u) { if (xb_ld(&bar[XB_TMO])) break; if (sp > XB_SPIN_CAP) { atomicAdd(&bar[XB_TMO], 1u); break; } }
    }
    nloc = mine > 0u ? mine : 1u; nx = cnt > 0u ? cnt : 1u;
}

__device__ __forceinline__ void xcd_barrier(const XcdBarrier& b) {
    asm volatile("s_waitcnt vmcnt(0)" ::: "memory");
    __syncthreads();
    if (threadIdx.x == 0) {
        unsigned* bar = b.bar;
        __builtin_amdgcn_s_waitcnt(0);
        unsigned nloc = b.st[0], nx = b.st[1];
        if (nloc == 0u) { xcd_barrier_complete(bar, b.x, nloc, nx); b.st[0] = nloc; b.st[1] = nx; }
        const unsigned old = xb_add(&bar[XB_XSUB(b.x)], 1u);
        const unsigned gen = old / nloc;
        if (old + 1u == (gen + 1u) * nloc) {
            __builtin_amdgcn_fence(__ATOMIC_RELEASE, "agent");
            asm volatile("s_waitcnt vmcnt(0)" ::: "memory");
            const unsigned og = xb_add(&bar[XB_TOP], 1u);
            const unsigned tg = og / nx;
            if (og + 1u == (tg + 1u) * nx) xb_add(&bar[XB_TOPGEN], 1u);
            else XB_SPIN(xb_ld(&bar[XB_TOPGEN]) == tg, bar);
            __builtin_amdgcn_fence(__ATOMIC_ACQUIRE, "agent");
            xb_add(&bar[XB_XGEN(b.x)], 1u);
            asm volatile("s_waitcnt vmcnt(0)" ::: "memory");
        } else {
            XB_SPIN(xb_ld(&bar[XB_XGEN(b.x)]) == gen, bar);
            __builtin_amdgcn_fence(__ATOMIC_ACQUIRE, "agent");
            asm volatile("s_waitcnt vmcnt(0)" ::: "memory");
        }
    }
    __syncthreads();
}

__device__ __forceinline__ void transpose_item(const float* W, int K, int N, bf16* WT, int k0, int n0, int drow0, LAS float* scr, int lane) {
#pragma unroll 8
    for (int i = 0; i < 32; ++i) { const int kk = 2 * i + (lane >> 5); scr[kk * 33 + (lane & 31)] = W[(size_t)(k0 + kk) * N + n0 + (lane & 31)]; }
    LDS_WAIT(); asm volatile("" ::: "memory");
    const int c = lane & 7;
#pragma unroll
    for (int j = 0; j < 4; ++j) { const int n = (lane >> 3) + 8 * j; const LAS float* s = scr + (8 * c) * 33 + n;
        v4u o; o.x = pk2(s[0 * 33], s[1 * 33]); o.y = pk2(s[2 * 33], s[3 * 33]); o.z = pk2(s[4 * 33], s[5 * 33]); o.w = pk2(s[6 * 33], s[7 * 33]);
        *(GAS v4u*)(WT + (size_t)(drow0 + n) * K + k0 + 8 * c) = o; }
    LDS_WAIT(); asm volatile("" ::: "memory");
}
constexpr int IT_QKV = (DM / 64) * (QKVD / 32), IT_SQ = (DM / 64) * (DM / 32), IT_IN = (DM / 64) * (6144 / 32), IT_GU = (DM / 64) * (NGU / 32), IT_DN = (DFF / 64) * (DM / 32);
constexpr int IT_TOTAL = 3 * IT_QKV + 4 * IT_SQ + IT_IN + 4 * IT_GU + 4 * IT_DN;

struct Args { const float* in[33]; float* out; unsigned char* ws; int ph_lo, ph_hi; };

__device__ __forceinline__ void weight_item(const Args& A, int it, LAS float* scr, int lane) {
    unsigned char* ws = A.ws;
    const float* src; bf16* dst; int K = DM, N; bool gu = false; int r = it;
    if (r < 3 * IT_QKV) { const int m = r / IT_QKV; r -= m * IT_QKV; N = QKVD;
        src = (m < 2) ? A.in[12] + (size_t)m * DM * QKVD : A.in[26]; dst = (bf16*)(ws + WS_WQKV0 + (size_t)m * W_QKV); }
    else if ((r -= 3 * IT_QKV) < 4 * IT_SQ) { const int m = r / IT_SQ; r -= m * IT_SQ; N = DM;
        src = (m < 2) ? A.in[13] + (size_t)m * DM * DM : (m == 2 ? A.in[29] : A.in[25]); dst = (bf16*)(ws + WS_WO0 + (size_t)m * W_SQ); }
    else if ((r -= 4 * IT_SQ) < IT_IN) { N = 6144; src = A.in[15]; dst = (bf16*)(ws + WS_WHI); }
    else if ((r -= IT_IN) < 4 * IT_GU) { const int m = r / IT_GU; r -= m * IT_GU; N = NGU; gu = true;
        src = A.in[30] + (size_t)m * DM * NGU; dst = (bf16*)(ws + WS_WGU + (size_t)m * W_GU); }
    else { r -= 4 * IT_GU; const int m = r / IT_DN; r -= m * IT_DN; N = DM; K = DFF;
        src = A.in[31] + (size_t)m * DFF * DM; dst = (bf16*)(ws + WS_WDN + (size_t)m * W_DN); }
    const int nblk = N / 32, kb = r / nblk, nb = r % nblk, k0 = 64 * kb, n0 = 32 * nb;
    int drow0 = n0;
    if (gu) { const int isu = n0 >= DFF ? 1 : 0; const int j = n0 - isu * DFF; drow0 = (j >> 7) * 256 + isu * 128 + (j & 127); }
    transpose_item(src, K, N, dst, k0, n0, drow0, scr, lane);
}

__device__ __forceinline__ void adaln_partial_unit(const Args& A, int u, LAS float* scr, int lane) {
    const int layer = u / 384, kc = (u / 48) % 8, cg = u % 48;
    const float* cctx = A.in[7]; const float* cin = A.in[6];
    for (int idx = lane; idx < 9 * 256; idx += 64) { const int c = idx >> 8, kk = idx & 255, k = kc * 256 + kk;
        const float v = (c == 0) ? cctx[k] : cin[(size_t)(c - 1) * DM + k]; scr[idx] = v / (1.0f + expf(-v)); }
    LDS_WAIT(); asm volatile("" ::: "memory");
    f32x4 acc[9];
#pragma unroll
    for (int c = 0; c < 9; ++c) acc[c] = (f32x4){0.f, 0.f, 0.f, 0.f};
    const float* wp = A.in[10] + (size_t)layer * DM * 12288 + (size_t)(kc * 256) * 12288 + cg * 256 + lane * 4;
#pragma unroll 8
    for (int kk = 0; kk < 256; ++kk) { const f32x4 w = *(const GAS f32x4*)(wp + (size_t)kk * 12288);
#pragma unroll
        for (int c = 0; c < 9; ++c) acc[c] += scr[c * 256 + kk] * w; }
    float* mp = (float*)(A.ws + WS_MODP) + (size_t)((layer * 8 + kc) * 9) * 12288 + cg * 256 + lane * 4;
#pragma unroll
    for (int c = 0; c < 9; ++c) *(f32x4*)(mp + (size_t)c * 12288) = acc[c];
    LDS_WAIT(); asm volatile("" ::: "memory");
}

__device__ __forceinline__ void filter_a2_row(const Args& A, int rr, int lane) {
    const int L = rr < 2048 ? 2048 : 256, t = rr < 2048 ? rr : rr - 2048;
    const float tn = (float)t / (float)(L - 1), w = 6.283185307179586f * (float)t / (float)L;
    float feat = 0.f;
    if (lane == 0) feat = tn;
    else if (lane <= 16) feat = cosf(w * (1e-4f + (float)(lane - 1) * ((15.0f - 1e-4f) / 15.0f)));
    else if (lane <= 32) feat = -sinf(w * (1e-4f + (float)(lane - 17) * ((15.0f - 1e-4f) / 15.0f)));
    const float* w1 = A.in[18]; const float* b1 = A.in[19]; const float* w2 = A.in[20]; const float* b2 = A.in[21]; const float* fq = A.in[23];
    float s = b1[lane];
    for (int f = 0; f < 33; ++f) s += __shfl(feat, f) * w1[f * 64 + lane];
    const float a1 = sinf(fq[lane] * s);
    float s2 = b2[lane];
    for (int k = 0; k < 64; ++k) s2 += __shfl(a1, k) * w2[k * 64 + lane];
    ((float*)(A.ws + WS_A2))[(size_t)rr * 64 + lane] = sinf(fq[64 + lane] * s2);
}

__device__ __forceinline__ void filter_hf_unit(const Args& A, int u, LAS float* scr, int lane) {
    const int variant = u < 2048 ? 0 : 1; const int uu = variant ? u - 2048 : u; const int tch = uu >> 7, cgp = uu & 127;
    const int L = variant ? 256 : 2048; const int col = cgp * 64 + lane, side = col >> 12, order = (col >> 11) & 1, d = col & 2047;
    const float* w3 = A.in[22];
    float w3r[64];
#pragma unroll
    for (int k = 0; k < 64; ++k) w3r[k] = w3[(size_t)k * 8192 + col];
    constexpr float MIND = -3.0701134573253944f, MAXD = -15.350567286626972f;
    const float delta = fabsf(MIND + (MAXD - MIND) * ((float)d / 2047.0f));
    const float* a2 = (const float*)(A.ws + WS_A2) + (size_t)(variant ? 2048 : 0) * 64;
    bf16* ft = (bf16*)(A.ws + (variant ? WS_FT_CTX : WS_FT)) + ((size_t)(order * 2048 + d) * 2 + side) * L;
    const float rl1 = 1.0f / (float)(L - 1);
    float asum = 0.f;
#pragma unroll 1
    for (int half = 0; half < 2; ++half) {
        const int tb = tch * 128 + half * 64;
        { const GAS f32x4* src = (const GAS f32x4*)(a2 + (size_t)(tb + lane) * 64);
#pragma unroll
          for (int q = 0; q < 16; ++q) *(LAS f32x4*)(scr + lane * 64 + q * 4) = src[q]; }
        LDS_WAIT(); asm volatile("" ::: "memory");
#pragma unroll 1
        for (int tt = 0; tt < 64; tt += 2) {
            float s0 = 0.f, s1 = 0.f;
#pragma unroll
            for (int q = 0; q < 16; ++q) { const f32x4 x0 = *(const LAS f32x4*)(scr + tt * 64 + q * 4), x1 = *(const LAS f32x4*)(scr + (tt + 1) * 64 + q * 4);
                s0 += x0.x * w3r[4 * q] + x0.y * w3r[4 * q + 1] + x0.z * w3r[4 * q + 2] + x0.w * w3r[4 * q + 3];
                s1 += x1.x * w3r[4 * q] + x1.y * w3r[4 * q + 1] + x1.z * w3r[4 * q + 2] + x1.w * w3r[4 * q + 3]; }
            const int t = tb + tt;
            s0 *= expf(-((float)t * rl1) * delta); s1 *= expf(-((float)(t + 1) * rl1) * delta);
            if (!(side == 1 && t == 0)) asum += fabsf(s0);
            asum += fabsf(s1);
            *(GAS unsigned*)(ft + t) = pk2(s0, s1);
        }
        LDS_WAIT(); asm volatile("" ::: "memory");
    }
    ((float*)(A.ws + WS_NP))[(size_t)(variant ? 16 + tch : tch) * 8192 + col] = asum;
}

__device__ __forceinline__ void norm_row(const float* xrow, const float* Ac, const float* Sc, bf16* orow, int lane) {
    const GAS f32x4* xr = (const GAS f32x4*)xrow + lane;
    f32x4 v[8]; float s = 0.f;
#pragma unroll
    for (int j = 0; j < 8; ++j) { v[j] = xr[64 * j]; s += (v[j].x * v[j].x + v[j].y * v[j].y) + (v[j].z * v[j].z + v[j].w * v[j].w); }
    const float rstd = 1.0f / sqrtf(wave_sum(s) * (1.0f / DM) + 1e-6f);
    GAS v2u* o8 = (GAS v2u*)orow + lane;
#pragma unroll
    for (int j = 0; j < 8; ++j) { const f32x4 a = *((const GAS f32x4*)Ac + lane + 64 * j), b = *((const GAS f32x4*)Sc + lane + 64 * j);
        const f32x4 y = v[j] * rstd * a + b; v2u w; w.x = pk2(y.x, y.y); w.y = pk2(y.z, y.w); o8[64 * j] = w; }
}
__device__ __forceinline__ void final_norm_row(float* xrow, const float* g, int lane) {
    GAS f32x4* xr = (GAS f32x4*)xrow + lane;
    f32x4 v[8]; float s = 0.f;
#pragma unroll
    for (int j = 0; j < 8; ++j) { v[j] = xr[64 * j]; s += (v[j].x * v[j].x + v[j].y * v[j].y) + (v[j].z * v[j].z + v[j].w * v[j].w); }
    const float rstd = 1.0f / sqrtf(wave_sum(s) * (1.0f / DM) + 1e-6f);
#pragma unroll
    for (int j = 0; j < 8; ++j) { const f32x4 a = *((const GAS f32x4*)g + lane + 64 * j); xr[64 * j] = v[j] * rstd * a; }
}

__device__ __forceinline__ void qkpost_row(bf16* qkv_row, int row, bool is_ax, const float* qg, const float* kg, float* state_k, int lane) {
    const bool is_lat = row >= NCTX;
    const int hsub = lane >> 4, a = (lane >> 3) & 1, i0 = (lane & 7) * 4;
    float cs[4], sn[4];
    if (is_lat) { const int t = (row - NCTX) & 2047; const float pos = (float)(a == 0 ? (t >> 6) : (t & 63));
#pragma unroll
        for (int e = 0; e < 4; ++e) { const float inv = expf(-(float)(i0 + e) * (9.210340371976184f / 32.0f)); sn[e] = sinf(pos * inv); cs[e] = cosf(pos * inv); } }
#pragma unroll
    for (int grp = 0; grp < 5; ++grp) {
        const int head = 4 * grp + hsub;
        bf16* base = qkv_row + head * 128 + a * 64 + i0;
        const v2u r1 = *(const GAS v2u*)base, r2 = *(const GAS v2u*)(base + 32);
        float x1[4] = {bflo(r1.x), bfhi(r1.x), bflo(r1.y), bfhi(r1.y)}, x2[4] = {bflo(r2.x), bfhi(r2.x), bflo(r2.y), bfhi(r2.y)};
        if (is_ax) {
            float ss = 0.f;
#pragma unroll
            for (int e = 0; e < 4; ++e) ss += x1[e] * x1[e] + x2[e] * x2[e];
            ss += __shfl_xor(ss, 1); ss += __shfl_xor(ss, 2); ss += __shfl_xor(ss, 4); ss += __shfl_xor(ss, 8);
            const float rstd = 1.0f / sqrtf(ss * (1.0f / 128.0f) + 1e-6f);
            const float* G = (head < 16 ? qg : kg) + a * 64 + i0;
#pragma unroll
            for (int e = 0; e < 4; ++e) { x1[e] = x1[e] * rstd * G[e]; x2[e] = x2[e] * rstd * G[32 + e]; }
        }
        if (is_lat) {
#pragma unroll
            for (int e = 0; e < 4; ++e) { const float y1 = x1[e] * cs[e] - x2[e] * sn[e], y2 = x2[e] * cs[e] + x1[e] * sn[e]; x1[e] = y1; x2[e] = y2; }
        }
        if (is_ax || is_lat) { v2u w1, w2; w1.x = pk2(x1[0], x1[1]); w1.y = pk2(x1[2], x1[3]); w2.x = pk2(x2[0], x2[1]); w2.y = pk2(x2[2], x2[3]);
            *(GAS v2u*)base = w1; *(GAS v2u*)(base + 32) = w2; }
        if (is_ax && !is_lat && head >= 16) { float* sp = state_k + (size_t)row * 512 + (head - 16) * 128 + a * 64 + i0;
            *(GAS f32x4*)sp = (f32x4){x1[0], x1[1], x1[2], x1[3]}; *(GAS f32x4*)(sp + 32) = (f32x4){x2[0], x2[1], x2[2], x2[3]}; }
    }
}

namespace hy {
constexpr int CPY_STRIDE = 8480;
constexpr int U_OFF = 8 * CPY_STRIDE;
constexpr int U_BYTES = 6144;
static_assert(U_OFF + 8 * U_BYTES <= RING_BYTES, "hyena LDS map");

__device__ __forceinline__ void build_copies(LAS unsigned char* lds, const bf16* ft, int L, int tid) {
    if (tid < 264) { const int c = tid / 33, e = tid % 33; const int qq = (e < 17 - c) ? e : 2 * L + 16 - c + (e - (17 - c));
        *(LAS unsigned short*)(lds + c * CPY_STRIDE + qq * 2) = 0; }
    if (tid < 2 * L / 8) { const int side = tid / (L / 8), t8 = (tid % (L / 8)) * 8;
        const v4u raw = *(const GAS v4u*)(ft + (size_t)side * L + t8);
        const unsigned wds[4] = {raw.x, raw.y, raw.z, raw.w};
#pragma unroll
        for (int e = 0; e < 8; ++e) { const int t = t8 + e; const unsigned short val = (unsigned short)((e & 1) ? (wds[e >> 1] >> 16) : (wds[e >> 1] & 0xffffu));
            if (!(side == 1 && t == 0)) { const int p = side == 0 ? L - t : L + t;
#pragma unroll
                for (int c = 0; c < 8; ++c) *(LAS unsigned short*)(lds + c * CPY_STRIDE + (p + 16 - c) * 2) = val; } } }
}
__device__ __forceinline__ void fill_u(LAS unsigned char* ub, const bf16* urow, int L, float w0, float w1, float w2, float bb, int lane) {
    { const int e0 = lane < 32 ? lane * 8 : L + 256 + (lane - 32) * 8; *(LAS v4u*)(ub + e0 * 2) = (v4u){0u, 0u, 0u, 0u}; }
    for (int q = lane; q < L / 8; q += 64) { const int s0 = 8 * q;
        const v4u raw = *(const GAS v4u*)(urow + s0);
        const float prev = s0 > 0 ? bf2f(urow[s0 - 1]) : 0.f, next = s0 + 8 < L ? bf2f(urow[s0 + 8]) : 0.f;
        const float x[10] = {prev, bflo(raw.x), bfhi(raw.x), bflo(raw.y), bfhi(raw.y), bflo(raw.z), bfhi(raw.z), bflo(raw.w), bfhi(raw.w), next};
        float y[8];
#pragma unroll
        for (int j = 0; j < 8; ++j) y[j] = w0 * x[j] + w1 * x[j + 1] + w2 * x[j + 2] + bb;
        v4u o; o.x = pk2(y[0], y[1]); o.y = pk2(y[2], y[3]); o.z = pk2(y[4], y[5]); o.w = pk2(y[6], y[7]);
        *(LAS v4u*)(ub + (256 + s0) * 2) = o; }
}
template <int NT>
__device__ __forceinline__ void toeplitz(const LAS unsigned char* cpy, const LAS unsigned char* ub, f32x4 (&acc)[NT], int lane) {
    constexpr int L = 256 * NT;
    const int i = lane & 15, g = lane >> 4, c = (-i) & 7;
    const LAS unsigned char* ap = cpy + c * CPY_STRIDE + 2 * (L + 8 * g + 16 - i - c);
    const LAS unsigned char* bp = ub + 2 * (256 + 8 * g + 16 * i);
#pragma unroll 2
    for (int S = -256; S <= L - 32; S += 32) {
        const bf16x8 b = *(const LAS bf16x8*)(bp + 2 * S);
        bf16x8 a[NT];
#pragma unroll
        for (int k = 0; k < NT; ++k) a[k] = *(const LAS bf16x8*)(ap + 2 * S - 512 * k);
#pragma unroll
        for (int k = 0; k < NT; ++k) acc[k] = __builtin_amdgcn_mfma_f32_16x16x32_bf16(a[k], b, acc[k], 0, 0, 0);
    }
}
template <int NT>
__device__ __forceinline__ void gate(const f32x4 (&acc)[NT], LAS unsigned char* ub, const bf16* xg, float cw0, float cw1, float cw2, float cb, float invn, float skip, int lane, bool last, bf16* zt) {
    constexpr int L = 256 * NT;
    const int sg = lane & 15, g = lane >> 4;
#pragma unroll
    for (int k = 0; k < NT; ++k) { const int t0 = 256 * k + 16 * sg + 4 * g;
        const v2u ur = *(const LAS v2u*)(ub + (256 + t0) * 2);
        const v2u xr = *(const GAS v2u*)(xg + t0);
        const float prev = t0 > 0 ? bf2f(xg[t0 - 1]) : 0.f, next = t0 + 4 < L ? bf2f(xg[t0 + 4]) : 0.f;
        const float x[6] = {prev, bflo(xr.x), bfhi(xr.x), bflo(xr.y), bfhi(xr.y), next};
        const float uu[4] = {bflo(ur.x), bfhi(ur.x), bflo(ur.y), bfhi(ur.y)};
        float z[4];
#pragma unroll
        for (int r = 0; r < 4; ++r) { const float xc = cw0 * x[r] + cw1 * x[r + 1] + cw2 * x[r + 2] + cb; z[r] = xc * (acc[k][r] * invn + skip * uu[r]); }
        v2u o; o.x = pk2(z[0], z[1]); o.y = pk2(z[2], z[3]);
        if (last) *(GAS v2u*)(zt + t0) = o; else *(LAS v2u*)(ub + (256 + t0) * 2) = o; }
}
}

constexpr int NPHASE = 35;
#ifndef PHMASK
#define PHMASK 0xFFFF
#endif
#define PHON(b) ((PHMASK >> (b)) & 1)
#ifndef REPMASK
#define REPMASK 0
#endif
#ifndef REPN
#define REPN 2
#endif
#define RUN(b, call) do { _Pragma("unroll 1") for (int r_ = 0; r_ < (((REPMASK >> (b)) & 1) ? REPN : 1); ++r_) { call; } } while (0)
#ifndef MK_PER_PHASE
#define MK_PER_PHASE 0
#endif


template <class T> __device__ __forceinline__ T* launder(T* p) { asm volatile("" : "+s"(p)); return p; }
#define ENV_IDS int tid_ = threadIdx.x; asm volatile("" : "+v"(tid_)); const int tid = tid_, lane = tid & 63, wave = __builtin_amdgcn_readfirstlane(tid >> 6); const int G = gridDim.x, bx = blockIdx.x; \
    const int vcu = (G % 8 == 0) ? (bx % 8) * (G / 8) + bx / 8 : bx; const int gw = vcu * NWAVES + wave, NGW = G * NWAVES; (void)tid; (void)lane; (void)gw; (void)NGW; (void)bx;
#define ENV_PTRS unsigned char* ws = launder(A.ws); float* out = launder(A.out); (void)out; (void)ws;

__device__ __forceinline__ void ph_prologue_a(const Args& A, LAS unsigned char* L) {
    ENV_IDS ENV_PTRS
    LAS float* wscr = (LAS float*)(L + wave * 16384);
    for (int it = gw; it < IT_TOTAL; it += NGW) weight_item(A, it, wscr, lane);
    { const size_t NCH = (size_t)2 * 524288 + 2 * 262144;
      for (size_t ch = (size_t)gw * 64 + lane; ch < NCH; ch += (size_t)NGW * 64) {
          int ten; size_t off; unsigned char* dstb;
          if (ch < 524288) { ten = 0; off = ch * 8; dstb = ws + WS_CWK; } else if (ch < 1048576) { ten = 1; off = (ch - 524288) * 8; dstb = ws + WS_CWV; }
          else if (ch < 1310720) { ten = 2; off = (ch - 1048576) * 8; dstb = ws + WS_CAK; } else { ten = 3; off = (ch - 1310720) * 8; dstb = ws + WS_CAV; }
          const float* src = A.in[2 + ten] + off; const f32x4 a = *(const GAS f32x4*)src, b = *(const GAS f32x4*)(src + 4);
          v4u o; o.x = pk2(a.x, a.y); o.y = pk2(a.z, a.w); o.z = pk2(b.x, b.y); o.w = pk2(b.z, b.w);
          *(GAS v4u*)((bf16*)dstb + off) = o; } }
    for (int u = gw; u < 1536; u += NGW) adaln_partial_unit(A, __builtin_amdgcn_readfirstlane(u), wscr, lane);
    for (int rr = gw; rr < 2304; rr += NGW) filter_a2_row(A, __builtin_amdgcn_readfirstlane(rr), lane);
}
__device__ __forceinline__ void ph_prologue_b(const Args& A, LAS unsigned char* L) {
    ENV_IDS ENV_PTRS
    LAS float* wscr = (LAS float*)(L + wave * 16384);
    float* MODF = (float*)(ws + WS_MODF);
    for (int e = gw * 64 + lane; e < DEPTH * 9 * DM; e += NGW * 64) { const int layer = e / (9 * DM), c = (e / DM) % 9, col = e % DM;
        float m[6];
#pragma unroll
        for (int q = 0; q < 6; ++q) { float s = A.in[11][(size_t)layer * 12288 + q * DM + col];
#pragma unroll
            for (int kc = 0; kc < 8; ++kc) s += ((const float*)(ws + WS_MODP))[(size_t)((layer * 8 + kc) * 9 + c) * 12288 + q * DM + col];
            m[q] = s; }
        float* mf = MODF + (size_t)((layer * 9 + c) * 6) * DM + col;
        mf[0 * DM] = A.in[8][layer * DM + col] * (1.0f + m[1]); mf[1 * DM] = m[0]; mf[2 * DM] = m[2];
        mf[3 * DM] = A.in[9][layer * DM + col] * (1.0f + m[4]); mf[4 * DM] = m[3]; mf[5 * DM] = m[5]; }
    for (int u = gw; u < 2304; u += NGW) filter_hf_unit(A, __builtin_amdgcn_readfirstlane(u), wscr, lane);
}
__device__ __forceinline__ void ph_norm(const Args& A, int layer, int which) {
    ENV_IDS ENV_PTRS
    const float* modf = (const float*)(ws + WS_MODF) + (size_t)layer * 9 * 6 * DM; bf16* HB = (bf16*)(ws + WS_H);
    const float* xc = (layer == 0 && which == 0) ? A.in[0] : out; const float* xl = (layer == 0 && which == 0) ? A.in[1] : out + (size_t)NCTX * DM;
    for (int row = gw; row < NTOK; row += NGW) { const int cv = row < NCTX ? 0 : 1 + ((row - NCTX) >> 11);
        const float* xr = row < NCTX ? xc + (size_t)row * DM : xl + (size_t)(row - NCTX) * DM;
        norm_row(xr, modf + (size_t)(cv * 6 + 3 * which) * DM, modf + (size_t)(cv * 6 + 3 * which + 1) * DM, HB + (size_t)row * DM, lane); }
}
__device__ __forceinline__ void ph_qkv(const Args& A, int layer, LAS unsigned char* L) {
    ENV_PTRS
    const int G = gridDim.x, bx = blockIdx.x; const bool is_ax = (layer % 3) == 2; const int jx = layer / 3;
    const bf16* W = (const bf16*)(ws + (is_ax ? WS_WQKVA : (jx == 0 ? WS_WQKV0 : WS_WQKV1)));
    pg8::Gemm g{(const bf16*)(ws + WS_H), W, NTOK, QKVD, DM}; pg8::StaticOrder S; S.init(NTOK, QKVD, G, bx);
    pg8::EpiQKV E{(bf16*)(ws + WS_BIG), is_ax ? nullptr : out + OUT_WK + (size_t)jx * 256 * 512, is_ax ? out + OUT_AV : out + OUT_WV + (size_t)jx * 256 * 512, is_ax ? 0 : 256};
    pg8::gemm_phase<pg8::EpiQKV, pg8::StaticOrder, true, true>(L, g, S, E);
}
__device__ __forceinline__ void ph_qkpost(const Args& A, int layer) {
    ENV_IDS ENV_PTRS
    const bool is_ax = (layer % 3) == 2; bf16* QKVB = (bf16*)(ws + WS_BIG);
    for (int row = (is_ax ? 0 : NCTX) + gw; row < NTOK; row += NGW)
        qkpost_row(QKVB + (size_t)row * QKVD, row, is_ax, A.in[27], A.in[28], out + OUT_AK, lane);
}
__device__ __forceinline__ void ph_attn(const Args& A, int layer, char* lds) {
    ENV_PTRS
    const int G = gridDim.x, bx = blockIdx.x; const bool is_ax = (layer % 3) == 2; const int jx = layer / 3;
    const att::bf16* QK = (const att::bf16*)(ws + WS_BIG); att::bf16* OB = (att::bf16*)(ws + WS_H);
    const att::bf16* CK = (const att::bf16*)(ws + (is_ax ? WS_CAK : WS_CWK));
    const att::bf16* CV = (const att::bf16*)(ws + (is_ax ? WS_CAV : WS_CWV));
    const int ncl = is_ax ? 1 : 2;
#pragma unroll 1
    for (int u = bx; u < 1536; u += G) {
        att::Unit U;
        if (u < 1024) { const int b = u >> 7, qb = (u >> 4) & 7, h = u & 15, kvh = h >> 2;
            const size_t r0 = (size_t)NCTX + (size_t)b * 2048 + (size_t)qb * 256;
            U.Q = QK + r0 * QKVD + h * 128; U.ldq = QKVD;
            const size_t coff = ((size_t)(b * ncl + (is_ax ? 0 : jx)) * 512) * 512 + kvh * 128;
            U.KA = CK + coff; U.VA = CV + coff; U.ldA = 512; U.nA = 8;
            const int klo = is_ax ? 0 : (qb * 256 - 128 < 0 ? 0 : qb * 256 - 128), khi = is_ax ? 2048 : (qb * 256 + 384 > 2048 ? 2048 : qb * 256 + 384);
            const size_t kr0 = (size_t)NCTX + (size_t)b * 2048 + klo;
            U.KB = QK + kr0 * QKVD + 2048 + kvh * 128; U.VB = QK + kr0 * QKVD + 2560 + kvh * 128; U.ldB = QKVD;
            U.NT = 8 + (khi - klo) / 64; U.win = is_ax ? 0 : 1; U.dq0 = qb * 256 - klo;
            U.O = OB + r0 * DM + h * 128; U.ldo = DM;
            U.has_sink = is_ax ? 0 : 1; U.sink = is_ax ? 0.f : A.in[14][jx * 16 + h];
        } else { const int uc = u - 1024, b = uc >> 4, h = uc & 15, kvh = h >> 2; const size_t r0 = (size_t)b * 256;
            U.Q = QK + r0 * QKVD + h * 128; U.ldq = QKVD;
            U.KA = QK + r0 * QKVD + 2048 + kvh * 128; U.VA = QK + r0 * QKVD + 2560 + kvh * 128; U.ldA = QKVD; U.nA = 4;
            U.KB = U.KA; U.VB = U.VA; U.ldB = QKVD; U.NT = 4; U.win = 0; U.dq0 = 0;
            U.O = OB + r0 * DM + h * 128; U.ldo = DM;
            U.has_sink = is_ax ? 0 : 1; U.sink = is_ax ? 0.f : A.in[14][jx * 16 + h];
        }
        att::attn_unit(U, lds);
    }
}
__device__ __forceinline__ void ph_hyin(const Args& A, LAS unsigned char* L) {
    ENV_PTRS
    const int G = gridDim.x, bx = blockIdx.x;
    pg8::Gemm g{(const bf16*)(ws + WS_WHI), (const bf16*)(ws + WS_H), 6144, NTOK, DM}; pg8::StaticOrder S; S.init(6144, NTOK, G, bx);
    pg8::EpiBf16 E{(bf16*)(ws + WS_BIG), NTOK};
    pg8::gemm_phase<pg8::EpiBf16, pg8::StaticOrder, true, true>(L, g, S, E);
}
__device__ __forceinline__ void ph_hyconv(const Args& A, LAS unsigned char* L) {
    ENV_IDS ENV_PTRS
    const bf16* UT = (const bf16*)(ws + WS_BIG); bf16* ZT = (bf16*)(ws + WS_ZT);
    const float* cw = A.in[16]; const float* cbv = A.in[17]; const float* skp = A.in[24]; const float* NP = (const float*)(ws + WS_NP);
    LAS unsigned char* ub = L + hy::U_OFF + wave * hy::U_BYTES;
#pragma unroll 1
    for (int d = bx; d < DM; d += G) {
        float w0[3], w1[3], w2[3], cb[3];
#pragma unroll
        for (int p = 0; p < 3; ++p) { const int ch = p * DM + d; w0[p] = cw[ch]; w1[p] = cw[6144 + ch]; w2[p] = cw[2 * 6144 + ch]; cb[p] = cbv[ch]; }
        float invn[2][2];
#pragma unroll
        for (int o = 0; o < 2; ++o) { float sl = 0.f, sc = 0.f;
            for (int ch = 0; ch < 16; ++ch) sl += NP[(size_t)ch * 8192 + o * 2048 + d] + NP[(size_t)ch * 8192 + 4096 + o * 2048 + d];
            for (int ch = 16; ch < 18; ++ch) sc += NP[(size_t)ch * 8192 + o * 2048 + d] + NP[(size_t)ch * 8192 + 4096 + o * 2048 + d];
            invn[0][o] = 1.0f / (sl + 1e-6f); invn[1][o] = 1.0f / (sc + 1e-6f); }
        const float sk0 = skp[d], sk1 = skp[DM + d];
        const bf16* ftl = (const bf16*)(ws + WS_FT) + (size_t)d * 2 * 2048; const bf16* ftc = (const bf16*)(ws + WS_FT_CTX) + (size_t)d * 2 * 256;
        { const size_t sb = (size_t)NCTX + (size_t)wave * 2048;
          hy::fill_u(ub, UT + (size_t)d * NTOK + sb, 2048, w0[0], w1[0], w2[0], cb[0], lane);
          __syncthreads(); hy::build_copies(L, ftl, 2048, tid); __syncthreads();
          f32x4 acc[8];
#pragma unroll
          for (int k = 0; k < 8; ++k) acc[k] = (f32x4){0.f, 0.f, 0.f, 0.f};
          hy::toeplitz<8>(L, ub, acc, lane);
          hy::gate<8>(acc, ub, UT + (size_t)(DM + d) * NTOK + sb, w0[1], w1[1], w2[1], cb[1], invn[0][0], sk0, lane, false, nullptr);
          __syncthreads(); hy::build_copies(L, ftl + (size_t)2048 * 2 * 2048, 2048, tid); __syncthreads();
#pragma unroll
          for (int k = 0; k < 8; ++k) acc[k] = (f32x4){0.f, 0.f, 0.f, 0.f};
          hy::toeplitz<8>(L, ub, acc, lane);
          hy::gate<8>(acc, ub, UT + (size_t)(2 * DM + d) * NTOK + sb, w0[2], w1[2], w2[2], cb[2], invn[0][1], sk1, lane, true, ZT + (size_t)d * NTOK + sb); }
        { for (int q = 0; q < 4; ++q) hy::fill_u(ub + q * 1536, UT + (size_t)d * NTOK + (size_t)(wave * 4 + q) * 256, 256, w0[0], w1[0], w2[0], cb[0], lane);
          __syncthreads(); hy::build_copies(L, ftc, 256, tid); __syncthreads();
#pragma unroll 1
          for (int q = 0; q < 4; ++q) { const size_t sb = (size_t)(wave * 4 + q) * 256; f32x4 acc[1]; acc[0] = (f32x4){0.f, 0.f, 0.f, 0.f};
              hy::toeplitz<1>(L, ub + q * 1536, acc, lane);
              hy::gate<1>(acc, ub + q * 1536, UT + (size_t)(DM + d) * NTOK + sb, w0[1], w1[1], w2[1], cb[1], invn[1][0], sk0, lane, false, nullptr); }
          __syncthreads(); hy::build_copies(L, ftc + (size_t)2048 * 2 * 256, 256, tid); __syncthreads();
#pragma unroll 1
          for (int q = 0; q < 4; ++q) { const size_t sb = (size_t)(wave * 4 + q) * 256; f32x4 acc[1]; acc[0] = (f32x4){0.f, 0.f, 0.f, 0.f};
              hy::toeplitz<1>(L, ub + q * 1536, acc, lane);
              hy::gate<1>(acc, ub + q * 1536, UT + (size_t)(2 * DM + d) * NTOK + sb, w0[2], w1[2], w2[2], cb[2], invn[1][1], sk1, lane, true, ZT + (size_t)d * NTOK + sb); } }
    }
    __syncthreads();
}
__device__ __forceinline__ void ph_hytr(const Args& A, LAS unsigned char* L) {
    ENV_IDS ENV_PTRS
    const bf16* ZT = (const bf16*)(ws + WS_ZT); bf16* HB = (bf16*)(ws + WS_H);
    LAS unsigned char* scr = L + wave * 16384;
    for (int tile = gw; tile < 32 * 384; tile += NGW) { const int d0 = (tile & 31) * 64, r0 = (tile >> 5) * 64;
#pragma unroll
        for (int j = 0; j < 8; ++j) { const int idx = j * 64 + lane, dl = idx >> 3, ch = idx & 7;
            *(LAS v4u*)(scr + dl * 144 + ch * 16) = *(const GAS v4u*)(ZT + (size_t)(d0 + dl) * NTOK + r0 + ch * 8); }
        LDS_WAIT(); asm volatile("" ::: "memory");
#pragma unroll
        for (int j = 0; j < 8; ++j) { unsigned e[8];
#pragma unroll
            for (int q = 0; q < 8; ++q) e[q] = *(const LAS unsigned short*)(scr + (j * 8 + q) * 144 + lane * 2);
            v4u o; o.x = e[0] | (e[1] << 16); o.y = e[2] | (e[3] << 16); o.z = e[4] | (e[5] << 16); o.w = e[6] | (e[7] << 16);
            *(GAS v4u*)(HB + (size_t)(r0 + lane) * DM + d0 + j * 8) = o; }
        LDS_WAIT(); asm volatile("" ::: "memory"); }
}
__device__ __forceinline__ void ph_mixout(const Args& A, int layer, LAS unsigned char* L) {
    ENV_PTRS
    const int G = gridDim.x, bx = blockIdx.x; const int kind = layer % 3, jx = layer / 3;
    const float* modf = (const float*)(ws + WS_MODF) + (size_t)layer * 9 * 6 * DM;
    const float* xc = layer == 0 ? A.in[0] : out; const float* xl = layer == 0 ? A.in[1] : out + (size_t)NCTX * DM;
    const bf16* W = (const bf16*)(ws + (kind == 1 ? WS_WHO : (kind == 2 ? WS_WOA : (jx == 0 ? WS_WO0 : WS_WO1))));
    pg8::Gemm g{(const bf16*)(ws + WS_H), W, NTOK, DM, DM}; pg8::StaticOrder S; S.init(NTOK, DM, G, bx);
    pg8::EpiResid E{xc, xl, out, modf + 2 * DM};
    pg8::gemm_phase<pg8::EpiResid, pg8::StaticOrder, true, true>(L, g, S, E);
}
__device__ __forceinline__ void ph_gu(const Args& A, int layer, LAS unsigned char* L) {
    ENV_PTRS
    const int G = gridDim.x, bx = blockIdx.x;
    pg8::Gemm g{(const bf16*)(ws + WS_H), (const bf16*)(ws + WS_WGU + (size_t)layer * W_GU), NTOK, NGU, DM}; pg8::StaticOrder S; S.init(NTOK, NGU, G, bx);
    pg8::EpiSwiglu E{(bf16*)(ws + WS_BIG)};
    pg8::gemm_phase<pg8::EpiSwiglu, pg8::StaticOrder, true, true>(L, g, S, E);
}
__device__ __forceinline__ void ph_down(const Args& A, int layer, LAS unsigned char* L) {
    ENV_PTRS
    const int G = gridDim.x, bx = blockIdx.x;
    const float* modf = (const float*)(ws + WS_MODF) + (size_t)layer * 9 * 6 * DM;
    pg8::Gemm g{(const bf16*)(ws + WS_BIG), (const bf16*)(ws + WS_WDN + (size_t)layer * W_DN), NTOK, DM, DFF}; pg8::StaticOrder S; S.init(NTOK, DM, G, bx);
    pg8::EpiResid E{out, out + (size_t)NCTX * DM, out, modf + 5 * DM};
    pg8::gemm_phase<pg8::EpiResid, pg8::StaticOrder, true, true>(L, g, S, E);
}
__device__ __forceinline__ void ph_final(const Args& A) {
    ENV_IDS ENV_PTRS
    for (int row = gw; row < NTOK; row += NGW) final_norm_row(out + (size_t)row * DM, A.in[32], lane);
}

__global__ void __launch_bounds__(NWAVES * 64, 2) hybrid_fwd(Args A) {
    extern __shared__ __attribute__((aligned(16))) unsigned char lds[];
    LAS unsigned char* L = (LAS unsigned char*)lds;
    for (int u = threadIdx.x; u < (LDS_BYTES - LDSCTL_OFF) / 4; u += NWAVES * 64) ((LAS unsigned*)(L + LDSCTL_OFF))[u] = 0u;
    __syncthreads();
    XcdBarrier bar; bar.bar = (unsigned*)(A.ws + WS_CTL) + CW_BAR; bar.x = 0; bar.st = nullptr;
    if (!MK_PER_PHASE) bar = xcd_barrier_post((unsigned*)(A.ws + WS_CTL) + CW_BAR, (volatile LAS unsigned*)(L + MISC_OFF) + 8);
    const int lo = A.ph_lo, hi = A.ph_hi;
#define IN(k) (lo <= (k) && (k) < hi)
#define SEAM(k) do { if (IN(k) && IN((k) + 1)) xcd_barrier(bar); } while (0)
    if (PHON(0) && IN(0)) RUN(0, ph_prologue_a(A, L));
    SEAM(0);
    if (PHON(1) && IN(1)) RUN(1, ph_prologue_b(A, L));
    SEAM(1);
#pragma unroll 1
    for (int layer = 0; layer < DEPTH; ++layer) {
        const int pb = 2 + 8 * layer;
        if (PHON(2) && IN(pb + 0)) RUN(2, ph_norm(A, layer, 0));
        SEAM(pb + 0);
        if ((layer % 3) != 1) {
            if (PHON(3) && IN(pb + 1)) RUN(3, ph_qkv(A, layer, L));
            SEAM(pb + 1);
            if (PHON(4) && IN(pb + 2)) RUN(4, ph_qkpost(A, layer));
            SEAM(pb + 2);
            if (PHON(5) && IN(pb + 3)) RUN(5, ph_attn(A, layer, (char*)lds));
            SEAM(pb + 3);
        } else {
            if (PHON(6) && IN(pb + 1)) RUN(6, ph_hyin(A, L));
            SEAM(pb + 1);
            if (PHON(7) && IN(pb + 2)) RUN(7, ph_hyconv(A, L));
            SEAM(pb + 2);
            if (PHON(8) && IN(pb + 3)) RUN(8, ph_hytr(A, L));
            SEAM(pb + 3);
        }
        if (PHON(9) && IN(pb + 4)) RUN(9, ph_mixout(A, layer, L));
        SEAM(pb + 4);
        if (PHON(10) && IN(pb + 5)) RUN(10, ph_norm(A, layer, 1));
        SEAM(pb + 5);
        if (PHON(11) && IN(pb + 6)) RUN(11, ph_gu(A, layer, L));
        SEAM(pb + 6);
        if (PHON(12) && IN(pb + 7)) RUN(12, ph_down(A, layer, L));
        SEAM(pb + 7);
    }
    if (PHON(13) && IN(34)) RUN(13, ph_final(A));
#undef IN
#undef SEAM
}

extern "C" void kernel_launch(void* const* d_in, const int* in_sizes, int n_in, void* d_out, int out_size, void* d_ws, size_t ws_size, hipStream_t stream) {
    static int grid = 0;
    if (grid == 0) {
        if (n_in != 33 || (size_t)out_size != OUT_END || ws_size < WS_END) { fprintf(stderr, "kernel_launch: unexpected shapes: n_in %d out %d ws %zu (need %zu)\n", n_in, out_size, ws_size, (size_t)WS_END); grid = -1; return; }
        int dev = 0, cus = 0, per_cu = 0;
        if (hipGetDevice(&dev) != hipSuccess || hipDeviceGetAttribute(&cus, hipDeviceAttributeMultiprocessorCount, dev) != hipSuccess) { grid = -1; return; }
        if (hipFuncSetAttribute((const void*)hybrid_fwd, hipFuncAttributeMaxDynamicSharedMemorySize, LDS_BYTES) != hipSuccess) { fprintf(stderr, "kernel_launch: hipFuncSetAttribute failed\n"); grid = -1; return; }
        if (hipOccupancyMaxActiveBlocksPerMultiprocessor(&per_cu, (const void*)hybrid_fwd, NWAVES * 64, LDS_BYTES) != hipSuccess || per_cu < 1)
            fprintf(stderr, "kernel_launch: occupancy query reports %d workgroups per CU\n", per_cu);
        (void)hipGetLastError();
        grid = cus;
    }
    if (grid < 0) return;
    if (hipMemsetAsync((char*)d_ws + WS_CTL, 0, CTL_ZERO_BYTES, stream) != hipSuccess) { fprintf(stderr, "kernel_launch: memset failed\n"); return; }
    Args a{};
    for (int i = 0; i < 33; ++i) a.in[i] = (const float*)d_in[i];
    a.out = (float*)d_out; a.ws = (unsigned char*)d_ws;
#if MK_PER_PHASE
    for (int ph = 0; ph < NPHASE; ++ph) { a.ph_lo = ph; a.ph_hi = ph + 1; hipLaunchKernelGGL(hybrid_fwd, dim3(grid), dim3(NWAVES * 64), LDS_BYTES, stream, a); }
#else
    a.ph_lo = 0; a.ph_hi = NPHASE; hipLaunchKernelGGL(hybrid_fwd, dim3(grid), dim3(NWAVES * 64), LDS_BYTES, stream, a);
#endif
    const hipError_t le = hipPeekAtLastError();
    if (le != hipSuccess) fprintf(stderr, "kernel_launch: launch failed: %s\n", hipGetErrorName(le));
}
```

```cpp
#include <hip/hip_runtime.h>
#include <cstdio>
#include <cstdint>
#include <hip/hip_bf16.h>
#include <cmath>
namespace pg8 {
#define PG8_LAS __attribute__((address_space(3)))
typedef unsigned short bf16_t;
typedef short bf16x8 __attribute__((ext_vector_type(8)));
typedef float f32x4 __attribute__((ext_vector_type(4)));
typedef unsigned u32x4 __attribute__((ext_vector_type(4)));
constexpr int BM = 256, BK = 64, HALF = 128, HTB = HALF * BK * 2  , STAGE_BYTES = 8 * HTB, NXCD = 8, WGM = 8;

__host__ __device__ __forceinline__ int lds_byte(int r, int c) { const int st = (r >> 4) * 2 + (c >> 5), rr = r & 15, cc = c & 31, ob = rr * 64 + cc * 2; return st * 1024 + (ob ^ (((ob >> 9) & 1) << 5)); }
__host__ __device__ __forceinline__ void stage_rc(int b, int& R, int& C) { const int st = b / 1024, sb = b % 1024, swz = sb ^ (((sb >> 9) & 1) << 5); R = (st >> 1) * 16 + swz / 64; C = (st & 1) * 32 + (swz % 64) / 2; }
__host__ __device__ __forceinline__ int perm32(int rho) { const int n = rho >> 4, i = rho & 15; return 8 * (i >> 2) + 4 * n + (i & 3); }

struct Unit { int pm, pn; };
struct Gemm { const bf16_t* A; const bf16_t* Bt; int M, N, K; };

struct StaticOrder {
    int nM, nN, nwg, G, c;
    __host__ __device__ void init(int M, int N, int G_, int c_) { nM = M / BM; nN = N / BM; nwg = nM * nN; G = G_; c = c_; }
    __host__ __device__ bool next(int i, Unit& u) const {
        const long L = (long)i * G + c; if (L >= nwg) return false;
        int wgid = (int)L; { const int q = nwg / NXCD, r = nwg % NXCD, xcd = wgid % NXCD, off = wgid / NXCD; wgid = (xcd < r ? xcd * (q + 1) : r * (q + 1) + (xcd - r) * q) + off; }
        const int nig = WGM * nN, gid = wgid / nig, fm = gid * WGM, gsz = (nM - fm) < WGM ? (nM - fm) : WGM;
        u.pm = fm + ((wgid % nig) % gsz); u.pn = (wgid % nig) / gsz; return true;
    }
    __device__ __forceinline__ void a_ready(const Unit&) const {}
    __device__ __forceinline__ void done(const Unit&) const {}
};

__device__ __forceinline__ unsigned cvt_pk_bf16(float lo, float hi) { unsigned r; asm volatile("v_cvt_pk_bf16_f32 %0, %1, %2" : "=v"(r) : "v"(lo), "v"(hi)); return r; }
typedef float f32x2 __attribute__((ext_vector_type(2)));
struct EpiBf16 {
    static constexpr bool PERM = true, AFTER_DRAIN = false;
    bf16_t* O; int ldc;
    __device__ __forceinline__ void operator()(const f32x4 (&acc)[2][2][4][2], const Unit& u, int wr, int wc, int fr, int fq) const {
        const int row0 = u.pm * BM + wr * 64 + fr; const int col0 = u.pn * BM + wc * 32 + 8 * fq;
#pragma unroll
        for (int ai = 0; ai < 2; ++ai)
#pragma unroll
            for (int m = 0; m < 4; ++m) { bf16_t* rowp = O + (size_t)(row0 + ai * HALF + m * 16) * ldc + col0;
#pragma unroll
                for (int bj = 0; bj < 2; ++bj) { const f32x4 v0 = acc[ai][bj][m][0], v1 = acc[ai][bj][m][1];
                    u32x4 w; w.x = cvt_pk_bf16(v0[0], v0[1]); w.y = cvt_pk_bf16(v0[2], v0[3]); w.z = cvt_pk_bf16(v1[0], v1[1]); w.w = cvt_pk_bf16(v1[2], v1[3]);
                    *(u32x4*)(rowp + bj * HALF) = w; } }
    }
};
struct EpiQKV {
    static constexpr bool PERM = true, AFTER_DRAIN = false;
    bf16_t* O; float* sk; float* sv; int extra;
    __device__ __forceinline__ void operator()(const f32x4 (&acc)[2][2][4][2], const Unit& u, int wr, int wc, int fr, int fq) const {
        const int row0 = u.pm * BM + wr * 64 + fr; const int col0 = u.pn * BM + wc * 32 + 8 * fq;
        float* sb = nullptr; int scol = 0;
        if (u.pm < 32 && u.pn >= 8) { if (u.pn < 10) { sb = sk; scol = col0 - 2048; } else { sb = sv; scol = col0 - 2560; } }
#pragma unroll
        for (int ai = 0; ai < 2; ++ai)
#pragma unroll
            for (int m = 0; m < 4; ++m) { const int row = row0 + ai * HALF + m * 16; bf16_t* rowp = O + (size_t)row * 3072 + col0;
#pragma unroll
                for (int bj = 0; bj < 2; ++bj) { const f32x4 v0 = acc[ai][bj][m][0], v1 = acc[ai][bj][m][1];
                    u32x4 w; w.x = cvt_pk_bf16(v0[0], v0[1]); w.y = cvt_pk_bf16(v0[2], v0[3]); w.z = cvt_pk_bf16(v1[0], v1[1]); w.w = cvt_pk_bf16(v1[2], v1[3]);
                    *(u32x4*)(rowp + bj * HALF) = w;
                    if (sb) { float* sp = sb + (size_t)(row + (row >> 8) * extra) * 512 + scol + bj * HALF; *(f32x4*)sp = v0; *(f32x4*)(sp + 4) = v1; } } }
    }
};
struct EpiResid {
    static constexpr bool PERM = false, AFTER_DRAIN = false;
    const float* xc; const float* xl; float* out; const float* gate;
    __device__ __forceinline__ void operator()(const f32x4 (&acc)[2][2][4][2], const Unit& u, int wr, int wc, int fr, int fq) const {
        const int row0 = u.pm * BM + wr * 64 + fr; const int col0 = u.pn * BM + wc * 32 + 4 * fq;
        const int cv = u.pm < 32 ? 0 : 1 + ((u.pm - 32) >> 3);
        const float* gp = gate + (size_t)cv * (6 * 2048) + col0;
        const float* xin = u.pm < 32 ? xc + (size_t)row0 * 2048 + col0 : xl + (size_t)(row0 - 8192) * 2048 + col0;
        float* op = out + (size_t)row0 * 2048 + col0;
        f32x4 gv[2][2];
#pragma unroll
        for (int bj = 0; bj < 2; ++bj)
#pragma unroll
            for (int n = 0; n < 2; ++n) gv[bj][n] = *(const f32x4*)(gp + bj * HALF + n * 16);
#pragma unroll
        for (int ai = 0; ai < 2; ++ai)
#pragma unroll
            for (int m = 0; m < 4; ++m) { const size_t ro = (size_t)(ai * HALF + m * 16) * 2048;
#pragma unroll
                for (int bj = 0; bj < 2; ++bj)
#pragma unroll
                    for (int n = 0; n < 2; ++n) { const f32x4 x = *(const f32x4*)(xin + ro + bj * HALF + n * 16);
                        *(f32x4*)(op + ro + bj * HALF + n * 16) = x + gv[bj][n] * acc[ai][bj][m][n]; }
                if (m & 1) asm volatile("" ::: "memory"); }
    }
};
struct EpiSwiglu {
    static constexpr bool PERM = true, AFTER_DRAIN = false;
    bf16_t* O;
    __device__ __forceinline__ float sw(float g, float uu) const { return g * __builtin_amdgcn_rcpf(1.0f + __builtin_amdgcn_exp2f(-1.4426950408889634f * g)) * uu; }
    __device__ __forceinline__ void operator()(const f32x4 (&acc)[2][2][4][2], const Unit& u, int wr, int wc, int fr, int fq) const {
        const int row0 = u.pm * BM + wr * 64 + fr; const int col0 = u.pn * HALF + wc * 32 + 8 * fq;
#pragma unroll
        for (int ai = 0; ai < 2; ++ai)
#pragma unroll
            for (int m = 0; m < 4; ++m) { bf16_t* rowp = O + (size_t)(row0 + ai * HALF + m * 16) * 5632 + col0;
                const f32x4 g0 = acc[ai][0][m][0], g1 = acc[ai][0][m][1], u0 = acc[ai][1][m][0], u1 = acc[ai][1][m][1];
                u32x4 w; w.x = cvt_pk_bf16(sw(g0[0], u0[0]), sw(g0[1], u0[1])); w.y = cvt_pk_bf16(sw(g0[2], u0[2]), sw(g0[3], u0[3]));
                w.z = cvt_pk_bf16(sw(g1[0], u1[0]), sw(g1[1], u1[1])); w.w = cvt_pk_bf16(sw(g1[2], u1[2]), sw(g1[3], u1[3]));
                *(u32x4*)rowp = w; }
    }
};

template <class Epi, class Sched, bool ALIGN_EPI = false, bool SP2 = false>
__device__ __forceinline__ void gemm_phase(PG8_LAS unsigned char* lds, const Gemm g, const Sched& S, const Epi& E) {
    int tid_ = threadIdx.x; asm volatile("" : "+v"(tid_));
    const int tid = tid_, wid = __builtin_amdgcn_readfirstlane(tid >> 6), lane = tid & 63, wr = wid >> 2, wc = wid & 3, fr = lane & 15, fq = lane >> 4;
    const int K = g.K, nt = K / BK;
    unsigned voffA[2], voffB[2];
#pragma unroll
    for (int i = 0; i < 2; ++i) { int R, C; stage_rc(tid * 16 + i * 8192, R, C); const int Rb = Epi::PERM ? ((R & ~31) + perm32(R & 31)) : R;
        voffA[i] = (unsigned)(R * K + C) * 2u; voffB[i] = (unsigned)(Rb * K + C) * 2u; }
    const size_t kstep = (size_t)(BK * 2);
    const size_t hstep = (size_t)HALF * K * 2;
    const size_t tstep = 2 * hstep;
    const unsigned ldsw = (unsigned)wid * 1024u;
    const int aoff = lds_byte(wr * 64 + fr, fq * 8), boff = lds_byte(wc * 32 + fr, fq * 8);
#define PG8_SA(b, h) (((b) * 2 + (h)) * HTB)
#define PG8_SB(b, h) ((4 + (b) * 2 + (h)) * HTB)
#define PG8_STAGE(bufoff, gbase, voff) do { _Pragma("unroll") for (int _i = 0; _i < 2; ++_i) \
        __builtin_amdgcn_global_load_lds((const unsigned*)((const char*)(gbase) + (voff)[_i]), (PG8_LAS unsigned*)(lds + (bufoff) + ldsw + _i * 8192), 16, 0, 0); } while (0)
#define PG8_LDA(dst, b, h) do { _Pragma("unroll") for (int m = 0; m < 4; ++m) _Pragma("unroll") for (int k = 0; k < 2; ++k) dst[m][k] = *(const PG8_LAS bf16x8*)(lds + PG8_SA(b, h) + aoff + m * 2048 + k * 1024); } while (0)
#define PG8_LDB(dst, b, h) do { _Pragma("unroll") for (int n = 0; n < 2; ++n) _Pragma("unroll") for (int k = 0; k < 2; ++k) dst[n][k] = *(const PG8_LAS bf16x8*)(lds + PG8_SB(b, h) + boff + n * 2048 + k * 1024); } while (0)
#define PG8_MMA(ai, bj, At, Bt) do { __builtin_amdgcn_s_setprio(1); _Pragma("unroll") for (int m = 0; m < 4; ++m) _Pragma("unroll") for (int n = 0; n < 2; ++n) _Pragma("unroll") for (int k = 0; k < 2; ++k) \
        acc[ai][bj][m][n] = __builtin_amdgcn_mfma_f32_16x16x32_bf16(Bt[n][k], At[m][k], acc[ai][bj][m][n], 0, 0, 0); __builtin_amdgcn_s_setprio(0); } while (0)
#define PG8_WAIT_V(n) asm volatile("s_waitcnt vmcnt(" #n ")" ::: "memory")
#define PG8_WAIT_L(n) asm volatile("s_waitcnt lgkmcnt(" #n ")" ::: "memory")
#define PG8_BAR __builtin_amdgcn_s_barrier()
#define PG8_SCHED __builtin_amdgcn_sched_barrier(0)
    Unit cur, nxt; int ui = 0;
    if (!S.next(0, cur)) return;
    f32x4 acc[2][2][4][2];
#pragma unroll
    for (int a = 0; a < 2; ++a)
#pragma unroll
        for (int b = 0; b < 2; ++b)
#pragma unroll
            for (int m = 0; m < 4; ++m)
#pragma unroll
                for (int n = 0; n < 2; ++n) acc[a][b][m][n] = (f32x4){0.f, 0.f, 0.f, 0.f};
    bf16x8 At[4][2], B0[2][2], B1[2][2];
    const char* cA = (const char*)g.A + (size_t)cur.pm * tstep; const char* cB = (const char*)g.Bt + (size_t)cur.pn * tstep;
    S.a_ready(cur);
    if constexpr (SP2) {
        PG8_STAGE(PG8_SB(0, 0), cB, voffB); PG8_STAGE(PG8_SB(0, 1), cB + hstep, voffB); PG8_STAGE(PG8_SA(0, 0), cA, voffA); PG8_STAGE(PG8_SA(0, 1), cA + hstep, voffA);
        if (wr == 1) PG8_BAR;
        PG8_WAIT_V(2); PG8_BAR;
        PG8_STAGE(PG8_SB(1, 0), cB + kstep, voffB); PG8_STAGE(PG8_SA(1, 0), cA + kstep, voffA); PG8_STAGE(PG8_SB(1, 1), cB + hstep + kstep, voffB);
        PG8_WAIT_V(6); PG8_BAR;
    } else {
        PG8_STAGE(PG8_SB(0, 0), cB, voffB); PG8_STAGE(PG8_SA(0, 0), cA, voffA); PG8_STAGE(PG8_SB(0, 1), cB + hstep, voffB); PG8_STAGE(PG8_SA(0, 1), cA + hstep, voffA);
        if (wr == 1) PG8_BAR;
        PG8_WAIT_V(4); PG8_BAR;
        PG8_STAGE(PG8_SB(1, 0), cB + kstep, voffB); PG8_STAGE(PG8_SA(1, 0), cA + kstep, voffA); PG8_STAGE(PG8_SB(1, 1), cB + hstep + kstep, voffB);
        PG8_WAIT_V(6); PG8_BAR;
    }
    for (;;) {
        const bool has_next = S.next(ui + 1, nxt);
        const char* nA = has_next ? (const char*)g.A + (size_t)nxt.pm * tstep : cA; const char* nB = has_next ? (const char*)g.Bt + (size_t)nxt.pn * tstep : cB;
        for (int t = 0; t < nt; t += 2) {
            const bool last = (t == nt - 2);
            const char* a1 = cA + (size_t)(t + 1) * kstep;
            const char* a2 = last ? nA : cA + (size_t)(t + 2) * kstep; const char* b2 = last ? nB : cB + (size_t)(t + 2) * kstep;
            const char* a3 = a2 + kstep; const char* b3 = b2 + kstep;
            if (last && has_next) S.a_ready(nxt);
            if constexpr (SP2) {
            PG8_LDB(B0, 0, 0); PG8_LDB(B1, 0, 1); PG8_SCHED; PG8_LDA(At, 0, 0); PG8_STAGE(PG8_SA(1, 1), a1 + hstep, voffA);
            PG8_WAIT_V(8); PG8_WAIT_L(0); PG8_BAR; PG8_MMA(0, 0, At, B0); PG8_MMA(0, 1, At, B1); PG8_BAR; PG8_SCHED;
            PG8_LDA(At, 0, 1); PG8_STAGE(PG8_SB(0, 0), b2, voffB); PG8_STAGE(PG8_SB(0, 1), b2 + hstep, voffB); PG8_STAGE(PG8_SA(0, 0), a2, voffA);
            PG8_WAIT_V(8); PG8_WAIT_L(0); PG8_BAR; PG8_MMA(1, 0, At, B0); PG8_MMA(1, 1, At, B1); PG8_BAR; PG8_SCHED;
            PG8_LDB(B0, 1, 0); PG8_LDB(B1, 1, 1); PG8_SCHED; PG8_LDA(At, 1, 0); PG8_STAGE(PG8_SA(0, 1), a2 + hstep, voffA);
            PG8_WAIT_V(8); PG8_WAIT_L(0); PG8_BAR; PG8_MMA(0, 0, At, B0); PG8_MMA(0, 1, At, B1); PG8_BAR; PG8_SCHED;
            PG8_LDA(At, 1, 1); PG8_STAGE(PG8_SB(1, 0), b3, voffB); PG8_STAGE(PG8_SB(1, 1), b3 + hstep, voffB); PG8_STAGE(PG8_SA(1, 0), a3, voffA);
            PG8_WAIT_V(8); PG8_WAIT_L(0); PG8_BAR; PG8_MMA(1, 0, At, B0); PG8_MMA(1, 1, At, B1); PG8_BAR; PG8_SCHED;
            } else {
            PG8_LDB(B0, 0, 0); PG8_SCHED; PG8_LDA(At, 0, 0); PG8_STAGE(PG8_SA(1, 1), a1 + hstep, voffA);
            PG8_WAIT_L(8); PG8_BAR; PG8_WAIT_L(0); PG8_MMA(0, 0, At, B0); PG8_BAR; PG8_SCHED;
            PG8_LDB(B1, 0, 1); PG8_STAGE(PG8_SB(0, 0), b2, voffB);
            PG8_BAR; PG8_WAIT_L(0); PG8_MMA(0, 1, At, B1); PG8_BAR;
            PG8_LDA(At, 0, 1); PG8_STAGE(PG8_SA(0, 0), a2, voffA);
            PG8_BAR; PG8_WAIT_L(0); PG8_MMA(1, 0, At, B0); PG8_BAR; PG8_SCHED;
            PG8_STAGE(PG8_SB(0, 1), b2 + hstep, voffB);
            PG8_WAIT_V(6); PG8_BAR; PG8_MMA(1, 1, At, B1); PG8_BAR;
            PG8_LDB(B0, 1, 0); PG8_SCHED; PG8_LDA(At, 1, 0); PG8_STAGE(PG8_SA(0, 1), a2 + hstep, voffA);
            PG8_WAIT_L(8); PG8_BAR; PG8_WAIT_L(0); PG8_MMA(0, 0, At, B0); PG8_BAR; PG8_SCHED;
            PG8_LDB(B1, 1, 1); PG8_STAGE(PG8_SB(1, 0), b3, voffB);
            PG8_BAR; PG8_WAIT_L(0); PG8_MMA(0, 1, At, B1); PG8_BAR;
            PG8_LDA(At, 1, 1); PG8_STAGE(PG8_SA(1, 0), a3, voffA);
            PG8_BAR; PG8_WAIT_L(0); PG8_MMA(1, 0, At, B0); PG8_BAR; PG8_SCHED;
            PG8_STAGE(PG8_SB(1, 1), b3 + hstep, voffB);
            PG8_WAIT_V(6); PG8_BAR; PG8_MMA(1, 1, At, B1); PG8_BAR;
            }
        }
        if constexpr (ALIGN_EPI) { if (wr == 0) PG8_BAR; }
        if constexpr (!Epi::AFTER_DRAIN) { E(acc, cur, wr, wc, fr, fq); S.done(cur); }
        if (!has_next) break;
#pragma unroll
        for (int a = 0; a < 2; ++a)
#pragma unroll
            for (int b = 0; b < 2; ++b)
#pragma unroll
                for (int m = 0; m < 4; ++m)
#pragma unroll
                    for (int n = 0; n < 2; ++n) acc[a][b][m][n] = (f32x4){0.f, 0.f, 0.f, 0.f};
        cur = nxt; cA = nA; cB = nB; ++ui;
        if constexpr (ALIGN_EPI) { if (wr == 1) PG8_BAR; }
    }
    PG8_WAIT_V(0);
    if constexpr (!ALIGN_EPI) { if (wr == 0) PG8_BAR; }
    PG8_BAR;
    if constexpr (Epi::AFTER_DRAIN) { E.fused(acc, cur, wr, wc, fr, fq, lds, wid, lane); S.done(cur); }
#undef PG8_SA
#undef PG8_SB
#undef PG8_STAGE
#undef PG8_LDA
#undef PG8_LDB
#undef PG8_MMA
#undef PG8_WAIT_V
#undef PG8_WAIT_L
#undef PG8_BAR
#undef PG8_SCHED
}
}

namespace att {
using bf16 = unsigned short;
#define AG __attribute__((address_space(1)))
#define AL __attribute__((address_space(3)))
constexpr int D = 128, NW = 8, QBLK = 32, KVBLK = 64;
constexpr float SCALE = 0.088388347648318440f;
constexpr float THR = 8.f;
using bf16x8 = __attribute__((ext_vector_type(8))) short;
using s16x4  = __attribute__((ext_vector_type(4))) short;
using f32x16 = __attribute__((ext_vector_type(16))) float;
using u32x4  = __attribute__((ext_vector_type(4))) unsigned;
constexpr size_t SHM_V = KVBLK * D * 2, SHM_K = KVBLK * D * 2, SHM_ATTN = 2 * SHM_V + 2 * SHM_K + NW * 64 * 4;
#define KSWZ(row, colB) ((row) * 256 + ((colB) ^ (((row) & 7) << 4)))
#define SBAR() __builtin_amdgcn_sched_barrier(0)
__device__ __forceinline__ int crow(int r, int hi) { return (r & 3) + 8 * (r >> 2) + 4 * hi; }
__device__ __forceinline__ unsigned cvtpk(float lo, float hi) { unsigned r; asm volatile("v_cvt_pk_bf16_f32 %0, %1, %2" : "=v"(r) : "v"(lo), "v"(hi)); return r; }
__device__ __forceinline__ bf16x8 ld8(const bf16* p) { return *(const AG bf16x8*)p; }

__device__ __forceinline__ void partialSM(f32x16& p0, f32x16& p1, float& m_reg, float& mn, float& alpha) {
  constexpr float C = SCALE * 1.4426950408889634f;
  float pmax = p0[0]; for (int r = 1; r < 16; ++r) pmax = fmaxf(pmax, p0[r]); for (int r = 0; r < 16; ++r) pmax = fmaxf(pmax, p1[r]);
  { auto rr = __builtin_amdgcn_permlane32_swap(__float_as_uint(pmax), __float_as_uint(pmax), false, false);
    pmax = fmaxf(__uint_as_float(rr[0]), __uint_as_float(rr[1])); }
  if (__builtin_expect(__all(pmax - m_reg <= THR / SCALE), 1)) { mn = m_reg; alpha = 1.f; }
  else { mn = fmaxf(m_reg, pmax); alpha = __builtin_amdgcn_exp2f((m_reg - mn) * C); m_reg = mn; }
  float mnC = -mn * C;
  for (int r = 0; r < 16; ++r) p0[r] = fmaf(p0[r], C, mnC); for (int r = 0; r < 16; ++r) p1[r] = fmaf(p1[r], C, mnC);
  for (int r = 0; r < 16; ++r) p0[r] = __builtin_amdgcn_exp2f(p0[r]);
}
__device__ __forceinline__ void finishSM(f32x16& p0, f32x16& p1, float alpha, float& l_reg, bf16x8& pa0, bf16x8& pa1, bf16x8& pa2, bf16x8& pa3) {
  for (int r = 0; r < 16; ++r) p1[r] = __builtin_amdgcn_exp2f(p1[r]);
  float ps = 0; for (int r = 0; r < 16; ++r) ps += p0[r]; for (int r = 0; r < 16; ++r) ps += p1[r];
  { auto rr = __builtin_amdgcn_permlane32_swap(__float_as_uint(ps), __float_as_uint(ps), false, false);
    ps = __uint_as_float(rr[0]) + __uint_as_float(rr[1]); }
  l_reg = l_reg * alpha + ps;
#define PK4(P, BASE, OUT) do { unsigned a0 = cvtpk(P[BASE + 0], P[BASE + 1]), a1 = cvtpk(P[BASE + 2], P[BASE + 3]);   \
    unsigned b0 = cvtpk(P[BASE + 4], P[BASE + 5]), b1 = cvtpk(P[BASE + 6], P[BASE + 7]);                              \
    auto r0 = __builtin_amdgcn_permlane32_swap(a0, b0, false, false); auto r1 = __builtin_amdgcn_permlane32_swap(a1, b1, false, false); \
    u32x4 w = {r0[0], r1[0], r0[1], r1[1]}; OUT = *reinterpret_cast<bf16x8*>(&w); } while (0)
  PK4(p0, 0, pa0); PK4(p0, 8, pa1); PK4(p1, 0, pa2); PK4(p1, 8, pa3);
#undef PK4
}
__device__ __forceinline__ void qkt(f32x16& p0, f32x16& p1, const AL char* Ks, const bf16x8* qr, int r32, int hi) {
  p0 = f32x16{}; p1 = f32x16{};
  for (int d0 = 0; d0 < 8; ++d0) { int cb = (d0 * 16 + hi * 8) * 2;
    bf16x8 b0 = *(const AL bf16x8*)(Ks + KSWZ(r32, cb));
    bf16x8 b1 = *(const AL bf16x8*)(Ks + KSWZ(32 + r32, cb));
    p0 = __builtin_amdgcn_mfma_f32_32x32x16_bf16(b0, qr[d0], p0, 0, 0, 0);
    p1 = __builtin_amdgcn_mfma_f32_32x32x16_bf16(b1, qr[d0], p1, 0, 0, 0); }
}
__device__ __forceinline__ void wmask(f32x16& p0, f32x16& p1, int dq, int hi) {
#pragma unroll
  for (int r = 0; r < 16; ++r) { const int df = dq - crow(r, hi);
    if (df > 128 || df < -128) p0[r] = -1e30f;
    if (df - 32 > 128 || df - 32 < -128) p1[r] = -1e30f; }
}
__device__ __forceinline__ int v_st(int k, int c) { const int kk = (k & ~0xC) | ((k & 4) << 1) | ((k & 8) >> 1); return ((kk >> 3) * 4 + (c >> 5)) * 512 + ((kk & 7) * 32 + (c & 31)) * 2; }
__device__ __forceinline__ int v_rd_base(int lane) { return ((lane & 3) << 3) | (((lane >> 2) & 3) << 6) | (((lane >> 4) & 1) << 5) | (((lane >> 5) & 1) << 8); }
constexpr int v_rd_off(int d0, int ks, int half) { return d0 * 512 + ks * 4096 + half * 2048; }
template <int OFF> __device__ __forceinline__ s16x4 tr_read(int vb) {
  s16x4 r; asm volatile("ds_read_b64_tr_b16 %0, %1 offset:%2" : "=&v"(r) : "v"(vb), "i"(OFF) : "memory"); return r;
}
template <int D0> __device__ __forceinline__ void pv_one(f32x16& od, int vb, bf16x8 pa0, bf16x8 pa1, bf16x8 pa2, bf16x8 pa3) {
  const s16x4 l0 = tr_read<v_rd_off(D0, 0, 0)>(vb), h0 = tr_read<v_rd_off(D0, 0, 1)>(vb), l1 = tr_read<v_rd_off(D0, 1, 0)>(vb), h1 = tr_read<v_rd_off(D0, 1, 1)>(vb);
  const s16x4 l2 = tr_read<v_rd_off(D0, 2, 0)>(vb), h2 = tr_read<v_rd_off(D0, 2, 1)>(vb), l3 = tr_read<v_rd_off(D0, 3, 0)>(vb), h3 = tr_read<v_rd_off(D0, 3, 1)>(vb);
  asm volatile("s_waitcnt lgkmcnt(0)" ::: "memory"); SBAR();
#define PK(L, H) (bf16x8){L[0], L[1], L[2], L[3], H[0], H[1], H[2], H[3]}
  od = __builtin_amdgcn_mfma_f32_32x32x16_bf16(pa0, PK(l0, h0), od, 0, 0, 0);
  od = __builtin_amdgcn_mfma_f32_32x32x16_bf16(pa1, PK(l1, h1), od, 0, 0, 0);
  od = __builtin_amdgcn_mfma_f32_32x32x16_bf16(pa2, PK(l2, h2), od, 0, 0, 0);
  od = __builtin_amdgcn_mfma_f32_32x32x16_bf16(pa3, PK(l3, h3), od, 0, 0, 0);
#undef PK
}
__device__ __forceinline__ void pv_d0(f32x16* o, int vb, bf16x8 pa0, bf16x8 pa1, bf16x8 pa2, bf16x8 pa3) {
  pv_one<0>(o[0], vb, pa0, pa1, pa2, pa3); pv_one<1>(o[1], vb, pa0, pa1, pa2, pa3); pv_one<2>(o[2], vb, pa0, pa1, pa2, pa3); pv_one<3>(o[3], vb, pa0, pa1, pa2, pa3);
}

struct Unit {
  const bf16* Q; int ldq;
  const bf16* KA; const bf16* VA; int ldA; int nA;
  const bf16* KB; const bf16* VB; int ldB;
  int NT;
  int win;
  int dq0;
  int has_sink; float sink;
  bf16* O; int ldo;
};

__device__ __forceinline__ void attn_unit(const Unit& U, AL char* lds) {
  int tid_ = threadIdx.x; asm volatile("" : "+v"(tid_));
  const int tid = tid_, wid = tid >> 6, lane = tid & 63, r32 = lane & 31, hi = lane >> 5;
  AL char* V_lds = lds; AL char* K_lds = lds + 2 * SHM_V;
  AL float* ws = (AL float*)(lds + 2 * SHM_V + 2 * SHM_K) + wid * 64; AL float* li_l = ws; AL float* al_l = ws + 32;
  float m_reg = -1e30f, l_reg = 0; f32x16 o[4] = {}; bf16x8 qr[8];
  const bf16* Qw = U.Q + (long)(wid * QBLK + r32) * U.ldq + hi * 8;
#pragma unroll
  for (int d0 = 0; d0 < 8; ++d0) qr[d0] = ld8(Qw + d0 * 16);
  const int sr = tid >> 4, sc = (tid & 15) * 8, vst0 = v_st(sr, sc), vst1 = v_st(32 + sr, sc);
  const int vb0 = (int)(unsigned)(uintptr_t)V_lds + v_rd_base(lane);
  const int nA = U.nA, NT = U.NT;
  const int dqw = U.dq0 + wid * QBLK + r32;
  struct { bf16x8 vs0, vs1, ks0, ks1; } sr_[1];
#define SLOAD(i, jt) do { const int jj_ = (jt); const bf16 *kp_, *vp_; long ld_; \
    if (jj_ < nA) { ld_ = U.ldA; kp_ = U.KA + (long)jj_ * 64 * ld_; vp_ = U.VA + (long)jj_ * 64 * ld_; } \
    else { ld_ = U.ldB; kp_ = U.KB + (long)(jj_ - nA) * 64 * ld_; vp_ = U.VB + (long)(jj_ - nA) * 64 * ld_; } \
    sr_[i].vs0 = ld8(vp_ + (long)sr * ld_ + sc); sr_[i].vs1 = ld8(vp_ + (long)(32 + sr) * ld_ + sc); \
    sr_[i].ks0 = ld8(kp_ + (long)sr * ld_ + sc); sr_[i].ks1 = ld8(kp_ + (long)(32 + sr) * ld_ + sc); } while (0)
#define SWRITE(b, i) do { *(AL bf16x8*)(V_lds + (b) * SHM_V + vst0) = sr_[i].vs0;          \
    *(AL bf16x8*)(V_lds + (b) * SHM_V + vst1) = sr_[i].vs1; int kc = sc * 2;               \
    *(AL bf16x8*)(K_lds + (b) * SHM_K + KSWZ(sr, kc)) = sr_[i].ks0;                       \
    *(AL bf16x8*)(K_lds + (b) * SHM_K + KSWZ(32 + sr, kc)) = sr_[i].ks1; } while (0)
#define RESC(a) do { if (__any((a) < 1.f)) { if (hi == 0) al_l[r32] = (a); asm volatile("s_waitcnt lgkmcnt(0)" ::: "memory"); \
    for (int d = 0; d < 4; ++d) for (int r = 0; r < 16; ++r) o[d][r] *= al_l[crow(r, hi)]; } } while (0)
#define MASK(P0, P1, jt) do { if (U.win && (jt) >= nA) { const int dq_ = dqw - ((jt) - nA) * 64; \
    if (__any(dq_ > 128 || dq_ - 63 < -128)) wmask(P0, P1, dq_, hi); } } while (0)
  f32x16 p0, p1; float mn, al; bf16x8 pa0, pa1, pa2, pa3;
  SLOAD(0, 0); asm volatile("s_waitcnt vmcnt(0)" ::: "memory"); SWRITE(0, 0); SLOAD(0, 1); __syncthreads();
#pragma unroll 1
  for (int j = 0; j < NT; ++j) {
    const int b = j & 1;
    qkt(p0, p1, K_lds + b * SHM_K, qr, r32, hi); MASK(p0, p1, j);
    partialSM(p0, p1, m_reg, mn, al);
    RESC(al);
    finishSM(p0, p1, al, l_reg, pa0, pa1, pa2, pa3); SBAR();
    pv_d0(o, vb0 + b * (int)SHM_V, pa0, pa1, pa2, pa3);
    if (j + 1 < NT) { asm volatile("s_waitcnt vmcnt(0)" ::: "memory"); SWRITE(b ^ 1, 0); if (j + 2 < NT) SLOAD(0, j + 2); }
    __syncthreads();
  }
  if (U.has_sink) { constexpr float C = SCALE * 1.4426950408889634f; l_reg += __builtin_amdgcn_exp2f(fminf(U.sink * 1.4426950408889634f - m_reg * C, 120.f)); }
  if (hi == 0) li_l[r32] = l_reg; asm volatile("s_waitcnt lgkmcnt(0)" ::: "memory");
  float rli[16];
#pragma unroll
  for (int r = 0; r < 16; ++r) rli[r] = __builtin_amdgcn_rcpf(li_l[crow(r, hi)]);
  bf16* Ow = U.O + (long)(wid * QBLK) * U.ldo;
#pragma unroll
  for (int r = 0; r < 16; ++r) { int orow = crow(r, hi);
    for (int d0 = 0; d0 < 4; ++d0) { const float v = o[d0][r] * rli[r]; const unsigned pk = cvtpk(v, v);
      *(AG unsigned short*)(Ow + (long)orow * U.ldo + d0 * 32 + r32) = (unsigned short)(pk & 0xffffu); } }
#undef SLOAD
#undef SWRITE
#undef RESC
#undef MASK
}
}

constexpr int DM = 2048, NCTX = 8192, NLAT = 16384, NTOK = 24576, QKVD = 3072, DFF = 5632, NGU = 11264, DEPTH = 4;
constexpr int NWAVES = 8;
constexpr size_t MiB = 1u << 20;
constexpr size_t OUT_YP = 0, OUT_YS = (size_t)NCTX * DM, OUT_WK = (size_t)NTOK * DM, OUT_WV = OUT_WK + (size_t)32 * 2 * 256 * 512,
                 OUT_AK = OUT_WV + (size_t)32 * 2 * 256 * 512, OUT_AV = OUT_AK + (size_t)32 * 256 * 512, OUT_END = OUT_AV + (size_t)32 * 256 * 512;
constexpr size_t WS_CTL = 0, CTL_ZERO_BYTES = 1 * MiB;
constexpr size_t WS_MODP = 1 * MiB;
constexpr size_t WS_MODF = 16 * MiB;
constexpr size_t WS_A2 = 18 * MiB;
constexpr size_t WS_NP = 19 * MiB;
constexpr size_t WS_CKV = 20 * MiB;
constexpr size_t WS_CWK = WS_CKV, WS_CWV = WS_CKV + 8 * MiB, WS_CAK = WS_CKV + 16 * MiB, WS_CAV = WS_CKV + 20 * MiB;
constexpr size_t WS_FT = 44 * MiB;
constexpr size_t WS_FT_CTX = WS_FT + 32 * MiB;
constexpr size_t WS_W = 80 * MiB;
constexpr size_t W_QKV = (size_t)QKVD * DM * 2, W_SQ = (size_t)DM * DM * 2, W_IN = (size_t)6144 * DM * 2, W_GU = (size_t)NGU * DM * 2, W_DN = (size_t)DM * DFF * 2;
constexpr size_t WS_WQKV0 = WS_W, WS_WQKV1 = WS_WQKV0 + W_QKV, WS_WQKVA = WS_WQKV1 + W_QKV, WS_WO0 = WS_WQKVA + W_QKV, WS_WO1 = WS_WO0 + W_SQ, WS_WOA = WS_WO1 + W_SQ,
                 WS_WHO = WS_WOA + W_SQ, WS_WHI = WS_WHO + W_SQ, WS_WGU = WS_WHI + W_IN, WS_WDN = WS_WGU + 4 * W_GU, WS_WEND = WS_WDN + 4 * W_DN;
constexpr size_t WS_H = 448 * MiB;
constexpr size_t WS_BIG = 544 * MiB;
constexpr size_t WS_ZT = WS_BIG + 288 * MiB;
constexpr size_t WS_END = WS_BIG + 384 * MiB;
static_assert(WS_WEND <= WS_H && WS_FT_CTX + 4 * MiB <= WS_W && WS_CAV + 4 * MiB <= WS_FT, "ws map");
static_assert(WS_MODP + (size_t)4 * 8 * 9 * 12288 * 4 <= WS_MODF && WS_MODF + (size_t)4 * 9 * 6 * 2048 * 4 <= WS_A2 && WS_A2 + (size_t)2304 * 64 * 4 <= WS_NP && WS_NP + (size_t)18 * 8192 * 4 <= WS_CKV, "small buffers");
constexpr int CW_TMO = 0;
constexpr int CW_BAR = 4096;
constexpr int RING_BYTES = 131072;
constexpr int LDSCTL_OFF = RING_BYTES, MISC_OFF = LDSCTL_OFF + 320;
constexpr int LDS_BYTES = 147456;

#define GAS __attribute__((address_space(1)))
#define LAS __attribute__((address_space(3)))
typedef unsigned short bf16;
typedef unsigned v4u __attribute__((ext_vector_type(4)));
typedef unsigned v2u __attribute__((ext_vector_type(2)));
typedef float f32x4 __attribute__((ext_vector_type(4)));
typedef short bf16x8 __attribute__((ext_vector_type(8)));
typedef short bf16x4 __attribute__((ext_vector_type(4)));
typedef GAS unsigned gu32;
#define RLX_AGENT __ATOMIC_RELAXED, __HIP_MEMORY_SCOPE_AGENT
#define LDS_WAIT() asm volatile("s_waitcnt lgkmcnt(0)" ::: "memory")
#define VM_WAIT() asm volatile("s_waitcnt vmcnt(0)" ::: "memory")
__device__ __forceinline__ unsigned f2bf(float f) { unsigned u = __builtin_bit_cast(unsigned, f); return (u + 0x7fffu + ((u >> 16) & 1u)) >> 16; }
__device__ __forceinline__ unsigned pk2(float lo, float hi) { return f2bf(lo) | (f2bf(hi) << 16); }
__device__ __forceinline__ float bf2f(unsigned short b) { return __builtin_bit_cast(float, (unsigned)b << 16); }
__device__ __forceinline__ float bflo(unsigned w) { return __builtin_bit_cast(float, w << 16); }
__device__ __forceinline__ float bfhi(unsigned w) { return __builtin_bit_cast(float, w & 0xffff0000u); }
__device__ __forceinline__ float wave_sum(float v) {
#pragma unroll
    for (int o = 1; o < 64; o <<= 1) v += __shfl_xor(v, o);
    return v;
}
#define XB_TMO      128
#define XB_XCNT(j)  (256  + 64 * (j))
#define XB_XSUB(j)  (1280 + 64 * (j))
#define XB_XGEN(j)  (2304 + 64 * (j))
#define XB_TOP      3328
#define XB_TOPGEN   3392
#define XCD_BAR_WORDS 3456
#define XB_SPIN_CAP (1u << 18)

__device__ __forceinline__ unsigned xb_ld(unsigned* p)              { return __hip_atomic_load(p, __ATOMIC_RELAXED, __HIP_MEMORY_SCOPE_AGENT); }
__device__ __forceinline__ unsigned xb_add(unsigned* p, unsigned v) { return __hip_atomic_fetch_add(p, v, __ATOMIC_RELAXED, __HIP_MEMORY_SCOPE_AGENT); }
__device__ __forceinline__ unsigned xb_xcc_id() { return (unsigned)__builtin_amdgcn_s_getreg((3 << 11) | 20) & 0xFu; }
#define XB_SPIN(cond, bar) do { unsigned _sp = 0; while (cond) { __builtin_amdgcn_s_sleep(1); \
    if ((++_sp & 255u) == 0u) { if (xb_ld(&(bar)[XB_TMO])) break; if (_sp > XB_SPIN_CAP) { atomicAdd(&(bar)[XB_TMO], 1u); break; } } } } while (0)

struct XcdBarrier {
    unsigned* bar; unsigned x;
    volatile LAS unsigned* st;
};

__device__ __forceinline__ XcdBarrier xcd_barrier_post(unsigned* bar, volatile LAS unsigned* st) {
    XcdBarrier b; b.bar = bar; b.x = xb_xcc_id(); b.st = st;
    if (threadIdx.x == 0) (void)xb_add(&bar[XB_XCNT(b.x)], 1u);
    return b;
}
__device__ __forceinline__ void xcd_barrier_complete(unsigned* bar, unsigned x, unsigned& nloc, unsigned& nx) {
    const unsigned G = gridDim.x * gridDim.y * gridDim.z;
    unsigned sum, cnt, mine, sp = 0u;
    for (;;) {
        sum = 0u; cnt = 0u; mine = 0u;
#pragma unroll
        for (unsigned j = 0; j < 16; ++j) { const unsigned c = xb_ld(&bar[XB_XCNT(j)]); sum += c; cnt += (c > 0u) ? 1u : 0u; mine = (j == x) ? c : mine; }
        if (sum == G) break;
        __builtin_amdgcn_s_sleep(1);
        if ((++sp & 255u) == 0u) { if (xb_ld(&bar[XB_TMO])) break; if (sp > XB_SPIN_CAP) { atomicAdd(&bar[XB_TMO], 1u); break; } }
    }
    nloc = mine > 0u ? mine : 1u; nx = cnt > 0u ? cnt : 1u;
}

__device__ __forceinline__ void xcd_barrier(const XcdBarrier& b) {
    asm volatile("s_waitcnt vmcnt(0)" ::: "memory");
    __syncthreads();
    if (threadIdx.x == 0) {
        unsigned* bar = b.bar;
        __builtin_amdgcn_s_waitcnt(0);
        unsigned nloc = b.st[0], nx = b.st[1];
        if (nloc == 0u) { xcd_barrier_complete(bar, b.x, nloc, nx); b.st[0] = nloc; b.st[1] = nx; }
        const unsigned old = xb_add(&bar[XB_XSUB(b.x)], 1u);
        const unsigned gen = old / nloc;
        if (old + 1u == (gen + 1u) * nloc) {
            __builtin_amdgcn_fence(__ATOMIC_RELEASE, "agent");
            asm volatile("s_waitcnt vmcnt(0)" ::: "memory");
            const unsigned og = xb_add(&bar[XB_TOP], 1u);
            const unsigned tg = og / nx;
            if (og + 1u == (tg + 1u) * nx) xb_add(&bar[XB_TOPGEN], 1u);
            else XB_SPIN(xb_ld(&bar[XB_TOPGEN]) == tg, bar);
            __builtin_amdgcn_fence(__ATOMIC_ACQUIRE, "agent");
            xb_add(&bar[XB_XGEN(b.x)], 1u);
            asm volatile("s_waitcnt vmcnt(0)" ::: "memory");
        } else {
            XB_SPIN(xb_ld(&bar[XB_XGEN(b.x)]) == gen, bar);
            __builtin_amdgcn_fence(__ATOMIC_ACQUIRE, "agent");
            asm volatile("s_waitcnt vmcnt(0)" ::: "memory");
        }
    }
    __syncthreads();
}

__device__ __forceinline__ void transpose_item(const float* W, int K, int N, bf16* WT, int k0, int n0, int drow0, LAS float* scr, int lane) {
#pragma unroll 8
    for (int i = 0; i < 32; ++i) { const int kk = 2 * i + (lane >> 5); scr[kk * 33 + (lane & 31)] = W[(size_t)(k0 + kk) * N + n0 + (lane & 31)]; }
    LDS_WAIT(); asm volatile("" ::: "memory");
    const int c = lane & 7;
#pragma unroll
    for (int j = 0; j < 4; ++j) { const int n = (lane >> 3) + 8 * j; const LAS float* s = scr + (8 * c) * 33 + n;
        v4u o; o.x = pk2(s[0 * 33], s[1 * 33]); o.y = pk2(s[2 * 33], s[3 * 33]); o.z = pk2(s[4 * 33], s[5 * 33]); o.w = pk2(s[6 * 33], s[7 * 33]);
        *(GAS v4u*)(WT + (size_t)(drow0 + n) * K + k0 + 8 * c) = o; }
    LDS_WAIT(); asm volatile("" ::: "memory");
}
constexpr int IT_QKV = (DM / 64) * (QKVD / 32), IT_SQ = (DM / 64) * (DM / 32), IT_IN = (DM / 64) * (6144 / 32), IT_GU = (DM / 64) * (NGU / 32), IT_DN = (DFF / 64) * (DM / 32);
constexpr int IT_TOTAL = 3 * IT_QKV + 4 * IT_SQ + IT_IN + 4 * IT_GU + 4 * IT_DN;

struct Args { const float* in[33]; float* out; unsigned char* ws; int ph_lo, ph_hi; };
#define GIN(k) ((const float*)(const GAS float*)A.in[k])

__device__ __forceinline__ void weight_item(const Args& A, int it, LAS float* scr, int lane) {
    unsigned char* ws = A.ws;
    const float* src; bf16* dst; int K = DM, N; bool gu = false; int r = it;
    if (r < 3 * IT_QKV) { const int m = r / IT_QKV; r -= m * IT_QKV; N = QKVD;
        src = (m < 2) ? GIN(12) + (size_t)m * DM * QKVD : GIN(26); dst = (bf16*)(ws + WS_WQKV0 + (size_t)m * W_QKV); }
    else if ((r -= 3 * IT_QKV) < 4 * IT_SQ) { const int m = r / IT_SQ; r -= m * IT_SQ; N = DM;
        src = (m < 2) ? GIN(13) + (size_t)m * DM * DM : (m == 2 ? GIN(29) : GIN(25)); dst = (bf16*)(ws + WS_WO0 + (size_t)m * W_SQ); }
    else if ((r -= 4 * IT_SQ) < IT_IN) { N = 6144; src = GIN(15); dst = (bf16*)(ws + WS_WHI); }
    else if ((r -= IT_IN) < 4 * IT_GU) { const int m = r / IT_GU; r -= m * IT_GU; N = NGU; gu = true;
        src = GIN(30) + (size_t)m * DM * NGU; dst = (bf16*)(ws + WS_WGU + (size_t)m * W_GU); }
    else { r -= 4 * IT_GU; const int m = r / IT_DN; r -= m * IT_DN; N = DM; K = DFF;
        src = GIN(31) + (size_t)m * DFF * DM; dst = (bf16*)(ws + WS_WDN + (size_t)m * W_DN); }
    const int nblk = N / 32, kb = r / nblk, nb = r % nblk, k0 = 64 * kb, n0 = 32 * nb;
    int drow0 = n0;
    if (gu) { const int isu = n0 >= DFF ? 1 : 0; const int j = n0 - isu * DFF; drow0 = (j >> 7) * 256 + isu * 128 + (j & 127); }
    transpose_item(src, K, N, dst, k0, n0, drow0, scr, lane);
}

__device__ __forceinline__ void adaln_partial_unit(const Args& A, int u, LAS float* scr, int lane) {
    const int layer = u / 384, kc = (u / 48) % 8, cg = u % 48;
    const float* cctx = GIN(7); const float* cin = GIN(6);
    for (int idx = lane; idx < 9 * 256; idx += 64) { const int c = idx >> 8, kk = idx & 255, k = kc * 256 + kk;
        const float v = (c == 0) ? cctx[k] : cin[(size_t)(c - 1) * DM + k]; scr[idx] = v / (1.0f + expf(-v)); }
    LDS_WAIT(); asm volatile("" ::: "memory");
    f32x4 acc[9];
#pragma unroll
    for (int c = 0; c < 9; ++c) acc[c] = (f32x4){0.f, 0.f, 0.f, 0.f};
    const float* wp = GIN(10) + (size_t)layer * DM * 12288 + (size_t)(kc * 256) * 12288 + cg * 256 + lane * 4;
#pragma unroll 8
    for (int kk = 0; kk < 256; ++kk) { const f32x4 w = *(const GAS f32x4*)(wp + (size_t)kk * 12288);
#pragma unroll
        for (int c = 0; c < 9; ++c) acc[c] += scr[c * 256 + kk] * w; }
    float* mp = (float*)(A.ws + WS_MODP) + (size_t)((layer * 8 + kc) * 9) * 12288 + cg * 256 + lane * 4;
#pragma unroll
    for (int c = 0; c < 9; ++c) *(f32x4*)(mp + (size_t)c * 12288) = acc[c];
    LDS_WAIT(); asm volatile("" ::: "memory");
}

__device__ __forceinline__ void filter_a2_row(const Args& A, int rr, int lane) {
    const int L = rr < 2048 ? 2048 : 256, t = rr < 2048 ? rr : rr - 2048;
    const float tn = (float)t / (float)(L - 1), w = 6.283185307179586f * (float)t / (float)L;
    float feat = 0.f;
    if (lane == 0) feat = tn;
    else if (lane <= 16) feat = cosf(w * (1e-4f + (float)(lane - 1) * ((15.0f - 1e-4f) / 15.0f)));
    else if (lane <= 32) feat = -sinf(w * (1e-4f + (float)(lane - 17) * ((15.0f - 1e-4f) / 15.0f)));
    const float* w1 = GIN(18); const float* b1 = GIN(19); const float* w2 = GIN(20); const float* b2 = GIN(21); const float* fq = GIN(23);
    float s = b1[lane];
    for (int f = 0; f < 33; ++f) s += __shfl(feat, f) * w1[f * 64 + lane];
    const float a1 = sinf(fq[lane] * s);
    float s2 = b2[lane];
    for (int k = 0; k < 64; ++k) s2 += __shfl(a1, k) * w2[k * 64 + lane];
    ((float*)(A.ws + WS_A2))[(size_t)rr * 64 + lane] = sinf(fq[64 + lane] * s2);
}

__device__ __forceinline__ void filter_hf_unit(const Args& A, int u, LAS float* scr, int lane) {
    const int variant = u < 2048 ? 0 : 1; const int uu = variant ? u - 2048 : u; const int tch = uu >> 7, cgp = uu & 127;
    const int L = variant ? 256 : 2048; const int col = cgp * 64 + lane, side = col >> 12, order = (col >> 11) & 1, d = col & 2047;
    const float* w3 = GIN(22);
    float w3r[64];
#pragma unroll
    for (int k = 0; k < 64; ++k) w3r[k] = w3[(size_t)k * 8192 + col];
    constexpr float MIND = -3.0701134573253944f, MAXD = -15.350567286626972f;
    const float delta = fabsf(MIND + (MAXD - MIND) * ((float)d / 2047.0f));
    const float* a2 = (const float*)(A.ws + WS_A2) + (size_t)(variant ? 2048 : 0) * 64;
    bf16* ft = (bf16*)(A.ws + (variant ? WS_FT_CTX : WS_FT)) + ((size_t)(order * 2048 + d) * 2 + side) * L;
    const float rl1 = 1.0f / (float)(L - 1);
    float asum = 0.f;
#pragma unroll 1
    for (int half = 0; half < 2; ++half) {
        const int tb = tch * 128 + half * 64;
        { const GAS f32x4* src = (const GAS f32x4*)(a2 + (size_t)(tb + lane) * 64);
#pragma unroll
          for (int q = 0; q < 16; ++q) *(LAS f32x4*)(scr + lane * 64 + q * 4) = src[q]; }
        LDS_WAIT(); asm volatile("" ::: "memory");
#pragma unroll 1
        for (int tt = 0; tt < 64; tt += 2) {
            float s0 = 0.f, s1 = 0.f;
#pragma unroll
            for (int q = 0; q < 16; ++q) { const f32x4 x0 = *(const LAS f32x4*)(scr + tt * 64 + q * 4), x1 = *(const LAS f32x4*)(scr + (tt + 1) * 64 + q * 4);
                s0 += x0.x * w3r[4 * q] + x0.y * w3r[4 * q + 1] + x0.z * w3r[4 * q + 2] + x0.w * w3r[4 * q + 3];
                s1 += x1.x * w3r[4 * q] + x1.y * w3r[4 * q + 1] + x1.z * w3r[4 * q + 2] + x1.w * w3r[4 * q + 3]; }
            const int t = tb + tt;
            s0 *= expf(-((float)t * rl1) * delta); s1 *= expf(-((float)(t + 1) * rl1) * delta);
            if (!(side == 1 && t == 0)) asum += fabsf(s0);
            asum += fabsf(s1);
            *(GAS unsigned*)(ft + t) = pk2(s0, s1);
        }
        LDS_WAIT(); asm volatile("" ::: "memory");
    }
    ((float*)(A.ws + WS_NP))[(size_t)(variant ? 16 + tch : tch) * 8192 + col] = asum;
}

__device__ __forceinline__ void norm_row(const float* xrow, const f32x4 (&a)[8], const f32x4 (&b)[8], bf16* orow, int lane) {
    const GAS f32x4* xr = (const GAS f32x4*)xrow + lane;
    f32x4 v[8]; float s = 0.f;
#pragma unroll
    for (int j = 0; j < 8; ++j) { v[j] = xr[64 * j]; s += (v[j].x * v[j].x + v[j].y * v[j].y) + (v[j].z * v[j].z + v[j].w * v[j].w); }
    const float rstd = 1.0f / sqrtf(wave_sum(s) * (1.0f / DM) + 1e-6f);
    GAS v2u* o8 = (GAS v2u*)orow + lane;
#pragma unroll
    for (int j = 0; j < 8; ++j) { const f32x4 y = v[j] * rstd * a[j] + b[j]; v2u w; w.x = pk2(y.x, y.y); w.y = pk2(y.z, y.w); o8[64 * j] = w; }
}
__device__ __forceinline__ void final_norm_row(float* xrow, const float* g, int lane) {
    GAS f32x4* xr = (GAS f32x4*)xrow + lane;
    f32x4 v[8]; float s = 0.f;
#pragma unroll
    for (int j = 0; j < 8; ++j) { v[j] = xr[64 * j]; s += (v[j].x * v[j].x + v[j].y * v[j].y) + (v[j].z * v[j].z + v[j].w * v[j].w); }
    const float rstd = 1.0f / sqrtf(wave_sum(s) * (1.0f / DM) + 1e-6f);
#pragma unroll
    for (int j = 0; j < 8; ++j) { const f32x4 a = *((const GAS f32x4*)g + lane + 64 * j); xr[64 * j] = v[j] * rstd * a; }
}

__device__ __forceinline__ void qkpost_row(bf16* qkv_row, int row, bool is_ax, const float* qg, const float* kg, float* state_k, int lane) {
    const bool is_lat = row >= NCTX;
    const int hsub = lane >> 4, a = (lane >> 3) & 1, i0 = (lane & 7) * 4;
    float cs[4], sn[4];
    if (is_lat) { const int t = (row - NCTX) & 2047; const float pos = (float)(a == 0 ? (t >> 6) : (t & 63));
#pragma unroll
        for (int e = 0; e < 4; ++e) { const float inv = expf(-(float)(i0 + e) * (9.210340371976184f / 32.0f)); sn[e] = sinf(pos * inv); cs[e] = cosf(pos * inv); } }
#pragma unroll
    for (int grp = 0; grp < 5; ++grp) {
        const int head = 4 * grp + hsub;
        bf16* base = qkv_row + head * 128 + a * 64 + i0;
        const v2u r1 = *(const GAS v2u*)base, r2 = *(const GAS v2u*)(base + 32);
        float x1[4] = {bflo(r1.x), bfhi(r1.x), bflo(r1.y), bfhi(r1.y)}, x2[4] = {bflo(r2.x), bfhi(r2.x), bflo(r2.y), bfhi(r2.y)};
        if (is_ax) {
            float ss = 0.f;
#pragma unroll
            for (int e = 0; e < 4; ++e) ss += x1[e] * x1[e] + x2[e] * x2[e];
            ss += __shfl_xor(ss, 1); ss += __shfl_xor(ss, 2); ss += __shfl_xor(ss, 4); ss += __shfl_xor(ss, 8);
            const float rstd = 1.0f / sqrtf(ss * (1.0f / 128.0f) + 1e-6f);
            const float* G = (head < 16 ? qg : kg) + a * 64 + i0;
#pragma unroll
            for (int e = 0; e < 4; ++e) { x1[e] = x1[e] * rstd * G[e]; x2[e] = x2[e] * rstd * G[32 + e]; }
        }
        if (is_lat) {
#pragma unroll
            for (int e = 0; e < 4; ++e) { const float y1 = x1[e] * cs[e] - x2[e] * sn[e], y2 = x2[e] * cs[e] + x1[e] * sn[e]; x1[e] = y1; x2[e] = y2; }
        }
        if (is_ax || is_lat) { v2u w1, w2; w1.x = pk2(x1[0], x1[1]); w1.y = pk2(x1[2], x1[3]); w2.x = pk2(x2[0], x2[1]); w2.y = pk2(x2[2], x2[3]);
            *(GAS v2u*)base = w1; *(GAS v2u*)(base + 32) = w2; }
        if (is_ax && !is_lat && head >= 16) { float* sp = state_k + (size_t)row * 512 + (head - 16) * 128 + a * 64 + i0;
            *(GAS f32x4*)sp = (f32x4){x1[0], x1[1], x1[2], x1[3]}; *(GAS f32x4*)(sp + 32) = (f32x4){x2[0], x2[1], x2[2], x2[3]}; }
    }
}

namespace hy {
constexpr int CPY_STRIDE = 8480;
constexpr int U_OFF = 8 * CPY_STRIDE;
constexpr int U_BYTES = 6144;
static_assert(U_OFF + 8 * U_BYTES <= RING_BYTES, "hyena LDS map");

__device__ __forceinline__ void build_copies(LAS unsigned char* lds, const bf16* ft, int L, int tid) {
    if (tid < 264) { const int c = tid / 33, e = tid % 33; const int qq = (e < 17 - c) ? e : 2 * L + 16 - c + (e - (17 - c));
        *(LAS unsigned short*)(lds + c * CPY_STRIDE + qq * 2) = 0; }
    if (tid < 2 * L / 8) { const int side = tid / (L / 8), t8 = (tid % (L / 8)) * 8;
        const v4u raw = *(const GAS v4u*)(ft + (size_t)side * L + t8);
        const unsigned wds[4] = {raw.x, raw.y, raw.z, raw.w};
#pragma unroll
        for (int e = 0; e < 8; ++e) { const int t = t8 + e; const unsigned short val = (unsigned short)((e & 1) ? (wds[e >> 1] >> 16) : (wds[e >> 1] & 0xffffu));
            if (!(side == 1 && t == 0)) { const int p = side == 0 ? L - t : L + t;
#pragma unroll
                for (int c = 0; c < 8; ++c) *(LAS unsigned short*)(lds + c * CPY_STRIDE + (p + 16 - c) * 2) = val; } } }
}
__device__ __forceinline__ void fill_u(LAS unsigned char* ub, const bf16* urow, int L, float w0, float w1, float w2, float bb, int lane) {
    { const int e0 = lane < 32 ? lane * 8 : L + 256 + (lane - 32) * 8; *(LAS v4u*)(ub + e0 * 2) = (v4u){0u, 0u, 0u, 0u}; }
    for (int q = lane; q < L / 8; q += 64) { const int s0 = 8 * q;
        const v4u raw = *(const GAS v4u*)(urow + s0);
        const float prev = s0 > 0 ? bf2f(urow[s0 - 1]) : 0.f, next = s0 + 8 < L ? bf2f(urow[s0 + 8]) : 0.f;
        const float x[10] = {prev, bflo(raw.x), bfhi(raw.x), bflo(raw.y), bfhi(raw.y), bflo(raw.z), bfhi(raw.z), bflo(raw.w), bfhi(raw.w), next};
        float y[8];
#pragma unroll
        for (int j = 0; j < 8; ++j) y[j] = w0 * x[j] + w1 * x[j + 1] + w2 * x[j + 2] + bb;
        v4u o; o.x = pk2(y[0], y[1]); o.y = pk2(y[2], y[3]); o.z = pk2(y[4], y[5]); o.w = pk2(y[6], y[7]);
        *(LAS v4u*)(ub + (256 + s0) * 2) = o; }
}
template <int NT>
__device__ __forceinline__ void toeplitz(const LAS unsigned char* cpy, const LAS unsigned char* ub, f32x4 (&acc)[NT], int lane) {
    constexpr int L = 256 * NT;
    const int i = lane & 15, g = lane >> 4, c = (-i) & 7;
    const LAS unsigned char* ap = cpy + c * CPY_STRIDE + 2 * (L + 8 * g + 16 - i - c);
    const LAS unsigned char* bp = ub + 2 * (256 + 8 * g + 16 * i);
#pragma unroll 2
    for (int S = -256; S <= L - 32; S += 32) {
        const bf16x8 b = *(const LAS bf16x8*)(bp + 2 * S);
        bf16x8 a[NT];
#pragma unroll
        for (int k = 0; k < NT; ++k) a[k] = *(const LAS bf16x8*)(ap + 2 * S - 512 * k);
#pragma unroll
        for (int k = 0; k < NT; ++k) acc[k] = __builtin_amdgcn_mfma_f32_16x16x32_bf16(a[k], b, acc[k], 0, 0, 0);
    }
}
template <int NT>
__device__ __forceinline__ void gate(const f32x4 (&acc)[NT], LAS unsigned char* ub, const bf16* xg, float cw0, float cw1, float cw2, float cb, float invn, float skip, int lane, bool last, bf16* zt) {
    constexpr int L = 256 * NT;
    const int sg = lane & 15, g = lane >> 4;
#pragma unroll
    for (int k = 0; k < NT; ++k) { const int t0 = 256 * k + 16 * sg + 4 * g;
        const v2u ur = *(const LAS v2u*)(ub + (256 + t0) * 2);
        const v2u xr = *(const GAS v2u*)(xg + t0);
        const float prev = t0 > 0 ? bf2f(xg[t0 - 1]) : 0.f, next = t0 + 4 < L ? bf2f(xg[t0 + 4]) : 0.f;
        const float x[6] = {prev, bflo(xr.x), bfhi(xr.x), bflo(xr.y), bfhi(xr.y), next};
        const float uu[4] = {bflo(ur.x), bfhi(ur.x), bflo(ur.y), bfhi(ur.y)};
        float z[4];
#pragma unroll
        for (int r = 0; r < 4; ++r) { const float xc = cw0 * x[r] + cw1 * x[r + 1] + cw2 * x[r + 2] + cb; z[r] = xc * (acc[k][r] * invn + skip * uu[r]); }
        v2u o; o.x = pk2(z[0], z[1]); o.y = pk2(z[2], z[3]);
        if (last) *(GAS v2u*)(zt + t0) = o; else *(LAS v2u*)(ub + (256 + t0) * 2) = o; }
}
}

constexpr int NPHASE = 35;
#ifndef PHMASK
#define PHMASK 0xFFFF
#endif
#define PHON(b) ((PHMASK >> (b)) & 1)
#ifndef REPMASK
#define REPMASK 0
#endif
#ifndef REPN
#define REPN 2
#endif
#define RUN(b, call) do { _Pragma("unroll 1") for (int r_ = 0; r_ < (((REPMASK >> (b)) & 1) ? REPN : 1); ++r_) { call; } } while (0)
#ifndef MK_PER_PHASE
#define MK_PER_PHASE 0
#endif


template <class T> __device__ __forceinline__ T* launder(T* p) { GAS T* q = (GAS T*)p; asm volatile("" : "+s"(q)); return (T*)q; }
#define ENV_IDS int tid_ = threadIdx.x; asm volatile("" : "+v"(tid_)); const int tid = tid_, lane = tid & 63, wave = __builtin_amdgcn_readfirstlane(tid >> 6); const int G = gridDim.x, bx = blockIdx.x; \
    const int vcu = (G % 8 == 0) ? (bx % 8) * (G / 8) + bx / 8 : bx; const int gw = vcu * NWAVES + wave, NGW = G * NWAVES; (void)tid; (void)lane; (void)gw; (void)NGW; (void)bx;
#define ENV_PTRS unsigned char* ws = launder(A.ws); float* out = launder(A.out); (void)out; (void)ws;

__device__ __forceinline__ void ph_prologue_a(const Args& A, LAS unsigned char* L) {
    ENV_IDS ENV_PTRS
    LAS float* wscr = (LAS float*)(L + wave * 16384);
    for (int it = gw; it < IT_TOTAL; it += NGW) weight_item(A, it, wscr, lane);
    { const size_t NCH = (size_t)2 * 524288 + 2 * 262144;
      for (size_t ch = (size_t)gw * 64 + lane; ch < NCH; ch += (size_t)NGW * 64) {
          int ten; size_t off; unsigned char* dstb;
          if (ch < 524288) { ten = 0; off = ch * 8; dstb = ws + WS_CWK; } else if (ch < 1048576) { ten = 1; off = (ch - 524288) * 8; dstb = ws + WS_CWV; }
          else if (ch < 1310720) { ten = 2; off = (ch - 1048576) * 8; dstb = ws + WS_CAK; } else { ten = 3; off = (ch - 1310720) * 8; dstb = ws + WS_CAV; }
          const float* src = GIN(2 + ten) + off; const f32x4 a = *(const GAS f32x4*)src, b = *(const GAS f32x4*)(src + 4);
          v4u o; o.x = pk2(a.x, a.y); o.y = pk2(a.z, a.w); o.z = pk2(b.x, b.y); o.w = pk2(b.z, b.w);
          *(GAS v4u*)((bf16*)dstb + off) = o; } }
    for (int u = gw; u < 1536; u += NGW) adaln_partial_unit(A, __builtin_amdgcn_readfirstlane(u), wscr, lane);
    for (int rr = gw; rr < 2304; rr += NGW) filter_a2_row(A, __builtin_amdgcn_readfirstlane(rr), lane);
}
__device__ __forceinline__ void ph_prologue_b(const Args& A, LAS unsigned char* L) {
    ENV_IDS ENV_PTRS
    LAS float* wscr = (LAS float*)(L + wave * 16384);
    float* MODF = (float*)(ws + WS_MODF);
    for (int e = gw * 64 + lane; e < DEPTH * 9 * DM; e += NGW * 64) { const int layer = e / (9 * DM), c = (e / DM) % 9, col = e % DM;
        float m[6];
#pragma unroll
        for (int q = 0; q < 6; ++q) { float s = GIN(11)[(size_t)layer * 12288 + q * DM + col];
#pragma unroll
            for (int kc = 0; kc < 8; ++kc) s += ((const float*)(ws + WS_MODP))[(size_t)((layer * 8 + kc) * 9 + c) * 12288 + q * DM + col];
            m[q] = s; }
        float* mf = MODF + (size_t)((layer * 9 + c) * 6) * DM + col;
        mf[0 * DM] = GIN(8)[layer * DM + col] * (1.0f + m[1]); mf[1 * DM] = m[0]; mf[2 * DM] = m[2];
        mf[3 * DM] = GIN(9)[layer * DM + col] * (1.0f + m[4]); mf[4 * DM] = m[3]; mf[5 * DM] = m[5]; }
    for (int u = gw; u < 2304; u += NGW) filter_hf_unit(A, __builtin_amdgcn_readfirstlane(u), wscr, lane);
}
__device__ __forceinline__ void ph_norm(const Args& A, int layer, int which) {
    ENV_IDS ENV_PTRS
    const float* modf = (const float*)(ws + WS_MODF) + (size_t)layer * 9 * 6 * DM; bf16* HB = (bf16*)(ws + WS_H);
    const float* xc = (layer == 0 && which == 0) ? GIN(0) : out; const float* xl = (layer == 0 && which == 0) ? GIN(1) : out + (size_t)NCTX * DM;
    const int per = (NTOK + NGW - 1) / NGW, r0 = gw * per, r1 = (r0 + per < NTOK) ? r0 + per : NTOK;
    int cur = -1; f32x4 ma[8], mb[8];
#pragma unroll 1
    for (int row = r0; row < r1; ++row) { const int cv = row < NCTX ? 0 : 1 + ((row - NCTX) >> 11);
        if (cv != cur) { cur = cv; const GAS f32x4* pa = (const GAS f32x4*)(modf + (size_t)(cv * 6 + 3 * which) * DM) + lane; const GAS f32x4* pb = (const GAS f32x4*)(modf + (size_t)(cv * 6 + 3 * which + 1) * DM) + lane;
#pragma unroll
            for (int j = 0; j < 8; ++j) { ma[j] = pa[64 * j]; mb[j] = pb[64 * j]; } }
        const float* xr = row < NCTX ? xc + (size_t)row * DM : xl + (size_t)(row - NCTX) * DM;
        norm_row(xr, ma, mb, HB + (size_t)row * DM, lane); }
}
__device__ __forceinline__ void ph_qkv(const Args& A, int layer, LAS unsigned char* L) {
    ENV_PTRS
    const int G = gridDim.x, bx = blockIdx.x; const bool is_ax = (layer % 3) == 2; const int jx = layer / 3;
    const bf16* W = (const bf16*)(ws + (is_ax ? WS_WQKVA : (jx == 0 ? WS_WQKV0 : WS_WQKV1)));
    pg8::Gemm g{(const bf16*)(ws + WS_H), W, NTOK, QKVD, DM}; pg8::StaticOrder S; S.init(NTOK, QKVD, G, bx);
    pg8::EpiQKV E{(bf16*)(ws + WS_BIG), is_ax ? nullptr : out + OUT_WK + (size_t)jx * 256 * 512, is_ax ? out + OUT_AV : out + OUT_WV + (size_t)jx * 256 * 512, is_ax ? 0 : 256};
    pg8::gemm_phase<pg8::EpiQKV, pg8::StaticOrder, true, true>(L, g, S, E);
}
__device__ __forceinline__ void ph_qkpost(const Args& A, int layer) {
    ENV_IDS ENV_PTRS
    const bool is_ax = (layer % 3) == 2; bf16* QKVB = (bf16*)(ws + WS_BIG);
    for (int row = (is_ax ? 0 : NCTX) + gw; row < NTOK; row += NGW)
        qkpost_row(QKVB + (size_t)row * QKVD, row, is_ax, GIN(27), GIN(28), out + OUT_AK, lane);
}
__device__ __forceinline__ void ph_attn(const Args& A, int layer, LAS char* lds) {
    ENV_PTRS
    const int G = gridDim.x, bx = blockIdx.x; const bool is_ax = (layer % 3) == 2; const int jx = layer / 3;
    const att::bf16* QK = (const att::bf16*)(ws + WS_BIG); att::bf16* OB = (att::bf16*)(ws + WS_H);
    const att::bf16* CK = (const att::bf16*)(ws + (is_ax ? WS_CAK : WS_CWK));
    const att::bf16* CV = (const att::bf16*)(ws + (is_ax ? WS_CAV : WS_CWV));
    const int ncl = is_ax ? 1 : 2;
#pragma unroll 1
    for (int u = bx; u < 1536; u += G) {
        att::Unit U;
        if (u < 1024) { const int b = u >> 7, qb = (u >> 4) & 7, h = u & 15, kvh = h >> 2;
            const size_t r0 = (size_t)NCTX + (size_t)b * 2048 + (size_t)qb * 256;
            U.Q = QK + r0 * QKVD + h * 128; U.ldq = QKVD;
            const size_t coff = ((size_t)(b * ncl + (is_ax ? 0 : jx)) * 512) * 512 + kvh * 128;
            U.KA = CK + coff; U.VA = CV + coff; U.ldA = 512; U.nA = 8;
            const int klo = is_ax ? 0 : (qb * 256 - 128 < 0 ? 0 : qb * 256 - 128), khi = is_ax ? 2048 : (qb * 256 + 384 > 2048 ? 2048 : qb * 256 + 384);
            const size_t kr0 = (size_t)NCTX + (size_t)b * 2048 + klo;
            U.KB = QK + kr0 * QKVD + 2048 + kvh * 128; U.VB = QK + kr0 * QKVD + 2560 + kvh * 128; U.ldB = QKVD;
            U.NT = 8 + (khi - klo) / 64; U.win = is_ax ? 0 : 1; U.dq0 = qb * 256 - klo;
            U.O = OB + r0 * DM + h * 128; U.ldo = DM;
            U.has_sink = is_ax ? 0 : 1; U.sink = is_ax ? 0.f : GIN(14)[jx * 16 + h];
        } else { const int uc = u - 1024, b = uc >> 4, h = uc & 15, kvh = h >> 2; const size_t r0 = (size_t)b * 256;
            U.Q = QK + r0 * QKVD + h * 128; U.ldq = QKVD;
            U.KA = QK + r0 * QKVD + 2048 + kvh * 128; U.VA = QK + r0 * QKVD + 2560 + kvh * 128; U.ldA = QKVD; U.nA = 4;
            U.KB = U.KA; U.VB = U.VA; U.ldB = QKVD; U.NT = 4; U.win = 0; U.dq0 = 0;
            U.O = OB + r0 * DM + h * 128; U.ldo = DM;
            U.has_sink = is_ax ? 0 : 1; U.sink = is_ax ? 0.f : GIN(14)[jx * 16 + h];
        }
        att::attn_unit(U, lds);
    }
}
__device__ __forceinline__ void ph_hyin(const Args& A, LAS unsigned char* L) {
    ENV_PTRS
    const int G = gridDim.x, bx = blockIdx.x;
    pg8::Gemm g{(const bf16*)(ws + WS_WHI), (const bf16*)(ws + WS_H), 6144, NTOK, DM}; pg8::StaticOrder S; S.init(6144, NTOK, G, bx);
    pg8::EpiBf16 E{(bf16*)(ws + WS_BIG), NTOK};
    pg8::gemm_phase<pg8::EpiBf16, pg8::StaticOrder, true, true>(L, g, S, E);
}
__device__ __forceinline__ void ph_hyconv(const Args& A, LAS unsigned char* L) {
    ENV_IDS ENV_PTRS
    const bf16* UT = (const bf16*)(ws + WS_BIG); bf16* ZT = (bf16*)(ws + WS_ZT);
    const float* cw = GIN(16); const float* cbv = GIN(17); const float* skp = GIN(24); const float* NP = (const float*)(ws + WS_NP);
    LAS unsigned char* ub = L + hy::U_OFF + wave * hy::U_BYTES;
#pragma unroll 1
    for (int d = bx; d < DM; d += G) {
        float w0[3], w1[3], w2[3], cb[3];
#pragma unroll
        for (int p = 0; p < 3; ++p) { const int ch = p * DM + d; w0[p] = cw[ch]; w1[p] = cw[6144 + ch]; w2[p] = cw[2 * 6144 + ch]; cb[p] = cbv[ch]; }
        float invn[2][2];
#pragma unroll
        for (int o = 0; o < 2; ++o) { float sl = 0.f, sc = 0.f;
            for (int ch = 0; ch < 16; ++ch) sl += NP[(size_t)ch * 8192 + o * 2048 + d] + NP[(size_t)ch * 8192 + 4096 + o * 2048 + d];
            for (int ch = 16; ch < 18; ++ch) sc += NP[(size_t)ch * 8192 + o * 2048 + d] + NP[(size_t)ch * 8192 + 4096 + o * 2048 + d];
            invn[0][o] = 1.0f / (sl + 1e-6f); invn[1][o] = 1.0f / (sc + 1e-6f); }
        const float sk0 = skp[d], sk1 = skp[DM + d];
        const bf16* ftl = (const bf16*)(ws + WS_FT) + (size_t)d * 2 * 2048; const bf16* ftc = (const bf16*)(ws + WS_FT_CTX) + (size_t)d * 2 * 256;
        { const size_t sb = (size_t)NCTX + (size_t)wave * 2048;
          hy::fill_u(ub, UT + (size_t)d * NTOK + sb, 2048, w0[0], w1[0], w2[0], cb[0], lane);
          __syncthreads(); hy::build_copies(L, ftl, 2048, tid); __syncthreads();
          f32x4 acc[8];
#pragma unroll
          for (int k = 0; k < 8; ++k) acc[k] = (f32x4){0.f, 0.f, 0.f, 0.f};
          hy::toeplitz<8>(L, ub, acc, lane);
          hy::gate<8>(acc, ub, UT + (size_t)(DM + d) * NTOK + sb, w0[1], w1[1], w2[1], cb[1], invn[0][0], sk0, lane, false, nullptr);
          __syncthreads(); hy::build_copies(L, ftl + (size_t)2048 * 2 * 2048, 2048, tid); __syncthreads();
#pragma unroll
          for (int k = 0; k < 8; ++k) acc[k] = (f32x4){0.f, 0.f, 0.f, 0.f};
          hy::toeplitz<8>(L, ub, acc, lane);
          hy::gate<8>(acc, ub, UT + (size_t)(2 * DM + d) * NTOK + sb, w0[2], w1[2], w2[2], cb[2], invn[0][1], sk1, lane, true, ZT + (size_t)d * NTOK + sb); }
        { for (int q = 0; q < 4; ++q) hy::fill_u(ub + q * 1536, UT + (size_t)d * NTOK + (size_t)(wave * 4 + q) * 256, 256, w0[0], w1[0], w2[0], cb[0], lane);
          __syncthreads(); hy::build_copies(L, ftc, 256, tid); __syncthreads();
#pragma unroll 1
          for (int q = 0; q < 4; ++q) { const size_t sb = (size_t)(wave * 4 + q) * 256; f32x4 acc[1]; acc[0] = (f32x4){0.f, 0.f, 0.f, 0.f};
              hy::toeplitz<1>(L, ub + q * 1536, acc, lane);
              hy::gate<1>(acc, ub + q * 1536, UT + (size_t)(DM + d) * NTOK + sb, w0[1], w1[1], w2[1], cb[1], invn[1][0], sk0, lane, false, nullptr); }
          __syncthreads(); hy::build_copies(L, ftc + (size_t)2048 * 2 * 256, 256, tid); __syncthreads();
#pragma unroll 1
          for (int q = 0; q < 4; ++q) { const size_t sb = (size_t)(wave * 4 + q) * 256; f32x4 acc[1]; acc[0] = (f32x4){0.f, 0.f, 0.f, 0.f};
              hy::toeplitz<1>(L, ub + q * 1536, acc, lane);
              hy::gate<1>(acc, ub + q * 1536, UT + (size_t)(2 * DM + d) * NTOK + sb, w0[2], w1[2], w2[2], cb[2], invn[1][1], sk1, lane, true, ZT + (size_t)d * NTOK + sb); } }
    }
    __syncthreads();
}
__device__ __forceinline__ void ph_hytr(const Args& A, LAS unsigned char* L) {
    ENV_IDS ENV_PTRS
    const bf16* ZT = (const bf16*)(ws + WS_ZT); bf16* HB = (bf16*)(ws + WS_H);
    LAS unsigned char* scr = L + wave * 16384;
    for (int tile = gw; tile < 32 * 384; tile += NGW) { const int d0 = (tile & 31) * 64, r0 = (tile >> 5) * 64;
#pragma unroll
        for (int j = 0; j < 8; ++j) { const int idx = j * 64 + lane, dl = idx >> 3, ch = idx & 7;
            *(LAS v4u*)(scr + dl * 144 + ch * 16) = *(const GAS v4u*)(ZT + (size_t)(d0 + dl) * NTOK + r0 + ch * 8); }
        LDS_WAIT(); asm volatile("" ::: "memory");
#pragma unroll
        for (int j = 0; j < 8; ++j) { unsigned e[8];
#pragma unroll
            for (int q = 0; q < 8; ++q) e[q] = *(const LAS unsigned short*)(scr + (j * 8 + q) * 144 + lane * 2);
            v4u o; o.x = e[0] | (e[1] << 16); o.y = e[2] | (e[3] << 16); o.z = e[4] | (e[5] << 16); o.w = e[6] | (e[7] << 16);
            *(GAS v4u*)(HB + (size_t)(r0 + lane) * DM + d0 + j * 8) = o; }
        LDS_WAIT(); asm volatile("" ::: "memory"); }
}
__device__ __forceinline__ void ph_mixout(const Args& A, int layer, LAS unsigned char* L) {
    ENV_PTRS
    const int G = gridDim.x, bx = blockIdx.x; const int kind = layer % 3, jx = layer / 3;
    const float* modf = (const float*)(ws + WS_MODF) + (size_t)layer * 9 * 6 * DM;
    const float* xc = layer == 0 ? GIN(0) : out; const float* xl = layer == 0 ? GIN(1) : out + (size_t)NCTX * DM;
    const bf16* W = (const bf16*)(ws + (kind == 1 ? WS_WHO : (kind == 2 ? WS_WOA : (jx == 0 ? WS_WO0 : WS_WO1))));
    pg8::Gemm g{(const bf16*)(ws + WS_H), W, NTOK, DM, DM}; pg8::StaticOrder S; S.init(NTOK, DM, G, bx);
    pg8::EpiResid E{xc, xl, out, modf + 2 * DM};
    pg8::gemm_phase<pg8::EpiResid, pg8::StaticOrder, true, true>(L, g, S, E);
}
__device__ __forceinline__ void ph_gu(const Args& A, int layer, LAS unsigned char* L) {
    ENV_PTRS
    const int G = gridDim.x, bx = blockIdx.x;
    pg8::Gemm g{(const bf16*)(ws + WS_H), (const bf16*)(ws + WS_WGU + (size_t)layer * W_GU), NTOK, NGU, DM}; pg8::StaticOrder S; S.init(NTOK, NGU, G, bx);
    pg8::EpiSwiglu E{(bf16*)(ws + WS_BIG)};
    pg8::gemm_phase<pg8::EpiSwiglu, pg8::StaticOrder, true, true>(L, g, S, E);
}
__device__ __forceinline__ void ph_down(const Args& A, int layer, LAS unsigned char* L) {
    ENV_PTRS
    const int G = gridDim.x, bx = blockIdx.x;
    const float* modf = (const float*)(ws + WS_MODF) + (size_t)layer * 9 * 6 * DM;
    pg8::Gemm g{(const bf16*)(ws + WS_BIG), (const bf16*)(ws + WS_WDN + (size_t)layer * W_DN), NTOK, DM, DFF}; pg8::StaticOrder S; S.init(NTOK, DM, G, bx);
    pg8::EpiResid E{out, out + (size_t)NCTX * DM, out, modf + 5 * DM};
    pg8::gemm_phase<pg8::EpiResid, pg8::StaticOrder, true, true>(L, g, S, E);
}
__device__ __forceinline__ void ph_final(const Args& A) {
    ENV_IDS ENV_PTRS
    for (int row = gw; row < NTOK; row += NGW) final_norm_row(out + (size_t)row * DM, GIN(32), lane);
}

__global__ void __launch_bounds__(NWAVES * 64, 2) hybrid_fwd(Args A) {
    extern __shared__ __attribute__((aligned(16))) unsigned char lds[];
    LAS unsigned char* L = (LAS unsigned char*)lds;
    for (int u = threadIdx.x; u < (LDS_BYTES - LDSCTL_OFF) / 4; u += NWAVES * 64) ((LAS unsigned*)(L + LDSCTL_OFF))[u] = 0u;
    __syncthreads();
    XcdBarrier bar; bar.bar = (unsigned*)(A.ws + WS_CTL) + CW_BAR; bar.x = 0; bar.st = nullptr;
    if (!MK_PER_PHASE) bar = xcd_barrier_post((unsigned*)(A.ws + WS_CTL) + CW_BAR, (volatile LAS unsigned*)(L + MISC_OFF) + 8);
    const int lo = A.ph_lo, hi = A.ph_hi;
#define IN(k) (lo <= (k) && (k) < hi)
#define SEAM(k) do { if (IN(k) && IN((k) + 1)) xcd_barrier(bar); } while (0)
    if (PHON(0) && IN(0)) RUN(0, ph_prologue_a(A, L));
    SEAM(0);
    if (PHON(1) && IN(1)) RUN(1, ph_prologue_b(A, L));
    SEAM(1);
#pragma unroll 1
    for (int layer = 0; layer < DEPTH; ++layer) {
        const int pb = 2 + 8 * layer;
        if (PHON(2) && IN(pb + 0)) RUN(2, ph_norm(A, layer, 0));
        SEAM(pb + 0);
        if ((layer % 3) != 1) {
            if (PHON(3) && IN(pb + 1)) RUN(3, ph_qkv(A, layer, L));
            SEAM(pb + 1);
            if (PHON(4) && IN(pb + 2)) RUN(4, ph_qkpost(A, layer));
            SEAM(pb + 2);
            if (PHON(5) && IN(pb + 3)) RUN(5, ph_attn(A, layer, (LAS char*)L));
            SEAM(pb + 3);
        } else {
            if (PHON(6) && IN(pb + 1)) RUN(6, ph_hyin(A, L));
            SEAM(pb + 1);
            if (PHON(7) && IN(pb + 2)) RUN(7, ph_hyconv(A, L));
            SEAM(pb + 2);
            if (PHON(8) && IN(pb + 3)) RUN(8, ph_hytr(A, L));
            SEAM(pb + 3);
        }
        if (PHON(9) && IN(pb + 4)) RUN(9, ph_mixout(A, layer, L));
        SEAM(pb + 4);
        if (PHON(10) && IN(pb + 5)) RUN(10, ph_norm(A, layer, 1));
        SEAM(pb + 5);
        if (PHON(11) && IN(pb + 6)) RUN(11, ph_gu(A, layer, L));
        SEAM(pb + 6);
        if (PHON(12) && IN(pb + 7)) RUN(12, ph_down(A, layer, L));
        SEAM(pb + 7);
    }
    if (PHON(13) && IN(34)) RUN(13, ph_final(A));
#undef IN
#undef SEAM
}

extern "C" void kernel_launch(void* const* d_in, const int* in_sizes, int n_in, void* d_out, int out_size, void* d_ws, size_t ws_size, hipStream_t stream) {
    static int grid = 0;
    if (grid == 0) {
        if (n_in != 33 || (size_t)out_size != OUT_END || ws_size < WS_END) { fprintf(stderr, "kernel_launch: unexpected shapes: n_in %d out %d ws %zu (need %zu)\n", n_in, out_size, ws_size, (size_t)WS_END); grid = -1; return; }
        int dev = 0, cus = 0, per_cu = 0;
        if (hipGetDevice(&dev) != hipSuccess || hipDeviceGetAttribute(&cus, hipDeviceAttributeMultiprocessorCount, dev) != hipSuccess) { grid = -1; return; }
        if (hipFuncSetAttribute((const void*)hybrid_fwd, hipFuncAttributeMaxDynamicSharedMemorySize, LDS_BYTES) != hipSuccess) { fprintf(stderr, "kernel_launch: hipFuncSetAttribute failed\n"); grid = -1; return; }
        if (hipOccupancyMaxActiveBlocksPerMultiprocessor(&per_cu, (const void*)hybrid_fwd, NWAVES * 64, LDS_BYTES) != hipSuccess || per_cu < 1)
            fprintf(stderr, "kernel_launch: occupancy query reports %d workgroups per CU\n", per_cu);
        (void)hipGetLastError();
        grid = cus;
    }
    if (grid < 0) return;
    if (hipMemsetAsync((char*)d_ws + WS_CTL, 0, CTL_ZERO_BYTES, stream) != hipSuccess) { fprintf(stderr, "kernel_launch: memset failed\n"); return; }
    Args a{};
    for (int i = 0; i < 33; ++i) a.in[i] = (const float*)d_in[i];
    a.out = (float*)d_out; a.ws = (unsigned char*)d_ws;
#if MK_PER_PHASE
    for (int ph = 0; ph < NPHASE; ++ph) { a.ph_lo = ph; a.ph_hi = ph + 1; hipLaunchKernelGGL(hybrid_fwd, dim3(grid), dim3(NWAVES * 64), LDS_BYTES, stream, a); }
#else
    a.ph_lo = 0; a.ph_hi = NPHASE; hipLaunchKernelGGL(hybrid_fwd, dim3(grid), dim3(NWAVES * 64), LDS_BYTES, stream, a);
#endif
    const hipError_t le = hipPeekAtLastError();
    if (le != hipSuccess) fprintf(stderr, "kernel_launch: launch failed: %s\n", hipGetErrorName(le));
}
```

```cpp
#include <hip/hip_runtime.h>
#include <cstdio>
#include <cstdint>
#include <hip/hip_bf16.h>
#include <cmath>
namespace pg8 {
#define PG8_LAS __attribute__((address_space(3)))
typedef unsigned short bf16_t;
typedef short bf16x8 __attribute__((ext_vector_type(8)));
typedef float f32x4 __attribute__((ext_vector_type(4)));
typedef unsigned u32x4 __attribute__((ext_vector_type(4)));
constexpr int BM = 256, BK = 64, HALF = 128, HTB = HALF * BK * 2  , STAGE_BYTES = 8 * HTB, NXCD = 8, WGM = 8;

__host__ __device__ __forceinline__ int lds_byte(int r, int c) { const int st = (r >> 4) * 2 + (c >> 5), rr = r & 15, cc = c & 31, ob = rr * 64 + cc * 2; return st * 1024 + (ob ^ (((ob >> 9) & 1) << 5)); }
__host__ __device__ __forceinline__ void stage_rc(int b, int& R, int& C) { const int st = b / 1024, sb = b % 1024, swz = sb ^ (((sb >> 9) & 1) << 5); R = (st >> 1) * 16 + swz / 64; C = (st & 1) * 32 + (swz % 64) / 2; }
__host__ __device__ __forceinline__ int perm32(int rho) { const int n = rho >> 4, i = rho & 15; return 8 * (i >> 2) + 4 * n + (i & 3); }

struct Unit { int pm, pn; };
struct Gemm { const bf16_t* A; const bf16_t* Bt; int M, N, K; };

struct StaticOrder {
    int nM, nN, nwg, G, c;
    __host__ __device__ void init(int M, int N, int G_, int c_) { nM = M / BM; nN = N / BM; nwg = nM * nN; G = G_; c = c_; }
    __host__ __device__ bool next(int i, Unit& u) const {
        const long L = (long)i * G + c; if (L >= nwg) return false;
        int wgid = (int)L; { const int q = nwg / NXCD, r = nwg % NXCD, xcd = wgid % NXCD, off = wgid / NXCD; wgid = (xcd < r ? xcd * (q + 1) : r * (q + 1) + (xcd - r) * q) + off; }
        const int nig = WGM * nN, gid = wgid / nig, fm = gid * WGM, gsz = (nM - fm) < WGM ? (nM - fm) : WGM;
        u.pm = fm + ((wgid % nig) % gsz); u.pn = (wgid % nig) / gsz; return true;
    }
    __device__ __forceinline__ void a_ready(const Unit&) const {}
    __device__ __forceinline__ void done(const Unit&) const {}
};

__device__ __forceinline__ unsigned cvt_pk_bf16(float lo, float hi) { unsigned r; asm volatile("v_cvt_pk_bf16_f32 %0, %1, %2" : "=v"(r) : "v"(lo), "v"(hi)); return r; }
typedef float f32x2 __attribute__((ext_vector_type(2)));
struct EpiBf16 {
    static constexpr bool PERM = true, AFTER_DRAIN = false;
    bf16_t* O; int ldc;
    __device__ __forceinline__ void operator()(const f32x4 (&acc)[2][2][4][2], const Unit& u, int wr, int wc, int fr, int fq) const {
        const int row0 = u.pm * BM + wr * 64 + fr; const int col0 = u.pn * BM + wc * 32 + 8 * fq;
#pragma unroll
        for (int ai = 0; ai < 2; ++ai)
#pragma unroll
            for (int m = 0; m < 4; ++m) { bf16_t* rowp = O + (size_t)(row0 + ai * HALF + m * 16) * ldc + col0;
#pragma unroll
                for (int bj = 0; bj < 2; ++bj) { const f32x4 v0 = acc[ai][bj][m][0], v1 = acc[ai][bj][m][1];
                    u32x4 w; w.x = cvt_pk_bf16(v0[0], v0[1]); w.y = cvt_pk_bf16(v0[2], v0[3]); w.z = cvt_pk_bf16(v1[0], v1[1]); w.w = cvt_pk_bf16(v1[2], v1[3]);
                    *(u32x4*)(rowp + bj * HALF) = w; } }
    }
};
struct EpiQKV {
    static constexpr bool PERM = true, AFTER_DRAIN = false;
    bf16_t* O; float* sk; float* sv; int extra;
    __device__ __forceinline__ void operator()(const f32x4 (&acc)[2][2][4][2], const Unit& u, int wr, int wc, int fr, int fq) const {
        const int row0 = u.pm * BM + wr * 64 + fr; const int col0 = u.pn * BM + wc * 32 + 8 * fq;
        float* sb = nullptr; int scol = 0;
        if (u.pm < 32 && u.pn >= 8) { if (u.pn < 10) { sb = sk; scol = col0 - 2048; } else { sb = sv; scol = col0 - 2560; } }
#pragma unroll
        for (int ai = 0; ai < 2; ++ai)
#pragma unroll
            for (int m = 0; m < 4; ++m) { const int row = row0 + ai * HALF + m * 16; bf16_t* rowp = O + (size_t)row * 3072 + col0;
#pragma unroll
                for (int bj = 0; bj < 2; ++bj) { const f32x4 v0 = acc[ai][bj][m][0], v1 = acc[ai][bj][m][1];
                    u32x4 w; w.x = cvt_pk_bf16(v0[0], v0[1]); w.y = cvt_pk_bf16(v0[2], v0[3]); w.z = cvt_pk_bf16(v1[0], v1[1]); w.w = cvt_pk_bf16(v1[2], v1[3]);
                    *(u32x4*)(rowp + bj * HALF) = w;
                    if (sb) { float* sp = sb + (size_t)(row + (row >> 8) * extra) * 512 + scol + bj * HALF; *(f32x4*)sp = v0; *(f32x4*)(sp + 4) = v1; } } }
    }
};
struct EpiResid {
    static constexpr bool PERM = false, AFTER_DRAIN = false;
    const float* xc; const float* xl; float* out; const float* gate;
    __device__ __forceinline__ void operator()(const f32x4 (&acc)[2][2][4][2], const Unit& u, int wr, int wc, int fr, int fq) const {
        const int row0 = u.pm * BM + wr * 64 + fr; const int col0 = u.pn * BM + wc * 32 + 4 * fq;
        const int cv = u.pm < 32 ? 0 : 1 + ((u.pm - 32) >> 3);
        const float* gp = gate + (size_t)cv * (6 * 2048) + col0;
        const float* xin = u.pm < 32 ? xc + (size_t)row0 * 2048 + col0 : xl + (size_t)(row0 - 8192) * 2048 + col0;
        float* op = out + (size_t)row0 * 2048 + col0;
        f32x4 gv[2][2];
#pragma unroll
        for (int bj = 0; bj < 2; ++bj)
#pragma unroll
            for (int n = 0; n < 2; ++n) gv[bj][n] = *(const f32x4*)(gp + bj * HALF + n * 16);
#pragma unroll
        for (int ai = 0; ai < 2; ++ai)
#pragma unroll
            for (int m = 0; m < 4; ++m) { const size_t ro = (size_t)(ai * HALF + m * 16) * 2048;
#pragma unroll
                for (int bj = 0; bj < 2; ++bj)
#pragma unroll
                    for (int n = 0; n < 2; ++n) { const f32x4 x = *(const f32x4*)(xin + ro + bj * HALF + n * 16);
                        *(f32x4*)(op + ro + bj * HALF + n * 16) = x + gv[bj][n] * acc[ai][bj][m][n]; }
                if (m & 1) asm volatile("" ::: "memory"); }
    }
};
struct EpiSwiglu {
    static constexpr bool PERM = true, AFTER_DRAIN = false;
    bf16_t* O;
    __device__ __forceinline__ float sw(float g, float uu) const { return g * __builtin_amdgcn_rcpf(1.0f + __builtin_amdgcn_exp2f(-1.4426950408889634f * g)) * uu; }
    __device__ __forceinline__ void operator()(const f32x4 (&acc)[2][2][4][2], const Unit& u, int wr, int wc, int fr, int fq) const {
        const int row0 = u.pm * BM + wr * 64 + fr; const int col0 = u.pn * HALF + wc * 32 + 8 * fq;
#pragma unroll
        for (int ai = 0; ai < 2; ++ai)
#pragma unroll
            for (int m = 0; m < 4; ++m) { bf16_t* rowp = O + (size_t)(row0 + ai * HALF + m * 16) * 5632 + col0;
                const f32x4 g0 = acc[ai][0][m][0], g1 = acc[ai][0][m][1], u0 = acc[ai][1][m][0], u1 = acc[ai][1][m][1];
                u32x4 w; w.x = cvt_pk_bf16(sw(g0[0], u0[0]), sw(g0[1], u0[1])); w.y = cvt_pk_bf16(sw(g0[2], u0[2]), sw(g0[3], u0[3]));
                w.z = cvt_pk_bf16(sw(g1[0], u1[0]), sw(g1[1], u1[1])); w.w = cvt_pk_bf16(sw(g1[2], u1[2]), sw(g1[3], u1[3]));
                *(u32x4*)rowp = w; }
    }
};

template <class Epi, class Sched, bool ALIGN_EPI = false, bool SP2 = false>
__device__ __forceinline__ void gemm_phase(PG8_LAS unsigned char* lds, const Gemm g, const Sched& S, const Epi& E) {
    int tid_ = threadIdx.x; asm volatile("" : "+v"(tid_));
    const int tid = tid_, wid = __builtin_amdgcn_readfirstlane(tid >> 6), lane = tid & 63, wr = wid >> 2, wc = wid & 3, fr = lane & 15, fq = lane >> 4;
    const int K = g.K, nt = K / BK;
    unsigned voffA[2], voffB[2];
#pragma unroll
    for (int i = 0; i < 2; ++i) { int R, C; stage_rc(tid * 16 + i * 8192, R, C); const int Rb = Epi::PERM ? ((R & ~31) + perm32(R & 31)) : R;
        voffA[i] = (unsigned)(R * K + C) * 2u; voffB[i] = (unsigned)(Rb * K + C) * 2u; }
    const size_t kstep = (size_t)(BK * 2);
    const size_t hstep = (size_t)HALF * K * 2;
    const size_t tstep = 2 * hstep;
    const unsigned ldsw = (unsigned)wid * 1024u;
    const int aoff = lds_byte(wr * 64 + fr, fq * 8), boff = lds_byte(wc * 32 + fr, fq * 8);
#define PG8_SA(b, h) (((b) * 2 + (h)) * HTB)
#define PG8_SB(b, h) ((4 + (b) * 2 + (h)) * HTB)
#define PG8_STAGE(bufoff, gbase, voff) do { _Pragma("unroll") for (int _i = 0; _i < 2; ++_i) \
        __builtin_amdgcn_global_load_lds((const unsigned*)((const char*)(gbase) + (voff)[_i]), (PG8_LAS unsigned*)(lds + (bufoff) + ldsw + _i * 8192), 16, 0, 0); } while (0)
#define PG8_LDA(dst, b, h) do { _Pragma("unroll") for (int m = 0; m < 4; ++m) _Pragma("unroll") for (int k = 0; k < 2; ++k) dst[m][k] = *(const PG8_LAS bf16x8*)(lds + PG8_SA(b, h) + aoff + m * 2048 + k * 1024); } while (0)
#define PG8_LDB(dst, b, h) do { _Pragma("unroll") for (int n = 0; n < 2; ++n) _Pragma("unroll") for (int k = 0; k < 2; ++k) dst[n][k] = *(const PG8_LAS bf16x8*)(lds + PG8_SB(b, h) + boff + n * 2048 + k * 1024); } while (0)
#define PG8_MMA(ai, bj, At, Bt) do { __builtin_amdgcn_s_setprio(1); _Pragma("unroll") for (int m = 0; m < 4; ++m) _Pragma("unroll") for (int n = 0; n < 2; ++n) _Pragma("unroll") for (int k = 0; k < 2; ++k) \
        acc[ai][bj][m][n] = __builtin_amdgcn_mfma_f32_16x16x32_bf16(Bt[n][k], At[m][k], acc[ai][bj][m][n], 0, 0, 0); __builtin_amdgcn_s_setprio(0); } while (0)
#define PG8_WAIT_V(n) asm volatile("s_waitcnt vmcnt(" #n ")" ::: "memory")
#define PG8_WAIT_L(n) asm volatile("s_waitcnt lgkmcnt(" #n ")" ::: "memory")
#define PG8_BAR __builtin_amdgcn_s_barrier()
#define PG8_SCHED __builtin_amdgcn_sched_barrier(0)
    Unit cur, nxt; int ui = 0;
    if (!S.next(0, cur)) return;
    f32x4 acc[2][2][4][2];
#pragma unroll
    for (int a = 0; a < 2; ++a)
#pragma unroll
        for (int b = 0; b < 2; ++b)
#pragma unroll
            for (int m = 0; m < 4; ++m)
#pragma unroll
                for (int n = 0; n < 2; ++n) acc[a][b][m][n] = (f32x4){0.f, 0.f, 0.f, 0.f};
    bf16x8 At[4][2], B0[2][2], B1[2][2];
    const char* cA = (const char*)g.A + (size_t)cur.pm * tstep; const char* cB = (const char*)g.Bt + (size_t)cur.pn * tstep;
    S.a_ready(cur);
    if constexpr (SP2) {
        PG8_STAGE(PG8_SB(0, 0), cB, voffB); PG8_STAGE(PG8_SB(0, 1), cB + hstep, voffB); PG8_STAGE(PG8_SA(0, 0), cA, voffA); PG8_STAGE(PG8_SA(0, 1), cA + hstep, voffA);
        if (wr == 1) PG8_BAR;
        PG8_WAIT_V(2); PG8_BAR;
        PG8_STAGE(PG8_SB(1, 0), cB + kstep, voffB); PG8_STAGE(PG8_SA(1, 0), cA + kstep, voffA); PG8_STAGE(PG8_SB(1, 1), cB + hstep + kstep, voffB);
        PG8_WAIT_V(6); PG8_BAR;
    } else {
        PG8_STAGE(PG8_SB(0, 0), cB, voffB); PG8_STAGE(PG8_SA(0, 0), cA, voffA); PG8_STAGE(PG8_SB(0, 1), cB + hstep, voffB); PG8_STAGE(PG8_SA(0, 1), cA + hstep, voffA);
        if (wr == 1) PG8_BAR;
        PG8_WAIT_V(4); PG8_BAR;
        PG8_STAGE(PG8_SB(1, 0), cB + kstep, voffB); PG8_STAGE(PG8_SA(1, 0), cA + kstep, voffA); PG8_STAGE(PG8_SB(1, 1), cB + hstep + kstep, voffB);
        PG8_WAIT_V(6); PG8_BAR;
    }
    for (;;) {
        const bool has_next = S.next(ui + 1, nxt);
        const char* nA = has_next ? (const char*)g.A + (size_t)nxt.pm * tstep : cA; const char* nB = has_next ? (const char*)g.Bt + (size_t)nxt.pn * tstep : cB;
        for (int t = 0; t < nt; t += 2) {
            const bool last = (t == nt - 2);
            const char* a1 = cA + (size_t)(t + 1) * kstep;
            const char* a2 = last ? nA : cA + (size_t)(t + 2) * kstep; const char* b2 = last ? nB : cB + (size_t)(t + 2) * kstep;
            const char* a3 = a2 + kstep; const char* b3 = b2 + kstep;
            if (last && has_next) S.a_ready(nxt);
            if constexpr (SP2) {
            PG8_LDB(B0, 0, 0); PG8_LDB(B1, 0, 1); PG8_SCHED; PG8_LDA(At, 0, 0); PG8_STAGE(PG8_SA(1, 1), a1 + hstep, voffA);
            PG8_WAIT_V(8); PG8_WAIT_L(0); PG8_BAR; PG8_MMA(0, 0, At, B0); PG8_MMA(0, 1, At, B1); PG8_BAR; PG8_SCHED;
            PG8_LDA(At, 0, 1); PG8_STAGE(PG8_SB(0, 0), b2, voffB); PG8_STAGE(PG8_SB(0, 1), b2 + hstep, voffB); PG8_STAGE(PG8_SA(0, 0), a2, voffA);
            PG8_WAIT_V(8); PG8_WAIT_L(0); PG8_BAR; PG8_MMA(1, 0, At, B0); PG8_MMA(1, 1, At, B1); PG8_BAR; PG8_SCHED;
            PG8_LDB(B0, 1, 0); PG8_LDB(B1, 1, 1); PG8_SCHED; PG8_LDA(At, 1, 0); PG8_STAGE(PG8_SA(0, 1), a2 + hstep, voffA);
            PG8_WAIT_V(8); PG8_WAIT_L(0); PG8_BAR; PG8_MMA(0, 0, At, B0); PG8_MMA(0, 1, At, B1); PG8_BAR; PG8_SCHED;
            PG8_LDA(At, 1, 1); PG8_STAGE(PG8_SB(1, 0), b3, voffB); PG8_STAGE(PG8_SB(1, 1), b3 + hstep, voffB); PG8_STAGE(PG8_SA(1, 0), a3, voffA);
            PG8_WAIT_V(8); PG8_WAIT_L(0); PG8_BAR; PG8_MMA(1, 0, At, B0); PG8_MMA(1, 1, At, B1); PG8_BAR; PG8_SCHED;
            } else {
            PG8_LDB(B0, 0, 0); PG8_SCHED; PG8_LDA(At, 0, 0); PG8_STAGE(PG8_SA(1, 1), a1 + hstep, voffA);
            PG8_WAIT_L(8); PG8_BAR; PG8_WAIT_L(0); PG8_MMA(0, 0, At, B0); PG8_BAR; PG8_SCHED;
            PG8_LDB(B1, 0, 1); PG8_STAGE(PG8_SB(0, 0), b2, voffB);
            PG8_BAR; PG8_WAIT_L(0); PG8_MMA(0, 1, At, B1); PG8_BAR;
            PG8_LDA(At, 0, 1); PG8_STAGE(PG8_SA(0, 0), a2, voffA);
            PG8_BAR; PG8_WAIT_L(0); PG8_MMA(1, 0, At, B0); PG8_BAR; PG8_SCHED;
            PG8_STAGE(PG8_SB(0, 1), b2 + hstep, voffB);
            PG8_WAIT_V(6); PG8_BAR; PG8_MMA(1, 1, At, B1); PG8_BAR;
            PG8_LDB(B0, 1, 0); PG8_SCHED; PG8_LDA(At, 1, 0); PG8_STAGE(PG8_SA(0, 1), a2 + hstep, voffA);
            PG8_WAIT_L(8); PG8_BAR; PG8_WAIT_L(0); PG8_MMA(0, 0, At, B0); PG8_BAR; PG8_SCHED;
            PG8_LDB(B1, 1, 1); PG8_STAGE(PG8_SB(1, 0), b3, voffB);
            PG8_BAR; PG8_WAIT_L(0); PG8_MMA(0, 1, At, B1); PG8_BAR;
            PG8_LDA(At, 1, 1); PG8_STAGE(PG8_SA(1, 0), a3, voffA);
            PG8_BAR; PG8_WAIT_L(0); PG8_MMA(1, 0, At, B0); PG8_BAR; PG8_SCHED;
            PG8_STAGE(PG8_SB(1, 1), b3 + hstep, voffB);
            PG8_WAIT_V(6); PG8_BAR; PG8_MMA(1, 1, At, B1); PG8_BAR;
            }
        }
        if constexpr (ALIGN_EPI) { if (wr == 0) PG8_BAR; }
        if constexpr (!Epi::AFTER_DRAIN) { E(acc, cur, wr, wc, fr, fq); S.done(cur); }
        if (!has_next) break;
#pragma unroll
        for (int a = 0; a < 2; ++a)
#pragma unroll
            for (int b = 0; b < 2; ++b)
#pragma unroll
                for (int m = 0; m < 4; ++m)
#pragma unroll
                    for (int n = 0; n < 2; ++n) acc[a][b][m][n] = (f32x4){0.f, 0.f, 0.f, 0.f};
        cur = nxt; cA = nA; cB = nB; ++ui;
        if constexpr (ALIGN_EPI) { if (wr == 1) PG8_BAR; }
    }
    PG8_WAIT_V(0);
    if constexpr (!ALIGN_EPI) { if (wr == 0) PG8_BAR; }
    PG8_BAR;
    if constexpr (Epi::AFTER_DRAIN) { E.fused(acc, cur, wr, wc, fr, fq, lds, wid, lane); S.done(cur); }
#undef PG8_SA
#undef PG8_SB
#undef PG8_STAGE
#undef PG8_LDA
#undef PG8_LDB
#undef PG8_MMA
#undef PG8_WAIT_V
#undef PG8_WAIT_L
#undef PG8_BAR
#undef PG8_SCHED
}
}

namespace att {
using bf16 = unsigned short;
#define AG __attribute__((address_space(1)))
#define AL __attribute__((address_space(3)))
constexpr int D = 128, NW = 8, QBLK = 32, KVBLK = 64;
constexpr float SCALE = 0.088388347648318440f;
constexpr float THR = 8.f;
using bf16x8 = __attribute__((ext_vector_type(8))) short;
using s16x4  = __attribute__((ext_vector_type(4))) short;
using f32x16 = __attribute__((ext_vector_type(16))) float;
using u32x4  = __attribute__((ext_vector_type(4))) unsigned;
constexpr size_t SHM_V = KVBLK * D * 2, SHM_K = KVBLK * D * 2, SHM_ATTN = 2 * SHM_V + 2 * SHM_K + NW * 64 * 4;
#define KSWZ(row, colB) ((row) * 256 + ((colB) ^ (((row) & 7) << 4)))
#define SBAR() __builtin_amdgcn_sched_barrier(0)
__device__ __forceinline__ int crow(int r, int hi) { return (r & 3) + 8 * (r >> 2) + 4 * hi; }
__device__ __forceinline__ unsigned cvtpk(float lo, float hi) { unsigned r; asm volatile("v_cvt_pk_bf16_f32 %0, %1, %2" : "=v"(r) : "v"(lo), "v"(hi)); return r; }
__device__ __forceinline__ bf16x8 ld8(const bf16* p) { return *(const AG bf16x8*)p; }

__device__ __forceinline__ void partialSM(f32x16& p0, f32x16& p1, float& m_reg, float& mn, float& alpha) {
  constexpr float C = SCALE * 1.4426950408889634f;
  float pmax = p0[0]; for (int r = 1; r < 16; ++r) pmax = fmaxf(pmax, p0[r]); for (int r = 0; r < 16; ++r) pmax = fmaxf(pmax, p1[r]);
  { auto rr = __builtin_amdgcn_permlane32_swap(__float_as_uint(pmax), __float_as_uint(pmax), false, false);
    pmax = fmaxf(__uint_as_float(rr[0]), __uint_as_float(rr[1])); }
  if (__builtin_expect(__all(pmax - m_reg <= THR / SCALE), 1)) { mn = m_reg; alpha = 1.f; }
  else { mn = fmaxf(m_reg, pmax); alpha = __builtin_amdgcn_exp2f((m_reg - mn) * C); m_reg = mn; }
  float mnC = -mn * C;
  for (int r = 0; r < 16; ++r) p0[r] = fmaf(p0[r], C, mnC); for (int r = 0; r < 16; ++r) p1[r] = fmaf(p1[r], C, mnC);
  for (int r = 0; r < 16; ++r) p0[r] = __builtin_amdgcn_exp2f(p0[r]);
}
__device__ __forceinline__ void finishSM(f32x16& p0, f32x16& p1, float alpha, float& l_reg, bf16x8& pa0, bf16x8& pa1, bf16x8& pa2, bf16x8& pa3) {
  for (int r = 0; r < 16; ++r) p1[r] = __builtin_amdgcn_exp2f(p1[r]);
  float ps = 0; for (int r = 0; r < 16; ++r) ps += p0[r]; for (int r = 0; r < 16; ++r) ps += p1[r];
  { auto rr = __builtin_amdgcn_permlane32_swap(__float_as_uint(ps), __float_as_uint(ps), false, false);
    ps = __uint_as_float(rr[0]) + __uint_as_float(rr[1]); }
  l_reg = l_reg * alpha + ps;
#define PK4(P, BASE, OUT) do { unsigned a0 = cvtpk(P[BASE + 0], P[BASE + 1]), a1 = cvtpk(P[BASE + 2], P[BASE + 3]);   \
    unsigned b0 = cvtpk(P[BASE + 4], P[BASE + 5]), b1 = cvtpk(P[BASE + 6], P[BASE + 7]);                              \
    auto r0 = __builtin_amdgcn_permlane32_swap(a0, b0, false, false); auto r1 = __builtin_amdgcn_permlane32_swap(a1, b1, false, false); \
    u32x4 w = {r0[0], r1[0], r0[1], r1[1]}; OUT = *reinterpret_cast<bf16x8*>(&w); } while (0)
  PK4(p0, 0, pa0); PK4(p0, 8, pa1); PK4(p1, 0, pa2); PK4(p1, 8, pa3);
#undef PK4
}
__device__ __forceinline__ void qkt(f32x16& p0, f32x16& p1, const AL char* Ks, const bf16x8* qr, int r32, int hi) {
  p0 = f32x16{}; p1 = f32x16{};
  for (int d0 = 0; d0 < 8; ++d0) { int cb = (d0 * 16 + hi * 8) * 2;
    bf16x8 b0 = *(const AL bf16x8*)(Ks + KSWZ(r32, cb));
    bf16x8 b1 = *(const AL bf16x8*)(Ks + KSWZ(32 + r32, cb));
    p0 = __builtin_amdgcn_mfma_f32_32x32x16_bf16(b0, qr[d0], p0, 0, 0, 0);
    p1 = __builtin_amdgcn_mfma_f32_32x32x16_bf16(b1, qr[d0], p1, 0, 0, 0); }
}
__device__ __forceinline__ void wmask(f32x16& p0, f32x16& p1, int dq, int hi) {
#pragma unroll
  for (int r = 0; r < 16; ++r) { const int df = dq - crow(r, hi);
    if (df > 128 || df < -128) p0[r] = -1e30f;
    if (df - 32 > 128 || df - 32 < -128) p1[r] = -1e30f; }
}
__device__ __forceinline__ int v_st(int k, int c) { const int kk = (k & ~0xC) | ((k & 4) << 1) | ((k & 8) >> 1); return ((kk >> 3) * 4 + (c >> 5)) * 512 + ((kk & 7) * 32 + (c & 31)) * 2; }
__device__ __forceinline__ int v_rd_base(int lane) { return ((lane & 3) << 3) | (((lane >> 2) & 3) << 6) | (((lane >> 4) & 1) << 5) | (((lane >> 5) & 1) << 8); }
constexpr int v_rd_off(int d0, int ks, int half) { return d0 * 512 + ks * 4096 + half * 2048; }
template <int OFF> __device__ __forceinline__ s16x4 tr_read(int vb) {
  s16x4 r; asm volatile("ds_read_b64_tr_b16 %0, %1 offset:%2" : "=&v"(r) : "v"(vb), "i"(OFF) : "memory"); return r;
}
template <int D0> __device__ __forceinline__ void pv_one(f32x16& od, int vb, bf16x8 pa0, bf16x8 pa1, bf16x8 pa2, bf16x8 pa3) {
  const s16x4 l0 = tr_read<v_rd_off(D0, 0, 0)>(vb), h0 = tr_read<v_rd_off(D0, 0, 1)>(vb), l1 = tr_read<v_rd_off(D0, 1, 0)>(vb), h1 = tr_read<v_rd_off(D0, 1, 1)>(vb);
  const s16x4 l2 = tr_read<v_rd_off(D0, 2, 0)>(vb), h2 = tr_read<v_rd_off(D0, 2, 1)>(vb), l3 = tr_read<v_rd_off(D0, 3, 0)>(vb), h3 = tr_read<v_rd_off(D0, 3, 1)>(vb);
  asm volatile("s_waitcnt lgkmcnt(0)" ::: "memory"); SBAR();
#define PK(L, H) (bf16x8){L[0], L[1], L[2], L[3], H[0], H[1], H[2], H[3]}
  od = __builtin_amdgcn_mfma_f32_32x32x16_bf16(pa0, PK(l0, h0), od, 0, 0, 0);
  od = __builtin_amdgcn_mfma_f32_32x32x16_bf16(pa1, PK(l1, h1), od, 0, 0, 0);
  od = __builtin_amdgcn_mfma_f32_32x32x16_bf16(pa2, PK(l2, h2), od, 0, 0, 0);
  od = __builtin_amdgcn_mfma_f32_32x32x16_bf16(pa3, PK(l3, h3), od, 0, 0, 0);
#undef PK
}
__device__ __forceinline__ void pv_d0(f32x16* o, int vb, bf16x8 pa0, bf16x8 pa1, bf16x8 pa2, bf16x8 pa3) {
  pv_one<0>(o[0], vb, pa0, pa1, pa2, pa3); pv_one<1>(o[1], vb, pa0, pa1, pa2, pa3); pv_one<2>(o[2], vb, pa0, pa1, pa2, pa3); pv_one<3>(o[3], vb, pa0, pa1, pa2, pa3);
}

struct Unit {
  const bf16* Q; int ldq;
  const bf16* KA; const bf16* VA; int ldA; int nA;
  const bf16* KB; const bf16* VB; int ldB;
  int NT;
  int win;
  int dq0;
  int has_sink; float sink;
  bf16* O; int ldo;
};

__device__ __forceinline__ void attn_unit(const Unit& U, AL char* lds) {
  int tid_ = threadIdx.x; asm volatile("" : "+v"(tid_));
  const int tid = tid_, wid = tid >> 6, lane = tid & 63, r32 = lane & 31, hi = lane >> 5;
  AL char* V_lds = lds; AL char* K_lds = lds + 2 * SHM_V;
  AL float* ws = (AL float*)(lds + 2 * SHM_V + 2 * SHM_K) + wid * 64; AL float* li_l = ws; AL float* al_l = ws + 32;
  float m_reg = -1e30f, l_reg = 0; f32x16 o[4] = {}; bf16x8 qr[8];
  const bf16* Qw = U.Q + (long)(wid * QBLK + r32) * U.ldq + hi * 8;
#pragma unroll
  for (int d0 = 0; d0 < 8; ++d0) qr[d0] = ld8(Qw + d0 * 16);
  const int sr = tid >> 4, sc = (tid & 15) * 8, vst0 = v_st(sr, sc), vst1 = v_st(32 + sr, sc);
  const int vb0 = (int)(unsigned)(uintptr_t)V_lds + v_rd_base(lane);
  const int nA = U.nA, NT = U.NT;
  const int dqw = U.dq0 + wid * QBLK + r32;
  struct { bf16x8 vs0, vs1, ks0, ks1; } sr_[1];
#define SLOAD(i, jt) do { const int jj_ = (jt); const bf16 *kp_, *vp_; long ld_; \
    if (jj_ < nA) { ld_ = U.ldA; kp_ = U.KA + (long)jj_ * 64 * ld_; vp_ = U.VA + (long)jj_ * 64 * ld_; } \
    else { ld_ = U.ldB; kp_ = U.KB + (long)(jj_ - nA) * 64 * ld_; vp_ = U.VB + (long)(jj_ - nA) * 64 * ld_; } \
    sr_[i].vs0 = ld8(vp_ + (long)sr * ld_ + sc); sr_[i].vs1 = ld8(vp_ + (long)(32 + sr) * ld_ + sc); \
    sr_[i].ks0 = ld8(kp_ + (long)sr * ld_ + sc); sr_[i].ks1 = ld8(kp_ + (long)(32 + sr) * ld_ + sc); } while (0)
#define SWRITE(b, i) do { *(AL bf16x8*)(V_lds + (b) * SHM_V + vst0) = sr_[i].vs0;          \
    *(AL bf16x8*)(V_lds + (b) * SHM_V + vst1) = sr_[i].vs1; int kc = sc * 2;               \
    *(AL bf16x8*)(K_lds + (b) * SHM_K + KSWZ(sr, kc)) = sr_[i].ks0;                       \
    *(AL bf16x8*)(K_lds + (b) * SHM_K + KSWZ(32 + sr, kc)) = sr_[i].ks1; } while (0)
#define RESC(a) do { if (__any((a) < 1.f)) { if (hi == 0) al_l[r32] = (a); asm volatile("s_waitcnt lgkmcnt(0)" ::: "memory"); \
    for (int d = 0; d < 4; ++d) for (int r = 0; r < 16; ++r) o[d][r] *= al_l[crow(r, hi)]; } } while (0)
#define MASK(P0, P1, jt) do { if (U.win && (jt) >= nA) { const int dq_ = dqw - ((jt) - nA) * 64; \
    if (__any(dq_ > 128 || dq_ - 63 < -128)) wmask(P0, P1, dq_, hi); } } while (0)
  f32x16 p0, p1; float mn, al; bf16x8 pa0, pa1, pa2, pa3;
  SLOAD(0, 0); asm volatile("s_waitcnt vmcnt(0)" ::: "memory"); SWRITE(0, 0); SLOAD(0, 1); __syncthreads();
#pragma unroll 1
  for (int j = 0; j < NT; ++j) {
    const int b = j & 1;
    qkt(p0, p1, K_lds + b * SHM_K, qr, r32, hi); MASK(p0, p1, j);
    partialSM(p0, p1, m_reg, mn, al);
    RESC(al);
    finishSM(p0, p1, al, l_reg, pa0, pa1, pa2, pa3); SBAR();
    pv_d0(o, vb0 + b * (int)SHM_V, pa0, pa1, pa2, pa3);
    if (j + 1 < NT) { asm volatile("s_waitcnt vmcnt(0)" ::: "memory"); SWRITE(b ^ 1, 0); if (j + 2 < NT) SLOAD(0, j + 2); }
    __syncthreads();
  }
  if (U.has_sink) { constexpr float C = SCALE * 1.4426950408889634f; l_reg += __builtin_amdgcn_exp2f(fminf(U.sink * 1.4426950408889634f - m_reg * C, 120.f)); }
  if (hi == 0) li_l[r32] = l_reg; asm volatile("s_waitcnt lgkmcnt(0)" ::: "memory");
  float rli[16];
#pragma unroll
  for (int r = 0; r < 16; ++r) rli[r] = __builtin_amdgcn_rcpf(li_l[crow(r, hi)]);
  bf16* Ow = U.O + (long)(wid * QBLK) * U.ldo;
#pragma unroll
  for (int r = 0; r < 16; ++r) { int orow = crow(r, hi);
    for (int d0 = 0; d0 < 4; ++d0) { const float v = o[d0][r] * rli[r]; const unsigned pk = cvtpk(v, v);
      *(AG unsigned short*)(Ow + (long)orow * U.ldo + d0 * 32 + r32) = (unsigned short)(pk & 0xffffu); } }
#undef SLOAD
#undef SWRITE
#undef RESC
#undef MASK
}
}

constexpr int DM = 2048, NCTX = 8192, NLAT = 16384, NTOK = 24576, QKVD = 3072, DFF = 5632, NGU = 11264, DEPTH = 4;
constexpr int NWAVES = 8;
constexpr size_t MiB = 1u << 20;
constexpr size_t OUT_YP = 0, OUT_YS = (size_t)NCTX * DM, OUT_WK = (size_t)NTOK * DM, OUT_WV = OUT_WK + (size_t)32 * 2 * 256 * 512,
                 OUT_AK = OUT_WV + (size_t)32 * 2 * 256 * 512, OUT_AV = OUT_AK + (size_t)32 * 256 * 512, OUT_END = OUT_AV + (size_t)32 * 256 * 512;
constexpr size_t WS_CTL = 0, CTL_ZERO_BYTES = 1 * MiB;
constexpr size_t WS_MODP = 1 * MiB;
constexpr size_t WS_MODF = 16 * MiB;
constexpr size_t WS_A2 = 18 * MiB;
constexpr size_t WS_NP = 19 * MiB;
constexpr size_t WS_CKV = 20 * MiB;
constexpr size_t WS_CWK = WS_CKV, WS_CWV = WS_CKV + 8 * MiB, WS_CAK = WS_CKV + 16 * MiB, WS_CAV = WS_CKV + 20 * MiB;
constexpr size_t WS_FT = 44 * MiB;
constexpr size_t WS_FT_CTX = WS_FT + 32 * MiB;
constexpr size_t WS_W = 80 * MiB;
constexpr size_t W_QKV = (size_t)QKVD * DM * 2, W_SQ = (size_t)DM * DM * 2, W_IN = (size_t)6144 * DM * 2, W_GU = (size_t)NGU * DM * 2, W_DN = (size_t)DM * DFF * 2;
constexpr size_t WS_WQKV0 = WS_W, WS_WQKV1 = WS_WQKV0 + W_QKV, WS_WQKVA = WS_WQKV1 + W_QKV, WS_WO0 = WS_WQKVA + W_QKV, WS_WO1 = WS_WO0 + W_SQ, WS_WOA = WS_WO1 + W_SQ,
                 WS_WHO = WS_WOA + W_SQ, WS_WHI = WS_WHO + W_SQ, WS_WGU = WS_WHI + W_IN, WS_WDN = WS_WGU + 4 * W_GU, WS_WEND = WS_WDN + 4 * W_DN;
constexpr size_t WS_H = 448 * MiB;
constexpr size_t WS_BIG = 544 * MiB;
constexpr size_t WS_ZT = WS_BIG + 288 * MiB;
constexpr size_t WS_END = WS_BIG + 384 * MiB;
static_assert(WS_WEND <= WS_H && WS_FT_CTX + 4 * MiB <= WS_W && WS_CAV + 4 * MiB <= WS_FT, "ws map");
static_assert(WS_MODP + (size_t)4 * 8 * 9 * 12288 * 4 <= WS_MODF && WS_MODF + (size_t)4 * 9 * 6 * 2048 * 4 <= WS_A2 && WS_A2 + (size_t)2304 * 64 * 4 <= WS_NP && WS_NP + (size_t)18 * 8192 * 4 <= WS_CKV, "small buffers");
constexpr int CW_TMO = 0;
constexpr int CW_BAR = 4096;
constexpr int RING_BYTES = 131072;
constexpr int LDSCTL_OFF = RING_BYTES, MISC_OFF = LDSCTL_OFF + 320;
constexpr int LDS_BYTES = 147456;

#define GAS __attribute__((address_space(1)))
#define LAS __attribute__((address_space(3)))
typedef unsigned short bf16;
typedef unsigned v4u __attribute__((ext_vector_type(4)));
typedef unsigned v2u __attribute__((ext_vector_type(2)));
typedef float f32x4 __attribute__((ext_vector_type(4)));
typedef short bf16x8 __attribute__((ext_vector_type(8)));
typedef short bf16x4 __attribute__((ext_vector_type(4)));
typedef GAS unsigned gu32;
#define RLX_AGENT __ATOMIC_RELAXED, __HIP_MEMORY_SCOPE_AGENT
#define LDS_WAIT() asm volatile("s_waitcnt lgkmcnt(0)" ::: "memory")
#define VM_WAIT() asm volatile("s_waitcnt vmcnt(0)" ::: "memory")
__device__ __forceinline__ unsigned f2bf(float f) { unsigned u = __builtin_bit_cast(unsigned, f); return (u + 0x7fffu + ((u >> 16) & 1u)) >> 16; }
__device__ __forceinline__ unsigned pk2(float lo, float hi) { return f2bf(lo) | (f2bf(hi) << 16); }
__device__ __forceinline__ float bf2f(unsigned short b) { return __builtin_bit_cast(float, (unsigned)b << 16); }
__device__ __forceinline__ float bflo(unsigned w) { return __builtin_bit_cast(float, w << 16); }
__device__ __forceinline__ float bfhi(unsigned w) { return __builtin_bit_cast(float, w & 0xffff0000u); }
__device__ __forceinline__ float wave_sum(float v) {
#pragma unroll
    for (int o = 1; o < 64; o <<= 1) v += __shfl_xor(v, o);
    return v;
}
#define XB_TMO      128
#define XB_XCNT(j)  (256  + 64 * (j))
#define XB_XSUB(j)  (1280 + 64 * (j))
#define XB_XGEN(j)  (2304 + 64 * (j))
#define XB_TOP      3328
#define XB_TOPGEN   3392
#define XCD_BAR_WORDS 3456
#define XB_SPIN_CAP (1u << 18)

__device__ __forceinline__ unsigned xb_ld(unsigned* p)              { return __hip_atomic_load(p, __ATOMIC_RELAXED, __HIP_MEMORY_SCOPE_AGENT); }
__device__ __forceinline__ unsigned xb_add(unsigned* p, unsigned v) { return __hip_atomic_fetch_add(p, v, __ATOMIC_RELAXED, __HIP_MEMORY_SCOPE_AGENT); }
__device__ __forceinline__ unsigned xb_xcc_id() { return (unsigned)__builtin_amdgcn_s_getreg((3 << 11) | 20) & 0xFu; }
#define XB_SPIN(cond, bar) do { unsigned _sp = 0; while (cond) { __builtin_amdgcn_s_sleep(1); \
    if ((++_sp & 255u) == 0u) { if (xb_ld(&(bar)[XB_TMO])) break; if (_sp > XB_SPIN_CAP) { atomicAdd(&(bar)[XB_TMO], 1u); break; } } } } while (0)

struct XcdBarrier {
    unsigned* bar; unsigned x;
    volatile LAS unsigned* st;
};

__device__ __forceinline__ XcdBarrier xcd_barrier_post(unsigned* bar, volatile LAS unsigned* st) {
    XcdBarrier b; b.bar = bar; b.x = xb_xcc_id(); b.st = st;
    if (threadIdx.x == 0) (void)xb_add(&bar[XB_XCNT(b.x)], 1u);
    return b;
}
__device__ __forceinline__ void xcd_barrier_complete(unsigned* bar, unsigned x, unsigned& nloc, unsigned& nx) {
    const unsigned G = gridDim.x * gridDim.y * gridDim.z;
    unsigned sum, cnt, mine, sp = 0u;
    for (;;) {
        sum = 0u; cnt = 0u; mine = 0u;
#pragma unroll
        for (unsigned j = 0; j < 16; ++j) { const unsigned c = xb_ld(&bar[XB_XCNT(j)]); sum += c; cnt += (c > 0u) ? 1u : 0u; mine = (j == x) ? c : mine; }
        if (sum == G) break;
        __builtin_amdgcn_s_sleep(1);
        if ((++sp & 255u) == 0u) { if (xb_ld(&bar[XB_TMO])) break; if (sp > XB_SPIN_CAP) { atomicAdd(&bar[XB_TMO], 1u); break; } }
    }
    nloc = mine > 0u ? mine : 1u; nx = cnt > 0u ? cnt : 1u;
}

__device__ __forceinline__ void xcd_barrier(const XcdBarrier& b) {
    asm volatile("s_waitcnt vmcnt(0)" ::: "memory");
    __syncthreads();
    if (threadIdx.x == 0) {
        unsigned* bar = b.bar;
        __builtin_amdgcn_s_waitcnt(0);
        unsigned nloc = b.st[0], nx = b.st[1];
        if (nloc == 0u) { xcd_barrier_complete(bar, b.x, nloc, nx); b.st[0] = nloc; b.st[1] = nx; }
        const unsigned old = xb_add(&bar[XB_XSUB(b.x)], 1u);
        const unsigned gen = old / nloc;
        if (old + 1u == (gen + 1u) * nloc) {
            __builtin_amdgcn_fence(__ATOMIC_RELEASE, "agent");
            asm volatile("s_waitcnt vmcnt(0)" ::: "memory");
            const unsigned og = xb_add(&bar[XB_TOP], 1u);
            const unsigned tg = og / nx;
            if (og + 1u == (tg + 1u) * nx) xb_add(&bar[XB_TOPGEN], 1u);
            else XB_SPIN(xb_ld(&bar[XB_TOPGEN]) == tg, bar);
            __builtin_amdgcn_fence(__ATOMIC_ACQUIRE, "agent");
            xb_add(&bar[XB_XGEN(b.x)], 1u);
            asm volatile("s_waitcnt vmcnt(0)" ::: "memory");
        } else {
            XB_SPIN(xb_ld(&bar[XB_XGEN(b.x)]) == gen, bar);
            __builtin_amdgcn_fence(__ATOMIC_ACQUIRE, "agent");
            asm volatile("s_waitcnt vmcnt(0)" ::: "memory");
        }
    }
    __syncthreads();
}

__device__ __forceinline__ void transpose_item(const float* W, int K, int N, bf16* WT, int k0, int n0, int drow0, LAS float* scr, int lane) {
#pragma unroll 8
    for (int i = 0; i < 32; ++i) { const int kk = 2 * i + (lane >> 5); scr[kk * 33 + (lane & 31)] = W[(size_t)(k0 + kk) * N + n0 + (lane & 31)]; }
    LDS_WAIT(); asm volatile("" ::: "memory");
    const int c = lane & 7;
#pragma unroll
    for (int j = 0; j < 4; ++j) { const int n = (lane >> 3) + 8 * j; const LAS float* s = scr + (8 * c) * 33 + n;
        v4u o; o.x = pk2(s[0 * 33], s[1 * 33]); o.y = pk2(s[2 * 33], s[3 * 33]); o.z = pk2(s[4 * 33], s[5 * 33]); o.w = pk2(s[6 * 33], s[7 * 33]);
        *(GAS v4u*)(WT + (size_t)(drow0 + n) * K + k0 + 8 * c) = o; }
    LDS_WAIT(); asm volatile("" ::: "memory");
}
constexpr int IT_QKV = (DM / 64) * (QKVD / 32), IT_SQ = (DM / 64) * (DM / 32), IT_IN = (DM / 64) * (6144 / 32), IT_GU = (DM / 64) * (NGU / 32), IT_DN = (DFF / 64) * (DM / 32);
constexpr int IT_TOTAL = 3 * IT_QKV + 4 * IT_SQ + IT_IN + 4 * IT_GU + 4 * IT_DN;

struct Args { const float* in[33]; float* out; unsigned char* ws; int ph_lo, ph_hi; };
#define GIN(k) ((const float*)(const GAS float*)A.in[k])

__device__ __forceinline__ void weight_item(const Args& A, int it, LAS float* scr, int lane) {
    unsigned char* ws = A.ws;
    const float* src; bf16* dst; int K = DM, N; bool gu = false; int r = it;
    if (r < 3 * IT_QKV) { const int m = r / IT_QKV; r -= m * IT_QKV; N = QKVD;
        src = (m < 2) ? GIN(12) + (size_t)m * DM * QKVD : GIN(26); dst = (bf16*)(ws + WS_WQKV0 + (size_t)m * W_QKV); }
    else if ((r -= 3 * IT_QKV) < 4 * IT_SQ) { const int m = r / IT_SQ; r -= m * IT_SQ; N = DM;
        src = (m < 2) ? GIN(13) + (size_t)m * DM * DM : (m == 2 ? GIN(29) : GIN(25)); dst = (bf16*)(ws + WS_WO0 + (size_t)m * W_SQ); }
    else if ((r -= 4 * IT_SQ) < IT_IN) { N = 6144; src = GIN(15); dst = (bf16*)(ws + WS_WHI); }
    else if ((r -= IT_IN) < 4 * IT_GU) { const int m = r / IT_GU; r -= m * IT_GU; N = NGU; gu = true;
        src = GIN(30) + (size_t)m * DM * NGU; dst = (bf16*)(ws + WS_WGU + (size_t)m * W_GU); }
    else { r -= 4 * IT_GU; const int m = r / IT_DN; r -= m * IT_DN; N = DM; K = DFF;
        src = GIN(31) + (size_t)m * DFF * DM; dst = (bf16*)(ws + WS_WDN + (size_t)m * W_DN); }
    const int nblk = N / 32, kb = r / nblk, nb = r % nblk, k0 = 64 * kb, n0 = 32 * nb;
    int drow0 = n0;
    if (gu) { const int isu = n0 >= DFF ? 1 : 0; const int j = n0 - isu * DFF; drow0 = (j >> 7) * 256 + isu * 128 + (j & 127); }
    transpose_item(src, K, N, dst, k0, n0, drow0, scr, lane);
}

__device__ __forceinline__ void adaln_partial_unit(const Args& A, int u, LAS float* scr, int lane) {
    const int layer = u / 384, kc = (u / 48) % 8, cg = u % 48;
    const float* cctx = GIN(7); const float* cin = GIN(6);
    for (int idx = lane; idx < 9 * 256; idx += 64) { const int c = idx >> 8, kk = idx & 255, k = kc * 256 + kk;
        const float v = (c == 0) ? cctx[k] : cin[(size_t)(c - 1) * DM + k]; scr[idx] = v / (1.0f + expf(-v)); }
    LDS_WAIT(); asm volatile("" ::: "memory");
    f32x4 acc[9];
#pragma unroll
    for (int c = 0; c < 9; ++c) acc[c] = (f32x4){0.f, 0.f, 0.f, 0.f};
    const float* wp = GIN(10) + (size_t)layer * DM * 12288 + (size_t)(kc * 256) * 12288 + cg * 256 + lane * 4;
#pragma unroll 8
    for (int kk = 0; kk < 256; ++kk) { const f32x4 w = *(const GAS f32x4*)(wp + (size_t)kk * 12288);
#pragma unroll
        for (int c = 0; c < 9; ++c) acc[c] += scr[c * 256 + kk] * w; }
    float* mp = (float*)(A.ws + WS_MODP) + (size_t)((layer * 8 + kc) * 9) * 12288 + cg * 256 + lane * 4;
#pragma unroll
    for (int c = 0; c < 9; ++c) *(f32x4*)(mp + (size_t)c * 12288) = acc[c];
    LDS_WAIT(); asm volatile("" ::: "memory");
}

__device__ __forceinline__ void filter_a2_row(const Args& A, int rr, int lane) {
    const int L = rr < 2048 ? 2048 : 256, t = rr < 2048 ? rr : rr - 2048;
    const float tn = (float)t / (float)(L - 1), w = 6.283185307179586f * (float)t / (float)L;
    float feat = 0.f;
    if (lane == 0) feat = tn;
    else if (lane <= 16) feat = cosf(w * (1e-4f + (float)(lane - 1) * ((15.0f - 1e-4f) / 15.0f)));
    else if (lane <= 32) feat = -sinf(w * (1e-4f + (float)(lane - 17) * ((15.0f - 1e-4f) / 15.0f)));
    const float* w1 = GIN(18); const float* b1 = GIN(19); const float* w2 = GIN(20); const float* b2 = GIN(21); const float* fq = GIN(23);
    float s = b1[lane];
    for (int f = 0; f < 33; ++f) s += __shfl(feat, f) * w1[f * 64 + lane];
    const float a1 = sinf(fq[lane] * s);
    float s2 = b2[lane];
    for (int k = 0; k < 64; ++k) s2 += __shfl(a1, k) * w2[k * 64 + lane];
    ((float*)(A.ws + WS_A2))[(size_t)rr * 64 + lane] = sinf(fq[64 + lane] * s2);
}

__device__ __forceinline__ void filter_hf_unit(const Args& A, int u, LAS float* scr, int lane) {
    const int variant = u < 2048 ? 0 : 1; const int uu = variant ? u - 2048 : u; const int tch = uu >> 7, cgp = uu & 127;
    const int L = variant ? 256 : 2048; const int col = cgp * 64 + lane, side = col >> 12, order = (col >> 11) & 1, d = col & 2047;
    const float* w3 = GIN(22);
    float w3r[64];
#pragma unroll
    for (int k = 0; k < 64; ++k) w3r[k] = w3[(size_t)k * 8192 + col];
    constexpr float MIND = -3.0701134573253944f, MAXD = -15.350567286626972f;
    const float delta = fabsf(MIND + (MAXD - MIND) * ((float)d / 2047.0f));
    const float* a2 = (const float*)(A.ws + WS_A2) + (size_t)(variant ? 2048 : 0) * 64;
    bf16* ft = (bf16*)(A.ws + (variant ? WS_FT_CTX : WS_FT)) + ((size_t)(order * 2048 + d) * 2 + side) * L;
    const float rl1 = 1.0f / (float)(L - 1);
    float asum = 0.f;
#pragma unroll 1
    for (int half = 0; half < 2; ++half) {
        const int tb = tch * 128 + half * 64;
        { const GAS f32x4* src = (const GAS f32x4*)(a2 + (size_t)(tb + lane) * 64);
#pragma unroll
          for (int q = 0; q < 16; ++q) *(LAS f32x4*)(scr + lane * 64 + q * 4) = src[q]; }
        LDS_WAIT(); asm volatile("" ::: "memory");
#pragma unroll 1
        for (int tt = 0; tt < 64; tt += 2) {
            float s0 = 0.f, s1 = 0.f;
#pragma unroll
            for (int q = 0; q < 16; ++q) { const f32x4 x0 = *(const LAS f32x4*)(scr + tt * 64 + q * 4), x1 = *(const LAS f32x4*)(scr + (tt + 1) * 64 + q * 4);
                s0 += x0.x * w3r[4 * q] + x0.y * w3r[4 * q + 1] + x0.z * w3r[4 * q + 2] + x0.w * w3r[4 * q + 3];
                s1 += x1.x * w3r[4 * q] + x1.y * w3r[4 * q + 1] + x1.z * w3r[4 * q + 2] + x1.w * w3r[4 * q + 3]; }
            const int t = tb + tt;
            s0 *= expf(-((float)t * rl1) * delta); s1 *= expf(-((float)(t + 1) * rl1) * delta);
            if (!(side == 1 && t == 0)) asum += fabsf(s0);
            asum += fabsf(s1);
            *(GAS unsigned*)(ft + t) = pk2(s0, s1);
        }
        LDS_WAIT(); asm volatile("" ::: "memory");
    }
    ((float*)(A.ws + WS_NP))[(size_t)(variant ? 16 + tch : tch) * 8192 + col] = asum;
}

__device__ __forceinline__ void norm_row(const float* xrow, const f32x4 (&a)[8], const f32x4 (&b)[8], bf16* orow, int lane) {
    const GAS f32x4* xr = (const GAS f32x4*)xrow + lane;
    f32x4 v[8]; float s = 0.f;
#pragma unroll
    for (int j = 0; j < 8; ++j) { v[j] = xr[64 * j]; s += (v[j].x * v[j].x + v[j].y * v[j].y) + (v[j].z * v[j].z + v[j].w * v[j].w); }
    const float rstd = 1.0f / sqrtf(wave_sum(s) * (1.0f / DM) + 1e-6f);
    GAS v2u* o8 = (GAS v2u*)orow + lane;
#pragma unroll
    for (int j = 0; j < 8; ++j) { const f32x4 y = v[j] * rstd * a[j] + b[j]; v2u w; w.x = pk2(y.x, y.y); w.y = pk2(y.z, y.w); o8[64 * j] = w; }
}
__device__ __forceinline__ void final_norm_row(float* xrow, const float* g, int lane) {
    GAS f32x4* xr = (GAS f32x4*)xrow + lane;
    f32x4 v[8]; float s = 0.f;
#pragma unroll
    for (int j = 0; j < 8; ++j) { v[j] = xr[64 * j]; s += (v[j].x * v[j].x + v[j].y * v[j].y) + (v[j].z * v[j].z + v[j].w * v[j].w); }
    const float rstd = 1.0f / sqrtf(wave_sum(s) * (1.0f / DM) + 1e-6f);
#pragma unroll
    for (int j = 0; j < 8; ++j) { const f32x4 a = *((const GAS f32x4*)g + lane + 64 * j); xr[64 * j] = v[j] * rstd * a; }
}

__device__ __forceinline__ void qkpost_row(bf16* qkv_row, int row, bool is_ax, const float* qg, const float* kg, float* state_k, int lane) {
    const bool is_lat = row >= NCTX;
    const int hsub = lane >> 4, a = (lane >> 3) & 1, i0 = (lane & 7) * 4;
    float cs[4], sn[4];
    if (is_lat) { const int t = (row - NCTX) & 2047; const float pos = (float)(a == 0 ? (t >> 6) : (t & 63));
#pragma unroll
        for (int e = 0; e < 4; ++e) { const float inv = expf(-(float)(i0 + e) * (9.210340371976184f / 32.0f)); sn[e] = sinf(pos * inv); cs[e] = cosf(pos * inv); } }
#pragma unroll
    for (int grp = 0; grp < 5; ++grp) {
        const int head = 4 * grp + hsub;
        bf16* base = qkv_row + head * 128 + a * 64 + i0;
        const v2u r1 = *(const GAS v2u*)base, r2 = *(const GAS v2u*)(base + 32);
        float x1[4] = {bflo(r1.x), bfhi(r1.x), bflo(r1.y), bfhi(r1.y)}, x2[4] = {bflo(r2.x), bfhi(r2.x), bflo(r2.y), bfhi(r2.y)};
        if (is_ax) {
            float ss = 0.f;
#pragma unroll
            for (int e = 0; e < 4; ++e) ss += x1[e] * x1[e] + x2[e] * x2[e];
            ss += __shfl_xor(ss, 1); ss += __shfl_xor(ss, 2); ss += __shfl_xor(ss, 4); ss += __shfl_xor(ss, 8);
            const float rstd = 1.0f / sqrtf(ss * (1.0f / 128.0f) + 1e-6f);
            const float* G = (head < 16 ? qg : kg) + a * 64 + i0;
#pragma unroll
            for (int e = 0; e < 4; ++e) { x1[e] = x1[e] * rstd * G[e]; x2[e] = x2[e] * rstd * G[32 + e]; }
        }
        if (is_lat) {
#pragma unroll
            for (int e = 0; e < 4; ++e) { const float y1 = x1[e] * cs[e] - x2[e] * sn[e], y2 = x2[e] * cs[e] + x1[e] * sn[e]; x1[e] = y1; x2[e] = y2; }
        }
        if (is_ax || is_lat) { v2u w1, w2; w1.x = pk2(x1[0], x1[1]); w1.y = pk2(x1[2], x1[3]); w2.x = pk2(x2[0], x2[1]); w2.y = pk2(x2[2], x2[3]);
            *(GAS v2u*)base = w1; *(GAS v2u*)(base + 32) = w2; }
        if (is_ax && !is_lat && head >= 16) { float* sp = state_k + (size_t)row * 512 + (head - 16) * 128 + a * 64 + i0;
            *(GAS f32x4*)sp = (f32x4){x1[0], x1[1], x1[2], x1[3]}; *(GAS f32x4*)(sp + 32) = (f32x4){x2[0], x2[1], x2[2], x2[3]}; }
    }
}

namespace hy {
constexpr int CPY_STRIDE = 8480;
constexpr int U_OFF = 8 * CPY_STRIDE;
constexpr int U_BYTES = 6144;
static_assert(U_OFF + 8 * U_BYTES <= RING_BYTES, "hyena LDS map");

__device__ __forceinline__ void build_copies(LAS unsigned char* lds, const bf16* ft, int L, int tid) {
    if (tid < 264) { const int c = tid / 33, e = tid % 33; const int qq = (e < 17 - c) ? e : 2 * L + 16 - c + (e - (17 - c));
        *(LAS unsigned short*)(lds + c * CPY_STRIDE + qq * 2) = 0; }
    if (tid < 2 * L / 8) { const int side = tid / (L / 8), t8 = (tid % (L / 8)) * 8;
        const v4u raw = *(const GAS v4u*)(ft + (size_t)side * L + t8);
        const unsigned wds[4] = {raw.x, raw.y, raw.z, raw.w};
#pragma unroll
        for (int e = 0; e < 8; ++e) { const int t = t8 + e; const unsigned short val = (unsigned short)((e & 1) ? (wds[e >> 1] >> 16) : (wds[e >> 1] & 0xffffu));
            if (!(side == 1 && t == 0)) { const int p = side == 0 ? L - t : L + t;
#pragma unroll
                for (int c = 0; c < 8; ++c) *(LAS unsigned short*)(lds + c * CPY_STRIDE + (p + 16 - c) * 2) = val; } } }
}
__device__ __forceinline__ void fill_u(LAS unsigned char* ub, const bf16* urow, int L, float w0, float w1, float w2, float bb, int lane) {
    { const int e0 = lane < 32 ? lane * 8 : L + 256 + (lane - 32) * 8; *(LAS v4u*)(ub + e0 * 2) = (v4u){0u, 0u, 0u, 0u}; }
    for (int q = lane; q < L / 8; q += 64) { const int s0 = 8 * q;
        const v4u raw = *(const GAS v4u*)(urow + s0);
        const float prev = s0 > 0 ? bf2f(urow[s0 - 1]) : 0.f, next = s0 + 8 < L ? bf2f(urow[s0 + 8]) : 0.f;
        const float x[10] = {prev, bflo(raw.x), bfhi(raw.x), bflo(raw.y), bfhi(raw.y), bflo(raw.z), bfhi(raw.z), bflo(raw.w), bfhi(raw.w), next};
        float y[8];
#pragma unroll
        for (int j = 0; j < 8; ++j) y[j] = w0 * x[j] + w1 * x[j + 1] + w2 * x[j + 2] + bb;
        v4u o; o.x = pk2(y[0], y[1]); o.y = pk2(y[2], y[3]); o.z = pk2(y[4], y[5]); o.w = pk2(y[6], y[7]);
        *(LAS v4u*)(ub + (256 + s0) * 2) = o; }
}
template <int NT>
__device__ __forceinline__ void toeplitz(const LAS unsigned char* cpy, const LAS unsigned char* ub, f32x4 (&acc)[NT], int lane) {
    constexpr int L = 256 * NT;
    const int i = lane & 15, g = lane >> 4, c = (-i) & 7;
    const LAS unsigned char* ap = cpy + c * CPY_STRIDE + 2 * (L + 8 * g + 16 - i - c);
    const LAS unsigned char* bp = ub + 2 * (256 + 8 * g + 16 * i);
#pragma unroll 2
    for (int S = -256; S <= L - 32; S += 32) {
        const bf16x8 b = *(const LAS bf16x8*)(bp + 2 * S);
        bf16x8 a[NT];
#pragma unroll
        for (int k = 0; k < NT; ++k) a[k] = *(const LAS bf16x8*)(ap + 2 * S - 512 * k);
#pragma unroll
        for (int k = 0; k < NT; ++k) acc[k] = __builtin_amdgcn_mfma_f32_16x16x32_bf16(a[k], b, acc[k], 0, 0, 0);
    }
}
template <int NT>
__device__ __forceinline__ void gate(const f32x4 (&acc)[NT], LAS unsigned char* ub, const bf16* xg, float cw0, float cw1, float cw2, float cb, float invn, float skip, int lane, bool last, bf16* zt) {
    constexpr int L = 256 * NT;
    const int sg = lane & 15, g = lane >> 4;
#pragma unroll
    for (int k = 0; k < NT; ++k) { const int t0 = 256 * k + 16 * sg + 4 * g;
        const v2u ur = *(const LAS v2u*)(ub + (256 + t0) * 2);
        const v2u xr = *(const GAS v2u*)(xg + t0);
        const float prev = t0 > 0 ? bf2f(xg[t0 - 1]) : 0.f, next = t0 + 4 < L ? bf2f(xg[t0 + 4]) : 0.f;
        const float x[6] = {prev, bflo(xr.x), bfhi(xr.x), bflo(xr.y), bfhi(xr.y), next};
        const float uu[4] = {bflo(ur.x), bfhi(ur.x), bflo(ur.y), bfhi(ur.y)};
        float z[4];
#pragma unroll
        for (int r = 0; r < 4; ++r) { const float xc = cw0 * x[r] + cw1 * x[r + 1] + cw2 * x[r + 2] + cb; z[r] = xc * (acc[k][r] * invn + skip * uu[r]); }
        v2u o; o.x = pk2(z[0], z[1]); o.y = pk2(z[2], z[3]);
        if (last) *(GAS v2u*)(zt + t0) = o; else *(LAS v2u*)(ub + (256 + t0) * 2) = o; }
}

constexpr int USH_STR = 4416;
__device__ __forceinline__ int ush_base(int b) { return b * USH_STR + (b >> 2) * 16; }
static_assert(U_OFF + 8 * USH_STR + 64 <= RING_BYTES, "hyena LDS map (shared u)");

__device__ __forceinline__ void build_copies2(LAS unsigned char* lds, const bf16* ft, int L, int ztop, int tid) {
    const int nz = ztop - 2 * L + 1;
    for (int z = tid; z < 8 * nz; z += 512) { const int c = z / nz, e = z % nz; const int qq = (e < 17 - c) ? e : 2 * L + 16 - c + (e - (17 - c));
        *(LAS unsigned short*)(lds + c * CPY_STRIDE + qq * 2) = 0; }
    for (int idx = tid; idx < 2 * L; idx += 512) { const int side = idx >= L ? 1 : 0, t = idx - side * L;
        if (!(side == 1 && t == 0)) { const unsigned short val = *(const GAS unsigned short*)(ft + idx); const int p = side ? L + t : L - t;
#pragma unroll
            for (int c = 0; c < 8; ++c) *(LAS unsigned short*)(lds + c * CPY_STRIDE + (p + 16 - c) * 2) = val; } }
}
__device__ __forceinline__ void fill_coop(LAS unsigned char* ush, const bf16* urow_ch, float w0, float w1, float w2, float bb, int tid) {
    for (int z = tid; z < 160; z += 512) { const int b = z / 20, e = z % 20; const int el = e < 4 ? e * 8 : 2080 + (e - 4) * 8;
        *(LAS v4u*)(ush + ush_base(b) + el * 2) = (v4u){0u, 0u, 0u, 0u}; }
#pragma unroll 1
    for (int ch = tid; ch < 2048; ch += 512) { const int b = ch >> 8, s0 = (ch & 255) * 8; const bf16* urow = urow_ch + b * 2048;
        const v4u raw = *(const GAS v4u*)(urow + s0);
        const float prev = s0 > 0 ? bf2f(*(const GAS bf16*)(urow + s0 - 1)) : 0.f, next = s0 + 8 < 2048 ? bf2f(*(const GAS bf16*)(urow + s0 + 8)) : 0.f;
        const float x[10] = {prev, bflo(raw.x), bfhi(raw.x), bflo(raw.y), bfhi(raw.y), bflo(raw.z), bfhi(raw.z), bflo(raw.w), bfhi(raw.w), next};
        float y[8];
#pragma unroll
        for (int j = 0; j < 8; ++j) y[j] = w0 * x[j] + w1 * x[j + 1] + w2 * x[j + 2] + bb;
        v4u o; o.x = pk2(y[0], y[1]); o.y = pk2(y[2], y[3]); o.z = pk2(y[4], y[5]); o.w = pk2(y[6], y[7]);
        *(LAS v4u*)(ush + ush_base(b) + 2 * (32 + s0)) = o; }
}
__device__ __forceinline__ void toeplitz_coop(const LAS unsigned char* cpy, const LAS unsigned char* ush, f32x4 (&acc)[8], int wave, int lane) {
    constexpr int L = 2048;
    const int i = lane & 15, g = lane >> 4, c = (-i) & 7, bb = i & 7, sg = i >> 3;
    const LAS unsigned char* aq = cpy + c * CPY_STRIDE + 2 * (L + 8 * g + 16 - i - c) - 64 * (8 * wave - 2);
    const LAS unsigned char* bq = ush + ush_base(bb) + 2 * (32 + 8 * g + 16 * sg) - 64;
#pragma unroll 1
    for (int q = 0; q < 17; ++q) {
        bf16x8 A[11], Bf[4];
#pragma unroll
        for (int m = 0; m < 11; ++m) A[m] = *(const LAS bf16x8*)(aq - 64 * m);
#pragma unroll
        for (int b4 = 0; b4 < 4; ++b4) Bf[b4] = *(const LAS bf16x8*)(bq + 64 * b4);
#pragma unroll
        for (int b4 = 0; b4 < 4; ++b4)
#pragma unroll
            for (int a = 0; a < 8; ++a) acc[a] = __builtin_amdgcn_mfma_f32_16x16x32_bf16(A[a - b4 + 3], Bf[b4], acc[a], 0, 0, 0);
        aq += 256; bq += 256;
    }
}
__device__ __forceinline__ void gate_coop(const f32x4 (&acc)[8], LAS unsigned char* ush, const bf16* xg_ch, float cw0, float cw1, float cw2, float cb, float invn, float skip, int wave, int lane, bool last, bf16* zt_ch) {
    const int i = lane & 15, g = lane >> 4, bb = i & 7, sg = i >> 3;
    const bf16* xg = xg_ch + bb * 2048; bf16* zt = zt_ch + bb * 2048; LAS unsigned char* ub = ush + ush_base(bb);
#pragma unroll
    for (int a = 0; a < 8; ++a) { const int t0 = 32 * (8 * wave + a) + 16 * sg + 4 * g;
        const v2u ur = *(const LAS v2u*)(ub + (32 + t0) * 2);
        const v2u xr = *(const GAS v2u*)(xg + t0);
        const float prev = t0 > 0 ? bf2f(*(const GAS bf16*)(xg + t0 - 1)) : 0.f, next = t0 + 4 < 2048 ? bf2f(*(const GAS bf16*)(xg + t0 + 4)) : 0.f;
        const float x[6] = {prev, bflo(xr.x), bfhi(xr.x), bflo(xr.y), bfhi(xr.y), next};
        const float uu[4] = {bflo(ur.x), bfhi(ur.x), bflo(ur.y), bfhi(ur.y)};
        float z[4];
#pragma unroll
        for (int r = 0; r < 4; ++r) { const float xc = cw0 * x[r] + cw1 * x[r + 1] + cw2 * x[r + 2] + cb; z[r] = xc * (acc[a][r] * invn + skip * uu[r]); }
        v2u o; o.x = pk2(z[0], z[1]); o.y = pk2(z[2], z[3]);
        if (last) *(GAS v2u*)(zt + t0) = o; else *(LAS v2u*)(ub + (32 + t0) * 2) = o; }
}
}

constexpr int NPHASE = 35;
#ifndef PHMASK
#define PHMASK 0xFFFF
#endif
#define PHON(b) ((PHMASK >> (b)) & 1)
#ifndef REPMASK
#define REPMASK 0
#endif
#ifndef REPN
#define REPN 2
#endif
#define RUN(b, call) do { _Pragma("unroll 1") for (int r_ = 0; r_ < (((REPMASK >> (b)) & 1) ? REPN : 1); ++r_) { call; } } while (0)
#ifndef MK_PER_PHASE
#define MK_PER_PHASE 0
#endif


template <class T> __device__ __forceinline__ T* launder(T* p) { GAS T* q = (GAS T*)p; asm volatile("" : "+s"(q)); return (T*)q; }
#define ENV_IDS int tid_ = threadIdx.x; asm volatile("" : "+v"(tid_)); const int tid = tid_, lane = tid & 63, wave = __builtin_amdgcn_readfirstlane(tid >> 6); const int G = gridDim.x, bx = blockIdx.x; \
    const int vcu = (G % 8 == 0) ? (bx % 8) * (G / 8) + bx / 8 : bx; const int gw = vcu * NWAVES + wave, NGW = G * NWAVES; (void)tid; (void)lane; (void)gw; (void)NGW; (void)bx;
#define ENV_PTRS unsigned char* ws = launder(A.ws); float* out = launder(A.out); (void)out; (void)ws;

__device__ __forceinline__ void ph_prologue_a(const Args& A, LAS unsigned char* L) {
    ENV_IDS ENV_PTRS
    LAS float* wscr = (LAS float*)(L + wave * 16384);
    for (int it = gw; it < IT_TOTAL; it += NGW) weight_item(A, it, wscr, lane);
    { const size_t NCH = (size_t)2 * 524288 + 2 * 262144;
      for (size_t ch = (size_t)gw * 64 + lane; ch < NCH; ch += (size_t)NGW * 64) {
          int ten; size_t off; unsigned char* dstb;
          if (ch < 524288) { ten = 0; off = ch * 8; dstb = ws + WS_CWK; } else if (ch < 1048576) { ten = 1; off = (ch - 524288) * 8; dstb = ws + WS_CWV; }
          else if (ch < 1310720) { ten = 2; off = (ch - 1048576) * 8; dstb = ws + WS_CAK; } else { ten = 3; off = (ch - 1310720) * 8; dstb = ws + WS_CAV; }
          const float* src = GIN(2 + ten) + off; const f32x4 a = *(const GAS f32x4*)src, b = *(const GAS f32x4*)(src + 4);
          v4u o; o.x = pk2(a.x, a.y); o.y = pk2(a.z, a.w); o.z = pk2(b.x, b.y); o.w = pk2(b.z, b.w);
          *(GAS v4u*)((bf16*)dstb + off) = o; } }
    for (int u = gw; u < 1536; u += NGW) adaln_partial_unit(A, __builtin_amdgcn_readfirstlane(u), wscr, lane);
    for (int rr = gw; rr < 2304; rr += NGW) filter_a2_row(A, __builtin_amdgcn_readfirstlane(rr), lane);
}
__device__ __forceinline__ void ph_prologue_b(const Args& A, LAS unsigned char* L) {
    ENV_IDS ENV_PTRS
    LAS float* wscr = (LAS float*)(L + wave * 16384);
    float* MODF = (float*)(ws + WS_MODF);
    for (int e = gw * 64 + lane; e < DEPTH * 9 * DM; e += NGW * 64) { const int layer = e / (9 * DM), c = (e / DM) % 9, col = e % DM;
        float m[6];
#pragma unroll
        for (int q = 0; q < 6; ++q) { float s = GIN(11)[(size_t)layer * 12288 + q * DM + col];
#pragma unroll
            for (int kc = 0; kc < 8; ++kc) s += ((const float*)(ws + WS_MODP))[(size_t)((layer * 8 + kc) * 9 + c) * 12288 + q * DM + col];
            m[q] = s; }
        float* mf = MODF + (size_t)((layer * 9 + c) * 6) * DM + col;
        mf[0 * DM] = GIN(8)[layer * DM + col] * (1.0f + m[1]); mf[1 * DM] = m[0]; mf[2 * DM] = m[2];
        mf[3 * DM] = GIN(9)[layer * DM + col] * (1.0f + m[4]); mf[4 * DM] = m[3]; mf[5 * DM] = m[5]; }
    for (int u = gw; u < 2304; u += NGW) filter_hf_unit(A, __builtin_amdgcn_readfirstlane(u), wscr, lane);
}
__device__ __forceinline__ void ph_norm(const Args& A, int layer, int which) {
    ENV_IDS ENV_PTRS
    const float* modf = (const float*)(ws + WS_MODF) + (size_t)layer * 9 * 6 * DM; bf16* HB = (bf16*)(ws + WS_H);
    const float* xc = (layer == 0 && which == 0) ? GIN(0) : out; const float* xl = (layer == 0 && which == 0) ? GIN(1) : out + (size_t)NCTX * DM;
    const int per = (NTOK + NGW - 1) / NGW, r0 = gw * per, r1 = (r0 + per < NTOK) ? r0 + per : NTOK;
    int cur = -1; f32x4 ma[8], mb[8];
#pragma unroll 1
    for (int row = r0; row < r1; ++row) { const int cv = row < NCTX ? 0 : 1 + ((row - NCTX) >> 11);
        if (cv != cur) { cur = cv; const GAS f32x4* pa = (const GAS f32x4*)(modf + (size_t)(cv * 6 + 3 * which) * DM) + lane; const GAS f32x4* pb = (const GAS f32x4*)(modf + (size_t)(cv * 6 + 3 * which + 1) * DM) + lane;
#pragma unroll
            for (int j = 0; j < 8; ++j) { ma[j] = pa[64 * j]; mb[j] = pb[64 * j]; } }
        const float* xr = row < NCTX ? xc + (size_t)row * DM : xl + (size_t)(row - NCTX) * DM;
        norm_row(xr, ma, mb, HB + (size_t)row * DM, lane); }
}
__device__ __forceinline__ void ph_qkv(const Args& A, int layer, LAS unsigned char* L) {
    ENV_PTRS
    const int G = gridDim.x, bx = blockIdx.x; const bool is_ax = (layer % 3) == 2; const int jx = layer / 3;
    const bf16* W = (const bf16*)(ws + (is_ax ? WS_WQKVA : (jx == 0 ? WS_WQKV0 : WS_WQKV1)));
    pg8::Gemm g{(const bf16*)(ws + WS_H), W, NTOK, QKVD, DM}; pg8::StaticOrder S; S.init(NTOK, QKVD, G, bx);
    pg8::EpiQKV E{(bf16*)(ws + WS_BIG), is_ax ? nullptr : out + OUT_WK + (size_t)jx * 256 * 512, is_ax ? out + OUT_AV : out + OUT_WV + (size_t)jx * 256 * 512, is_ax ? 0 : 256};
    pg8::gemm_phase<pg8::EpiQKV, pg8::StaticOrder, true, true>(L, g, S, E);
}
__device__ __forceinline__ void ph_qkpost(const Args& A, int layer) {
    ENV_IDS ENV_PTRS
    const bool is_ax = (layer % 3) == 2; bf16* QKVB = (bf16*)(ws + WS_BIG);
    for (int row = (is_ax ? 0 : NCTX) + gw; row < NTOK; row += NGW)
        qkpost_row(QKVB + (size_t)row * QKVD, row, is_ax, GIN(27), GIN(28), out + OUT_AK, lane);
}
__device__ __forceinline__ void ph_attn(const Args& A, int layer, LAS char* lds) {
    ENV_PTRS
    const int G = gridDim.x, bx = blockIdx.x; const bool is_ax = (layer % 3) == 2; const int jx = layer / 3;
    const att::bf16* QK = (const att::bf16*)(ws + WS_BIG); att::bf16* OB = (att::bf16*)(ws + WS_H);
    const att::bf16* CK = (const att::bf16*)(ws + (is_ax ? WS_CAK : WS_CWK));
    const att::bf16* CV = (const att::bf16*)(ws + (is_ax ? WS_CAV : WS_CWV));
    const int ncl = is_ax ? 1 : 2;
#pragma unroll 1
    for (int u = bx; u < 1536; u += G) {
        att::Unit U;
        if (u < 1024) { const int b = u >> 7, qb = (u >> 4) & 7, h = u & 15, kvh = h >> 2;
            const size_t r0 = (size_t)NCTX + (size_t)b * 2048 + (size_t)qb * 256;
            U.Q = QK + r0 * QKVD + h * 128; U.ldq = QKVD;
            const size_t coff = ((size_t)(b * ncl + (is_ax ? 0 : jx)) * 512) * 512 + kvh * 128;
            U.KA = CK + coff; U.VA = CV + coff; U.ldA = 512; U.nA = 8;
            const int klo = is_ax ? 0 : (qb * 256 - 128 < 0 ? 0 : qb * 256 - 128), khi = is_ax ? 2048 : (qb * 256 + 384 > 2048 ? 2048 : qb * 256 + 384);
            const size_t kr0 = (size_t)NCTX + (size_t)b * 2048 + klo;
            U.KB = QK + kr0 * QKVD + 2048 + kvh * 128; U.VB = QK + kr0 * QKVD + 2560 + kvh * 128; U.ldB = QKVD;
            U.NT = 8 + (khi - klo) / 64; U.win = is_ax ? 0 : 1; U.dq0 = qb * 256 - klo;
            U.O = OB + r0 * DM + h * 128; U.ldo = DM;
            U.has_sink = is_ax ? 0 : 1; U.sink = is_ax ? 0.f : GIN(14)[jx * 16 + h];
        } else { const int uc = u - 1024, b = uc >> 4, h = uc & 15, kvh = h >> 2; const size_t r0 = (size_t)b * 256;
            U.Q = QK + r0 * QKVD + h * 128; U.ldq = QKVD;
            U.KA = QK + r0 * QKVD + 2048 + kvh * 128; U.VA = QK + r0 * QKVD + 2560 + kvh * 128; U.ldA = QKVD; U.nA = 4;
            U.KB = U.KA; U.VB = U.VA; U.ldB = QKVD; U.NT = 4; U.win = 0; U.dq0 = 0;
            U.O = OB + r0 * DM + h * 128; U.ldo = DM;
            U.has_sink = is_ax ? 0 : 1; U.sink = is_ax ? 0.f : GIN(14)[jx * 16 + h];
        }
        att::attn_unit(U, lds);
    }
}
__device__ __forceinline__ void ph_hyin(const Args& A, LAS unsigned char* L) {
    ENV_PTRS
    const int G = gridDim.x, bx = blockIdx.x;
    pg8::Gemm g{(const bf16*)(ws + WS_WHI), (const bf16*)(ws + WS_H), 6144, NTOK, DM}; pg8::StaticOrder S; S.init(6144, NTOK, G, bx);
    pg8::EpiBf16 E{(bf16*)(ws + WS_BIG), NTOK};
    pg8::gemm_phase<pg8::EpiBf16, pg8::StaticOrder, true, true>(L, g, S, E);
}
__device__ __forceinline__ void ph_hyconv(const Args& A, LAS unsigned char* L) {
    ENV_IDS ENV_PTRS
    const bf16* UT = (const bf16*)(ws + WS_BIG); bf16* ZT = (bf16*)(ws + WS_ZT);
    const float* cw = GIN(16); const float* cbv = GIN(17); const float* skp = GIN(24); const float* NP = (const float*)(ws + WS_NP);
    LAS unsigned char* ub = L + hy::U_OFF + wave * hy::U_BYTES;
#pragma unroll 1
    for (int d = bx; d < DM; d += G) {
        float w0[3], w1[3], w2[3], cb[3];
#pragma unroll
        for (int p = 0; p < 3; ++p) { const int ch = p * DM + d; w0[p] = cw[ch]; w1[p] = cw[6144 + ch]; w2[p] = cw[2 * 6144 + ch]; cb[p] = cbv[ch]; }
        float invn[2][2];
#pragma unroll
        for (int o = 0; o < 2; ++o) { float sl = 0.f, sc = 0.f;
            for (int ch = 0; ch < 16; ++ch) sl += NP[(size_t)ch * 8192 + o * 2048 + d] + NP[(size_t)ch * 8192 + 4096 + o * 2048 + d];
            for (int ch = 16; ch < 18; ++ch) sc += NP[(size_t)ch * 8192 + o * 2048 + d] + NP[(size_t)ch * 8192 + 4096 + o * 2048 + d];
            invn[0][o] = 1.0f / (sl + 1e-6f); invn[1][o] = 1.0f / (sc + 1e-6f); }
        const float sk0 = skp[d], sk1 = skp[DM + d];
        const bf16* ftl = (const bf16*)(ws + WS_FT) + (size_t)d * 2 * 2048; const bf16* ftc = (const bf16*)(ws + WS_FT_CTX) + (size_t)d * 2 * 256;
        { LAS unsigned char* ush = L + hy::U_OFF;
          hy::fill_coop(ush, UT + (size_t)d * NTOK + NCTX, w0[0], w1[0], w2[0], cb[0], tid);
          hy::build_copies2(L, ftl, 2048, 2 * 2048 + 136, tid); __syncthreads();
          f32x4 acc[8];
#pragma unroll
          for (int k = 0; k < 8; ++k) acc[k] = (f32x4){0.f, 0.f, 0.f, 0.f};
          hy::toeplitz_coop(L, ush, acc, wave, lane); __syncthreads();
          hy::gate_coop(acc, ush, UT + (size_t)(DM + d) * NTOK + NCTX, w0[1], w1[1], w2[1], cb[1], invn[0][0], sk0, wave, lane, false, nullptr);
          hy::build_copies2(L, ftl + (size_t)2048 * 2 * 2048, 2048, 2 * 2048 + 136, tid); __syncthreads();
#pragma unroll
          for (int k = 0; k < 8; ++k) acc[k] = (f32x4){0.f, 0.f, 0.f, 0.f};
          hy::toeplitz_coop(L, ush, acc, wave, lane);
          hy::gate_coop(acc, ush, UT + (size_t)(2 * DM + d) * NTOK + NCTX, w0[2], w1[2], w2[2], cb[2], invn[0][1], sk1, wave, lane, true, ZT + (size_t)d * NTOK + NCTX);
          __syncthreads(); }
        { for (int q = 0; q < 4; ++q) hy::fill_u(ub + q * 1536, UT + (size_t)d * NTOK + (size_t)(wave * 4 + q) * 256, 256, w0[0], w1[0], w2[0], cb[0], lane);
          __syncthreads(); hy::build_copies2(L, ftc, 256, 2 * 256 + 32, tid); __syncthreads();
#pragma unroll 1
          for (int q = 0; q < 4; ++q) { const size_t sb = (size_t)(wave * 4 + q) * 256; f32x4 acc[1]; acc[0] = (f32x4){0.f, 0.f, 0.f, 0.f};
              hy::toeplitz<1>(L, ub + q * 1536, acc, lane);
              hy::gate<1>(acc, ub + q * 1536, UT + (size_t)(DM + d) * NTOK + sb, w0[1], w1[1], w2[1], cb[1], invn[1][0], sk0, lane, false, nullptr); }
          __syncthreads(); hy::build_copies2(L, ftc + (size_t)2048 * 2 * 256, 256, 2 * 256 + 32, tid); __syncthreads();
#pragma unroll 1
          for (int q = 0; q < 4; ++q) { const size_t sb = (size_t)(wave * 4 + q) * 256; f32x4 acc[1]; acc[0] = (f32x4){0.f, 0.f, 0.f, 0.f};
              hy::toeplitz<1>(L, ub + q * 1536, acc, lane);
              hy::gate<1>(acc, ub + q * 1536, UT + (size_t)(2 * DM + d) * NTOK + sb, w0[2], w1[2], w2[2], cb[2], invn[1][1], sk1, lane, true, ZT + (size_t)d * NTOK + sb); } }
        __syncthreads();
    }
}
__device__ __forceinline__ void ph_hytr(const Args& A, LAS unsigned char* L) {
    ENV_IDS ENV_PTRS
    const bf16* ZT = (const bf16*)(ws + WS_ZT); bf16* HB = (bf16*)(ws + WS_H);
    LAS unsigned char* scr = L + wave * 16384;
    for (int tile = gw; tile < 32 * 384; tile += NGW) { const int d0 = (tile & 31) * 64, r0 = (tile >> 5) * 64;
#pragma unroll
        for (int j = 0; j < 8; ++j) { const int idx = j * 64 + lane, dl = idx >> 3, ch = idx & 7;
            *(LAS v4u*)(scr + dl * 144 + ch * 16) = *(const GAS v4u*)(ZT + (size_t)(d0 + dl) * NTOK + r0 + ch * 8); }
        LDS_WAIT(); asm volatile("" ::: "memory");
#pragma unroll
        for (int j = 0; j < 8; ++j) { unsigned e[8];
#pragma unroll
            for (int q = 0; q < 8; ++q) e[q] = *(const LAS unsigned short*)(scr + (j * 8 + q) * 144 + lane * 2);
            v4u o; o.x = e[0] | (e[1] << 16); o.y = e[2] | (e[3] << 16); o.z = e[4] | (e[5] << 16); o.w = e[6] | (e[7] << 16);
            *(GAS v4u*)(HB + (size_t)(r0 + lane) * DM + d0 + j * 8) = o; }
        LDS_WAIT(); asm volatile("" ::: "memory"); }
}
__device__ __forceinline__ void ph_mixout(const Args& A, int layer, LAS unsigned char* L) {
    ENV_PTRS
    const int G = gridDim.x, bx = blockIdx.x; const int kind = layer % 3, jx = layer / 3;
    const float* modf = (const float*)(ws + WS_MODF) + (size_t)layer * 9 * 6 * DM;
    const float* xc = layer == 0 ? GIN(0) : out; const float* xl = layer == 0 ? GIN(1) : out + (size_t)NCTX * DM;
    const bf16* W = (const bf16*)(ws + (kind == 1 ? WS_WHO : (kind == 2 ? WS_WOA : (jx == 0 ? WS_WO0 : WS_WO1))));
    pg8::Gemm g{(const bf16*)(ws + WS_H), W, NTOK, DM, DM}; pg8::StaticOrder S; S.init(NTOK, DM, G, bx);
    pg8::EpiResid E{xc, xl, out, modf + 2 * DM};
    pg8::gemm_phase<pg8::EpiResid, pg8::StaticOrder, true, true>(L, g, S, E);
}
__device__ __forceinline__ void ph_gu(const Args& A, int layer, LAS unsigned char* L) {
    ENV_PTRS
    const int G = gridDim.x, bx = blockIdx.x;
    pg8::Gemm g{(const bf16*)(ws + WS_H), (const bf16*)(ws + WS_WGU + (size_t)layer * W_GU), NTOK, NGU, DM}; pg8::StaticOrder S; S.init(NTOK, NGU, G, bx);
    pg8::EpiSwiglu E{(bf16*)(ws + WS_BIG)};
    pg8::gemm_phase<pg8::EpiSwiglu, pg8::StaticOrder, true, true>(L, g, S, E);
}
__device__ __forceinline__ void ph_down(const Args& A, int layer, LAS unsigned char* L) {
    ENV_PTRS
    const int G = gridDim.x, bx = blockIdx.x;
    const float* modf = (const float*)(ws + WS_MODF) + (size_t)layer * 9 * 6 * DM;
    pg8::Gemm g{(const bf16*)(ws + WS_BIG), (const bf16*)(ws + WS_WDN + (size_t)layer * W_DN), NTOK, DM, DFF}; pg8::StaticOrder S; S.init(NTOK, DM, G, bx);
    pg8::EpiResid E{out, out + (size_t)NCTX * DM, out, modf + 5 * DM};
    pg8::gemm_phase<pg8::EpiResid, pg8::StaticOrder, true, true>(L, g, S, E);
}
__device__ __forceinline__ void ph_final(const Args& A) {
    ENV_IDS ENV_PTRS
    for (int row = gw; row < NTOK; row += NGW) final_norm_row(out + (size_t)row * DM, GIN(32), lane);
}

__global__ void __launch_bounds__(NWAVES * 64, 2) hybrid_fwd(Args A) {
    extern __shared__ __attribute__((aligned(16))) unsigned char lds[];
    LAS unsigned char* L = (LAS unsigned char*)lds;
    for (int u = threadIdx.x; u < (LDS_BYTES - LDSCTL_OFF) / 4; u += NWAVES * 64) ((LAS unsigned*)(L + LDSCTL_OFF))[u] = 0u;
    __syncthreads();
    XcdBarrier bar; bar.bar = (unsigned*)(A.ws + WS_CTL) + CW_BAR; bar.x = 0; bar.st = nullptr;
    if (!MK_PER_PHASE) bar = xcd_barrier_post((unsigned*)(A.ws + WS_CTL) + CW_BAR, (volatile LAS unsigned*)(L + MISC_OFF) + 8);
    const int lo = A.ph_lo, hi = A.ph_hi;
#define IN(k) (lo <= (k) && (k) < hi)
#define SEAM(k) do { if (IN(k) && IN((k) + 1)) xcd_barrier(bar); } while (0)
    if (PHON(0) && IN(0)) RUN(0, ph_prologue_a(A, L));
    SEAM(0);
    if (PHON(1) && IN(1)) RUN(1, ph_prologue_b(A, L));
    SEAM(1);
#pragma unroll 1
    for (int layer = 0; layer < DEPTH; ++layer) {
        const int pb = 2 + 8 * layer;
        if (PHON(2) && IN(pb + 0)) RUN(2, ph_norm(A, layer, 0));
        SEAM(pb + 0);
        if ((layer % 3) != 1) {
            if (PHON(3) && IN(pb + 1)) RUN(3, ph_qkv(A, layer, L));
            SEAM(pb + 1);
            if (PHON(4) && IN(pb + 2)) RUN(4, ph_qkpost(A, layer));
            SEAM(pb + 2);
            if (PHON(5) && IN(pb + 3)) RUN(5, ph_attn(A, layer, (LAS char*)L));
            SEAM(pb + 3);
        } else {
            if (PHON(6) && IN(pb + 1)) RUN(6, ph_hyin(A, L));
            SEAM(pb + 1);
            if (PHON(7) && IN(pb + 2)) RUN(7, ph_hyconv(A, L));
            SEAM(pb + 2);
            if (PHON(8) && IN(pb + 3)) RUN(8, ph_hytr(A, L));
            SEAM(pb + 3);
        }
        if (PHON(9) && IN(pb + 4)) RUN(9, ph_mixout(A, layer, L));
        SEAM(pb + 4);
        if (PHON(10) && IN(pb + 5)) RUN(10, ph_norm(A, layer, 1));
        SEAM(pb + 5);
        if (PHON(11) && IN(pb + 6)) RUN(11, ph_gu(A, layer, L));
        SEAM(pb + 6);
        if (PHON(12) && IN(pb + 7)) RUN(12, ph_down(A, layer, L));
        SEAM(pb + 7);
    }
    if (PHON(13) && IN(34)) RUN(13, ph_final(A));
#undef IN
#undef SEAM
}

extern "C" void kernel_launch(void* const* d_in, const int* in_sizes, int n_in, void* d_out, int out_size, void* d_ws, size_t ws_size, hipStream_t stream) {
    static int grid = 0;
    if (grid == 0) {
        if (n_in != 33 || (size_t)out_size != OUT_END || ws_size < WS_END) { fprintf(stderr, "kernel_launch: unexpected shapes: n_in %d out %d ws %zu (need %zu)\n", n_in, out_size, ws_size, (size_t)WS_END); grid = -1; return; }
        int dev = 0, cus = 0, per_cu = 0;
        if (hipGetDevice(&dev) != hipSuccess || hipDeviceGetAttribute(&cus, hipDeviceAttributeMultiprocessorCount, dev) != hipSuccess) { grid = -1; return; }
        if (hipFuncSetAttribute((const void*)hybrid_fwd, hipFuncAttributeMaxDynamicSharedMemorySize, LDS_BYTES) != hipSuccess) { fprintf(stderr, "kernel_launch: hipFuncSetAttribute failed\n"); grid = -1; return; }
        if (hipOccupancyMaxActiveBlocksPerMultiprocessor(&per_cu, (const void*)hybrid_fwd, NWAVES * 64, LDS_BYTES) != hipSuccess || per_cu < 1)
            fprintf(stderr, "kernel_launch: occupancy query reports %d workgroups per CU\n", per_cu);
        (void)hipGetLastError();
        grid = cus;
    }
    if (grid < 0) return;
    if (hipMemsetAsync((char*)d_ws + WS_CTL, 0, CTL_ZERO_BYTES, stream) != hipSuccess) { fprintf(stderr, "kernel_launch: memset failed\n"); return; }
    Args a{};
    for (int i = 0; i < 33; ++i) a.in[i] = (const float*)d_in[i];
    a.out = (float*)d_out; a.ws = (unsigned char*)d_ws;
#if MK_PER_PHASE
    for (int ph = 0; ph < NPHASE; ++ph) { a.ph_lo = ph; a.ph_hi = ph + 1; hipLaunchKernelGGL(hybrid_fwd, dim3(grid), dim3(NWAVES * 64), LDS_BYTES, stream, a); }
#else
    a.ph_lo = 0; a.ph_hi = NPHASE; hipLaunchKernelGGL(hybrid_fwd, dim3(grid), dim3(NWAVES * 64), LDS_BYTES, stream, a);
#endif
    const hipError_t le = hipPeekAtLastError();
    if (le != hipSuccess) fprintf(stderr, "kernel_launch: launch failed: %s\n", hipGetErrorName(le));
}
```

```cpp
#include <hip/hip_runtime.h>
#include <cstdio>
#include <cstdint>
#include <hip/hip_bf16.h>
#include <cmath>
namespace pg8 {
#define PG8_LAS __attribute__((address_space(3)))
typedef unsigned short bf16_t;
typedef short bf16x8 __attribute__((ext_vector_type(8)));
typedef float f32x4 __attribute__((ext_vector_type(4)));
typedef unsigned u32x4 __attribute__((ext_vector_type(4)));
constexpr int BM = 256, BK = 64, HALF = 128, HTB = HALF * BK * 2  , STAGE_BYTES = 8 * HTB, NXCD = 8, WGM = 8;

__host__ __device__ __forceinline__ int lds_byte(int r, int c) { const int st = (r >> 4) * 2 + (c >> 5), rr = r & 15, cc = c & 31, ob = rr * 64 + cc * 2; return st * 1024 + (ob ^ (((ob >> 9) & 1) << 5)); }
__host__ __device__ __forceinline__ void stage_rc(int b, int& R, int& C) { const int st = b / 1024, sb = b % 1024, swz = sb ^ (((sb >> 9) & 1) << 5); R = (st >> 1) * 16 + swz / 64; C = (st & 1) * 32 + (swz % 64) / 2; }
__host__ __device__ __forceinline__ int perm32(int rho) { const int n = rho >> 4, i = rho & 15; return 8 * (i >> 2) + 4 * n + (i & 3); }

struct Unit { int pm, pn; };
struct Gemm { const bf16_t* A; const bf16_t* Bt; int M, N, K; };

struct StaticOrder {
    int nM, nN, nwg, G, c;
    __host__ __device__ void init(int M, int N, int G_, int c_) { nM = M / BM; nN = N / BM; nwg = nM * nN; G = G_; c = c_; }
    __host__ __device__ bool next(int i, Unit& u) const {
        const long L = (long)i * G + c; if (L >= nwg) return false;
        int wgid = (int)L; { const int q = nwg / NXCD, r = nwg % NXCD, xcd = wgid % NXCD, off = wgid / NXCD; wgid = (xcd < r ? xcd * (q + 1) : r * (q + 1) + (xcd - r) * q) + off; }
        const int nig = WGM * nN, gid = wgid / nig, fm = gid * WGM, gsz = (nM - fm) < WGM ? (nM - fm) : WGM;
        u.pm = fm + ((wgid % nig) % gsz); u.pn = (wgid % nig) / gsz; return true;
    }
    __device__ __forceinline__ void a_ready(const Unit&) const {}
    __device__ __forceinline__ void done(const Unit&) const {}
};

__device__ __forceinline__ unsigned cvt_pk_bf16(float lo, float hi) { unsigned r; asm volatile("v_cvt_pk_bf16_f32 %0, %1, %2" : "=v"(r) : "v"(lo), "v"(hi)); return r; }
typedef float f32x2 __attribute__((ext_vector_type(2)));
struct EpiBf16 {
    static constexpr bool PERM = true, AFTER_DRAIN = false;
    bf16_t* O; int ldc;
    __device__ __forceinline__ void operator()(const f32x4 (&acc)[2][2][4][2], const Unit& u, int wr, int wc, int fr, int fq) const {
        const int row0 = u.pm * BM + wr * 64 + fr; const int col0 = u.pn * BM + wc * 32 + 8 * fq;
#pragma unroll
        for (int ai = 0; ai < 2; ++ai)
#pragma unroll
            for (int m = 0; m < 4; ++m) { bf16_t* rowp = O + (size_t)(row0 + ai * HALF + m * 16) * ldc + col0;
#pragma unroll
                for (int bj = 0; bj < 2; ++bj) { const f32x4 v0 = acc[ai][bj][m][0], v1 = acc[ai][bj][m][1];
                    u32x4 w; w.x = cvt_pk_bf16(v0[0], v0[1]); w.y = cvt_pk_bf16(v0[2], v0[3]); w.z = cvt_pk_bf16(v1[0], v1[1]); w.w = cvt_pk_bf16(v1[2], v1[3]);
                    *(u32x4*)(rowp + bj * HALF) = w; } }
    }
};
struct EpiQKV {
    static constexpr bool PERM = true, AFTER_DRAIN = false;
    bf16_t* O; float* sk; float* sv; int extra;
    __device__ __forceinline__ void operator()(const f32x4 (&acc)[2][2][4][2], const Unit& u, int wr, int wc, int fr, int fq) const {
        const int row0 = u.pm * BM + wr * 64 + fr; const int col0 = u.pn * BM + wc * 32 + 8 * fq;
        float* sb = nullptr; int scol = 0;
        if (u.pm < 32 && u.pn >= 8) { if (u.pn < 10) { sb = sk; scol = col0 - 2048; } else { sb = sv; scol = col0 - 2560; } }
#pragma unroll
        for (int ai = 0; ai < 2; ++ai)
#pragma unroll
            for (int m = 0; m < 4; ++m) { const int row = row0 + ai * HALF + m * 16; bf16_t* rowp = O + (size_t)row * 3072 + col0;
#pragma unroll
                for (int bj = 0; bj < 2; ++bj) { const f32x4 v0 = acc[ai][bj][m][0], v1 = acc[ai][bj][m][1];
                    u32x4 w; w.x = cvt_pk_bf16(v0[0], v0[1]); w.y = cvt_pk_bf16(v0[2], v0[3]); w.z = cvt_pk_bf16(v1[0], v1[1]); w.w = cvt_pk_bf16(v1[2], v1[3]);
                    *(u32x4*)(rowp + bj * HALF) = w;
                    if (sb) { float* sp = sb + (size_t)(row + (row >> 8) * extra) * 512 + scol + bj * HALF; *(f32x4*)sp = v0; *(f32x4*)(sp + 4) = v1; } } }
    }
};
struct EpiResid {
    static constexpr bool PERM = false, AFTER_DRAIN = false;
    const float* xc; const float* xl; float* out; const float* gate; float gs;
    __device__ __forceinline__ void operator()(const f32x4 (&acc)[2][2][4][2], const Unit& u, int wr, int wc, int fr, int fq) const {
        const int row0 = u.pm * BM + wr * 64 + fr; const int col0 = u.pn * BM + wc * 32 + 4 * fq;
        const int cv = u.pm < 32 ? 0 : 1 + ((u.pm - 32) >> 3);
        const float* gp = gate + (size_t)cv * (6 * 2048) + col0;
        const float* xin = u.pm < 32 ? xc + (size_t)row0 * 2048 + col0 : xl + (size_t)(row0 - 8192) * 2048 + col0;
        float* op = out + (size_t)row0 * 2048 + col0;
        f32x4 gv[2][2];
#pragma unroll
        for (int bj = 0; bj < 2; ++bj)
#pragma unroll
            for (int n = 0; n < 2; ++n) gv[bj][n] = *(const f32x4*)(gp + bj * HALF + n * 16) * gs;
#pragma unroll
        for (int ai = 0; ai < 2; ++ai)
#pragma unroll
            for (int m = 0; m < 4; ++m) { const size_t ro = (size_t)(ai * HALF + m * 16) * 2048;
#pragma unroll
                for (int bj = 0; bj < 2; ++bj)
#pragma unroll
                    for (int n = 0; n < 2; ++n) { const f32x4 x = *(const f32x4*)(xin + ro + bj * HALF + n * 16);
                        *(f32x4*)(op + ro + bj * HALF + n * 16) = x + gv[bj][n] * acc[ai][bj][m][n]; }
                if (m & 1) asm volatile("" ::: "memory"); }
    }
};
struct EpiSwiglu {
    static constexpr bool PERM = true, AFTER_DRAIN = false;
    bf16_t* O;
    __device__ __forceinline__ float sw(float g, float uu) const { return g * __builtin_amdgcn_rcpf(1.0f + __builtin_amdgcn_exp2f(-1.4426950408889634f * g)) * uu; }
    __device__ __forceinline__ void operator()(const f32x4 (&acc)[2][2][4][2], const Unit& u, int wr, int wc, int fr, int fq) const {
        const int row0 = u.pm * BM + wr * 64 + fr; const int col0 = u.pn * HALF + wc * 32 + 8 * fq;
#pragma unroll
        for (int ai = 0; ai < 2; ++ai)
#pragma unroll
            for (int m = 0; m < 4; ++m) { bf16_t* rowp = O + (size_t)(row0 + ai * HALF + m * 16) * 5632 + col0;
                const f32x4 g0 = acc[ai][0][m][0], g1 = acc[ai][0][m][1], u0 = acc[ai][1][m][0], u1 = acc[ai][1][m][1];
                u32x4 w; w.x = cvt_pk_bf16(sw(g0[0], u0[0]), sw(g0[1], u0[1])); w.y = cvt_pk_bf16(sw(g0[2], u0[2]), sw(g0[3], u0[3]));
                w.z = cvt_pk_bf16(sw(g1[0], u1[0]), sw(g1[1], u1[1])); w.w = cvt_pk_bf16(sw(g1[2], u1[2]), sw(g1[3], u1[3]));
                *(u32x4*)rowp = w; }
    }
};

template <class Epi, class Sched, bool ALIGN_EPI = false, bool SP2 = false>
__device__ __forceinline__ void gemm_phase(PG8_LAS unsigned char* lds, const Gemm g, const Sched& S, const Epi& E) {
    int tid_ = threadIdx.x; asm volatile("" : "+v"(tid_));
    const int tid = tid_, wid = __builtin_amdgcn_readfirstlane(tid >> 6), lane = tid & 63, wr = wid >> 2, wc = wid & 3, fr = lane & 15, fq = lane >> 4;
    const int K = g.K, nt = K / BK;
    unsigned voffA[2], voffB[2];
#pragma unroll
    for (int i = 0; i < 2; ++i) { int R, C; stage_rc(tid * 16 + i * 8192, R, C); const int Rb = Epi::PERM ? ((R & ~31) + perm32(R & 31)) : R;
        voffA[i] = (unsigned)(R * K + C) * 2u; voffB[i] = (unsigned)(Rb * K + C) * 2u; }
    const size_t kstep = (size_t)(BK * 2);
    const size_t hstep = (size_t)HALF * K * 2;
    const size_t tstep = 2 * hstep;
    const unsigned ldsw = (unsigned)wid * 1024u;
    const int aoff = lds_byte(wr * 64 + fr, fq * 8), boff = lds_byte(wc * 32 + fr, fq * 8);
#define PG8_SA(b, h) (((b) * 2 + (h)) * HTB)
#define PG8_SB(b, h) ((4 + (b) * 2 + (h)) * HTB)
#define PG8_STAGE(bufoff, gbase, voff) do { _Pragma("unroll") for (int _i = 0; _i < 2; ++_i) \
        __builtin_amdgcn_global_load_lds((const unsigned*)((const char*)(gbase) + (voff)[_i]), (PG8_LAS unsigned*)(lds + (bufoff) + ldsw + _i * 8192), 16, 0, 0); } while (0)
#define PG8_LDA(dst, b, h) do { _Pragma("unroll") for (int m = 0; m < 4; ++m) _Pragma("unroll") for (int k = 0; k < 2; ++k) dst[m][k] = *(const PG8_LAS bf16x8*)(lds + PG8_SA(b, h) + aoff + m * 2048 + k * 1024); } while (0)
#define PG8_LDB(dst, b, h) do { _Pragma("unroll") for (int n = 0; n < 2; ++n) _Pragma("unroll") for (int k = 0; k < 2; ++k) dst[n][k] = *(const PG8_LAS bf16x8*)(lds + PG8_SB(b, h) + boff + n * 2048 + k * 1024); } while (0)
#define PG8_MMA(ai, bj, At, Bt) do { __builtin_amdgcn_s_setprio(1); _Pragma("unroll") for (int m = 0; m < 4; ++m) _Pragma("unroll") for (int n = 0; n < 2; ++n) _Pragma("unroll") for (int k = 0; k < 2; ++k) \
        acc[ai][bj][m][n] = __builtin_amdgcn_mfma_f32_16x16x32_bf16(Bt[n][k], At[m][k], acc[ai][bj][m][n], 0, 0, 0); __builtin_amdgcn_s_setprio(0); } while (0)
#define PG8_WAIT_V(n) asm volatile("s_waitcnt vmcnt(" #n ")" ::: "memory")
#define PG8_WAIT_L(n) asm volatile("s_waitcnt lgkmcnt(" #n ")" ::: "memory")
#define PG8_BAR __builtin_amdgcn_s_barrier()
#define PG8_SCHED __builtin_amdgcn_sched_barrier(0)
    Unit cur, nxt; int ui = 0;
    if (!S.next(0, cur)) return;
    f32x4 acc[2][2][4][2];
#pragma unroll
    for (int a = 0; a < 2; ++a)
#pragma unroll
        for (int b = 0; b < 2; ++b)
#pragma unroll
            for (int m = 0; m < 4; ++m)
#pragma unroll
                for (int n = 0; n < 2; ++n) acc[a][b][m][n] = (f32x4){0.f, 0.f, 0.f, 0.f};
    bf16x8 At[4][2], B0[2][2], B1[2][2];
    const char* cA = (const char*)g.A + (size_t)cur.pm * tstep; const char* cB = (const char*)g.Bt + (size_t)cur.pn * tstep;
    S.a_ready(cur);
    if constexpr (SP2) {
        PG8_STAGE(PG8_SB(0, 0), cB, voffB); PG8_STAGE(PG8_SB(0, 1), cB + hstep, voffB); PG8_STAGE(PG8_SA(0, 0), cA, voffA); PG8_STAGE(PG8_SA(0, 1), cA + hstep, voffA);
        if (wr == 1) PG8_BAR;
        PG8_WAIT_V(2); PG8_BAR;
        PG8_STAGE(PG8_SB(1, 0), cB + kstep, voffB); PG8_STAGE(PG8_SA(1, 0), cA + kstep, voffA); PG8_STAGE(PG8_SB(1, 1), cB + hstep + kstep, voffB);
        PG8_WAIT_V(6); PG8_BAR;
    } else {
        PG8_STAGE(PG8_SB(0, 0), cB, voffB); PG8_STAGE(PG8_SA(0, 0), cA, voffA); PG8_STAGE(PG8_SB(0, 1), cB + hstep, voffB); PG8_STAGE(PG8_SA(0, 1), cA + hstep, voffA);
        if (wr == 1) PG8_BAR;
        PG8_WAIT_V(4); PG8_BAR;
        PG8_STAGE(PG8_SB(1, 0), cB + kstep, voffB); PG8_STAGE(PG8_SA(1, 0), cA + kstep, voffA); PG8_STAGE(PG8_SB(1, 1), cB + hstep + kstep, voffB);
        PG8_WAIT_V(6); PG8_BAR;
    }
    for (;;) {
        const bool has_next = S.next(ui + 1, nxt);
        const char* nA = has_next ? (const char*)g.A + (size_t)nxt.pm * tstep : cA; const char* nB = has_next ? (const char*)g.Bt + (size_t)nxt.pn * tstep : cB;
        for (int t = 0; t < nt; t += 2) {
            const bool last = (t == nt - 2);
            const char* a1 = cA + (size_t)(t + 1) * kstep;
            const char* a2 = last ? nA : cA + (size_t)(t + 2) * kstep; const char* b2 = last ? nB : cB + (size_t)(t + 2) * kstep;
            const char* a3 = a2 + kstep; const char* b3 = b2 + kstep;
            if (last && has_next) S.a_ready(nxt);
            if constexpr (SP2) {
            PG8_LDB(B0, 0, 0); PG8_LDB(B1, 0, 1); PG8_SCHED; PG8_LDA(At, 0, 0); PG8_STAGE(PG8_SA(1, 1), a1 + hstep, voffA);
            PG8_WAIT_V(8); PG8_WAIT_L(0); PG8_BAR; PG8_MMA(0, 0, At, B0); PG8_MMA(0, 1, At, B1); PG8_BAR; PG8_SCHED;
            PG8_LDA(At, 0, 1); PG8_STAGE(PG8_SB(0, 0), b2, voffB); PG8_STAGE(PG8_SB(0, 1), b2 + hstep, voffB); PG8_STAGE(PG8_SA(0, 0), a2, voffA);
            PG8_WAIT_V(8); PG8_WAIT_L(0); PG8_BAR; PG8_MMA(1, 0, At, B0); PG8_MMA(1, 1, At, B1); PG8_BAR; PG8_SCHED;
            PG8_LDB(B0, 1, 0); PG8_LDB(B1, 1, 1); PG8_SCHED; PG8_LDA(At, 1, 0); PG8_STAGE(PG8_SA(0, 1), a2 + hstep, voffA);
            PG8_WAIT_V(8); PG8_WAIT_L(0); PG8_BAR; PG8_MMA(0, 0, At, B0); PG8_MMA(0, 1, At, B1); PG8_BAR; PG8_SCHED;
            PG8_LDA(At, 1, 1); PG8_STAGE(PG8_SB(1, 0), b3, voffB); PG8_STAGE(PG8_SB(1, 1), b3 + hstep, voffB); PG8_STAGE(PG8_SA(1, 0), a3, voffA);
            PG8_WAIT_V(8); PG8_WAIT_L(0); PG8_BAR; PG8_MMA(1, 0, At, B0); PG8_MMA(1, 1, At, B1); PG8_BAR; PG8_SCHED;
            } else {
            PG8_LDB(B0, 0, 0); PG8_SCHED; PG8_LDA(At, 0, 0); PG8_STAGE(PG8_SA(1, 1), a1 + hstep, voffA);
            PG8_WAIT_L(8); PG8_BAR; PG8_WAIT_L(0); PG8_MMA(0, 0, At, B0); PG8_BAR; PG8_SCHED;
            PG8_LDB(B1, 0, 1); PG8_STAGE(PG8_SB(0, 0), b2, voffB);
            PG8_BAR; PG8_WAIT_L(0); PG8_MMA(0, 1, At, B1); PG8_BAR;
            PG8_LDA(At, 0, 1); PG8_STAGE(PG8_SA(0, 0), a2, voffA);
            PG8_BAR; PG8_WAIT_L(0); PG8_MMA(1, 0, At, B0); PG8_BAR; PG8_SCHED;
            PG8_STAGE(PG8_SB(0, 1), b2 + hstep, voffB);
            PG8_WAIT_V(6); PG8_BAR; PG8_MMA(1, 1, At, B1); PG8_BAR;
            PG8_LDB(B0, 1, 0); PG8_SCHED; PG8_LDA(At, 1, 0); PG8_STAGE(PG8_SA(0, 1), a2 + hstep, voffA);
            PG8_WAIT_L(8); PG8_BAR; PG8_WAIT_L(0); PG8_MMA(0, 0, At, B0); PG8_BAR; PG8_SCHED;
            PG8_LDB(B1, 1, 1); PG8_STAGE(PG8_SB(1, 0), b3, voffB);
            PG8_BAR; PG8_WAIT_L(0); PG8_MMA(0, 1, At, B1); PG8_BAR;
            PG8_LDA(At, 1, 1); PG8_STAGE(PG8_SA(1, 0), a3, voffA);
            PG8_BAR; PG8_WAIT_L(0); PG8_MMA(1, 0, At, B0); PG8_BAR; PG8_SCHED;
            PG8_STAGE(PG8_SB(1, 1), b3 + hstep, voffB);
            PG8_WAIT_V(6); PG8_BAR; PG8_MMA(1, 1, At, B1); PG8_BAR;
            }
        }
        if constexpr (ALIGN_EPI) { if (wr == 0) PG8_BAR; }
        if constexpr (!Epi::AFTER_DRAIN) { E(acc, cur, wr, wc, fr, fq); S.done(cur); }
        if (!has_next) break;
#pragma unroll
        for (int a = 0; a < 2; ++a)
#pragma unroll
            for (int b = 0; b < 2; ++b)
#pragma unroll
                for (int m = 0; m < 4; ++m)
#pragma unroll
                    for (int n = 0; n < 2; ++n) acc[a][b][m][n] = (f32x4){0.f, 0.f, 0.f, 0.f};
        cur = nxt; cA = nA; cB = nB; ++ui;
        if constexpr (ALIGN_EPI) { if (wr == 1) PG8_BAR; }
    }
    PG8_WAIT_V(0);
    if constexpr (!ALIGN_EPI) { if (wr == 0) PG8_BAR; }
    PG8_BAR;
    if constexpr (Epi::AFTER_DRAIN) { E.fused(acc, cur, wr, wc, fr, fq, lds, wid, lane); S.done(cur); }
#undef PG8_SA
#undef PG8_SB
#undef PG8_STAGE
#undef PG8_LDA
#undef PG8_LDB
#undef PG8_MMA
#undef PG8_WAIT_V
#undef PG8_WAIT_L
#undef PG8_BAR
#undef PG8_SCHED
}
}

namespace att {
using bf16 = unsigned short;
#define AG __attribute__((address_space(1)))
#define AL __attribute__((address_space(3)))
constexpr int D = 128, NW = 8, QBLK = 32, KVBLK = 64;
constexpr float SCALE = 0.088388347648318440f;
constexpr float THR = 8.f;
using bf16x8 = __attribute__((ext_vector_type(8))) short;
using s16x4  = __attribute__((ext_vector_type(4))) short;
using f32x16 = __attribute__((ext_vector_type(16))) float;
using u32x4  = __attribute__((ext_vector_type(4))) unsigned;
constexpr size_t SHM_V = KVBLK * D * 2, SHM_K = KVBLK * D * 2, SHM_ATTN = 2 * SHM_V + 2 * SHM_K + NW * 64 * 4;
#define KSWZ(row, colB) ((row) * 256 + ((colB) ^ (((row) & 7) << 4)))
#define SBAR() __builtin_amdgcn_sched_barrier(0)
__device__ __forceinline__ int crow(int r, int hi) { return (r & 3) + 8 * (r >> 2) + 4 * hi; }
__device__ __forceinline__ unsigned cvtpk(float lo, float hi) { unsigned r; asm volatile("v_cvt_pk_bf16_f32 %0, %1, %2" : "=v"(r) : "v"(lo), "v"(hi)); return r; }
__device__ __forceinline__ bf16x8 ld8(const bf16* p) { return *(const AG bf16x8*)p; }

__device__ __forceinline__ void partialSM(f32x16& p0, f32x16& p1, float& m_reg, float& mn, float& alpha) {
  constexpr float C = SCALE * 1.4426950408889634f;
  float pmax = p0[0]; for (int r = 1; r < 16; ++r) pmax = fmaxf(pmax, p0[r]); for (int r = 0; r < 16; ++r) pmax = fmaxf(pmax, p1[r]);
  { auto rr = __builtin_amdgcn_permlane32_swap(__float_as_uint(pmax), __float_as_uint(pmax), false, false);
    pmax = fmaxf(__uint_as_float(rr[0]), __uint_as_float(rr[1])); }
  if (__builtin_expect(__all(pmax - m_reg <= THR / SCALE), 1)) { mn = m_reg; alpha = 1.f; }
  else { mn = fmaxf(m_reg, pmax); alpha = __builtin_amdgcn_exp2f((m_reg - mn) * C); m_reg = mn; }
  float mnC = -mn * C;
  for (int r = 0; r < 16; ++r) p0[r] = fmaf(p0[r], C, mnC); for (int r = 0; r < 16; ++r) p1[r] = fmaf(p1[r], C, mnC);
  for (int r = 0; r < 16; ++r) p0[r] = __builtin_amdgcn_exp2f(p0[r]);
}
__device__ __forceinline__ void finishSM(f32x16& p0, f32x16& p1, float alpha, float& l_reg, bf16x8& pa0, bf16x8& pa1, bf16x8& pa2, bf16x8& pa3) {
  for (int r = 0; r < 16; ++r) p1[r] = __builtin_amdgcn_exp2f(p1[r]);
  float ps = 0; for (int r = 0; r < 16; ++r) ps += p0[r]; for (int r = 0; r < 16; ++r) ps += p1[r];
  { auto rr = __builtin_amdgcn_permlane32_swap(__float_as_uint(ps), __float_as_uint(ps), false, false);
    ps = __uint_as_float(rr[0]) + __uint_as_float(rr[1]); }
  l_reg = l_reg * alpha + ps;
#define PK4(P, BASE, OUT) do { unsigned a0 = cvtpk(P[BASE + 0], P[BASE + 1]), a1 = cvtpk(P[BASE + 2], P[BASE + 3]);   \
    unsigned b0 = cvtpk(P[BASE + 4], P[BASE + 5]), b1 = cvtpk(P[BASE + 6], P[BASE + 7]);                              \
    auto r0 = __builtin_amdgcn_permlane32_swap(a0, b0, false, false); auto r1 = __builtin_amdgcn_permlane32_swap(a1, b1, false, false); \
    u32x4 w = {r0[0], r1[0], r0[1], r1[1]}; OUT = *reinterpret_cast<bf16x8*>(&w); } while (0)
  PK4(p0, 0, pa0); PK4(p0, 8, pa1); PK4(p1, 0, pa2); PK4(p1, 8, pa3);
#undef PK4
}
__device__ __forceinline__ void qkt(f32x16& p0, f32x16& p1, const AL char* Ks, const bf16x8* qr, int r32, int hi) {
  p0 = f32x16{}; p1 = f32x16{};
  for (int d0 = 0; d0 < 8; ++d0) { int cb = (d0 * 16 + hi * 8) * 2;
    bf16x8 b0 = *(const AL bf16x8*)(Ks + KSWZ(r32, cb));
    bf16x8 b1 = *(const AL bf16x8*)(Ks + KSWZ(32 + r32, cb));
    p0 = __builtin_amdgcn_mfma_f32_32x32x16_bf16(b0, qr[d0], p0, 0, 0, 0);
    p1 = __builtin_amdgcn_mfma_f32_32x32x16_bf16(b1, qr[d0], p1, 0, 0, 0); }
}
__device__ __forceinline__ void wmask(f32x16& p0, f32x16& p1, int dq, int hi) {
#pragma unroll
  for (int r = 0; r < 16; ++r) { const int df = dq - crow(r, hi);
    if (df > 128 || df < -128) p0[r] = -1e30f;
    if (df - 32 > 128 || df - 32 < -128) p1[r] = -1e30f; }
}
__device__ __forceinline__ int v_st(int k, int c) { const int kk = (k & ~0xC) | ((k & 4) << 1) | ((k & 8) >> 1); return ((kk >> 3) * 4 + (c >> 5)) * 512 + ((kk & 7) * 32 + (c & 31)) * 2; }
__device__ __forceinline__ int v_rd_base(int lane) { return ((lane & 3) << 3) | (((lane >> 2) & 3) << 6) | (((lane >> 4) & 1) << 5) | (((lane >> 5) & 1) << 8); }
constexpr int v_rd_off(int d0, int ks, int half) { return d0 * 512 + ks * 4096 + half * 2048; }
template <int OFF> __device__ __forceinline__ s16x4 tr_read(int vb) {
  s16x4 r; asm volatile("ds_read_b64_tr_b16 %0, %1 offset:%2" : "=&v"(r) : "v"(vb), "i"(OFF) : "memory"); return r;
}
template <int D0> __device__ __forceinline__ void pv_one(f32x16& od, int vb, bf16x8 pa0, bf16x8 pa1, bf16x8 pa2, bf16x8 pa3) {
  const s16x4 l0 = tr_read<v_rd_off(D0, 0, 0)>(vb), h0 = tr_read<v_rd_off(D0, 0, 1)>(vb), l1 = tr_read<v_rd_off(D0, 1, 0)>(vb), h1 = tr_read<v_rd_off(D0, 1, 1)>(vb);
  const s16x4 l2 = tr_read<v_rd_off(D0, 2, 0)>(vb), h2 = tr_read<v_rd_off(D0, 2, 1)>(vb), l3 = tr_read<v_rd_off(D0, 3, 0)>(vb), h3 = tr_read<v_rd_off(D0, 3, 1)>(vb);
  asm volatile("s_waitcnt lgkmcnt(0)" ::: "memory"); SBAR();
#define PK(L, H) (bf16x8){L[0], L[1], L[2], L[3], H[0], H[1], H[2], H[3]}
  od = __builtin_amdgcn_mfma_f32_32x32x16_bf16(pa0, PK(l0, h0), od, 0, 0, 0);
  od = __builtin_amdgcn_mfma_f32_32x32x16_bf16(pa1, PK(l1, h1), od, 0, 0, 0);
  od = __builtin_amdgcn_mfma_f32_32x32x16_bf16(pa2, PK(l2, h2), od, 0, 0, 0);
  od = __builtin_amdgcn_mfma_f32_32x32x16_bf16(pa3, PK(l3, h3), od, 0, 0, 0);
#undef PK
}
__device__ __forceinline__ void pv_d0(f32x16* o, int vb, bf16x8 pa0, bf16x8 pa1, bf16x8 pa2, bf16x8 pa3) {
  pv_one<0>(o[0], vb, pa0, pa1, pa2, pa3); pv_one<1>(o[1], vb, pa0, pa1, pa2, pa3); pv_one<2>(o[2], vb, pa0, pa1, pa2, pa3); pv_one<3>(o[3], vb, pa0, pa1, pa2, pa3);
}

struct Unit {
  const bf16* Q; int ldq;
  const bf16* KA; const bf16* VA; int ldA; int nA;
  const bf16* KB; const bf16* VB; int ldB;
  int NT;
  int win;
  int dq0;
  int has_sink; float sink;
  bf16* O; int ldo;
};

__device__ __forceinline__ void attn_unit(const Unit& U, AL char* lds) {
  int tid_ = threadIdx.x; asm volatile("" : "+v"(tid_));
  const int tid = tid_, wid = __builtin_amdgcn_readfirstlane(tid >> 6), lane = tid & 63, r32 = lane & 31, hi = lane >> 5;
  AL char* V_lds = lds; AL char* K_lds = lds + 2 * SHM_V;
  AL float* ws = (AL float*)(lds + 2 * SHM_V + 2 * SHM_K) + wid * 64; AL float* li_l = ws; AL float* al_l = ws + 32;
  float m_reg = -1e30f, l_reg = 0; f32x16 o[4] = {}; bf16x8 qr[8];
  const bf16* Qw = U.Q + (long)(wid * QBLK + r32) * U.ldq + hi * 8;
#pragma unroll
  for (int d0 = 0; d0 < 8; ++d0) qr[d0] = ld8(Qw + d0 * 16);
  const int sr = tid >> 4, sc = (tid & 15) * 8, vst0 = v_st(sr, sc), vst1 = v_st(32 + sr, sc);
  const int vb0 = (int)(unsigned)(uintptr_t)V_lds + v_rd_base(lane);
  const int nA = U.nA, NT = U.NT;
  const int dqw = U.dq0 + wid * QBLK + r32;
  struct { bf16x8 vs0, vs1, ks0, ks1; } sr_[1];
#define SLOAD(i, jt) do { const int jj_ = (jt); const bf16 *kp_, *vp_; long ld_; \
    if (jj_ < nA) { ld_ = U.ldA; kp_ = U.KA + (long)jj_ * 64 * ld_; vp_ = U.VA + (long)jj_ * 64 * ld_; } \
    else { ld_ = U.ldB; kp_ = U.KB + (long)(jj_ - nA) * 64 * ld_; vp_ = U.VB + (long)(jj_ - nA) * 64 * ld_; } \
    sr_[i].vs0 = ld8(vp_ + (long)sr * ld_ + sc); sr_[i].vs1 = ld8(vp_ + (long)(32 + sr) * ld_ + sc); \
    sr_[i].ks0 = ld8(kp_ + (long)sr * ld_ + sc); sr_[i].ks1 = ld8(kp_ + (long)(32 + sr) * ld_ + sc); } while (0)
#define SWRITE(b, i) do { *(AL bf16x8*)(V_lds + (b) * SHM_V + vst0) = sr_[i].vs0;          \
    *(AL bf16x8*)(V_lds + (b) * SHM_V + vst1) = sr_[i].vs1; int kc = sc * 2;               \
    *(AL bf16x8*)(K_lds + (b) * SHM_K + KSWZ(sr, kc)) = sr_[i].ks0;                       \
    *(AL bf16x8*)(K_lds + (b) * SHM_K + KSWZ(32 + sr, kc)) = sr_[i].ks1; } while (0)
#define RESC(a) do { if (__any((a) < 1.f)) { if (hi == 0) al_l[r32] = (a); asm volatile("s_waitcnt lgkmcnt(0)" ::: "memory"); \
    for (int d = 0; d < 4; ++d) for (int r = 0; r < 16; ++r) o[d][r] *= al_l[crow(r, hi)]; } } while (0)
#define MASK(P0, P1, jt) do { if (U.win && (jt) >= nA) { const int dq_ = dqw - ((jt) - nA) * 64; \
    if (__any(dq_ > 128 || dq_ - 63 < -128)) wmask(P0, P1, dq_, hi); } } while (0)
  f32x16 p0, p1; float mn, al; bf16x8 pa0, pa1, pa2, pa3;
#define LBAR() asm volatile("s_waitcnt lgkmcnt(0)\n\ts_barrier" ::: "memory")
#define STAGE_NEXT() do { if (j + 1 < NT) { asm volatile("s_waitcnt vmcnt(0)" ::: "memory"); SWRITE(b ^ 1, 0); if (j + 2 < NT) SLOAD(0, j + 2); } } while (0)
  SLOAD(0, 0); asm volatile("s_waitcnt vmcnt(0)" ::: "memory"); SWRITE(0, 0); SLOAD(0, 1); LBAR();
  const bool trail = wid >= 4;
  if (trail) LBAR();
#pragma unroll 1
  for (int j = 0; j < NT; ++j) {
    const int b = j & 1;
    qkt(p0, p1, K_lds + b * SHM_K, qr, r32, hi); MASK(p0, p1, j);
    partialSM(p0, p1, m_reg, mn, al);
    if (trail) STAGE_NEXT();
    LBAR();
    RESC(al);
    finishSM(p0, p1, al, l_reg, pa0, pa1, pa2, pa3); SBAR();
    pv_d0(o, vb0 + b * (int)SHM_V, pa0, pa1, pa2, pa3);
    if (!trail) STAGE_NEXT();
    LBAR();
  }
  if (!trail) LBAR();
#undef STAGE_NEXT
  if (U.has_sink) { constexpr float C = SCALE * 1.4426950408889634f; l_reg += __builtin_amdgcn_exp2f(fminf(U.sink * 1.4426950408889634f - m_reg * C, 120.f)); }
  if (hi == 0) li_l[r32] = l_reg; asm volatile("s_waitcnt lgkmcnt(0)" ::: "memory");
  float rli[16];
#pragma unroll
  for (int r = 0; r < 16; ++r) rli[r] = __builtin_amdgcn_rcpf(li_l[crow(r, hi)]);
  bf16* Ow = U.O + (long)(wid * QBLK) * U.ldo;
#pragma unroll
  for (int r = 0; r < 16; ++r) { int orow = crow(r, hi);
    for (int d0 = 0; d0 < 4; ++d0) { const float v = o[d0][r] * rli[r]; const unsigned pk = cvtpk(v, v);
      *(AG unsigned short*)(Ow + (long)orow * U.ldo + d0 * 32 + r32) = (unsigned short)(pk & 0xffffu); } }
#undef SLOAD
#undef SWRITE
#undef RESC
#undef MASK
#undef LBAR
}
}

constexpr int DM = 2048, NCTX = 8192, NLAT = 16384, NTOK = 24576, QKVD = 3072, DFF = 5632, NGU = 11264, DEPTH = 4;
constexpr int NWAVES = 8;
constexpr size_t MiB = 1u << 20;
constexpr size_t OUT_YP = 0, OUT_YS = (size_t)NCTX * DM, OUT_WK = (size_t)NTOK * DM, OUT_WV = OUT_WK + (size_t)32 * 2 * 256 * 512,
                 OUT_AK = OUT_WV + (size_t)32 * 2 * 256 * 512, OUT_AV = OUT_AK + (size_t)32 * 256 * 512, OUT_END = OUT_AV + (size_t)32 * 256 * 512;
constexpr size_t WS_CTL = 0, CTL_ZERO_BYTES = 1 * MiB;
constexpr size_t WS_MODP = 1 * MiB;
constexpr size_t WS_MODF = 16 * MiB;
constexpr size_t WS_A2 = 18 * MiB;
constexpr size_t WS_NP = 19 * MiB;
constexpr size_t WS_INV = WS_NP + (size_t)18 * 8192 * 4;
constexpr size_t WS_CKV = 20 * MiB;
constexpr size_t WS_CWK = WS_CKV, WS_CWV = WS_CKV + 8 * MiB, WS_CAK = WS_CKV + 16 * MiB, WS_CAV = WS_CKV + 20 * MiB;
constexpr size_t WS_FT = 44 * MiB;
constexpr size_t WS_FT_CTX = WS_FT + 32 * MiB;
constexpr size_t WS_W = 80 * MiB;
constexpr size_t W_QKV = (size_t)QKVD * DM * 2, W_SQ = (size_t)DM * DM * 2, W_IN = (size_t)6144 * DM * 2, W_GU = (size_t)NGU * DM * 2, W_DN = (size_t)DM * DFF * 2;
constexpr size_t WS_WQKV0 = WS_W, WS_WQKV1 = WS_WQKV0 + W_QKV, WS_WQKVA = WS_WQKV1 + W_QKV, WS_WO0 = WS_WQKVA + W_QKV, WS_WO1 = WS_WO0 + W_SQ, WS_WOA = WS_WO1 + W_SQ,
                 WS_WHO = WS_WOA + W_SQ, WS_WHI = WS_WHO + W_SQ, WS_WGU = WS_WHI + W_IN, WS_WDN = WS_WGU + 4 * W_GU, WS_WEND = WS_WDN + 4 * W_DN;
constexpr size_t WS_H = 448 * MiB;
constexpr size_t WS_BIG = 544 * MiB;
constexpr size_t WS_ZT = WS_BIG + 288 * MiB;
constexpr size_t WS_END = WS_BIG + 384 * MiB;
static_assert(WS_WEND <= WS_H && WS_FT_CTX + 4 * MiB <= WS_W && WS_CAV + 4 * MiB <= WS_FT, "ws map");
static_assert(WS_MODP + (size_t)4 * 8 * 9 * 12288 * 4 <= WS_MODF && WS_MODF + (size_t)4 * 9 * 6 * 2048 * 4 <= WS_A2 && WS_A2 + (size_t)2304 * 64 * 4 <= WS_NP && WS_INV + (size_t)4 * 2048 * 4 <= WS_CKV, "small buffers");
constexpr int CW_TMO = 0;
constexpr int CW_BAR = 4096;
constexpr int RING_BYTES = 131072;
constexpr int LDSCTL_OFF = RING_BYTES, MISC_OFF = LDSCTL_OFF + 320;
constexpr int LDS_BYTES = 147456;

#define GAS __attribute__((address_space(1)))
#define LAS __attribute__((address_space(3)))
typedef unsigned short bf16;
typedef unsigned v4u __attribute__((ext_vector_type(4)));
typedef unsigned v2u __attribute__((ext_vector_type(2)));
typedef float f32x4 __attribute__((ext_vector_type(4)));
typedef short bf16x8 __attribute__((ext_vector_type(8)));
typedef short bf16x4 __attribute__((ext_vector_type(4)));
typedef GAS unsigned gu32;
#define RLX_AGENT __ATOMIC_RELAXED, __HIP_MEMORY_SCOPE_AGENT
#define LDS_WAIT() asm volatile("s_waitcnt lgkmcnt(0)" ::: "memory")
#define VM_WAIT() asm volatile("s_waitcnt vmcnt(0)" ::: "memory")
__device__ __forceinline__ unsigned f2bf(float f) { unsigned u = __builtin_bit_cast(unsigned, f); return (u + 0x7fffu + ((u >> 16) & 1u)) >> 16; }
__device__ __forceinline__ unsigned pk2(float lo, float hi) { return f2bf(lo) | (f2bf(hi) << 16); }
__device__ __forceinline__ float bf2f(unsigned short b) { return __builtin_bit_cast(float, (unsigned)b << 16); }
__device__ __forceinline__ float bflo(unsigned w) { return __builtin_bit_cast(float, w << 16); }
__device__ __forceinline__ float bfhi(unsigned w) { return __builtin_bit_cast(float, w & 0xffff0000u); }
__device__ __forceinline__ float wave_sum(float v) {
#pragma unroll
    for (int o = 1; o < 64; o <<= 1) v += __shfl_xor(v, o);
    return v;
}
#define XB_TMO      128
#define XB_XCNT(j)  (256  + 64 * (j))
#define XB_XSUB(j)  (1280 + 64 * (j))
#define XB_XGEN(j)  (2304 + 64 * (j))
#define XB_TOP      3328
#define XB_TOPGEN   3392
#define XCD_BAR_WORDS 3456
#define XB_SPIN_CAP (1u << 18)

__device__ __forceinline__ unsigned xb_ld(unsigned* p)              { return __hip_atomic_load(p, __ATOMIC_RELAXED, __HIP_MEMORY_SCOPE_AGENT); }
__device__ __forceinline__ unsigned xb_add(unsigned* p, unsigned v) { return __hip_atomic_fetch_add(p, v, __ATOMIC_RELAXED, __HIP_MEMORY_SCOPE_AGENT); }
__device__ __forceinline__ unsigned xb_xcc_id() { return (unsigned)__builtin_amdgcn_s_getreg((3 << 11) | 20) & 0xFu; }
#define XB_SPIN(cond, bar) do { unsigned _sp = 0; while (cond) { __builtin_amdgcn_s_sleep(1); \
    if ((++_sp & 255u) == 0u) { if (xb_ld(&(bar)[XB_TMO])) break; if (_sp > XB_SPIN_CAP) { atomicAdd(&(bar)[XB_TMO], 1u); break; } } } } while (0)

struct XcdBarrier {
    unsigned* bar; unsigned x;
    volatile LAS unsigned* st;
};

__device__ __forceinline__ XcdBarrier xcd_barrier_post(unsigned* bar, volatile LAS unsigned* st) {
    XcdBarrier b; b.bar = bar; b.x = xb_xcc_id(); b.st = st;
    if (threadIdx.x == 0) (void)xb_add(&bar[XB_XCNT(b.x)], 1u);
    return b;
}
__device__ __forceinline__ void xcd_barrier_complete(unsigned* bar, unsigned x, unsigned& nloc, unsigned& nx) {
    const unsigned G = gridDim.x * gridDim.y * gridDim.z;
    unsigned sum, cnt, mine, sp = 0u;
    for (;;) {
        sum = 0u; cnt = 0u; mine = 0u;
#pragma unroll
        for (unsigned j = 0; j < 16; ++j) { const unsigned c = xb_ld(&bar[XB_XCNT(j)]); sum += c; cnt += (c > 0u) ? 1u : 0u; mine = (j == x) ? c : mine; }
        if (sum == G) break;
        __builtin_amdgcn_s_sleep(1);
        if ((++sp & 255u) == 0u) { if (xb_ld(&bar[XB_TMO])) break; if (sp > XB_SPIN_CAP) { atomicAdd(&bar[XB_TMO], 1u); break; } }
    }
    nloc = mine > 0u ? mine : 1u; nx = cnt > 0u ? cnt : 1u;
}

__device__ __forceinline__ void xcd_barrier(const XcdBarrier& b) {
    asm volatile("s_waitcnt vmcnt(0)" ::: "memory");
    __syncthreads();
    if (threadIdx.x == 0) {
        unsigned* bar = b.bar;
        __builtin_amdgcn_s_waitcnt(0);
        unsigned nloc = b.st[0], nx = b.st[1];
        if (nloc == 0u) { xcd_barrier_complete(bar, b.x, nloc, nx); b.st[0] = nloc; b.st[1] = nx; }
        const unsigned old = xb_add(&bar[XB_XSUB(b.x)], 1u);
        const unsigned gen = old / nloc;
        if (old + 1u == (gen + 1u) * nloc) {
            __builtin_amdgcn_fence(__ATOMIC_RELEASE, "agent");
            asm volatile("s_waitcnt vmcnt(0)" ::: "memory");
            const unsigned og = xb_add(&bar[XB_TOP], 1u);
            const unsigned tg = og / nx;
            if (og + 1u == (tg + 1u) * nx) xb_add(&bar[XB_TOPGEN], 1u);
            else XB_SPIN(xb_ld(&bar[XB_TOPGEN]) == tg, bar);
            __builtin_amdgcn_fence(__ATOMIC_ACQUIRE, "agent");
            xb_add(&bar[XB_XGEN(b.x)], 1u);
            asm volatile("s_waitcnt vmcnt(0)" ::: "memory");
        } else {
            XB_SPIN(xb_ld(&bar[XB_XGEN(b.x)]) == gen, bar);
            __builtin_amdgcn_fence(__ATOMIC_ACQUIRE, "agent");
            asm volatile("s_waitcnt vmcnt(0)" ::: "memory");
        }
    }
    __syncthreads();
}

__device__ __forceinline__ void transpose_item(const float* W, int K, int N, bf16* WT, int k0, int n0, int drow0, LAS float* scr, int lane) {
#pragma unroll 8
    for (int i = 0; i < 32; ++i) { const int kk = 2 * i + (lane >> 5); scr[kk * 33 + (lane & 31)] = W[(size_t)(k0 + kk) * N + n0 + (lane & 31)]; }
    LDS_WAIT(); asm volatile("" ::: "memory");
    const int c = lane & 7;
#pragma unroll
    for (int j = 0; j < 4; ++j) { const int n = (lane >> 3) + 8 * j; const LAS float* s = scr + (8 * c) * 33 + n;
        v4u o; o.x = pk2(s[0 * 33], s[1 * 33]); o.y = pk2(s[2 * 33], s[3 * 33]); o.z = pk2(s[4 * 33], s[5 * 33]); o.w = pk2(s[6 * 33], s[7 * 33]);
        *(GAS v4u*)(WT + (size_t)(drow0 + n) * K + k0 + 8 * c) = o; }
    LDS_WAIT(); asm volatile("" ::: "memory");
}
constexpr int IT_QKV = (DM / 64) * (QKVD / 32), IT_SQ = (DM / 64) * (DM / 32), IT_IN = (DM / 64) * (6144 / 32), IT_GU = (DM / 64) * (NGU / 32), IT_DN = (DFF / 64) * (DM / 32);
constexpr int IT_TOTAL = 3 * IT_QKV + 4 * IT_SQ + IT_IN + 4 * IT_GU + 4 * IT_DN;

struct Args { const float* in[33]; float* out; unsigned char* ws; int ph_lo, ph_hi; };
#define GIN(k) ((const float*)(const GAS float*)A.in[k])

__device__ __forceinline__ void weight_item(const Args& A, int it, LAS float* scr, int lane) {
    unsigned char* ws = A.ws;
    const float* src; bf16* dst; int K = DM, N; bool gu = false; int r = it;
    if (r < 3 * IT_QKV) { const int m = r / IT_QKV; r -= m * IT_QKV; N = QKVD;
        src = (m < 2) ? GIN(12) + (size_t)m * DM * QKVD : GIN(26); dst = (bf16*)(ws + WS_WQKV0 + (size_t)m * W_QKV); }
    else if ((r -= 3 * IT_QKV) < 4 * IT_SQ) { const int m = r / IT_SQ; r -= m * IT_SQ; N = DM;
        src = (m < 2) ? GIN(13) + (size_t)m * DM * DM : (m == 2 ? GIN(29) : GIN(25)); dst = (bf16*)(ws + WS_WO0 + (size_t)m * W_SQ); }
    else if ((r -= 4 * IT_SQ) < IT_IN) { N = 6144; src = GIN(15); dst = (bf16*)(ws + WS_WHI); }
    else if ((r -= IT_IN) < 4 * IT_GU) { const int m = r / IT_GU; r -= m * IT_GU; N = NGU; gu = true;
        src = GIN(30) + (size_t)m * DM * NGU; dst = (bf16*)(ws + WS_WGU + (size_t)m * W_GU); }
    else { r -= 4 * IT_GU; const int m = r / IT_DN; r -= m * IT_DN; N = DM; K = DFF;
        src = GIN(31) + (size_t)m * DFF * DM; dst = (bf16*)(ws + WS_WDN + (size_t)m * W_DN); }
    const int nblk = N / 32, kb = r / nblk, nb = r % nblk, k0 = 64 * kb, n0 = 32 * nb;
    int drow0 = n0;
    if (gu) { const int isu = n0 >= DFF ? 1 : 0; const int j = n0 - isu * DFF; drow0 = (j >> 7) * 256 + isu * 128 + (j & 127); }
    transpose_item(src, K, N, dst, k0, n0, drow0, scr, lane);
}

__device__ __forceinline__ void adaln_partial_unit(const Args& A, int u, LAS float* scr, int lane) {
    const int layer = u / 384, kc = (u / 48) % 8, cg = u % 48;
    const float* cctx = GIN(7); const float* cin = GIN(6);
    for (int idx = lane; idx < 9 * 256; idx += 64) { const int c = idx >> 8, kk = idx & 255, k = kc * 256 + kk;
        const float v = (c == 0) ? cctx[k] : cin[(size_t)(c - 1) * DM + k]; scr[idx] = v / (1.0f + expf(-v)); }
    LDS_WAIT(); asm volatile("" ::: "memory");
    f32x4 acc[9];
#pragma unroll
    for (int c = 0; c < 9; ++c) acc[c] = (f32x4){0.f, 0.f, 0.f, 0.f};
    const float* wp = GIN(10) + (size_t)layer * DM * 12288 + (size_t)(kc * 256) * 12288 + cg * 256 + lane * 4;
#pragma unroll 8
    for (int kk = 0; kk < 256; ++kk) { const f32x4 w = *(const GAS f32x4*)(wp + (size_t)kk * 12288);
#pragma unroll
        for (int c = 0; c < 9; ++c) acc[c] += scr[c * 256 + kk] * w; }
    float* mp = (float*)(A.ws + WS_MODP) + (size_t)((layer * 8 + kc) * 9) * 12288 + cg * 256 + lane * 4;
#pragma unroll
    for (int c = 0; c < 9; ++c) *(f32x4*)(mp + (size_t)c * 12288) = acc[c];
    LDS_WAIT(); asm volatile("" ::: "memory");
}

__device__ __forceinline__ void filter_a2_row(const Args& A, int rr, int lane) {
    const int L = rr < 2048 ? 2048 : 256, t = rr < 2048 ? rr : rr - 2048;
    const float tn = (float)t / (float)(L - 1), w = 6.283185307179586f * (float)t / (float)L;
    float feat = 0.f;
    if (lane == 0) feat = tn;
    else if (lane <= 16) feat = cosf(w * (1e-4f + (float)(lane - 1) * ((15.0f - 1e-4f) / 15.0f)));
    else if (lane <= 32) feat = -sinf(w * (1e-4f + (float)(lane - 17) * ((15.0f - 1e-4f) / 15.0f)));
    const float* w1 = GIN(18); const float* b1 = GIN(19); const float* w2 = GIN(20); const float* b2 = GIN(21); const float* fq = GIN(23);
    float s = b1[lane];
    for (int f = 0; f < 33; ++f) s += __shfl(feat, f) * w1[f * 64 + lane];
    const float a1 = sinf(fq[lane] * s);
    float s2 = b2[lane];
    for (int k = 0; k < 64; ++k) s2 += __shfl(a1, k) * w2[k * 64 + lane];
    ((float*)(A.ws + WS_A2))[(size_t)rr * 64 + lane] = sinf(fq[64 + lane] * s2);
}

__device__ __forceinline__ void filter_hf_unit(const Args& A, int u, LAS float* scr, int lane) {
    const int variant = u < 2048 ? 0 : 1; const int uu = variant ? u - 2048 : u; const int tch = uu >> 7, cgp = uu & 127;
    const int L = variant ? 256 : 2048; const int col = cgp * 64 + lane, side = col >> 12, order = (col >> 11) & 1, d = col & 2047;
    const float* w3 = GIN(22);
    float w3r[64];
#pragma unroll
    for (int k = 0; k < 64; ++k) w3r[k] = w3[(size_t)k * 8192 + col];
    constexpr float MIND = -3.0701134573253944f, MAXD = -15.350567286626972f;
    const float delta = fabsf(MIND + (MAXD - MIND) * ((float)d / 2047.0f));
    const float* a2 = (const float*)(A.ws + WS_A2) + (size_t)(variant ? 2048 : 0) * 64;
    bf16* ft = (bf16*)(A.ws + (variant ? WS_FT_CTX : WS_FT)) + ((size_t)(order * 2048 + d) * 2 + side) * L;
    const float rl1 = 1.0f / (float)(L - 1);
    float asum = 0.f;
#pragma unroll 1
    for (int half = 0; half < 2; ++half) {
        const int tb = tch * 128 + half * 64;
        { const GAS f32x4* src = (const GAS f32x4*)(a2 + (size_t)(tb + lane) * 64);
#pragma unroll
          for (int q = 0; q < 16; ++q) *(LAS f32x4*)(scr + lane * 64 + q * 4) = src[q]; }
        LDS_WAIT(); asm volatile("" ::: "memory");
#pragma unroll 1
        for (int tt = 0; tt < 64; tt += 2) {
            float s0 = 0.f, s1 = 0.f;
#pragma unroll
            for (int q = 0; q < 16; ++q) { const f32x4 x0 = *(const LAS f32x4*)(scr + tt * 64 + q * 4), x1 = *(const LAS f32x4*)(scr + (tt + 1) * 64 + q * 4);
                s0 += x0.x * w3r[4 * q] + x0.y * w3r[4 * q + 1] + x0.z * w3r[4 * q + 2] + x0.w * w3r[4 * q + 3];
                s1 += x1.x * w3r[4 * q] + x1.y * w3r[4 * q + 1] + x1.z * w3r[4 * q + 2] + x1.w * w3r[4 * q + 3]; }
            const int t = tb + tt;
            s0 *= expf(-((float)t * rl1) * delta); s1 *= expf(-((float)(t + 1) * rl1) * delta);
            if (!(side == 1 && t == 0)) asum += fabsf(s0);
            asum += fabsf(s1);
            *(GAS unsigned*)(ft + t) = pk2(s0, s1);
        }
        LDS_WAIT(); asm volatile("" ::: "memory");
    }
    ((float*)(A.ws + WS_NP))[(size_t)(variant ? 16 + tch : tch) * 8192 + col] = asum;
}

__device__ __forceinline__ void norm_row(const float* xrow, const f32x4 (&a)[8], const f32x4 (&b)[8], bf16* orow, int lane) {
    const GAS f32x4* xr = (const GAS f32x4*)xrow + lane;
    f32x4 v[8]; float s = 0.f;
#pragma unroll
    for (int j = 0; j < 8; ++j) { v[j] = xr[64 * j]; s += (v[j].x * v[j].x + v[j].y * v[j].y) + (v[j].z * v[j].z + v[j].w * v[j].w); }
    const float rstd = 1.0f / sqrtf(wave_sum(s) * (1.0f / DM) + 1e-6f);
    GAS v2u* o8 = (GAS v2u*)orow + lane;
#pragma unroll
    for (int j = 0; j < 8; ++j) { const f32x4 y = v[j] * rstd * a[j] + b[j]; v2u w; w.x = pk2(y.x, y.y); w.y = pk2(y.z, y.w); o8[64 * j] = w; }
}
__device__ __forceinline__ void final_norm_row(float* xrow, const float* g, int lane) {
    GAS f32x4* xr = (GAS f32x4*)xrow + lane;
    f32x4 v[8]; float s = 0.f;
#pragma unroll
    for (int j = 0; j < 8; ++j) { v[j] = xr[64 * j]; s += (v[j].x * v[j].x + v[j].y * v[j].y) + (v[j].z * v[j].z + v[j].w * v[j].w); }
    const float rstd = 1.0f / sqrtf(wave_sum(s) * (1.0f / DM) + 1e-6f);
#pragma unroll
    for (int j = 0; j < 8; ++j) { const f32x4 a = *((const GAS f32x4*)g + lane + 64 * j); xr[64 * j] = v[j] * rstd * a; }
}

__device__ __forceinline__ void qkpost_row(bf16* qkv_row, int row, bool is_ax, const float* qg, const float* kg, float* state_k, int lane) {
    const bool is_lat = row >= NCTX;
    const int hsub = lane >> 4, a = (lane >> 3) & 1, i0 = (lane & 7) * 4;
    float cs[4], sn[4];
    if (is_lat) { const int t = (row - NCTX) & 2047; const float pos = (float)(a == 0 ? (t >> 6) : (t & 63));
#pragma unroll
        for (int e = 0; e < 4; ++e) { const float inv = expf(-(float)(i0 + e) * (9.210340371976184f / 32.0f)); sn[e] = sinf(pos * inv); cs[e] = cosf(pos * inv); } }
#pragma unroll
    for (int grp = 0; grp < 5; ++grp) {
        const int head = 4 * grp + hsub;
        bf16* base = qkv_row + head * 128 + a * 64 + i0;
        const v2u r1 = *(const GAS v2u*)base, r2 = *(const GAS v2u*)(base + 32);
        float x1[4] = {bflo(r1.x), bfhi(r1.x), bflo(r1.y), bfhi(r1.y)}, x2[4] = {bflo(r2.x), bfhi(r2.x), bflo(r2.y), bfhi(r2.y)};
        if (is_ax) {
            float ss = 0.f;
#pragma unroll
            for (int e = 0; e < 4; ++e) ss += x1[e] * x1[e] + x2[e] * x2[e];
            ss += __shfl_xor(ss, 1); ss += __shfl_xor(ss, 2); ss += __shfl_xor(ss, 4); ss += __shfl_xor(ss, 8);
            const float rstd = 1.0f / sqrtf(ss * (1.0f / 128.0f) + 1e-6f);
            const float* G = (head < 16 ? qg : kg) + a * 64 + i0;
#pragma unroll
            for (int e = 0; e < 4; ++e) { x1[e] = x1[e] * rstd * G[e]; x2[e] = x2[e] * rstd * G[32 + e]; }
        }
        if (is_lat) {
#pragma unroll
            for (int e = 0; e < 4; ++e) { const float y1 = x1[e] * cs[e] - x2[e] * sn[e], y2 = x2[e] * cs[e] + x1[e] * sn[e]; x1[e] = y1; x2[e] = y2; }
        }
        if (is_ax || is_lat) { v2u w1, w2; w1.x = pk2(x1[0], x1[1]); w1.y = pk2(x1[2], x1[3]); w2.x = pk2(x2[0], x2[1]); w2.y = pk2(x2[2], x2[3]);
            *(GAS v2u*)base = w1; *(GAS v2u*)(base + 32) = w2; }
        if (is_ax && !is_lat && head >= 16) { float* sp = state_k + (size_t)row * 512 + (head - 16) * 128 + a * 64 + i0;
            *(GAS f32x4*)sp = (f32x4){x1[0], x1[1], x1[2], x1[3]}; *(GAS f32x4*)(sp + 32) = (f32x4){x2[0], x2[1], x2[2], x2[3]}; }
    }
}

namespace hy {
constexpr int CPY_STRIDE = 8480;
constexpr int U_OFF = 8 * CPY_STRIDE;
constexpr int U_BYTES = 6144;
static_assert(U_OFF + 8 * U_BYTES <= RING_BYTES, "hyena LDS map");

__device__ __forceinline__ void build_copies(LAS unsigned char* lds, const bf16* ft, int L, int tid) {
    if (tid < 264) { const int c = tid / 33, e = tid % 33; const int qq = (e < 17 - c) ? e : 2 * L + 16 - c + (e - (17 - c));
        *(LAS unsigned short*)(lds + c * CPY_STRIDE + qq * 2) = 0; }
    if (tid < 2 * L / 8) { const int side = tid / (L / 8), t8 = (tid % (L / 8)) * 8;
        const v4u raw = *(const GAS v4u*)(ft + (size_t)side * L + t8);
        const unsigned wds[4] = {raw.x, raw.y, raw.z, raw.w};
#pragma unroll
        for (int e = 0; e < 8; ++e) { const int t = t8 + e; const unsigned short val = (unsigned short)((e & 1) ? (wds[e >> 1] >> 16) : (wds[e >> 1] & 0xffffu));
            if (!(side == 1 && t == 0)) { const int p = side == 0 ? L - t : L + t;
#pragma unroll
                for (int c = 0; c < 8; ++c) *(LAS unsigned short*)(lds + c * CPY_STRIDE + (p + 16 - c) * 2) = val; } } }
}
__device__ __forceinline__ void fill_u(LAS unsigned char* ub, const bf16* urow, int L, float w0, float w1, float w2, float bb, int lane) {
    { const int e0 = lane < 32 ? lane * 8 : L + 256 + (lane - 32) * 8; *(LAS v4u*)(ub + e0 * 2) = (v4u){0u, 0u, 0u, 0u}; }
    for (int q = lane; q < L / 8; q += 64) { const int s0 = 8 * q;
        const v4u raw = *(const GAS v4u*)(urow + s0);
        const float prev = s0 > 0 ? bf2f(urow[s0 - 1]) : 0.f, next = s0 + 8 < L ? bf2f(urow[s0 + 8]) : 0.f;
        const float x[10] = {prev, bflo(raw.x), bfhi(raw.x), bflo(raw.y), bfhi(raw.y), bflo(raw.z), bfhi(raw.z), bflo(raw.w), bfhi(raw.w), next};
        float y[8];
#pragma unroll
        for (int j = 0; j < 8; ++j) y[j] = w0 * x[j] + w1 * x[j + 1] + w2 * x[j + 2] + bb;
        v4u o; o.x = pk2(y[0], y[1]); o.y = pk2(y[2], y[3]); o.z = pk2(y[4], y[5]); o.w = pk2(y[6], y[7]);
        *(LAS v4u*)(ub + (256 + s0) * 2) = o; }
}
template <int NT>
__device__ __forceinline__ void toeplitz(const LAS unsigned char* cpy, const LAS unsigned char* ub, f32x4 (&acc)[NT], int lane) {
    constexpr int L = 256 * NT;
    const int i = lane & 15, g = lane >> 4, c = (-i) & 7;
    const LAS unsigned char* ap = cpy + c * CPY_STRIDE + 2 * (L + 8 * g + 16 - i - c);
    const LAS unsigned char* bp = ub + 2 * (256 + 8 * g + 16 * i);
#pragma unroll 2
    for (int S = -256; S <= L - 32; S += 32) {
        const bf16x8 b = *(const LAS bf16x8*)(bp + 2 * S);
        bf16x8 a[NT];
#pragma unroll
        for (int k = 0; k < NT; ++k) a[k] = *(const LAS bf16x8*)(ap + 2 * S - 512 * k);
#pragma unroll
        for (int k = 0; k < NT; ++k) acc[k] = __builtin_amdgcn_mfma_f32_16x16x32_bf16(a[k], b, acc[k], 0, 0, 0);
    }
}
template <int NT>
__device__ __forceinline__ void gate(const f32x4 (&acc)[NT], LAS unsigned char* ub, const bf16* xg, float cw0, float cw1, float cw2, float cb, float invn, float skip, int lane, bool last, bf16* zt) {
    constexpr int L = 256 * NT;
    const int sg = lane & 15, g = lane >> 4;
#pragma unroll
    for (int k = 0; k < NT; ++k) { const int t0 = 256 * k + 16 * sg + 4 * g;
        const v2u ur = *(const LAS v2u*)(ub + (256 + t0) * 2);
        const v2u xr = *(const GAS v2u*)(xg + t0);
        const float prev = t0 > 0 ? bf2f(xg[t0 - 1]) : 0.f, next = t0 + 4 < L ? bf2f(xg[t0 + 4]) : 0.f;
        const float x[6] = {prev, bflo(xr.x), bfhi(xr.x), bflo(xr.y), bfhi(xr.y), next};
        const float uu[4] = {bflo(ur.x), bfhi(ur.x), bflo(ur.y), bfhi(ur.y)};
        float z[4];
#pragma unroll
        for (int r = 0; r < 4; ++r) { const float xc = cw0 * x[r] + cw1 * x[r + 1] + cw2 * x[r + 2] + cb; z[r] = xc * (acc[k][r] * invn + skip * uu[r]); }
        v2u o; o.x = pk2(z[0], z[1]); o.y = pk2(z[2], z[3]);
        if (last) *(GAS v2u*)(zt + t0) = o; else *(LAS v2u*)(ub + (256 + t0) * 2) = o; }
}

constexpr int USH_STR = 4416;
__device__ __forceinline__ int ush_base(int b) { return b * USH_STR + (b >> 2) * 16; }
static_assert(U_OFF + 8 * USH_STR + 64 <= RING_BYTES, "hyena LDS map (shared u)");

__device__ __forceinline__ void build_copies2(LAS unsigned char* lds, const bf16* ft, int L, int ztop, int tid) {
    const int nz = ztop - 2 * L + 1;
    for (int z = tid; z < 8 * nz; z += 512) { const int c = z / nz, e = z % nz; const int qq = (e < 17 - c) ? e : 2 * L + 16 - c + (e - (17 - c));
        *(LAS unsigned short*)(lds + c * CPY_STRIDE + qq * 2) = 0; }
    for (int idx = tid; idx < 2 * L; idx += 512) { const int side = idx >= L ? 1 : 0, t = idx - side * L;
        if (!(side == 1 && t == 0)) { const unsigned short val = *(const GAS unsigned short*)(ft + idx); const int p = side ? L + t : L - t;
#pragma unroll
            for (int c = 0; c < 8; ++c) *(LAS unsigned short*)(lds + c * CPY_STRIDE + (p + 16 - c) * 2) = val; } }
}
__device__ __forceinline__ void fill_coop(LAS unsigned char* ush, const bf16* urow_ch, float w0, float w1, float w2, float bb, int tid) {
    for (int z = tid; z < 160; z += 512) { const int b = z / 20, e = z % 20; const int el = e < 4 ? e * 8 : 2080 + (e - 4) * 8;
        *(LAS v4u*)(ush + ush_base(b) + el * 2) = (v4u){0u, 0u, 0u, 0u}; }
#pragma unroll 1
    for (int ch = tid; ch < 2048; ch += 512) { const int b = ch >> 8, s0 = (ch & 255) * 8; const bf16* urow = urow_ch + b * 2048;
        const v4u raw = *(const GAS v4u*)(urow + s0);
        const float prev = s0 > 0 ? bf2f(*(const GAS bf16*)(urow + s0 - 1)) : 0.f, next = s0 + 8 < 2048 ? bf2f(*(const GAS bf16*)(urow + s0 + 8)) : 0.f;
        const float x[10] = {prev, bflo(raw.x), bfhi(raw.x), bflo(raw.y), bfhi(raw.y), bflo(raw.z), bfhi(raw.z), bflo(raw.w), bfhi(raw.w), next};
        float y[8];
#pragma unroll
        for (int j = 0; j < 8; ++j) y[j] = w0 * x[j] + w1 * x[j + 1] + w2 * x[j + 2] + bb;
        v4u o; o.x = pk2(y[0], y[1]); o.y = pk2(y[2], y[3]); o.z = pk2(y[4], y[5]); o.w = pk2(y[6], y[7]);
        *(LAS v4u*)(ush + ush_base(b) + 2 * (32 + s0)) = o; }
}
__device__ __forceinline__ void toeplitz_coop(const LAS unsigned char* cpy, const LAS unsigned char* ush, f32x4 (&acc)[8], int wave, int lane) {
    constexpr int L = 2048;
    const int i = lane & 15, g = lane >> 4, c = (-i) & 7, bb = i & 7, sg = i >> 3;
    const LAS unsigned char* aq = cpy + c * CPY_STRIDE + 2 * (L + 8 * g + 16 - i - c) - 64 * (8 * wave - 2);
    const LAS unsigned char* bq = ush + ush_base(bb) + 2 * (32 + 8 * g + 16 * sg) - 64;
#pragma unroll 1
    for (int q = 0; q < 17; ++q) {
        bf16x8 A[11], Bf[4];
#pragma unroll
        for (int m = 0; m < 11; ++m) A[m] = *(const LAS bf16x8*)(aq - 64 * m);
#pragma unroll
        for (int b4 = 0; b4 < 4; ++b4) Bf[b4] = *(const LAS bf16x8*)(bq + 64 * b4);
#pragma unroll
        for (int b4 = 0; b4 < 4; ++b4)
#pragma unroll
            for (int a = 0; a < 8; ++a) acc[a] = __builtin_amdgcn_mfma_f32_16x16x32_bf16(A[a - b4 + 3], Bf[b4], acc[a], 0, 0, 0);
        aq += 256; bq += 256;
    }
}
__device__ __forceinline__ void gate_coop(const f32x4 (&acc)[8], LAS unsigned char* ush, const bf16* xg_ch, float cw0, float cw1, float cw2, float cb, float invn, float skip, int wave, int lane, bool last, bf16* zt_ch) {
    const int i = lane & 15, g = lane >> 4, bb = i & 7, sg = i >> 3;
    const bf16* xg = xg_ch + bb * 2048; bf16* zt = zt_ch + bb * 2048; LAS unsigned char* ub = ush + ush_base(bb);
#pragma unroll
    for (int a = 0; a < 8; ++a) { const int t0 = 32 * (8 * wave + a) + 16 * sg + 4 * g;
        const v2u ur = *(const LAS v2u*)(ub + (32 + t0) * 2);
        const v2u xr = *(const GAS v2u*)(xg + t0);
        const float prev = t0 > 0 ? bf2f(*(const GAS bf16*)(xg + t0 - 1)) : 0.f, next = t0 + 4 < 2048 ? bf2f(*(const GAS bf16*)(xg + t0 + 4)) : 0.f;
        const float x[6] = {prev, bflo(xr.x), bfhi(xr.x), bflo(xr.y), bfhi(xr.y), next};
        const float uu[4] = {bflo(ur.x), bfhi(ur.x), bflo(ur.y), bfhi(ur.y)};
        float z[4];
#pragma unroll
        for (int r = 0; r < 4; ++r) { const float xc = cw0 * x[r] + cw1 * x[r + 1] + cw2 * x[r + 2] + cb; z[r] = xc * (acc[a][r] * invn + skip * uu[r]); }
        v2u o; o.x = pk2(z[0], z[1]); o.y = pk2(z[2], z[3]);
        if (last) *(GAS v2u*)(zt + t0) = o; else *(LAS v2u*)(ub + (32 + t0) * 2) = o; }
}

struct GPre { v2u xr; unsigned pn; };
struct FPre { v4u raw; unsigned pn; };
constexpr int ZTOP_L = 2 * 2048 + 136, ZTOP_C = 2 * 256 + 32;

template <int NTAP> __device__ __forceinline__ void taps_load(unsigned (&tp)[NTAP], const bf16* ft, int L, int tid) {
#pragma unroll
    for (int e = 0; e < NTAP; ++e) { const int idx = tid + 512 * e; tp[e] = idx < 2 * L ? (unsigned)*(const GAS unsigned short*)(ft + idx) : 0u; }
}
template <int NTAP> __device__ __forceinline__ void copies_write(LAS unsigned char* lds, const unsigned (&tp)[NTAP], int L, int ztop, int tid) {
    const int nz = ztop - 2 * L + 1;
    for (int z = tid; z < 8 * nz; z += 512) { const int c = z / nz, e = z % nz; const int qq = (e < 17 - c) ? e : 2 * L + 16 - c + (e - (17 - c));
        *(LAS unsigned short*)(lds + c * CPY_STRIDE + qq * 2) = 0; }
#pragma unroll
    for (int e = 0; e < NTAP; ++e) { const int idx = tid + 512 * e;
        if (idx < 2 * L) { const int side = idx >= L ? 1 : 0, t = idx - side * L;
            if (!(side == 1 && t == 0)) { const int p = side ? L + t : L - t;
#pragma unroll
                for (int c = 0; c < 8; ++c) *(LAS unsigned short*)(lds + c * CPY_STRIDE + (p + 16 - c) * 2) = (unsigned short)tp[e]; } } }
}
__device__ __forceinline__ void conv8_store(LAS unsigned char* dst, const FPre& f, float w0, float w1, float w2, float bb) {
    const float x[10] = {bflo(f.pn), bflo(f.raw.x), bfhi(f.raw.x), bflo(f.raw.y), bfhi(f.raw.y), bflo(f.raw.z), bfhi(f.raw.z), bflo(f.raw.w), bfhi(f.raw.w), bfhi(f.pn)};
    float y[8];
#pragma unroll
    for (int j = 0; j < 8; ++j) y[j] = w0 * x[j] + w1 * x[j + 1] + w2 * x[j + 2] + bb;
    v4u o; o.x = pk2(y[0], y[1]); o.y = pk2(y[2], y[3]); o.z = pk2(y[4], y[5]); o.w = pk2(y[6], y[7]);
    *(LAS v4u*)dst = o;
}
__device__ __forceinline__ void fpre_load(FPre& f, const bf16* urow, int s0, int L) {
    f.raw = *(const GAS v4u*)(urow + s0);
    const unsigned p = s0 > 0 ? (unsigned)*(const GAS unsigned short*)(urow + s0 - 1) : 0u, n = s0 + 8 < L ? (unsigned)*(const GAS unsigned short*)(urow + s0 + 8) : 0u;
    f.pn = p | (n << 16);
}
__device__ __forceinline__ void fill_coop_load(FPre (&fp)[4], const bf16* urow_ch, int tid) {
#pragma unroll
    for (int q = 0; q < 4; ++q) { const int ch = tid + 512 * q, b = ch >> 8, s0 = (ch & 255) * 8; fpre_load(fp[q], urow_ch + b * 2048, s0, 2048); }
}
__device__ __forceinline__ void fill_coop_write(LAS unsigned char* ush, const FPre (&fp)[4], float w0, float w1, float w2, float bb, int tid) {
    for (int z = tid; z < 160; z += 512) { const int b = z / 20, e = z % 20; const int el = e < 4 ? e * 8 : 2080 + (e - 4) * 8;
        *(LAS v4u*)(ush + ush_base(b) + el * 2) = (v4u){0u, 0u, 0u, 0u}; }
#pragma unroll
    for (int q = 0; q < 4; ++q) { const int ch = tid + 512 * q, b = ch >> 8, s0 = (ch & 255) * 8; conv8_store(ush + ush_base(b) + 2 * (32 + s0), fp[q], w0, w1, w2, bb); }
}
__device__ __forceinline__ void fill_ctx_load(FPre (&fp)[2], const bf16* urow_wave, int lane) {
#pragma unroll
    for (int j = 0; j < 2; ++j) { const int q = 2 * (lane >> 5) + j, s0 = (lane & 31) * 8; fpre_load(fp[j], urow_wave + q * 256, s0, 256); }
}
__device__ __forceinline__ void fill_ctx_write(LAS unsigned char* ubw, const FPre (&fp)[2], float w0, float w1, float w2, float bb, int lane) {
    const int e0 = lane < 32 ? lane * 8 : 512 + (lane - 32) * 8;
#pragma unroll
    for (int q = 0; q < 4; ++q) *(LAS v4u*)(ubw + q * 1536 + e0 * 2) = (v4u){0u, 0u, 0u, 0u};
#pragma unroll
    for (int j = 0; j < 2; ++j) { const int q = 2 * (lane >> 5) + j, s0 = (lane & 31) * 8; conv8_store(ubw + q * 1536 + (256 + s0) * 2, fp[j], w0, w1, w2, bb); }
}
__device__ __forceinline__ void gpre_load(GPre& p, const bf16* xg, int t0, int L) {
    p.xr = *(const GAS v2u*)(xg + t0);
    const unsigned a = t0 > 0 ? (unsigned)*(const GAS unsigned short*)(xg + t0 - 1) : 0u, n = t0 + 4 < L ? (unsigned)*(const GAS unsigned short*)(xg + t0 + 4) : 0u;
    p.pn = a | (n << 16);
}
__device__ __forceinline__ void gate4(const f32x4& y, const GPre& p, LAS unsigned char* up, float cw0, float cw1, float cw2, float cb, float invn, float skip, bool last, bf16* zp) {
    const v2u ur = *(const LAS v2u*)up;
    const float x[6] = {bflo(p.pn), bflo(p.xr.x), bfhi(p.xr.x), bflo(p.xr.y), bfhi(p.xr.y), bfhi(p.pn)};
    const float uu[4] = {bflo(ur.x), bfhi(ur.x), bflo(ur.y), bfhi(ur.y)};
    float z[4];
#pragma unroll
    for (int r = 0; r < 4; ++r) { const float xc = cw0 * x[r] + cw1 * x[r + 1] + cw2 * x[r + 2] + cb; z[r] = xc * (y[r] * invn + skip * uu[r]); }
    v2u o; o.x = pk2(z[0], z[1]); o.y = pk2(z[2], z[3]);
    if (last) *(GAS v2u*)zp = o; else *(LAS v2u*)up = o;
}
__device__ __forceinline__ void gate_coop_load(GPre (&pre)[8], const bf16* xg_ch, int wave, int lane) {
    const int i = lane & 15, g = lane >> 4, bb = i & 7, sg = i >> 3;
#pragma unroll
    for (int a = 0; a < 8; ++a) gpre_load(pre[a], xg_ch + bb * 2048, 32 * (8 * wave + a) + 16 * sg + 4 * g, 2048);
}
__device__ __forceinline__ void gate_coop_apply(const f32x4 (&acc)[8], const GPre (&pre)[8], LAS unsigned char* ush, float cw0, float cw1, float cw2, float cb, float invn, float skip, int wave, int lane, bool last, bf16* zt_ch) {
    const int i = lane & 15, g = lane >> 4, bb = i & 7, sg = i >> 3;
#pragma unroll
    for (int a = 0; a < 8; ++a) { const int t0 = 32 * (8 * wave + a) + 16 * sg + 4 * g;
        gate4(acc[a], pre[a], ush + ush_base(bb) + (32 + t0) * 2, cw0, cw1, cw2, cb, invn, skip, last, zt_ch + bb * 2048 + t0);
        __builtin_amdgcn_sched_barrier(0); }
}
__device__ __forceinline__ void toeplitz_ctx4(const LAS unsigned char* cpy, const LAS unsigned char* ubw, f32x4 (&acc)[4], int lane) {
    const int i = lane & 15, g = lane >> 4, c = (-i) & 7;
    const LAS unsigned char* ap = cpy + c * CPY_STRIDE + 2 * (256 + 8 * g + 16 - i - c);
    const LAS unsigned char* bp = ubw + 2 * (256 + 8 * g + 16 * i);
#pragma unroll 2
    for (int S = -256; S <= 224; S += 32) {
        const bf16x8 a = *(const LAS bf16x8*)(ap + 2 * S);
        bf16x8 b[4];
#pragma unroll
        for (int q = 0; q < 4; ++q) b[q] = *(const LAS bf16x8*)(bp + 1536 * q + 2 * S);
#pragma unroll
        for (int q = 0; q < 4; ++q) acc[q] = __builtin_amdgcn_mfma_f32_16x16x32_bf16(a, b[q], acc[q], 0, 0, 0);
    }
}
__device__ __forceinline__ void gate_ctx_load(GPre (&pre)[4], const bf16* xg_wave, int lane) {
    const int t0 = 16 * (lane & 15) + 4 * (lane >> 4);
#pragma unroll
    for (int q = 0; q < 4; ++q) gpre_load(pre[q], xg_wave + q * 256, t0, 256);
}
__device__ __forceinline__ void gate_ctx_apply(const f32x4 (&acc)[4], const GPre (&pre)[4], LAS unsigned char* ubw, float cw0, float cw1, float cw2, float cb, float invn, float skip, int lane, bool last, bf16* zt_wave) {
    const int t0 = 16 * (lane & 15) + 4 * (lane >> 4);
#pragma unroll
    for (int q = 0; q < 4; ++q) { gate4(acc[q], pre[q], ubw + q * 1536 + (256 + t0) * 2, cw0, cw1, cw2, cb, invn, skip, last, zt_wave + q * 256 + t0); __builtin_amdgcn_sched_barrier(0); }
}
}

constexpr int NPHASE = 35;
#ifndef PHMASK
#define PHMASK 0xFFFF
#endif
#define PHON(b) ((PHMASK >> (b)) & 1)
#ifndef REPMASK
#define REPMASK 0
#endif
#ifndef REPN
#define REPN 2
#endif
#define RSCALE (r_ == 0 ? 1.0f : 0.0f)
#define RUN(b, call) do { _Pragma("unroll 1") for (int r_ = 0; r_ < (((REPMASK >> (b)) & 1) ? REPN : 1); ++r_) { call; } } while (0)
#ifndef MK_PER_PHASE
#define MK_PER_PHASE 0
#endif


template <class T> __device__ __forceinline__ T* launder(T* p) { GAS T* q = (GAS T*)p; asm volatile("" : "+s"(q)); return (T*)q; }
#define ENV_IDS int tid_ = threadIdx.x; asm volatile("" : "+v"(tid_)); const int tid = tid_, lane = tid & 63, wave = __builtin_amdgcn_readfirstlane(tid >> 6); const int G = gridDim.x, bx = blockIdx.x; \
    const int vcu = (G % 8 == 0) ? (bx % 8) * (G / 8) + bx / 8 : bx; const int gw = vcu * NWAVES + wave, NGW = G * NWAVES; (void)tid; (void)lane; (void)gw; (void)NGW; (void)bx;
#define ENV_PTRS unsigned char* ws = launder(A.ws); float* out = launder(A.out); (void)out; (void)ws;

__device__ __forceinline__ void ph_prologue_a(const Args& A, LAS unsigned char* L) {
    ENV_IDS ENV_PTRS
    LAS float* wscr = (LAS float*)(L + wave * 16384);
    for (int u = gw; u < 1536; u += NGW) adaln_partial_unit(A, __builtin_amdgcn_readfirstlane(u), wscr, lane);
    for (int rr = NGW - 1 - gw; rr < 2304; rr += NGW) filter_a2_row(A, __builtin_amdgcn_readfirstlane(rr), lane);
}
__device__ __forceinline__ void ph_prologue_b(const Args& A, LAS unsigned char* L) {
    ENV_IDS ENV_PTRS
    LAS float* wscr = (LAS float*)(L + wave * 16384);
    float* MODF = (float*)(ws + WS_MODF);
    for (int e = gw * 64 + lane; e < DEPTH * 9 * DM; e += NGW * 64) { const int layer = e / (9 * DM), c = (e / DM) % 9, col = e % DM;
        float m[6];
#pragma unroll
        for (int q = 0; q < 6; ++q) { float s = GIN(11)[(size_t)layer * 12288 + q * DM + col];
#pragma unroll
            for (int kc = 0; kc < 8; ++kc) s += ((const float*)(ws + WS_MODP))[(size_t)((layer * 8 + kc) * 9 + c) * 12288 + q * DM + col];
            m[q] = s; }
        float* mf = MODF + (size_t)((layer * 9 + c) * 6) * DM + col;
        mf[0 * DM] = GIN(8)[layer * DM + col] * (1.0f + m[1]); mf[1 * DM] = m[0]; mf[2 * DM] = m[2];
        mf[3 * DM] = GIN(9)[layer * DM + col] * (1.0f + m[4]); mf[4 * DM] = m[3]; mf[5 * DM] = m[5]; }
    for (int u = gw; u < 2304; u += NGW) filter_hf_unit(A, __builtin_amdgcn_readfirstlane(u), wscr, lane);
    for (int it = gw; it < IT_TOTAL; it += NGW) weight_item(A, it, wscr, lane);
    { const size_t NCH = (size_t)2 * 524288 + 2 * 262144;
      for (size_t ch = (size_t)gw * 64 + lane; ch < NCH; ch += (size_t)NGW * 64) {
          int ten; size_t off; unsigned char* dstb;
          if (ch < 524288) { ten = 0; off = ch * 8; dstb = ws + WS_CWK; } else if (ch < 1048576) { ten = 1; off = (ch - 524288) * 8; dstb = ws + WS_CWV; }
          else if (ch < 1310720) { ten = 2; off = (ch - 1048576) * 8; dstb = ws + WS_CAK; } else { ten = 3; off = (ch - 1310720) * 8; dstb = ws + WS_CAV; }
          const float* src = GIN(2 + ten) + off; const f32x4 a = *(const GAS f32x4*)src, b = *(const GAS f32x4*)(src + 4);
          v4u o; o.x = pk2(a.x, a.y); o.y = pk2(a.z, a.w); o.z = pk2(b.x, b.y); o.w = pk2(b.z, b.w);
          *(GAS v4u*)((bf16*)dstb + off) = o; } }
}
__device__ __forceinline__ void ph_norm(const Args& A, int layer, int which) {
    ENV_IDS ENV_PTRS
    const float* modf = (const float*)(ws + WS_MODF) + (size_t)layer * 9 * 6 * DM; bf16* HB = (bf16*)(ws + WS_H);
    const float* xc = (layer == 0 && which == 0) ? GIN(0) : out; const float* xl = (layer == 0 && which == 0) ? GIN(1) : out + (size_t)NCTX * DM;
    if (layer == 0 && which == 0) {
        const float* NP = (const float*)(ws + WS_NP); float* INV = (float*)(ws + WS_INV);
        for (int e = gw * 64 + lane; e < 4 * DM; e += NGW * 64) { const int variant = e >> 12, o = (e >> 11) & 1, d = e & 2047; float s = 0.f;
            const int c0 = variant ? 16 : 0, c1 = variant ? 18 : 16;
            for (int ch = c0; ch < c1; ++ch) s += NP[(size_t)ch * 8192 + o * 2048 + d] + NP[(size_t)ch * 8192 + 4096 + o * 2048 + d];
            INV[e] = 1.0f / (s + 1e-6f); } }
    const int per = (NTOK + NGW - 1) / NGW, r0 = gw * per, r1 = (r0 + per < NTOK) ? r0 + per : NTOK;
    int cur = -1; f32x4 ma[8], mb[8];
#pragma unroll 1
    for (int row = r0; row < r1; ++row) { const int cv = row < NCTX ? 0 : 1 + ((row - NCTX) >> 11);
        if (cv != cur) { cur = cv; const GAS f32x4* pa = (const GAS f32x4*)(modf + (size_t)(cv * 6 + 3 * which) * DM) + lane; const GAS f32x4* pb = (const GAS f32x4*)(modf + (size_t)(cv * 6 + 3 * which + 1) * DM) + lane;
#pragma unroll
            for (int j = 0; j < 8; ++j) { ma[j] = pa[64 * j]; mb[j] = pb[64 * j]; } }
        const float* xr = row < NCTX ? xc + (size_t)row * DM : xl + (size_t)(row - NCTX) * DM;
        norm_row(xr, ma, mb, HB + (size_t)row * DM, lane); }
}
__device__ __forceinline__ void ph_qkv(const Args& A, int layer, LAS unsigned char* L) {
    ENV_PTRS
    const int G = gridDim.x, bx = blockIdx.x; const bool is_ax = (layer % 3) == 2; const int jx = layer / 3;
    const bf16* W = (const bf16*)(ws + (is_ax ? WS_WQKVA : (jx == 0 ? WS_WQKV0 : WS_WQKV1)));
    pg8::Gemm g{(const bf16*)(ws + WS_H), W, NTOK, QKVD, DM}; pg8::StaticOrder S; S.init(NTOK, QKVD, G, bx);
    pg8::EpiQKV E{(bf16*)(ws + WS_BIG), is_ax ? nullptr : out + OUT_WK + (size_t)jx * 256 * 512, is_ax ? out + OUT_AV : out + OUT_WV + (size_t)jx * 256 * 512, is_ax ? 0 : 256};
    pg8::gemm_phase<pg8::EpiQKV, pg8::StaticOrder, true, true>(L, g, S, E);
}
__device__ __forceinline__ void ph_qkpost(const Args& A, int layer) {
    ENV_IDS ENV_PTRS
    const bool is_ax = (layer % 3) == 2; bf16* QKVB = (bf16*)(ws + WS_BIG);
    for (int row = (is_ax ? 0 : NCTX) + gw; row < NTOK; row += NGW)
        qkpost_row(QKVB + (size_t)row * QKVD, row, is_ax, GIN(27), GIN(28), out + OUT_AK, lane);
}
__device__ __forceinline__ void ph_attn(const Args& A, int layer, LAS char* lds) {
    ENV_PTRS
    const int G = gridDim.x, bx = blockIdx.x; const bool is_ax = (layer % 3) == 2; const int jx = layer / 3;
    const att::bf16* QK = (const att::bf16*)(ws + WS_BIG); att::bf16* OB = (att::bf16*)(ws + WS_H);
    const att::bf16* CK = (const att::bf16*)(ws + (is_ax ? WS_CAK : WS_CWK));
    const att::bf16* CV = (const att::bf16*)(ws + (is_ax ? WS_CAV : WS_CWV));
    const int ncl = is_ax ? 1 : 2;
#pragma unroll 1
    for (int u = bx; u < 1536; u += G) {
        att::Unit U;
        if (u < 1024) { const int b = u >> 7, qb = (u >> 4) & 7, h = u & 15, kvh = h >> 2;
            const size_t r0 = (size_t)NCTX + (size_t)b * 2048 + (size_t)qb * 256;
            U.Q = QK + r0 * QKVD + h * 128; U.ldq = QKVD;
            const size_t coff = ((size_t)(b * ncl + (is_ax ? 0 : jx)) * 512) * 512 + kvh * 128;
            U.KA = CK + coff; U.VA = CV + coff; U.ldA = 512; U.nA = 8;
            const int klo = is_ax ? 0 : (qb * 256 - 128 < 0 ? 0 : qb * 256 - 128), khi = is_ax ? 2048 : (qb * 256 + 384 > 2048 ? 2048 : qb * 256 + 384);
            const size_t kr0 = (size_t)NCTX + (size_t)b * 2048 + klo;
            U.KB = QK + kr0 * QKVD + 2048 + kvh * 128; U.VB = QK + kr0 * QKVD + 2560 + kvh * 128; U.ldB = QKVD;
            U.NT = 8 + (khi - klo) / 64; U.win = is_ax ? 0 : 1; U.dq0 = qb * 256 - klo;
            U.O = OB + r0 * DM + h * 128; U.ldo = DM;
            U.has_sink = is_ax ? 0 : 1; U.sink = is_ax ? 0.f : GIN(14)[jx * 16 + h];
        } else { const int uc = u - 1024, b = uc >> 4, h = uc & 15, kvh = h >> 2; const size_t r0 = (size_t)b * 256;
            U.Q = QK + r0 * QKVD + h * 128; U.ldq = QKVD;
            U.KA = QK + r0 * QKVD + 2048 + kvh * 128; U.VA = QK + r0 * QKVD + 2560 + kvh * 128; U.ldA = QKVD; U.nA = 4;
            U.KB = U.KA; U.VB = U.VA; U.ldB = QKVD; U.NT = 4; U.win = 0; U.dq0 = 0;
            U.O = OB + r0 * DM + h * 128; U.ldo = DM;
            U.has_sink = is_ax ? 0 : 1; U.sink = is_ax ? 0.f : GIN(14)[jx * 16 + h];
        }
        att::attn_unit(U, lds);
    }
}
__device__ __forceinline__ void ph_hyin(const Args& A, LAS unsigned char* L) {
    ENV_PTRS
    const int G = gridDim.x, bx = blockIdx.x;
    pg8::Gemm g{(const bf16*)(ws + WS_WHI), (const bf16*)(ws + WS_H), 6144, NTOK, DM}; pg8::StaticOrder S; S.init(6144, NTOK, G, bx);
    pg8::EpiBf16 E{(bf16*)(ws + WS_BIG), NTOK};
    pg8::gemm_phase<pg8::EpiBf16, pg8::StaticOrder, true, true>(L, g, S, E);
}
__device__ __forceinline__ void ph_hyconv(const Args& A, LAS unsigned char* L) {
    ENV_IDS ENV_PTRS
    const bf16* UT = (const bf16*)(ws + WS_BIG); bf16* ZT = (bf16*)(ws + WS_ZT);
    const float* cw = GIN(16); const float* cbv = GIN(17); const float* skp = GIN(24); const float* INV = (const float*)(ws + WS_INV);
    LAS unsigned char* ush = L + hy::U_OFF; LAS unsigned char* ubw = L + hy::U_OFF + wave * hy::U_BYTES;
    const bf16* FTL = (const bf16*)(ws + WS_FT); const bf16* FTC = (const bf16*)(ws + WS_FT_CTX);
    hy::FPre fl[4]; unsigned tl0[8];
#pragma unroll 1
    for (int d = bx; d < DM; d += G) {
        float w0[3], w1[3], w2[3], cb[3];
#pragma unroll
        for (int p = 0; p < 3; ++p) { const int ch = p * DM + d; w0[p] = cw[ch]; w1[p] = cw[6144 + ch]; w2[p] = cw[2 * 6144 + ch]; cb[p] = cbv[ch]; }
        const float inl0 = INV[d], inl1 = INV[2048 + d], inc0 = INV[4096 + d], inc1 = INV[6144 + d];
        const float sk0 = skp[d], sk1 = skp[DM + d];
        const bf16* ftl = FTL + (size_t)d * 2 * 2048; const bf16* ftc = FTC + (size_t)d * 2 * 256;
        const size_t cb0 = (size_t)wave * 1024;
        hy::fill_coop_load(fl, UT + (size_t)d * NTOK + NCTX, tid); hy::taps_load<8>(tl0, ftl, 2048, tid);
        hy::fill_coop_write(ush, fl, w0[0], w1[0], w2[0], cb[0], tid); hy::copies_write<8>(L, tl0, 2048, hy::ZTOP_L, tid); __syncthreads();
        hy::GPre g0[8]; unsigned tl1[8];
        hy::taps_load<8>(tl1, ftl + (size_t)2048 * 2 * 2048, 2048, tid);
        f32x4 acc[8];
#pragma unroll
        for (int k = 0; k < 8; ++k) acc[k] = (f32x4){0.f, 0.f, 0.f, 0.f};
        hy::toeplitz_coop(L, ush, acc, wave, lane); __syncthreads();
        hy::gate_coop_load(g0, UT + (size_t)(DM + d) * NTOK + NCTX, wave, lane);
        hy::gate_coop_apply(acc, g0, ush, w0[1], w1[1], w2[1], cb[1], inl0, sk0, wave, lane, false, nullptr); hy::copies_write<8>(L, tl1, 2048, hy::ZTOP_L, tid); __syncthreads();
        hy::GPre g1[8]; hy::FPre fc[2]; unsigned tc0[1];
        hy::fill_ctx_load(fc, UT + (size_t)d * NTOK + cb0, lane); hy::taps_load<1>(tc0, ftc, 256, tid);
#pragma unroll
        for (int k = 0; k < 8; ++k) acc[k] = (f32x4){0.f, 0.f, 0.f, 0.f};
        hy::toeplitz_coop(L, ush, acc, wave, lane);
        hy::gate_coop_load(g1, UT + (size_t)(2 * DM + d) * NTOK + NCTX, wave, lane);
        hy::gate_coop_apply(acc, g1, ush, w0[2], w1[2], w2[2], cb[2], inl1, sk1, wave, lane, true, ZT + (size_t)d * NTOK + NCTX); __syncthreads();
        hy::fill_ctx_write(ubw, fc, w0[0], w1[0], w2[0], cb[0], lane); hy::copies_write<1>(L, tc0, 256, hy::ZTOP_C, tid); __syncthreads();
        hy::GPre h0[4]; unsigned tc1[1];
        hy::gate_ctx_load(h0, UT + (size_t)(DM + d) * NTOK + cb0, lane); hy::taps_load<1>(tc1, ftc + (size_t)2048 * 2 * 256, 256, tid);
        f32x4 ac4[4];
#pragma unroll
        for (int q = 0; q < 4; ++q) ac4[q] = (f32x4){0.f, 0.f, 0.f, 0.f};
        hy::toeplitz_ctx4(L, ubw, ac4, lane);
        hy::gate_ctx_apply(ac4, h0, ubw, w0[1], w1[1], w2[1], cb[1], inc0, sk0, lane, false, nullptr); __syncthreads();
        hy::copies_write<1>(L, tc1, 256, hy::ZTOP_C, tid); __syncthreads();
        hy::GPre h1[4];
        hy::gate_ctx_load(h1, UT + (size_t)(2 * DM + d) * NTOK + cb0, lane);
#pragma unroll
        for (int q = 0; q < 4; ++q) ac4[q] = (f32x4){0.f, 0.f, 0.f, 0.f};
        hy::toeplitz_ctx4(L, ubw, ac4, lane);
        hy::gate_ctx_apply(ac4, h1, ubw, w0[2], w1[2], w2[2], cb[2], inc1, sk1, lane, true, ZT + (size_t)d * NTOK + cb0); __syncthreads();
    }
}
__device__ __forceinline__ void ph_hytr(const Args& A, LAS unsigned char* L) {
    ENV_IDS ENV_PTRS
    const bf16* ZT = (const bf16*)(ws + WS_ZT); bf16* HB = (bf16*)(ws + WS_H);
    LAS unsigned char* scr = L + wave * 16384;
    for (int tile = gw; tile < 32 * 384; tile += NGW) { const int d0 = (tile & 31) * 64, r0 = (tile >> 5) * 64;
#pragma unroll
        for (int j = 0; j < 8; ++j) { const int idx = j * 64 + lane, dl = idx >> 3, ch = idx & 7;
            *(LAS v4u*)(scr + dl * 144 + ch * 16) = *(const GAS v4u*)(ZT + (size_t)(d0 + dl) * NTOK + r0 + ch * 8); }
        LDS_WAIT(); asm volatile("" ::: "memory");
#pragma unroll
        for (int j = 0; j < 8; ++j) { unsigned e[8];
#pragma unroll
            for (int q = 0; q < 8; ++q) e[q] = *(const LAS unsigned short*)(scr + (j * 8 + q) * 144 + lane * 2);
            v4u o; o.x = e[0] | (e[1] << 16); o.y = e[2] | (e[3] << 16); o.z = e[4] | (e[5] << 16); o.w = e[6] | (e[7] << 16);
            *(GAS v4u*)(HB + (size_t)(r0 + lane) * DM + d0 + j * 8) = o; }
        LDS_WAIT(); asm volatile("" ::: "memory"); }
}
__device__ __forceinline__ void ph_mixout(const Args& A, int layer, LAS unsigned char* L, float gs) {
    ENV_PTRS
    const int G = gridDim.x, bx = blockIdx.x; const int kind = layer % 3, jx = layer / 3;
    const float* modf = (const float*)(ws + WS_MODF) + (size_t)layer * 9 * 6 * DM;
    const float* xc = layer == 0 ? GIN(0) : out; const float* xl = layer == 0 ? GIN(1) : out + (size_t)NCTX * DM;
    const bf16* W = (const bf16*)(ws + (kind == 1 ? WS_WHO : (kind == 2 ? WS_WOA : (jx == 0 ? WS_WO0 : WS_WO1))));
    pg8::Gemm g{(const bf16*)(ws + WS_H), W, NTOK, DM, DM}; pg8::StaticOrder S; S.init(NTOK, DM, G, bx);
    pg8::EpiResid E{xc, xl, out, modf + 2 * DM, gs};
    pg8::gemm_phase<pg8::EpiResid, pg8::StaticOrder, true, true>(L, g, S, E);
}
__device__ __forceinline__ void ph_gu(const Args& A, int layer, LAS unsigned char* L) {
    ENV_PTRS
    const int G = gridDim.x, bx = blockIdx.x;
    pg8::Gemm g{(const bf16*)(ws + WS_H), (const bf16*)(ws + WS_WGU + (size_t)layer * W_GU), NTOK, NGU, DM}; pg8::StaticOrder S; S.init(NTOK, NGU, G, bx);
    pg8::EpiSwiglu E{(bf16*)(ws + WS_BIG)};
    pg8::gemm_phase<pg8::EpiSwiglu, pg8::StaticOrder, true, true>(L, g, S, E);
}
__device__ __forceinline__ void ph_down(const Args& A, int layer, LAS unsigned char* L, float gs) {
    ENV_PTRS
    const int G = gridDim.x, bx = blockIdx.x;
    const float* modf = (const float*)(ws + WS_MODF) + (size_t)layer * 9 * 6 * DM;
    pg8::Gemm g{(const bf16*)(ws + WS_BIG), (const bf16*)(ws + WS_WDN + (size_t)layer * W_DN), NTOK, DM, DFF}; pg8::StaticOrder S; S.init(NTOK, DM, G, bx);
    pg8::EpiResid E{out, out + (size_t)NCTX * DM, out, modf + 5 * DM, gs};
    pg8::gemm_phase<pg8::EpiResid, pg8::StaticOrder, true, true>(L, g, S, E);
}
__device__ __forceinline__ void ph_final(const Args& A) {
    ENV_IDS ENV_PTRS
    for (int row = gw; row < NTOK; row += NGW) final_norm_row(out + (size_t)row * DM, GIN(32), lane);
}

__global__ void __launch_bounds__(NWAVES * 64, 2) hybrid_fwd(Args A) {
    extern __shared__ __attribute__((aligned(16))) unsigned char lds[];
    LAS unsigned char* L = (LAS unsigned char*)lds;
    for (int u = threadIdx.x; u < (LDS_BYTES - LDSCTL_OFF) / 4; u += NWAVES * 64) ((LAS unsigned*)(L + LDSCTL_OFF))[u] = 0u;
    __syncthreads();
    XcdBarrier bar; bar.bar = (unsigned*)(A.ws + WS_CTL) + CW_BAR; bar.x = 0; bar.st = nullptr;
    if (!MK_PER_PHASE) bar = xcd_barrier_post((unsigned*)(A.ws + WS_CTL) + CW_BAR, (volatile LAS unsigned*)(L + MISC_OFF) + 8);
    const int lo = A.ph_lo, hi = A.ph_hi;
#define IN(k) (lo <= (k) && (k) < hi)
#define SEAM(k) do { if (IN(k) && IN((k) + 1)) xcd_barrier(bar); } while (0)
    if (PHON(0) && IN(0)) RUN(0, ph_prologue_a(A, L));
    SEAM(0);
    if (PHON(1) && IN(1)) RUN(1, ph_prologue_b(A, L));
    SEAM(1);
#pragma unroll 1
    for (int layer = 0; layer < DEPTH; ++layer) {
        const int pb = 2 + 8 * layer;
        if (PHON(2) && IN(pb + 0)) RUN(2, ph_norm(A, layer, 0));
        SEAM(pb + 0);
        if ((layer % 3) != 1) {
            if (PHON(3) && IN(pb + 1)) RUN(3, ph_qkv(A, layer, L));
            SEAM(pb + 1);
            if (PHON(4) && IN(pb + 2)) RUN(4, ph_qkpost(A, layer));
            SEAM(pb + 2);
            if (PHON(5) && IN(pb + 3)) RUN(5, ph_attn(A, layer, (LAS char*)L));
            SEAM(pb + 3);
        } else {
            if (PHON(6) && IN(pb + 1)) RUN(6, ph_hyin(A, L));
            SEAM(pb + 1);
            if (PHON(7) && IN(pb + 2)) RUN(7, ph_hyconv(A, L));
            SEAM(pb + 2);
            if (PHON(8) && IN(pb + 3)) RUN(8, ph_hytr(A, L));
            SEAM(pb + 3);
        }
        if (PHON(9) && IN(pb + 4)) RUN(9, ph_mixout(A, layer, L, RSCALE));
        SEAM(pb + 4);
        if (PHON(10) && IN(pb + 5)) RUN(10, ph_norm(A, layer, 1));
        SEAM(pb + 5);
        if (PHON(11) && IN(pb + 6)) RUN(11, ph_gu(A, layer, L));
        SEAM(pb + 6);
        if (PHON(12) && IN(pb + 7)) RUN(12, ph_down(A, layer, L, RSCALE));
        SEAM(pb + 7);
    }
    if (PHON(13) && IN(34)) RUN(13, ph_final(A));
#undef IN
#undef SEAM
}

extern "C" void kernel_launch(void* const* d_in, const int* in_sizes, int n_in, void* d_out, int out_size, void* d_ws, size_t ws_size, hipStream_t stream) {
    static int grid = 0;
    if (grid == 0) {
        if (n_in != 33 || (size_t)out_size != OUT_END || ws_size < WS_END) { fprintf(stderr, "kernel_launch: unexpected shapes: n_in %d out %d ws %zu (need %zu)\n", n_in, out_size, ws_size, (size_t)WS_END); grid = -1; return; }
        int dev = 0, cus = 0, per_cu = 0;
        if (hipGetDevice(&dev) != hipSuccess || hipDeviceGetAttribute(&cus, hipDeviceAttributeMultiprocessorCount, dev) != hipSuccess) { grid = -1; return; }
        if (hipFuncSetAttribute((const void*)hybrid_fwd, hipFuncAttributeMaxDynamicSharedMemorySize, LDS_BYTES) != hipSuccess) { fprintf(stderr, "kernel_launch: hipFuncSetAttribute failed\n"); grid = -1; return; }
        if (hipOccupancyMaxActiveBlocksPerMultiprocessor(&per_cu, (const void*)hybrid_fwd, NWAVES * 64, LDS_BYTES) != hipSuccess || per_cu < 1)
            fprintf(stderr, "kernel_launch: occupancy query reports %d workgroups per CU\n", per_cu);
        (void)hipGetLastError();
        grid = cus;
    }
    if (grid < 0) return;
    if (hipMemsetAsync((char*)d_ws + WS_CTL, 0, CTL_ZERO_BYTES, stream) != hipSuccess) { fprintf(stderr, "kernel_launch: memset failed\n"); return; }
    Args a{};
    for (int i = 0; i < 33; ++i) a.in[i] = (const float*)d_in[i];
    a.out = (float*)d_out; a.ws = (unsigned char*)d_ws;
#if MK_PER_PHASE
    for (int ph = 0; ph < NPHASE; ++ph) { a.ph_lo = ph; a.ph_hi = ph + 1; hipLaunchKernelGGL(hybrid_fwd, dim3(grid), dim3(NWAVES * 64), LDS_BYTES, stream, a); }
#else
    a.ph_lo = 0; a.ph_hi = NPHASE; hipLaunchKernelGGL(hybrid_fwd, dim3(grid), dim3(NWAVES * 64), LDS_BYTES, stream, a);
#endif
    const hipError_t le = hipPeekAtLastError();
    if (le != hipSuccess) fprintf(stderr, "kernel_launch: launch failed: %s\n", hipGetErrorName(le));
}
```

```cpp
#include <hip/hip_runtime.h>
#include <cstdio>
#include <cstdint>
#include <hip/hip_bf16.h>
#include <cmath>
namespace pg8 {
#define PG8_LAS __attribute__((address_space(3)))
typedef unsigned short bf16_t;
typedef short bf16x8 __attribute__((ext_vector_type(8)));
typedef float f32x4 __attribute__((ext_vector_type(4)));
typedef unsigned u32x4 __attribute__((ext_vector_type(4)));
constexpr int BM = 256, BK = 64, HALF = 128, HTB = HALF * BK * 2  , STAGE_BYTES = 8 * HTB, NXCD = 8, WGM = 8;

__host__ __device__ __forceinline__ int lds_byte(int r, int c) { const int st = (r >> 4) * 2 + (c >> 5), rr = r & 15, cc = c & 31, ob = rr * 64 + cc * 2; return st * 1024 + (ob ^ (((ob >> 9) & 1) << 5)); }
__host__ __device__ __forceinline__ void stage_rc(int b, int& R, int& C) { const int st = b / 1024, sb = b % 1024, swz = sb ^ (((sb >> 9) & 1) << 5); R = (st >> 1) * 16 + swz / 64; C = (st & 1) * 32 + (swz % 64) / 2; }
__host__ __device__ __forceinline__ int perm32(int rho) { const int n = rho >> 4, i = rho & 15; return 8 * (i >> 2) + 4 * n + (i & 3); }

struct Unit { int pm, pn; };
struct Gemm { const bf16_t* A; const bf16_t* Bt; int M, N, K; };

struct StaticOrder {
    int nM, nN, nwg, G, c;
    __host__ __device__ void init(int M, int N, int G_, int c_) { nM = M / BM; nN = N / BM; nwg = nM * nN; G = G_; c = c_; }
    __host__ __device__ bool next(int i, Unit& u) const {
        const long L = (long)i * G + c; if (L >= nwg) return false;
        int wgid = (int)L; { const int q = nwg / NXCD, r = nwg % NXCD, xcd = wgid % NXCD, off = wgid / NXCD; wgid = (xcd < r ? xcd * (q + 1) : r * (q + 1) + (xcd - r) * q) + off; }
        const int nig = WGM * nN, gid = wgid / nig, fm = gid * WGM, gsz = (nM - fm) < WGM ? (nM - fm) : WGM;
        u.pm = fm + ((wgid % nig) % gsz); u.pn = (wgid % nig) / gsz; return true;
    }
    __device__ __forceinline__ void a_ready(const Unit&) const {}
    __device__ __forceinline__ void done(const Unit&) const {}
};

__device__ __forceinline__ unsigned cvt_pk_bf16(float lo, float hi) { unsigned r; asm volatile("v_cvt_pk_bf16_f32 %0, %1, %2" : "=v"(r) : "v"(lo), "v"(hi)); return r; }
typedef float f32x2 __attribute__((ext_vector_type(2)));
struct EpiBf16 {
    static constexpr bool PERM = true, AFTER_DRAIN = false;
    bf16_t* O; int ldc;
    __device__ __forceinline__ void operator()(const f32x4 (&acc)[2][2][4][2], const Unit& u, int wr, int wc, int fr, int fq) const {
        const int row0 = u.pm * BM + wr * 64 + fr; const int col0 = u.pn * BM + wc * 32 + 8 * fq;
#pragma unroll
        for (int ai = 0; ai < 2; ++ai)
#pragma unroll
            for (int m = 0; m < 4; ++m) { bf16_t* rowp = O + (size_t)(row0 + ai * HALF + m * 16) * ldc + col0;
#pragma unroll
                for (int bj = 0; bj < 2; ++bj) { const f32x4 v0 = acc[ai][bj][m][0], v1 = acc[ai][bj][m][1];
                    u32x4 w; w.x = cvt_pk_bf16(v0[0], v0[1]); w.y = cvt_pk_bf16(v0[2], v0[3]); w.z = cvt_pk_bf16(v1[0], v1[1]); w.w = cvt_pk_bf16(v1[2], v1[3]);
                    *(u32x4*)(rowp + bj * HALF) = w; } }
    }
};
struct EpiQKV {
    static constexpr bool PERM = true, AFTER_DRAIN = false;
    bf16_t* O; float* sk; float* sv; int extra;
    __device__ __forceinline__ void operator()(const f32x4 (&acc)[2][2][4][2], const Unit& u, int wr, int wc, int fr, int fq) const {
        const int row0 = u.pm * BM + wr * 64 + fr; const int col0 = u.pn * BM + wc * 32 + 8 * fq;
        float* sb = nullptr; int scol = 0;
        if (u.pm < 32 && u.pn >= 8) { if (u.pn < 10) { sb = sk; scol = col0 - 2048; } else { sb = sv; scol = col0 - 2560; } }
#pragma unroll
        for (int ai = 0; ai < 2; ++ai)
#pragma unroll
            for (int m = 0; m < 4; ++m) { const int row = row0 + ai * HALF + m * 16; bf16_t* rowp = O + (size_t)row * 3072 + col0;
#pragma unroll
                for (int bj = 0; bj < 2; ++bj) { const f32x4 v0 = acc[ai][bj][m][0], v1 = acc[ai][bj][m][1];
                    u32x4 w; w.x = cvt_pk_bf16(v0[0], v0[1]); w.y = cvt_pk_bf16(v0[2], v0[3]); w.z = cvt_pk_bf16(v1[0], v1[1]); w.w = cvt_pk_bf16(v1[2], v1[3]);
                    *(u32x4*)(rowp + bj * HALF) = w;
                    if (sb) { float* sp = sb + (size_t)(row + (row >> 8) * extra) * 512 + scol + bj * HALF; *(f32x4*)sp = v0; *(f32x4*)(sp + 4) = v1; } } }
    }
};
struct EpiResid {
    static constexpr bool PERM = false, AFTER_DRAIN = false;
    const float* xc; const float* xl; float* out; const float* gate; float gs;
    __device__ __forceinline__ void operator()(const f32x4 (&acc)[2][2][4][2], const Unit& u, int wr, int wc, int fr, int fq) const {
        const int row0 = u.pm * BM + wr * 64 + fr; const int col0 = u.pn * BM + wc * 32 + 4 * fq;
        const int cv = u.pm < 32 ? 0 : 1 + ((u.pm - 32) >> 3);
        const float* gp = gate + (size_t)cv * (6 * 2048) + col0;
        const float* xin = u.pm < 32 ? xc + (size_t)row0 * 2048 + col0 : xl + (size_t)(row0 - 8192) * 2048 + col0;
        float* op = out + (size_t)row0 * 2048 + col0;
        f32x4 gv[2][2];
#pragma unroll
        for (int bj = 0; bj < 2; ++bj)
#pragma unroll
            for (int n = 0; n < 2; ++n) gv[bj][n] = *(const f32x4*)(gp + bj * HALF + n * 16) * gs;
#pragma unroll
        for (int ai = 0; ai < 2; ++ai)
#pragma unroll
            for (int m = 0; m < 4; ++m) { const size_t ro = (size_t)(ai * HALF + m * 16) * 2048;
#pragma unroll
                for (int bj = 0; bj < 2; ++bj)
#pragma unroll
                    for (int n = 0; n < 2; ++n) { const f32x4 x = *(const f32x4*)(xin + ro + bj * HALF + n * 16);
                        *(f32x4*)(op + ro + bj * HALF + n * 16) = x + gv[bj][n] * acc[ai][bj][m][n]; }
                if (m & 1) asm volatile("" ::: "memory"); }
    }
};
struct EpiSwiglu {
    static constexpr bool PERM = true, AFTER_DRAIN = false;
    bf16_t* O;
    __device__ __forceinline__ float sw(float g, float uu) const { return g * __builtin_amdgcn_rcpf(1.0f + __builtin_amdgcn_exp2f(-1.4426950408889634f * g)) * uu; }
    __device__ __forceinline__ void operator()(const f32x4 (&acc)[2][2][4][2], const Unit& u, int wr, int wc, int fr, int fq) const {
        const int row0 = u.pm * BM + wr * 64 + fr; const int col0 = u.pn * HALF + wc * 32 + 8 * fq;
#pragma unroll
        for (int ai = 0; ai < 2; ++ai)
#pragma unroll
            for (int m = 0; m < 4; ++m) { bf16_t* rowp = O + (size_t)(row0 + ai * HALF + m * 16) * 5632 + col0;
                const f32x4 g0 = acc[ai][0][m][0], g1 = acc[ai][0][m][1], u0 = acc[ai][1][m][0], u1 = acc[ai][1][m][1];
                u32x4 w; w.x = cvt_pk_bf16(sw(g0[0], u0[0]), sw(g0[1], u0[1])); w.y = cvt_pk_bf16(sw(g0[2], u0[2]), sw(g0[3], u0[3]));
                w.z = cvt_pk_bf16(sw(g1[0], u1[0]), sw(g1[1], u1[1])); w.w = cvt_pk_bf16(sw(g1[2], u1[2]), sw(g1[3], u1[3]));
                *(u32x4*)rowp = w; }
    }
};

template <class Epi, class Sched, bool ALIGN_EPI = false, bool SP2 = false>
__device__ __forceinline__ void gemm_phase(PG8_LAS unsigned char* lds, const Gemm g, const Sched& S, const Epi& E) {
    int tid_ = threadIdx.x; asm volatile("" : "+v"(tid_));
    const int tid = tid_, wid = __builtin_amdgcn_readfirstlane(tid >> 6), lane = tid & 63, wr = wid >> 2, wc = wid & 3, fr = lane & 15, fq = lane >> 4;
    const int K = g.K, nt = K / BK;
    unsigned voffA[2], voffB[2];
#pragma unroll
    for (int i = 0; i < 2; ++i) { int R, C; stage_rc(tid * 16 + i * 8192, R, C); const int Rb = Epi::PERM ? ((R & ~31) + perm32(R & 31)) : R;
        voffA[i] = (unsigned)(R * K + C) * 2u; voffB[i] = (unsigned)(Rb * K + C) * 2u; }
    const size_t kstep = (size_t)(BK * 2);
    const size_t hstep = (size_t)HALF * K * 2;
    const size_t tstep = 2 * hstep;
    const unsigned ldsw = (unsigned)wid * 1024u;
    const int aoff = lds_byte(wr * 64 + fr, fq * 8), boff = lds_byte(wc * 32 + fr, fq * 8);
#define PG8_SA(b, h) (((b) * 2 + (h)) * HTB)
#define PG8_SB(b, h) ((4 + (b) * 2 + (h)) * HTB)
#define PG8_STAGE(bufoff, gbase, voff) do { _Pragma("unroll") for (int _i = 0; _i < 2; ++_i) \
        __builtin_amdgcn_global_load_lds((const unsigned*)((const char*)(gbase) + (voff)[_i]), (PG8_LAS unsigned*)(lds + (bufoff) + ldsw + _i * 8192), 16, 0, 0); } while (0)
#define PG8_LDA(dst, b, h) do { _Pragma("unroll") for (int m = 0; m < 4; ++m) _Pragma("unroll") for (int k = 0; k < 2; ++k) dst[m][k] = *(const PG8_LAS bf16x8*)(lds + PG8_SA(b, h) + aoff + m * 2048 + k * 1024); } while (0)
#define PG8_LDB(dst, b, h) do { _Pragma("unroll") for (int n = 0; n < 2; ++n) _Pragma("unroll") for (int k = 0; k < 2; ++k) dst[n][k] = *(const PG8_LAS bf16x8*)(lds + PG8_SB(b, h) + boff + n * 2048 + k * 1024); } while (0)
#define PG8_MMA(ai, bj, At, Bt) do { __builtin_amdgcn_s_setprio(1); _Pragma("unroll") for (int m = 0; m < 4; ++m) _Pragma("unroll") for (int n = 0; n < 2; ++n) _Pragma("unroll") for (int k = 0; k < 2; ++k) \
        acc[ai][bj][m][n] = __builtin_amdgcn_mfma_f32_16x16x32_bf16(Bt[n][k], At[m][k], acc[ai][bj][m][n], 0, 0, 0); __builtin_amdgcn_s_setprio(0); } while (0)
#define PG8_WAIT_V(n) asm volatile("s_waitcnt vmcnt(" #n ")" ::: "memory")
#define PG8_WAIT_L(n) asm volatile("s_waitcnt lgkmcnt(" #n ")" ::: "memory")
#define PG8_BAR __builtin_amdgcn_s_barrier()
#define PG8_SCHED __builtin_amdgcn_sched_barrier(0)
    Unit cur, nxt; int ui = 0;
    if (!S.next(0, cur)) return;
    f32x4 acc[2][2][4][2];
#pragma unroll
    for (int a = 0; a < 2; ++a)
#pragma unroll
        for (int b = 0; b < 2; ++b)
#pragma unroll
            for (int m = 0; m < 4; ++m)
#pragma unroll
                for (int n = 0; n < 2; ++n) acc[a][b][m][n] = (f32x4){0.f, 0.f, 0.f, 0.f};
    bf16x8 At[4][2], B0[2][2], B1[2][2];
    const char* cA = (const char*)g.A + (size_t)cur.pm * tstep; const char* cB = (const char*)g.Bt + (size_t)cur.pn * tstep;
    S.a_ready(cur);
    if constexpr (SP2) {
        PG8_STAGE(PG8_SB(0, 0), cB, voffB); PG8_STAGE(PG8_SB(0, 1), cB + hstep, voffB); PG8_STAGE(PG8_SA(0, 0), cA, voffA); PG8_STAGE(PG8_SA(0, 1), cA + hstep, voffA);
        if (wr == 1) PG8_BAR;
        PG8_WAIT_V(2); PG8_BAR;
        PG8_STAGE(PG8_SB(1, 0), cB + kstep, voffB); PG8_STAGE(PG8_SA(1, 0), cA + kstep, voffA); PG8_STAGE(PG8_SB(1, 1), cB + hstep + kstep, voffB);
        PG8_WAIT_V(6); PG8_BAR;
    } else {
        PG8_STAGE(PG8_SB(0, 0), cB, voffB); PG8_STAGE(PG8_SA(0, 0), cA, voffA); PG8_STAGE(PG8_SB(0, 1), cB + hstep, voffB); PG8_STAGE(PG8_SA(0, 1), cA + hstep, voffA);
        if (wr == 1) PG8_BAR;
        PG8_WAIT_V(4); PG8_BAR;
        PG8_STAGE(PG8_SB(1, 0), cB + kstep, voffB); PG8_STAGE(PG8_SA(1, 0), cA + kstep, voffA); PG8_STAGE(PG8_SB(1, 1), cB + hstep + kstep, voffB);
        PG8_WAIT_V(6); PG8_BAR;
    }
    for (;;) {
        const bool has_next = S.next(ui + 1, nxt);
        const char* nA = has_next ? (const char*)g.A + (size_t)nxt.pm * tstep : cA; const char* nB = has_next ? (const char*)g.Bt + (size_t)nxt.pn * tstep : cB;
        for (int t = 0; t < nt; t += 2) {
            const bool last = (t == nt - 2);
            const char* a1 = cA + (size_t)(t + 1) * kstep;
            const char* a2 = last ? nA : cA + (size_t)(t + 2) * kstep; const char* b2 = last ? nB : cB + (size_t)(t + 2) * kstep;
            const char* a3 = a2 + kstep; const char* b3 = b2 + kstep;
            if (last && has_next) S.a_ready(nxt);
            if constexpr (SP2) {
            PG8_LDB(B0, 0, 0); PG8_LDB(B1, 0, 1); PG8_SCHED; PG8_LDA(At, 0, 0); PG8_STAGE(PG8_SA(1, 1), a1 + hstep, voffA);
            PG8_WAIT_V(8); PG8_WAIT_L(0); PG8_BAR; PG8_MMA(0, 0, At, B0); PG8_MMA(0, 1, At, B1); PG8_BAR; PG8_SCHED;
            PG8_LDA(At, 0, 1); PG8_STAGE(PG8_SB(0, 0), b2, voffB); PG8_STAGE(PG8_SB(0, 1), b2 + hstep, voffB); PG8_STAGE(PG8_SA(0, 0), a2, voffA);
            PG8_WAIT_V(8); PG8_WAIT_L(0); PG8_BAR; PG8_MMA(1, 0, At, B0); PG8_MMA(1, 1, At, B1); PG8_BAR; PG8_SCHED;
            PG8_LDB(B0, 1, 0); PG8_LDB(B1, 1, 1); PG8_SCHED; PG8_LDA(At, 1, 0); PG8_STAGE(PG8_SA(0, 1), a2 + hstep, voffA);
            PG8_WAIT_V(8); PG8_WAIT_L(0); PG8_BAR; PG8_MMA(0, 0, At, B0); PG8_MMA(0, 1, At, B1); PG8_BAR; PG8_SCHED;
            PG8_LDA(At, 1, 1); PG8_STAGE(PG8_SB(1, 0), b3, voffB); PG8_STAGE(PG8_SB(1, 1), b3 + hstep, voffB); PG8_STAGE(PG8_SA(1, 0), a3, voffA);
            PG8_WAIT_V(8); PG8_WAIT_L(0); PG8_BAR; PG8_MMA(1, 0, At, B0); PG8_MMA(1, 1, At, B1); PG8_BAR; PG8_SCHED;
            } else {
            PG8_LDB(B0, 0, 0); PG8_SCHED; PG8_LDA(At, 0, 0); PG8_STAGE(PG8_SA(1, 1), a1 + hstep, voffA);
            PG8_WAIT_L(8); PG8_BAR; PG8_WAIT_L(0); PG8_MMA(0, 0, At, B0); PG8_BAR; PG8_SCHED;
            PG8_LDB(B1, 0, 1); PG8_STAGE(PG8_SB(0, 0), b2, voffB);
            PG8_BAR; PG8_WAIT_L(0); PG8_MMA(0, 1, At, B1); PG8_BAR;
            PG8_LDA(At, 0, 1); PG8_STAGE(PG8_SA(0, 0), a2, voffA);
            PG8_BAR; PG8_WAIT_L(0); PG8_MMA(1, 0, At, B0); PG8_BAR; PG8_SCHED;
            PG8_STAGE(PG8_SB(0, 1), b2 + hstep, voffB);
            PG8_WAIT_V(6); PG8_BAR; PG8_MMA(1, 1, At, B1); PG8_BAR;
            PG8_LDB(B0, 1, 0); PG8_SCHED; PG8_LDA(At, 1, 0); PG8_STAGE(PG8_SA(0, 1), a2 + hstep, voffA);
            PG8_WAIT_L(8); PG8_BAR; PG8_WAIT_L(0); PG8_MMA(0, 0, At, B0); PG8_BAR; PG8_SCHED;
            PG8_LDB(B1, 1, 1); PG8_STAGE(PG8_SB(1, 0), b3, voffB);
            PG8_BAR; PG8_WAIT_L(0); PG8_MMA(0, 1, At, B1); PG8_BAR;
            PG8_LDA(At, 1, 1); PG8_STAGE(PG8_SA(1, 0), a3, voffA);
            PG8_BAR; PG8_WAIT_L(0); PG8_MMA(1, 0, At, B0); PG8_BAR; PG8_SCHED;
            PG8_STAGE(PG8_SB(1, 1), b3 + hstep, voffB);
            PG8_WAIT_V(6); PG8_BAR; PG8_MMA(1, 1, At, B1); PG8_BAR;
            }
        }
        if constexpr (ALIGN_EPI) { if (wr == 0) PG8_BAR; }
        if constexpr (!Epi::AFTER_DRAIN) { E(acc, cur, wr, wc, fr, fq); S.done(cur); }
        if (!has_next) break;
#pragma unroll
        for (int a = 0; a < 2; ++a)
#pragma unroll
            for (int b = 0; b < 2; ++b)
#pragma unroll
                for (int m = 0; m < 4; ++m)
#pragma unroll
                    for (int n = 0; n < 2; ++n) acc[a][b][m][n] = (f32x4){0.f, 0.f, 0.f, 0.f};
        cur = nxt; cA = nA; cB = nB; ++ui;
        if constexpr (ALIGN_EPI) { if (wr == 1) PG8_BAR; }
    }
    PG8_WAIT_V(0);
    if constexpr (!ALIGN_EPI) { if (wr == 0) PG8_BAR; }
    PG8_BAR;
    if constexpr (Epi::AFTER_DRAIN) { E.fused(acc, cur, wr, wc, fr, fq, lds, wid, lane); S.done(cur); }
#undef PG8_SA
#undef PG8_SB
#undef PG8_STAGE
#undef PG8_LDA
#undef PG8_LDB
#undef PG8_MMA
#undef PG8_WAIT_V
#undef PG8_WAIT_L
#undef PG8_BAR
#undef PG8_SCHED
}
}

namespace att {
using bf16 = unsigned short;
#define AG __attribute__((address_space(1)))
#define AL __attribute__((address_space(3)))
constexpr int D = 128, NW = 8, QBLK = 32, KVBLK = 64;
constexpr float SCALE = 0.088388347648318440f;
constexpr float THR = 8.f;
using bf16x8 = __attribute__((ext_vector_type(8))) short;
using s16x4  = __attribute__((ext_vector_type(4))) short;
using f32x16 = __attribute__((ext_vector_type(16))) float;
using u32x4  = __attribute__((ext_vector_type(4))) unsigned;
constexpr size_t SHM_V = KVBLK * D * 2, SHM_K = KVBLK * D * 2, SHM_ATTN = 2 * SHM_V + 2 * SHM_K + NW * 64 * 4;
#define KSWZ(row, colB) ((row) * 256 + ((colB) ^ (((row) & 7) << 4)))
#define SBAR() __builtin_amdgcn_sched_barrier(0)
__device__ __forceinline__ int crow(int r, int hi) { return (r & 3) + 8 * (r >> 2) + 4 * hi; }
__device__ __forceinline__ unsigned cvtpk(float lo, float hi) { unsigned r; asm volatile("v_cvt_pk_bf16_f32 %0, %1, %2" : "=v"(r) : "v"(lo), "v"(hi)); return r; }
__device__ __forceinline__ bf16x8 ld8(const bf16* p) { return *(const AG bf16x8*)p; }

__device__ __forceinline__ void partialSM(f32x16& p0, f32x16& p1, float& m_reg, float& mn, float& alpha) {
  constexpr float C = SCALE * 1.4426950408889634f;
  float pmax = p0[0]; for (int r = 1; r < 16; ++r) pmax = fmaxf(pmax, p0[r]); for (int r = 0; r < 16; ++r) pmax = fmaxf(pmax, p1[r]);
  { auto rr = __builtin_amdgcn_permlane32_swap(__float_as_uint(pmax), __float_as_uint(pmax), false, false);
    pmax = fmaxf(__uint_as_float(rr[0]), __uint_as_float(rr[1])); }
  if (__builtin_expect(__all(pmax - m_reg <= THR / SCALE), 1)) { mn = m_reg; alpha = 1.f; }
  else { mn = fmaxf(m_reg, pmax); alpha = __builtin_amdgcn_exp2f((m_reg - mn) * C); m_reg = mn; }
  float mnC = -mn * C;
  for (int r = 0; r < 16; ++r) p0[r] = fmaf(p0[r], C, mnC); for (int r = 0; r < 16; ++r) p1[r] = fmaf(p1[r], C, mnC);
  for (int r = 0; r < 16; ++r) p0[r] = __builtin_amdgcn_exp2f(p0[r]);
}
__device__ __forceinline__ void finishSM(f32x16& p0, f32x16& p1, float alpha, float& l_reg, bf16x8& pa0, bf16x8& pa1, bf16x8& pa2, bf16x8& pa3) {
  for (int r = 0; r < 16; ++r) p1[r] = __builtin_amdgcn_exp2f(p1[r]);
  float ps = 0; for (int r = 0; r < 16; ++r) ps += p0[r]; for (int r = 0; r < 16; ++r) ps += p1[r];
  { auto rr = __builtin_amdgcn_permlane32_swap(__float_as_uint(ps), __float_as_uint(ps), false, false);
    ps = __uint_as_float(rr[0]) + __uint_as_float(rr[1]); }
  l_reg = l_reg * alpha + ps;
#define PK4(P, BASE, OUT) do { unsigned a0 = cvtpk(P[BASE + 0], P[BASE + 1]), a1 = cvtpk(P[BASE + 2], P[BASE + 3]);   \
    unsigned b0 = cvtpk(P[BASE + 4], P[BASE + 5]), b1 = cvtpk(P[BASE + 6], P[BASE + 7]);                              \
    auto r0 = __builtin_amdgcn_permlane32_swap(a0, b0, false, false); auto r1 = __builtin_amdgcn_permlane32_swap(a1, b1, false, false); \
    u32x4 w = {r0[0], r1[0], r0[1], r1[1]}; OUT = *reinterpret_cast<bf16x8*>(&w); } while (0)
  PK4(p0, 0, pa0); PK4(p0, 8, pa1); PK4(p1, 0, pa2); PK4(p1, 8, pa3);
#undef PK4
}
__device__ __forceinline__ void qkt(f32x16& p0, f32x16& p1, const AL char* Ks, const bf16x8* qr, int r32, int hi) {
  p0 = f32x16{}; p1 = f32x16{};
  for (int d0 = 0; d0 < 8; ++d0) { int cb = (d0 * 16 + hi * 8) * 2;
    bf16x8 b0 = *(const AL bf16x8*)(Ks + KSWZ(r32, cb));
    bf16x8 b1 = *(const AL bf16x8*)(Ks + KSWZ(32 + r32, cb));
    p0 = __builtin_amdgcn_mfma_f32_32x32x16_bf16(b0, qr[d0], p0, 0, 0, 0);
    p1 = __builtin_amdgcn_mfma_f32_32x32x16_bf16(b1, qr[d0], p1, 0, 0, 0); }
}
__device__ __forceinline__ void wmask(f32x16& p0, f32x16& p1, int dq, int hi) {
#pragma unroll
  for (int r = 0; r < 16; ++r) { const int df = dq - crow(r, hi);
    if (df > 128 || df < -128) p0[r] = -1e30f;
    if (df - 32 > 128 || df - 32 < -128) p1[r] = -1e30f; }
}
__device__ __forceinline__ int v_st(int k, int c) { const int kk = (k & ~0xC) | ((k & 4) << 1) | ((k & 8) >> 1); return ((kk >> 3) * 4 + (c >> 5)) * 512 + ((kk & 7) * 32 + (c & 31)) * 2; }
__device__ __forceinline__ int v_rd_base(int lane) { return ((lane & 3) << 3) | (((lane >> 2) & 3) << 6) | (((lane >> 4) & 1) << 5) | (((lane >> 5) & 1) << 8); }
constexpr int v_rd_off(int d0, int ks, int half) { return d0 * 512 + ks * 4096 + half * 2048; }
template <int OFF> __device__ __forceinline__ s16x4 tr_read(int vb) {
  s16x4 r; asm volatile("ds_read_b64_tr_b16 %0, %1 offset:%2" : "=&v"(r) : "v"(vb), "i"(OFF) : "memory"); return r;
}
template <int D0> __device__ __forceinline__ void pv_one(f32x16& od, int vb, bf16x8 pa0, bf16x8 pa1, bf16x8 pa2, bf16x8 pa3) {
  const s16x4 l0 = tr_read<v_rd_off(D0, 0, 0)>(vb), h0 = tr_read<v_rd_off(D0, 0, 1)>(vb), l1 = tr_read<v_rd_off(D0, 1, 0)>(vb), h1 = tr_read<v_rd_off(D0, 1, 1)>(vb);
  const s16x4 l2 = tr_read<v_rd_off(D0, 2, 0)>(vb), h2 = tr_read<v_rd_off(D0, 2, 1)>(vb), l3 = tr_read<v_rd_off(D0, 3, 0)>(vb), h3 = tr_read<v_rd_off(D0, 3, 1)>(vb);
  asm volatile("s_waitcnt lgkmcnt(0)" ::: "memory"); SBAR();
#define PK(L, H) (bf16x8){L[0], L[1], L[2], L[3], H[0], H[1], H[2], H[3]}
  od = __builtin_amdgcn_mfma_f32_32x32x16_bf16(pa0, PK(l0, h0), od, 0, 0, 0);
  od = __builtin_amdgcn_mfma_f32_32x32x16_bf16(pa1, PK(l1, h1), od, 0, 0, 0);
  od = __builtin_amdgcn_mfma_f32_32x32x16_bf16(pa2, PK(l2, h2), od, 0, 0, 0);
  od = __builtin_amdgcn_mfma_f32_32x32x16_bf16(pa3, PK(l3, h3), od, 0, 0, 0);
#undef PK
}
__device__ __forceinline__ void pv_d0(f32x16* o, int vb, bf16x8 pa0, bf16x8 pa1, bf16x8 pa2, bf16x8 pa3) {
  pv_one<0>(o[0], vb, pa0, pa1, pa2, pa3); pv_one<1>(o[1], vb, pa0, pa1, pa2, pa3); pv_one<2>(o[2], vb, pa0, pa1, pa2, pa3); pv_one<3>(o[3], vb, pa0, pa1, pa2, pa3);
}

struct Unit {
  const bf16* Q; int ldq;
  const bf16* KA; const bf16* VA; int ldA; int nA;
  const bf16* KB; const bf16* VB; int ldB;
  int NT;
  int win;
  int dq0;
  int has_sink; float sink;
  bf16* O; int ldo;
};

__device__ __forceinline__ void attn_unit(const Unit& U, AL char* lds) {
  int tid_ = threadIdx.x; asm volatile("" : "+v"(tid_));
  const int tid = tid_, wid = __builtin_amdgcn_readfirstlane(tid >> 6), lane = tid & 63, r32 = lane & 31, hi = lane >> 5;
  AL char* V_lds = lds; AL char* K_lds = lds + 2 * SHM_V;
  AL float* ws = (AL float*)(lds + 2 * SHM_V + 2 * SHM_K) + wid * 64; AL float* li_l = ws; AL float* al_l = ws + 32;
  float m_reg = -1e30f, l_reg = 0; f32x16 o[4] = {}; bf16x8 qr[8];
  const bf16* Qw = U.Q + (long)(wid * QBLK + r32) * U.ldq + hi * 8;
#pragma unroll
  for (int d0 = 0; d0 < 8; ++d0) qr[d0] = ld8(Qw + d0 * 16);
  const int sr = tid >> 4, sc = (tid & 15) * 8, vst0 = v_st(sr, sc), vst1 = v_st(32 + sr, sc);
  const int vb0 = (int)(unsigned)(uintptr_t)V_lds + v_rd_base(lane);
  const int nA = U.nA, NT = U.NT;
  const int dqw = U.dq0 + wid * QBLK + r32;
  struct { bf16x8 vs0, vs1, ks0, ks1; } sr_[1];
#define SLOAD(i, jt) do { const int jj_ = (jt); const bf16 *kp_, *vp_; long ld_; \
    if (jj_ < nA) { ld_ = U.ldA; kp_ = U.KA + (long)jj_ * 64 * ld_; vp_ = U.VA + (long)jj_ * 64 * ld_; } \
    else { ld_ = U.ldB; kp_ = U.KB + (long)(jj_ - nA) * 64 * ld_; vp_ = U.VB + (long)(jj_ - nA) * 64 * ld_; } \
    sr_[i].vs0 = ld8(vp_ + (long)sr * ld_ + sc); sr_[i].vs1 = ld8(vp_ + (long)(32 + sr) * ld_ + sc); \
    sr_[i].ks0 = ld8(kp_ + (long)sr * ld_ + sc); sr_[i].ks1 = ld8(kp_ + (long)(32 + sr) * ld_ + sc); } while (0)
#define SWRITE(b, i) do { *(AL bf16x8*)(V_lds + (b) * SHM_V + vst0) = sr_[i].vs0;          \
    *(AL bf16x8*)(V_lds + (b) * SHM_V + vst1) = sr_[i].vs1; int kc = sc * 2;               \
    *(AL bf16x8*)(K_lds + (b) * SHM_K + KSWZ(sr, kc)) = sr_[i].ks0;                       \
    *(AL bf16x8*)(K_lds + (b) * SHM_K + KSWZ(32 + sr, kc)) = sr_[i].ks1; } while (0)
#define RESC(a) do { if (__any((a) < 1.f)) { if (hi == 0) al_l[r32] = (a); asm volatile("s_waitcnt lgkmcnt(0)" ::: "memory"); \
    for (int d = 0; d < 4; ++d) for (int r = 0; r < 16; ++r) o[d][r] *= al_l[crow(r, hi)]; } } while (0)
#define MASK(P0, P1, jt) do { if (U.win && (jt) >= nA) { const int dq_ = dqw - ((jt) - nA) * 64; \
    if (__any(dq_ > 128 || dq_ - 63 < -128)) wmask(P0, P1, dq_, hi); } } while (0)
  f32x16 p0, p1; float mn, al; bf16x8 pa0, pa1, pa2, pa3;
#define LBAR() asm volatile("s_waitcnt lgkmcnt(0)\n\ts_barrier" ::: "memory")
#define STAGE_NEXT() do { if (j + 1 < NT) { asm volatile("s_waitcnt vmcnt(0)" ::: "memory"); SWRITE(b ^ 1, 0); if (j + 2 < NT) SLOAD(0, j + 2); } } while (0)
  SLOAD(0, 0); asm volatile("s_waitcnt vmcnt(0)" ::: "memory"); SWRITE(0, 0); SLOAD(0, 1); LBAR();
  const bool trail = wid >= 4;
  if (trail) LBAR();
#pragma unroll 1
  for (int j = 0; j < NT; ++j) {
    const int b = j & 1;
    qkt(p0, p1, K_lds + b * SHM_K, qr, r32, hi); MASK(p0, p1, j);
    partialSM(p0, p1, m_reg, mn, al);
    if (trail) STAGE_NEXT();
    LBAR();
    RESC(al);
    finishSM(p0, p1, al, l_reg, pa0, pa1, pa2, pa3); SBAR();
    pv_d0(o, vb0 + b * (int)SHM_V, pa0, pa1, pa2, pa3);
    if (!trail) STAGE_NEXT();
    LBAR();
  }
  if (!trail) LBAR();
#undef STAGE_NEXT
  if (U.has_sink) { constexpr float C = SCALE * 1.4426950408889634f; l_reg += __builtin_amdgcn_exp2f(fminf(U.sink * 1.4426950408889634f - m_reg * C, 120.f)); }
  if (hi == 0) li_l[r32] = l_reg; asm volatile("s_waitcnt lgkmcnt(0)" ::: "memory");
  float rli[16];
#pragma unroll
  for (int r = 0; r < 16; ++r) rli[r] = __builtin_amdgcn_rcpf(li_l[crow(r, hi)]);
  bf16* Ow = U.O + (long)(wid * QBLK) * U.ldo;
#pragma unroll
  for (int r = 0; r < 16; ++r) { int orow = crow(r, hi);
    for (int d0 = 0; d0 < 4; ++d0) { const float v = o[d0][r] * rli[r]; const unsigned pk = cvtpk(v, v);
      *(AG unsigned short*)(Ow + (long)orow * U.ldo + d0 * 32 + r32) = (unsigned short)(pk & 0xffffu); } }
#undef SLOAD
#undef SWRITE
#undef RESC
#undef MASK
#undef LBAR
}
}

constexpr int DM = 2048, NCTX = 8192, NLAT = 16384, NTOK = 24576, QKVD = 3072, DFF = 5632, NGU = 11264, DEPTH = 4;
constexpr int NWAVES = 8;
constexpr size_t MiB = 1u << 20;
constexpr size_t OUT_YP = 0, OUT_YS = (size_t)NCTX * DM, OUT_WK = (size_t)NTOK * DM, OUT_WV = OUT_WK + (size_t)32 * 2 * 256 * 512,
                 OUT_AK = OUT_WV + (size_t)32 * 2 * 256 * 512, OUT_AV = OUT_AK + (size_t)32 * 256 * 512, OUT_END = OUT_AV + (size_t)32 * 256 * 512;
constexpr size_t WS_CTL = 0, CTL_ZERO_BYTES = 1 * MiB;
constexpr size_t WS_MODP = 1 * MiB;
constexpr size_t WS_MODF = 16 * MiB;
constexpr size_t WS_A2 = 18 * MiB;
constexpr size_t WS_NP = 19 * MiB;
constexpr size_t WS_INV = WS_NP + (size_t)18 * 8192 * 4;
constexpr size_t WS_CKV = 20 * MiB;
constexpr size_t WS_CWK = WS_CKV, WS_CWV = WS_CKV + 8 * MiB, WS_CAK = WS_CKV + 16 * MiB, WS_CAV = WS_CKV + 20 * MiB;
constexpr size_t WS_FT = 44 * MiB;
constexpr size_t WS_FT_CTX = WS_FT + 32 * MiB;
constexpr size_t WS_W = 80 * MiB;
constexpr size_t W_QKV = (size_t)QKVD * DM * 2, W_SQ = (size_t)DM * DM * 2, W_IN = (size_t)6144 * DM * 2, W_GU = (size_t)NGU * DM * 2, W_DN = (size_t)DM * DFF * 2;
constexpr size_t WS_WQKV0 = WS_W, WS_WQKV1 = WS_WQKV0 + W_QKV, WS_WQKVA = WS_WQKV1 + W_QKV, WS_WO0 = WS_WQKVA + W_QKV, WS_WO1 = WS_WO0 + W_SQ, WS_WOA = WS_WO1 + W_SQ,
                 WS_WHO = WS_WOA + W_SQ, WS_WHI = WS_WHO + W_SQ, WS_WGU = WS_WHI + W_IN, WS_WDN = WS_WGU + 4 * W_GU, WS_WEND = WS_WDN + 4 * W_DN;
constexpr size_t WS_H = 448 * MiB;
constexpr size_t WS_BIG = 544 * MiB;
constexpr size_t WS_ZT = WS_BIG + 288 * MiB;
constexpr size_t WS_END = WS_BIG + 384 * MiB;
static_assert(WS_WEND <= WS_H && WS_FT_CTX + 4 * MiB <= WS_W && WS_CAV + 4 * MiB <= WS_FT, "ws map");
static_assert(WS_MODP + (size_t)4 * 8 * 9 * 12288 * 4 <= WS_MODF && WS_MODF + (size_t)4 * 9 * 6 * 2048 * 4 <= WS_A2 && WS_A2 + (size_t)2304 * 64 * 4 <= WS_NP && WS_INV + (size_t)4 * 2048 * 4 <= WS_CKV, "small buffers");
constexpr int CW_TMO = 0;
constexpr int CW_BAR = 4096;
constexpr int RING_BYTES = 131072;
constexpr int LDSCTL_OFF = RING_BYTES, MISC_OFF = LDSCTL_OFF + 320;
constexpr int LDS_BYTES = 147456;

#define GAS __attribute__((address_space(1)))
#define LAS __attribute__((address_space(3)))
typedef unsigned short bf16;
typedef unsigned v4u __attribute__((ext_vector_type(4)));
typedef unsigned v2u __attribute__((ext_vector_type(2)));
typedef float f32x4 __attribute__((ext_vector_type(4)));
typedef short bf16x8 __attribute__((ext_vector_type(8)));
typedef short bf16x4 __attribute__((ext_vector_type(4)));
typedef GAS unsigned gu32;
#define RLX_AGENT __ATOMIC_RELAXED, __HIP_MEMORY_SCOPE_AGENT
#define LDS_WAIT() asm volatile("s_waitcnt lgkmcnt(0)" ::: "memory")
#define VM_WAIT() asm volatile("s_waitcnt vmcnt(0)" ::: "memory")
__device__ __forceinline__ unsigned f2bf(float f) { unsigned u = __builtin_bit_cast(unsigned, f); return (u + 0x7fffu + ((u >> 16) & 1u)) >> 16; }
__device__ __forceinline__ unsigned pk2(float lo, float hi) { return f2bf(lo) | (f2bf(hi) << 16); }
__device__ __forceinline__ float bf2f(unsigned short b) { return __builtin_bit_cast(float, (unsigned)b << 16); }
__device__ __forceinline__ float bflo(unsigned w) { return __builtin_bit_cast(float, w << 16); }
__device__ __forceinline__ float bfhi(unsigned w) { return __builtin_bit_cast(float, w & 0xffff0000u); }
__device__ __forceinline__ float wave_sum(float v) {
#pragma unroll
    for (int o = 1; o < 64; o <<= 1) v += __shfl_xor(v, o);
    return v;
}
#define XB_TMO      128
#define XB_XCNT(j)  (256  + 64 * (j))
#define XB_XSUB(j)  (1280 + 64 * (j))
#define XB_XGEN(j)  (2304 + 64 * (j))
#define XB_TOP      3328
#define XB_TOPGEN   3392
#define XCD_BAR_WORDS 3456
#define XB_SPIN_CAP (1u << 18)

__device__ __forceinline__ unsigned xb_ld(unsigned* p)              { return __hip_atomic_load(p, __ATOMIC_RELAXED, __HIP_MEMORY_SCOPE_AGENT); }
__device__ __forceinline__ unsigned xb_add(unsigned* p, unsigned v) { return __hip_atomic_fetch_add(p, v, __ATOMIC_RELAXED, __HIP_MEMORY_SCOPE_AGENT); }
__device__ __forceinline__ unsigned xb_xcc_id() { return (unsigned)__builtin_amdgcn_s_getreg((3 << 11) | 20) & 0xFu; }
#define XB_SPIN(cond, bar) do { unsigned _sp = 0; while (cond) { __builtin_amdgcn_s_sleep(1); \
    if ((++_sp & 255u) == 0u) { if (xb_ld(&(bar)[XB_TMO])) break; if (_sp > XB_SPIN_CAP) { atomicAdd(&(bar)[XB_TMO], 1u); break; } } } } while (0)

struct XcdBarrier {
    unsigned* bar; unsigned x;
    volatile LAS unsigned* st;
};

__device__ __forceinline__ XcdBarrier xcd_barrier_post(unsigned* bar, volatile LAS unsigned* st) {
    XcdBarrier b; b.bar = bar; b.x = xb_xcc_id(); b.st = st;
    if (threadIdx.x == 0) (void)xb_add(&bar[XB_XCNT(b.x)], 1u);
    return b;
}
__device__ __forceinline__ void xcd_barrier_complete(unsigned* bar, unsigned x, unsigned& nloc, unsigned& nx) {
    const unsigned G = gridDim.x * gridDim.y * gridDim.z;
    unsigned sum, cnt, mine, sp = 0u;
    for (;;) {
        sum = 0u; cnt = 0u; mine = 0u;
#pragma unroll
        for (unsigned j = 0; j < 16; ++j) { const unsigned c = xb_ld(&bar[XB_XCNT(j)]); sum += c; cnt += (c > 0u) ? 1u : 0u; mine = (j == x) ? c : mine; }
        if (sum == G) break;
        __builtin_amdgcn_s_sleep(1);
        if ((++sp & 255u) == 0u) { if (xb_ld(&bar[XB_TMO])) break; if (sp > XB_SPIN_CAP) { atomicAdd(&bar[XB_TMO], 1u); break; } }
    }
    nloc = mine > 0u ? mine : 1u; nx = cnt > 0u ? cnt : 1u;
}

__device__ __forceinline__ void xcd_barrier(const XcdBarrier& b) {
    asm volatile("s_waitcnt vmcnt(0)" ::: "memory");
    __syncthreads();
    if (threadIdx.x == 0) {
        unsigned* bar = b.bar;
        __builtin_amdgcn_s_waitcnt(0);
        unsigned nloc = b.st[0], nx = b.st[1];
        if (nloc == 0u) { xcd_barrier_complete(bar, b.x, nloc, nx); b.st[0] = nloc; b.st[1] = nx; }
        const unsigned old = xb_add(&bar[XB_XSUB(b.x)], 1u);
        const unsigned gen = old / nloc;
        if (old + 1u == (gen + 1u) * nloc) {
            __builtin_amdgcn_fence(__ATOMIC_RELEASE, "agent");
            asm volatile("s_waitcnt vmcnt(0)" ::: "memory");
            const unsigned og = xb_add(&bar[XB_TOP], 1u);
            const unsigned tg = og / nx;
            if (og + 1u == (tg + 1u) * nx) xb_add(&bar[XB_TOPGEN], 1u);
            else XB_SPIN(xb_ld(&bar[XB_TOPGEN]) == tg, bar);
            __builtin_amdgcn_fence(__ATOMIC_ACQUIRE, "agent");
            xb_add(&bar[XB_XGEN(b.x)], 1u);
            asm volatile("s_waitcnt vmcnt(0)" ::: "memory");
        } else {
            XB_SPIN(xb_ld(&bar[XB_XGEN(b.x)]) == gen, bar);
            __builtin_amdgcn_fence(__ATOMIC_ACQUIRE, "agent");
            asm volatile("s_waitcnt vmcnt(0)" ::: "memory");
        }
    }
    __syncthreads();
}

__device__ __forceinline__ void transpose_item(const float* W, int K, int N, bf16* WT, int k0, int n0, int drow0, LAS float* scr, int lane) {
#pragma unroll 8
    for (int i = 0; i < 32; ++i) { const int kk = 2 * i + (lane >> 5); scr[kk * 33 + (lane & 31)] = W[(size_t)(k0 + kk) * N + n0 + (lane & 31)]; }
    LDS_WAIT(); asm volatile("" ::: "memory");
    const int c = lane & 7;
#pragma unroll
    for (int j = 0; j < 4; ++j) { const int n = (lane >> 3) + 8 * j; const LAS float* s = scr + (8 * c) * 33 + n;
        v4u o; o.x = pk2(s[0 * 33], s[1 * 33]); o.y = pk2(s[2 * 33], s[3 * 33]); o.z = pk2(s[4 * 33], s[5 * 33]); o.w = pk2(s[6 * 33], s[7 * 33]);
        *(GAS v4u*)(WT + (size_t)(drow0 + n) * K + k0 + 8 * c) = o; }
    LDS_WAIT(); asm volatile("" ::: "memory");
}
constexpr int IT_QKV = (DM / 64) * (QKVD / 32), IT_SQ = (DM / 64) * (DM / 32), IT_IN = (DM / 64) * (6144 / 32), IT_GU = (DM / 64) * (NGU / 32), IT_DN = (DFF / 64) * (DM / 32);
constexpr int IT_TOTAL = 3 * IT_QKV + 4 * IT_SQ + IT_IN + 4 * IT_GU + 4 * IT_DN;

struct Args { const float* in[33]; float* out; unsigned char* ws; int ph_lo, ph_hi; };
#define GIN(k) ((const float*)(const GAS float*)A.in[k])

__device__ __forceinline__ void weight_item(const Args& A, int it, LAS float* scr, int lane) {
    unsigned char* ws = A.ws;
    const float* src; bf16* dst; int K = DM, N; bool gu = false; int r = it;
    if (r < 3 * IT_QKV) { const int m = r / IT_QKV; r -= m * IT_QKV; N = QKVD;
        src = (m < 2) ? GIN(12) + (size_t)m * DM * QKVD : GIN(26); dst = (bf16*)(ws + WS_WQKV0 + (size_t)m * W_QKV); }
    else if ((r -= 3 * IT_QKV) < 4 * IT_SQ) { const int m = r / IT_SQ; r -= m * IT_SQ; N = DM;
        src = (m < 2) ? GIN(13) + (size_t)m * DM * DM : (m == 2 ? GIN(29) : GIN(25)); dst = (bf16*)(ws + WS_WO0 + (size_t)m * W_SQ); }
    else if ((r -= 4 * IT_SQ) < IT_IN) { N = 6144; src = GIN(15); dst = (bf16*)(ws + WS_WHI); }
    else if ((r -= IT_IN) < 4 * IT_GU) { const int m = r / IT_GU; r -= m * IT_GU; N = NGU; gu = true;
        src = GIN(30) + (size_t)m * DM * NGU; dst = (bf16*)(ws + WS_WGU + (size_t)m * W_GU); }
    else { r -= 4 * IT_GU; const int m = r / IT_DN; r -= m * IT_DN; N = DM; K = DFF;
        src = GIN(31) + (size_t)m * DFF * DM; dst = (bf16*)(ws + WS_WDN + (size_t)m * W_DN); }
    const int nblk = N / 32, kb = r / nblk, nb = r % nblk, k0 = 64 * kb, n0 = 32 * nb;
    int drow0 = n0;
    if (gu) { const int isu = n0 >= DFF ? 1 : 0; const int j = n0 - isu * DFF; drow0 = (j >> 7) * 256 + isu * 128 + (j & 127); }
    transpose_item(src, K, N, dst, k0, n0, drow0, scr, lane);
}

__device__ __forceinline__ void adaln_partial_unit(const Args& A, int u, LAS float* scr, int lane) {
    const int layer = u / 384, kc = (u / 48) % 8, cg = u % 48;
    const float* cctx = GIN(7); const float* cin = GIN(6);
    for (int idx = lane; idx < 9 * 256; idx += 64) { const int c = idx >> 8, kk = idx & 255, k = kc * 256 + kk;
        const float v = (c == 0) ? cctx[k] : cin[(size_t)(c - 1) * DM + k]; scr[idx] = v / (1.0f + expf(-v)); }
    LDS_WAIT(); asm volatile("" ::: "memory");
    f32x4 acc[9];
#pragma unroll
    for (int c = 0; c < 9; ++c) acc[c] = (f32x4){0.f, 0.f, 0.f, 0.f};
    const float* wp = GIN(10) + (size_t)layer * DM * 12288 + (size_t)(kc * 256) * 12288 + cg * 256 + lane * 4;
#pragma unroll 8
    for (int kk = 0; kk < 256; ++kk) { const f32x4 w = *(const GAS f32x4*)(wp + (size_t)kk * 12288);
#pragma unroll
        for (int c = 0; c < 9; ++c) acc[c] += scr[c * 256 + kk] * w; }
    float* mp = (float*)(A.ws + WS_MODP) + (size_t)((layer * 8 + kc) * 9) * 12288 + cg * 256 + lane * 4;
#pragma unroll
    for (int c = 0; c < 9; ++c) *(f32x4*)(mp + (size_t)c * 12288) = acc[c];
    LDS_WAIT(); asm volatile("" ::: "memory");
}

__device__ __forceinline__ void filter_a2_row(const Args& A, int rr, int lane) {
    const int L = rr < 2048 ? 2048 : 256, t = rr < 2048 ? rr : rr - 2048;
    const float tn = (float)t / (float)(L - 1), w = 6.283185307179586f * (float)t / (float)L;
    float feat = 0.f;
    if (lane == 0) feat = tn;
    else if (lane <= 16) feat = cosf(w * (1e-4f + (float)(lane - 1) * ((15.0f - 1e-4f) / 15.0f)));
    else if (lane <= 32) feat = -sinf(w * (1e-4f + (float)(lane - 17) * ((15.0f - 1e-4f) / 15.0f)));
    const float* w1 = GIN(18); const float* b1 = GIN(19); const float* w2 = GIN(20); const float* b2 = GIN(21); const float* fq = GIN(23);
    float s = b1[lane];
    for (int f = 0; f < 33; ++f) s += __shfl(feat, f) * w1[f * 64 + lane];
    const float a1 = sinf(fq[lane] * s);
    float s2 = b2[lane];
    for (int k = 0; k < 64; ++k) s2 += __shfl(a1, k) * w2[k * 64 + lane];
    ((float*)(A.ws + WS_A2))[(size_t)rr * 64 + lane] = sinf(fq[64 + lane] * s2);
}

__device__ __forceinline__ void filter_hf_unit(const Args& A, int u, LAS float* scr, int lane) {
    const int variant = u < 2048 ? 0 : 1; const int uu = variant ? u - 2048 : u; const int tch = uu >> 7, cgp = uu & 127;
    const int L = variant ? 256 : 2048; const int col = cgp * 64 + lane, side = col >> 12, order = (col >> 11) & 1, d = col & 2047;
    const float* w3 = GIN(22);
    float w3r[64];
#pragma unroll
    for (int k = 0; k < 64; ++k) w3r[k] = w3[(size_t)k * 8192 + col];
    constexpr float MIND = -3.0701134573253944f, MAXD = -15.350567286626972f;
    const float delta = fabsf(MIND + (MAXD - MIND) * ((float)d / 2047.0f));
    const float* a2 = (const float*)(A.ws + WS_A2) + (size_t)(variant ? 2048 : 0) * 64;
    bf16* ft = (bf16*)(A.ws + (variant ? WS_FT_CTX : WS_FT)) + ((size_t)(order * 2048 + d) * 2 + side) * L;
    const float rl1 = 1.0f / (float)(L - 1);
    float asum = 0.f;
#pragma unroll 1
    for (int half = 0; half < 2; ++half) {
        const int tb = tch * 128 + half * 64;
        { const GAS f32x4* src = (const GAS f32x4*)(a2 + (size_t)(tb + lane) * 64);
#pragma unroll
          for (int q = 0; q < 16; ++q) *(LAS f32x4*)(scr + lane * 64 + q * 4) = src[q]; }
        LDS_WAIT(); asm volatile("" ::: "memory");
#pragma unroll 1
        for (int tt = 0; tt < 64; tt += 2) {
            float s0 = 0.f, s1 = 0.f;
#pragma unroll
            for (int q = 0; q < 16; ++q) { const f32x4 x0 = *(const LAS f32x4*)(scr + tt * 64 + q * 4), x1 = *(const LAS f32x4*)(scr + (tt + 1) * 64 + q * 4);
                s0 += x0.x * w3r[4 * q] + x0.y * w3r[4 * q + 1] + x0.z * w3r[4 * q + 2] + x0.w * w3r[4 * q + 3];
                s1 += x1.x * w3r[4 * q] + x1.y * w3r[4 * q + 1] + x1.z * w3r[4 * q + 2] + x1.w * w3r[4 * q + 3]; }
            const int t = tb + tt;
            s0 *= expf(-((float)t * rl1) * delta); s1 *= expf(-((float)(t + 1) * rl1) * delta);
            if (!(side == 1 && t == 0)) asum += fabsf(s0);
            asum += fabsf(s1);
            *(GAS unsigned*)(ft + t) = pk2(s0, s1);
        }
        LDS_WAIT(); asm volatile("" ::: "memory");
    }
    ((float*)(A.ws + WS_NP))[(size_t)(variant ? 16 + tch : tch) * 8192 + col] = asum;
}

__device__ __forceinline__ void norm_row(const float* xrow, const f32x4 (&a)[8], const f32x4 (&b)[8], bf16* orow, int lane) {
    const GAS f32x4* xr = (const GAS f32x4*)xrow + lane;
    f32x4 v[8]; float s = 0.f;
#pragma unroll
    for (int j = 0; j < 8; ++j) { v[j] = xr[64 * j]; s += (v[j].x * v[j].x + v[j].y * v[j].y) + (v[j].z * v[j].z + v[j].w * v[j].w); }
    const float rstd = 1.0f / sqrtf(wave_sum(s) * (1.0f / DM) + 1e-6f);
    GAS v2u* o8 = (GAS v2u*)orow + lane;
#pragma unroll
    for (int j = 0; j < 8; ++j) { const f32x4 y = v[j] * rstd * a[j] + b[j]; v2u w; w.x = pk2(y.x, y.y); w.y = pk2(y.z, y.w); o8[64 * j] = w; }
}
__device__ __forceinline__ void final_norm_row(float* xrow, const float* g, int lane) {
    GAS f32x4* xr = (GAS f32x4*)xrow + lane;
    f32x4 v[8]; float s = 0.f;
#pragma unroll
    for (int j = 0; j < 8; ++j) { v[j] = xr[64 * j]; s += (v[j].x * v[j].x + v[j].y * v[j].y) + (v[j].z * v[j].z + v[j].w * v[j].w); }
    const float rstd = 1.0f / sqrtf(wave_sum(s) * (1.0f / DM) + 1e-6f);
#pragma unroll
    for (int j = 0; j < 8; ++j) { const f32x4 a = *((const GAS f32x4*)g + lane + 64 * j); xr[64 * j] = v[j] * rstd * a; }
}

__device__ __forceinline__ void qkpost_row(bf16* qkv_row, int row, bool is_ax, const float* qg, const float* kg, float* state_k, int lane) {
    const bool is_lat = row >= NCTX;
    const int hsub = lane >> 4, a = (lane >> 3) & 1, i0 = (lane & 7) * 4;
    float cs[4], sn[4];
    if (is_lat) { const int t = (row - NCTX) & 2047; const float pos = (float)(a == 0 ? (t >> 6) : (t & 63));
#pragma unroll
        for (int e = 0; e < 4; ++e) { const float inv = expf(-(float)(i0 + e) * (9.210340371976184f / 32.0f)); sn[e] = sinf(pos * inv); cs[e] = cosf(pos * inv); } }
#pragma unroll
    for (int grp = 0; grp < 5; ++grp) {
        const int head = 4 * grp + hsub;
        bf16* base = qkv_row + head * 128 + a * 64 + i0;
        const v2u r1 = *(const GAS v2u*)base, r2 = *(const GAS v2u*)(base + 32);
        float x1[4] = {bflo(r1.x), bfhi(r1.x), bflo(r1.y), bfhi(r1.y)}, x2[4] = {bflo(r2.x), bfhi(r2.x), bflo(r2.y), bfhi(r2.y)};
        if (is_ax) {
            float ss = 0.f;
#pragma unroll
            for (int e = 0; e < 4; ++e) ss += x1[e] * x1[e] + x2[e] * x2[e];
            ss += __shfl_xor(ss, 1); ss += __shfl_xor(ss, 2); ss += __shfl_xor(ss, 4); ss += __shfl_xor(ss, 8);
            const float rstd = 1.0f / sqrtf(ss * (1.0f / 128.0f) + 1e-6f);
            const float* G = (head < 16 ? qg : kg) + a * 64 + i0;
#pragma unroll
            for (int e = 0; e < 4; ++e) { x1[e] = x1[e] * rstd * G[e]; x2[e] = x2[e] * rstd * G[32 + e]; }
        }
        if (is_lat) {
#pragma unroll
            for (int e = 0; e < 4; ++e) { const float y1 = x1[e] * cs[e] - x2[e] * sn[e], y2 = x2[e] * cs[e] + x1[e] * sn[e]; x1[e] = y1; x2[e] = y2; }
        }
        if (is_ax || is_lat) { v2u w1, w2; w1.x = pk2(x1[0], x1[1]); w1.y = pk2(x1[2], x1[3]); w2.x = pk2(x2[0], x2[1]); w2.y = pk2(x2[2], x2[3]);
            *(GAS v2u*)base = w1; *(GAS v2u*)(base + 32) = w2; }
        if (is_ax && !is_lat && head >= 16) { float* sp = state_k + (size_t)row * 512 + (head - 16) * 128 + a * 64 + i0;
            *(GAS f32x4*)sp = (f32x4){x1[0], x1[1], x1[2], x1[3]}; *(GAS f32x4*)(sp + 32) = (f32x4){x2[0], x2[1], x2[2], x2[3]}; }
    }
}

namespace hy {
constexpr int CPY_STRIDE = 8480;
constexpr int U_OFF = 8 * CPY_STRIDE;
constexpr int U_BYTES = 6144;
static_assert(U_OFF + 8 * U_BYTES <= RING_BYTES, "hyena LDS map");

__device__ __forceinline__ void build_copies(LAS unsigned char* lds, const bf16* ft, int L, int tid) {
    if (tid < 264) { const int c = tid / 33, e = tid % 33; const int qq = (e < 17 - c) ? e : 2 * L + 16 - c + (e - (17 - c));
        *(LAS unsigned short*)(lds + c * CPY_STRIDE + qq * 2) = 0; }
    if (tid < 2 * L / 8) { const int side = tid / (L / 8), t8 = (tid % (L / 8)) * 8;
        const v4u raw = *(const GAS v4u*)(ft + (size_t)side * L + t8);
        const unsigned wds[4] = {raw.x, raw.y, raw.z, raw.w};
#pragma unroll
        for (int e = 0; e < 8; ++e) { const int t = t8 + e; const unsigned short val = (unsigned short)((e & 1) ? (wds[e >> 1] >> 16) : (wds[e >> 1] & 0xffffu));
            if (!(side == 1 && t == 0)) { const int p = side == 0 ? L - t : L + t;
#pragma unroll
                for (int c = 0; c < 8; ++c) *(LAS unsigned short*)(lds + c * CPY_STRIDE + (p + 16 - c) * 2) = val; } } }
}
__device__ __forceinline__ void fill_u(LAS unsigned char* ub, const bf16* urow, int L, float w0, float w1, float w2, float bb, int lane) {
    { const int e0 = lane < 32 ? lane * 8 : L + 256 + (lane - 32) * 8; *(LAS v4u*)(ub + e0 * 2) = (v4u){0u, 0u, 0u, 0u}; }
    for (int q = lane; q < L / 8; q += 64) { const int s0 = 8 * q;
        const v4u raw = *(const GAS v4u*)(urow + s0);
        const float prev = s0 > 0 ? bf2f(urow[s0 - 1]) : 0.f, next = s0 + 8 < L ? bf2f(urow[s0 + 8]) : 0.f;
        const float x[10] = {prev, bflo(raw.x), bfhi(raw.x), bflo(raw.y), bfhi(raw.y), bflo(raw.z), bfhi(raw.z), bflo(raw.w), bfhi(raw.w), next};
        float y[8];
#pragma unroll
        for (int j = 0; j < 8; ++j) y[j] = w0 * x[j] + w1 * x[j + 1] + w2 * x[j + 2] + bb;
        v4u o; o.x = pk2(y[0], y[1]); o.y = pk2(y[2], y[3]); o.z = pk2(y[4], y[5]); o.w = pk2(y[6], y[7]);
        *(LAS v4u*)(ub + (256 + s0) * 2) = o; }
}
template <int NT>
__device__ __forceinline__ void toeplitz(const LAS unsigned char* cpy, const LAS unsigned char* ub, f32x4 (&acc)[NT], int lane) {
    constexpr int L = 256 * NT;
    const int i = lane & 15, g = lane >> 4, c = (-i) & 7;
    const LAS unsigned char* ap = cpy + c * CPY_STRIDE + 2 * (L + 8 * g + 16 - i - c);
    const LAS unsigned char* bp = ub + 2 * (256 + 8 * g + 16 * i);
#pragma unroll 2
    for (int S = -256; S <= L - 32; S += 32) {
        const bf16x8 b = *(const LAS bf16x8*)(bp + 2 * S);
        bf16x8 a[NT];
#pragma unroll
        for (int k = 0; k < NT; ++k) a[k] = *(const LAS bf16x8*)(ap + 2 * S - 512 * k);
#pragma unroll
        for (int k = 0; k < NT; ++k) acc[k] = __builtin_amdgcn_mfma_f32_16x16x32_bf16(a[k], b, acc[k], 0, 0, 0);
    }
}
template <int NT>
__device__ __forceinline__ void gate(const f32x4 (&acc)[NT], LAS unsigned char* ub, const bf16* xg, float cw0, float cw1, float cw2, float cb, float invn, float skip, int lane, bool last, bf16* zt) {
    constexpr int L = 256 * NT;
    const int sg = lane & 15, g = lane >> 4;
#pragma unroll
    for (int k = 0; k < NT; ++k) { const int t0 = 256 * k + 16 * sg + 4 * g;
        const v2u ur = *(const LAS v2u*)(ub + (256 + t0) * 2);
        const v2u xr = *(const GAS v2u*)(xg + t0);
        const float prev = t0 > 0 ? bf2f(xg[t0 - 1]) : 0.f, next = t0 + 4 < L ? bf2f(xg[t0 + 4]) : 0.f;
        const float x[6] = {prev, bflo(xr.x), bfhi(xr.x), bflo(xr.y), bfhi(xr.y), next};
        const float uu[4] = {bflo(ur.x), bfhi(ur.x), bflo(ur.y), bfhi(ur.y)};
        float z[4];
#pragma unroll
        for (int r = 0; r < 4; ++r) { const float xc = cw0 * x[r] + cw1 * x[r + 1] + cw2 * x[r + 2] + cb; z[r] = xc * (acc[k][r] * invn + skip * uu[r]); }
        v2u o; o.x = pk2(z[0], z[1]); o.y = pk2(z[2], z[3]);
        if (last) *(GAS v2u*)(zt + t0) = o; else *(LAS v2u*)(ub + (256 + t0) * 2) = o; }
}

constexpr int USH_STR = 4416;
__device__ __forceinline__ int ush_base(int b) { return b * USH_STR + (b >> 2) * 16; }
static_assert(U_OFF + 8 * USH_STR + 64 <= RING_BYTES, "hyena LDS map (shared u)");

__device__ __forceinline__ void build_copies2(LAS unsigned char* lds, const bf16* ft, int L, int ztop, int tid) {
    const int nz = ztop - 2 * L + 1;
    for (int z = tid; z < 8 * nz; z += 512) { const int c = z / nz, e = z % nz; const int qq = (e < 17 - c) ? e : 2 * L + 16 - c + (e - (17 - c));
        *(LAS unsigned short*)(lds + c * CPY_STRIDE + qq * 2) = 0; }
    for (int idx = tid; idx < 2 * L; idx += 512) { const int side = idx >= L ? 1 : 0, t = idx - side * L;
        if (!(side == 1 && t == 0)) { const unsigned short val = *(const GAS unsigned short*)(ft + idx); const int p = side ? L + t : L - t;
#pragma unroll
            for (int c = 0; c < 8; ++c) *(LAS unsigned short*)(lds + c * CPY_STRIDE + (p + 16 - c) * 2) = val; } }
}
__device__ __forceinline__ void fill_coop(LAS unsigned char* ush, const bf16* urow_ch, float w0, float w1, float w2, float bb, int tid) {
    for (int z = tid; z < 160; z += 512) { const int b = z / 20, e = z % 20; const int el = e < 4 ? e * 8 : 2080 + (e - 4) * 8;
        *(LAS v4u*)(ush + ush_base(b) + el * 2) = (v4u){0u, 0u, 0u, 0u}; }
#pragma unroll 1
    for (int ch = tid; ch < 2048; ch += 512) { const int b = ch >> 8, s0 = (ch & 255) * 8; const bf16* urow = urow_ch + b * 2048;
        const v4u raw = *(const GAS v4u*)(urow + s0);
        const float prev = s0 > 0 ? bf2f(*(const GAS bf16*)(urow + s0 - 1)) : 0.f, next = s0 + 8 < 2048 ? bf2f(*(const GAS bf16*)(urow + s0 + 8)) : 0.f;
        const float x[10] = {prev, bflo(raw.x), bfhi(raw.x), bflo(raw.y), bfhi(raw.y), bflo(raw.z), bfhi(raw.z), bflo(raw.w), bfhi(raw.w), next};
        float y[8];
#pragma unroll
        for (int j = 0; j < 8; ++j) y[j] = w0 * x[j] + w1 * x[j + 1] + w2 * x[j + 2] + bb;
        v4u o; o.x = pk2(y[0], y[1]); o.y = pk2(y[2], y[3]); o.z = pk2(y[4], y[5]); o.w = pk2(y[6], y[7]);
        *(LAS v4u*)(ush + ush_base(b) + 2 * (32 + s0)) = o; }
}
__device__ __forceinline__ void toeplitz_coop(const LAS unsigned char* cpy, const LAS unsigned char* ush, f32x4 (&acc)[8], int wave, int lane) {
    constexpr int L = 2048;
    const int i = lane & 15, g = lane >> 4, c = (-i) & 7, bb = i & 7, sg = i >> 3;
    const LAS unsigned char* aq = cpy + c * CPY_STRIDE + 2 * (L + 8 * g + 16 - i - c) - 64 * (8 * wave - 2);
    const LAS unsigned char* bq = ush + ush_base(bb) + 2 * (32 + 8 * g + 16 * sg) - 64;
#pragma unroll 1
    for (int q = 0; q < 17; ++q) {
        bf16x8 A[11], Bf[4];
#pragma unroll
        for (int m = 0; m < 11; ++m) A[m] = *(const LAS bf16x8*)(aq - 64 * m);
#pragma unroll
        for (int b4 = 0; b4 < 4; ++b4) Bf[b4] = *(const LAS bf16x8*)(bq + 64 * b4);
#pragma unroll
        for (int b4 = 0; b4 < 4; ++b4)
#pragma unroll
            for (int a = 0; a < 8; ++a) acc[a] = __builtin_amdgcn_mfma_f32_16x16x32_bf16(A[a - b4 + 3], Bf[b4], acc[a], 0, 0, 0);
        aq += 256; bq += 256;
    }
}
__device__ __forceinline__ void gate_coop(const f32x4 (&acc)[8], LAS unsigned char* ush, const bf16* xg_ch, float cw0, float cw1, float cw2, float cb, float invn, float skip, int wave, int lane, bool last, bf16* zt_ch) {
    const int i = lane & 15, g = lane >> 4, bb = i & 7, sg = i >> 3;
    const bf16* xg = xg_ch + bb * 2048; bf16* zt = zt_ch + bb * 2048; LAS unsigned char* ub = ush + ush_base(bb);
#pragma unroll
    for (int a = 0; a < 8; ++a) { const int t0 = 32 * (8 * wave + a) + 16 * sg + 4 * g;
        const v2u ur = *(const LAS v2u*)(ub + (32 + t0) * 2);
        const v2u xr = *(const GAS v2u*)(xg + t0);
        const float prev = t0 > 0 ? bf2f(*(const GAS bf16*)(xg + t0 - 1)) : 0.f, next = t0 + 4 < 2048 ? bf2f(*(const GAS bf16*)(xg + t0 + 4)) : 0.f;
        const float x[6] = {prev, bflo(xr.x), bfhi(xr.x), bflo(xr.y), bfhi(xr.y), next};
        const float uu[4] = {bflo(ur.x), bfhi(ur.x), bflo(ur.y), bfhi(ur.y)};
        float z[4];
#pragma unroll
        for (int r = 0; r < 4; ++r) { const float xc = cw0 * x[r] + cw1 * x[r + 1] + cw2 * x[r + 2] + cb; z[r] = xc * (acc[a][r] * invn + skip * uu[r]); }
        v2u o; o.x = pk2(z[0], z[1]); o.y = pk2(z[2], z[3]);
        if (last) *(GAS v2u*)(zt + t0) = o; else *(LAS v2u*)(ub + (32 + t0) * 2) = o; }
}

struct GPre { v2u xr; unsigned pn; };
struct FPre { v4u raw; unsigned pn; };
constexpr int ZTOP_L = 2 * 2048 + 136, ZTOP_C = 2 * 256 + 32;

template <int NTAP> __device__ __forceinline__ void taps_load(unsigned (&tp)[NTAP], const bf16* ft, int L, int tid) {
#pragma unroll
    for (int e = 0; e < NTAP; ++e) { const int idx = tid + 512 * e; tp[e] = idx < 2 * L ? (unsigned)*(const GAS unsigned short*)(ft + idx) : 0u; }
}
template <int NTAP> __device__ __forceinline__ void copies_write(LAS unsigned char* lds, const unsigned (&tp)[NTAP], int L, int ztop, int tid) {
    const int nz = ztop - 2 * L + 1;
    for (int z = tid; z < 8 * nz; z += 512) { const int c = z / nz, e = z % nz; const int qq = (e < 17 - c) ? e : 2 * L + 16 - c + (e - (17 - c));
        *(LAS unsigned short*)(lds + c * CPY_STRIDE + qq * 2) = 0; }
#pragma unroll
    for (int e = 0; e < NTAP; ++e) { const int idx = tid + 512 * e;
        if (idx < 2 * L) { const int side = idx >= L ? 1 : 0, t = idx - side * L;
            if (!(side == 1 && t == 0)) { const int p = side ? L + t : L - t;
#pragma unroll
                for (int c = 0; c < 8; ++c) *(LAS unsigned short*)(lds + c * CPY_STRIDE + (p + 16 - c) * 2) = (unsigned short)tp[e]; } } }
}
__device__ __forceinline__ void conv8_store(LAS unsigned char* dst, const FPre& f, float w0, float w1, float w2, float bb) {
    const float x[10] = {bflo(f.pn), bflo(f.raw.x), bfhi(f.raw.x), bflo(f.raw.y), bfhi(f.raw.y), bflo(f.raw.z), bfhi(f.raw.z), bflo(f.raw.w), bfhi(f.raw.w), bfhi(f.pn)};
    float y[8];
#pragma unroll
    for (int j = 0; j < 8; ++j) y[j] = w0 * x[j] + w1 * x[j + 1] + w2 * x[j + 2] + bb;
    v4u o; o.x = pk2(y[0], y[1]); o.y = pk2(y[2], y[3]); o.z = pk2(y[4], y[5]); o.w = pk2(y[6], y[7]);
    *(LAS v4u*)dst = o;
}
__device__ __forceinline__ void fpre_load(FPre& f, const bf16* urow, int s0, int L) {
    f.raw = *(const GAS v4u*)(urow + s0);
    const unsigned p = s0 > 0 ? (unsigned)*(const GAS unsigned short*)(urow + s0 - 1) : 0u, n = s0 + 8 < L ? (unsigned)*(const GAS unsigned short*)(urow + s0 + 8) : 0u;
    f.pn = p | (n << 16);
}
__device__ __forceinline__ void fill_coop_load(FPre (&fp)[4], const bf16* urow_ch, int tid) {
#pragma unroll
    for (int q = 0; q < 4; ++q) { const int ch = tid + 512 * q, b = ch >> 8, s0 = (ch & 255) * 8; fpre_load(fp[q], urow_ch + b * 2048, s0, 2048); }
}
__device__ __forceinline__ void fill_coop_write(LAS unsigned char* ush, const FPre (&fp)[4], float w0, float w1, float w2, float bb, int tid) {
    for (int z = tid; z < 160; z += 512) { const int b = z / 20, e = z % 20; const int el = e < 4 ? e * 8 : 2080 + (e - 4) * 8;
        *(LAS v4u*)(ush + ush_base(b) + el * 2) = (v4u){0u, 0u, 0u, 0u}; }
#pragma unroll
    for (int q = 0; q < 4; ++q) { const int ch = tid + 512 * q, b = ch >> 8, s0 = (ch & 255) * 8; conv8_store(ush + ush_base(b) + 2 * (32 + s0), fp[q], w0, w1, w2, bb); }
}
__device__ __forceinline__ void fill_ctx_load(FPre (&fp)[2], const bf16* urow_wave, int lane) {
#pragma unroll
    for (int j = 0; j < 2; ++j) { const int q = 2 * (lane >> 5) + j, s0 = (lane & 31) * 8; fpre_load(fp[j], urow_wave + q * 256, s0, 256); }
}
__device__ __forceinline__ void fill_ctx_write(LAS unsigned char* ubw, const FPre (&fp)[2], float w0, float w1, float w2, float bb, int lane) {
    const int e0 = lane < 32 ? lane * 8 : 512 + (lane - 32) * 8;
#pragma unroll
    for (int q = 0; q < 4; ++q) *(LAS v4u*)(ubw + q * 1536 + e0 * 2) = (v4u){0u, 0u, 0u, 0u};
#pragma unroll
    for (int j = 0; j < 2; ++j) { const int q = 2 * (lane >> 5) + j, s0 = (lane & 31) * 8; conv8_store(ubw + q * 1536 + (256 + s0) * 2, fp[j], w0, w1, w2, bb); }
}
__device__ __forceinline__ void gpre_load(GPre& p, const bf16* xg, int t0, int L) {
    p.xr = *(const GAS v2u*)(xg + t0);
    const unsigned a = t0 > 0 ? (unsigned)*(const GAS unsigned short*)(xg + t0 - 1) : 0u, n = t0 + 4 < L ? (unsigned)*(const GAS unsigned short*)(xg + t0 + 4) : 0u;
    p.pn = a | (n << 16);
}
__device__ __forceinline__ void gate4(const f32x4& y, const GPre& p, LAS unsigned char* up, float cw0, float cw1, float cw2, float cb, float invn, float skip, bool last, bf16* zp) {
    const v2u ur = *(const LAS v2u*)up;
    const float x[6] = {bflo(p.pn), bflo(p.xr.x), bfhi(p.xr.x), bflo(p.xr.y), bfhi(p.xr.y), bfhi(p.pn)};
    const float uu[4] = {bflo(ur.x), bfhi(ur.x), bflo(ur.y), bfhi(ur.y)};
    float z[4];
#pragma unroll
    for (int r = 0; r < 4; ++r) { const float xc = cw0 * x[r] + cw1 * x[r + 1] + cw2 * x[r + 2] + cb; z[r] = xc * (y[r] * invn + skip * uu[r]); }
    v2u o; o.x = pk2(z[0], z[1]); o.y = pk2(z[2], z[3]);
    if (last) *(GAS v2u*)zp = o; else *(LAS v2u*)up = o;
}
__device__ __forceinline__ void gate_coop_load(GPre (&pre)[8], const bf16* xg_ch, int wave, int lane) {
    const int i = lane & 15, g = lane >> 4, bb = i & 7, sg = i >> 3;
#pragma unroll
    for (int a = 0; a < 8; ++a) gpre_load(pre[a], xg_ch + bb * 2048, 32 * (8 * wave + a) + 16 * sg + 4 * g, 2048);
}
__device__ __forceinline__ void gate_coop_apply(const f32x4 (&acc)[8], const GPre (&pre)[8], LAS unsigned char* ush, float cw0, float cw1, float cw2, float cb, float invn, float skip, int wave, int lane, bool last, bf16* zt_ch) {
    const int i = lane & 15, g = lane >> 4, bb = i & 7, sg = i >> 3;
#pragma unroll
    for (int a = 0; a < 8; ++a) { const int t0 = 32 * (8 * wave + a) + 16 * sg + 4 * g;
        gate4(acc[a], pre[a], ush + ush_base(bb) + (32 + t0) * 2, cw0, cw1, cw2, cb, invn, skip, last, zt_ch + bb * 2048 + t0);
        __builtin_amdgcn_sched_barrier(0); }
}
__device__ __forceinline__ void toeplitz_ctx4(const LAS unsigned char* cpy, const LAS unsigned char* ubw, f32x4 (&acc)[4], int lane) {
    const int i = lane & 15, g = lane >> 4, c = (-i) & 7;
    const LAS unsigned char* ap = cpy + c * CPY_STRIDE + 2 * (256 + 8 * g + 16 - i - c);
    const LAS unsigned char* bp = ubw + 2 * (256 + 8 * g + 16 * i);
#pragma unroll 2
    for (int S = -256; S <= 224; S += 32) {
        const bf16x8 a = *(const LAS bf16x8*)(ap + 2 * S);
        bf16x8 b[4];
#pragma unroll
        for (int q = 0; q < 4; ++q) b[q] = *(const LAS bf16x8*)(bp + 1536 * q + 2 * S);
#pragma unroll
        for (int q = 0; q < 4; ++q) acc[q] = __builtin_amdgcn_mfma_f32_16x16x32_bf16(a, b[q], acc[q], 0, 0, 0);
    }
}
__device__ __forceinline__ void gate_ctx_load(GPre (&pre)[4], const bf16* xg_wave, int lane) {
    const int t0 = 16 * (lane & 15) + 4 * (lane >> 4);
#pragma unroll
    for (int q = 0; q < 4; ++q) gpre_load(pre[q], xg_wave + q * 256, t0, 256);
}
__device__ __forceinline__ void gate_ctx_apply(const f32x4 (&acc)[4], const GPre (&pre)[4], LAS unsigned char* ubw, float cw0, float cw1, float cw2, float cb, float invn, float skip, int lane, bool last, bf16* zt_wave) {
    const int t0 = 16 * (lane & 15) + 4 * (lane >> 4);
#pragma unroll
    for (int q = 0; q < 4; ++q) { gate4(acc[q], pre[q], ubw + q * 1536 + (256 + t0) * 2, cw0, cw1, cw2, cb, invn, skip, last, zt_wave + q * 256 + t0); __builtin_amdgcn_sched_barrier(0); }
}
}

constexpr int NPHASE = 35;
#ifndef PHMASK
#define PHMASK 0xFFFF
#endif
#define PHON(b) ((PHMASK >> (b)) & 1)
#ifndef REPMASK
#define REPMASK 0
#endif
#ifndef REPN
#define REPN 2
#endif
#define RSCALE (r_ == 0 ? 1.0f : 0.0f)
#define RUN(b, call) do { _Pragma("unroll 1") for (int r_ = 0; r_ < (((REPMASK >> (b)) & 1) ? REPN : 1); ++r_) { call; } } while (0)
#ifndef MK_PER_PHASE
#define MK_PER_PHASE 0
#endif


template <class T> __device__ __forceinline__ T* launder(T* p) { GAS T* q = (GAS T*)p; asm volatile("" : "+s"(q)); return (T*)q; }
#define ENV_IDS int tid_ = threadIdx.x; asm volatile("" : "+v"(tid_)); const int tid = tid_, lane = tid & 63, wave = __builtin_amdgcn_readfirstlane(tid >> 6); const int G = gridDim.x, bx = blockIdx.x; \
    const int vcu = (G % 8 == 0) ? (bx % 8) * (G / 8) + bx / 8 : bx; const int gw = vcu * NWAVES + wave, NGW = G * NWAVES; (void)tid; (void)lane; (void)gw; (void)NGW; (void)bx;
#define ENV_PTRS unsigned char* ws = launder(A.ws); float* out = launder(A.out); (void)out; (void)ws;

__device__ __forceinline__ void ph_prologue_a(const Args& A, LAS unsigned char* L) {
    ENV_IDS ENV_PTRS
    LAS float* wscr = (LAS float*)(L + wave * 16384);
    for (int it = gw; it < IT_TOTAL; it += NGW) weight_item(A, it, wscr, lane);
    { const size_t NCH = (size_t)2 * 524288 + 2 * 262144;
      for (size_t ch = (size_t)gw * 64 + lane; ch < NCH; ch += (size_t)NGW * 64) {
          int ten; size_t off; unsigned char* dstb;
          if (ch < 524288) { ten = 0; off = ch * 8; dstb = ws + WS_CWK; } else if (ch < 1048576) { ten = 1; off = (ch - 524288) * 8; dstb = ws + WS_CWV; }
          else if (ch < 1310720) { ten = 2; off = (ch - 1048576) * 8; dstb = ws + WS_CAK; } else { ten = 3; off = (ch - 1310720) * 8; dstb = ws + WS_CAV; }
          const float* src = GIN(2 + ten) + off; const f32x4 a = *(const GAS f32x4*)src, b = *(const GAS f32x4*)(src + 4);
          v4u o; o.x = pk2(a.x, a.y); o.y = pk2(a.z, a.w); o.z = pk2(b.x, b.y); o.w = pk2(b.z, b.w);
          *(GAS v4u*)((bf16*)dstb + off) = o; } }
    for (int u = gw; u < 1536; u += NGW) adaln_partial_unit(A, __builtin_amdgcn_readfirstlane(u), wscr, lane);
    for (int rr = gw; rr < 2304; rr += NGW) filter_a2_row(A, __builtin_amdgcn_readfirstlane(rr), lane);
}
__device__ __forceinline__ void ph_prologue_b(const Args& A, LAS unsigned char* L) {
    ENV_IDS ENV_PTRS
    LAS float* wscr = (LAS float*)(L + wave * 16384);
    float* MODF = (float*)(ws + WS_MODF);
    for (int e = gw * 64 + lane; e < DEPTH * 9 * DM; e += NGW * 64) { const int layer = e / (9 * DM), c = (e / DM) % 9, col = e % DM;
        float m[6];
#pragma unroll
        for (int q = 0; q < 6; ++q) { float s = GIN(11)[(size_t)layer * 12288 + q * DM + col];
#pragma unroll
            for (int kc = 0; kc < 8; ++kc) s += ((const float*)(ws + WS_MODP))[(size_t)((layer * 8 + kc) * 9 + c) * 12288 + q * DM + col];
            m[q] = s; }
        float* mf = MODF + (size_t)((layer * 9 + c) * 6) * DM + col;
        mf[0 * DM] = GIN(8)[layer * DM + col] * (1.0f + m[1]); mf[1 * DM] = m[0]; mf[2 * DM] = m[2];
        mf[3 * DM] = GIN(9)[layer * DM + col] * (1.0f + m[4]); mf[4 * DM] = m[3]; mf[5 * DM] = m[5]; }
    for (int u = gw; u < 2304; u += NGW) filter_hf_unit(A, __builtin_amdgcn_readfirstlane(u), wscr, lane);
}
__device__ __forceinline__ void ph_norm(const Args& A, int layer, int which) {
    ENV_IDS ENV_PTRS
    const float* modf = (const float*)(ws + WS_MODF) + (size_t)layer * 9 * 6 * DM; bf16* HB = (bf16*)(ws + WS_H);
    const float* xc = (layer == 0 && which == 0) ? GIN(0) : out; const float* xl = (layer == 0 && which == 0) ? GIN(1) : out + (size_t)NCTX * DM;
    if (layer == 0 && which == 0) {
        const float* NP = (const float*)(ws + WS_NP); float* INV = (float*)(ws + WS_INV);
        for (int e = gw * 64 + lane; e < 4 * DM; e += NGW * 64) { const int variant = e >> 12, o = (e >> 11) & 1, d = e & 2047; float s = 0.f;
            const int c0 = variant ? 16 : 0, c1 = variant ? 18 : 16;
            for (int ch = c0; ch < c1; ++ch) s += NP[(size_t)ch * 8192 + o * 2048 + d] + NP[(size_t)ch * 8192 + 4096 + o * 2048 + d];
            INV[e] = 1.0f / (s + 1e-6f); } }
    const int per = (NTOK + NGW - 1) / NGW, r0 = gw * per, r1 = (r0 + per < NTOK) ? r0 + per : NTOK;
    int cur = -1; f32x4 ma[8], mb[8];
#pragma unroll 1
    for (int row = r0; row < r1; ++row) { const int cv = row < NCTX ? 0 : 1 + ((row - NCTX) >> 11);
        if (cv != cur) { cur = cv; const GAS f32x4* pa = (const GAS f32x4*)(modf + (size_t)(cv * 6 + 3 * which) * DM) + lane; const GAS f32x4* pb = (const GAS f32x4*)(modf + (size_t)(cv * 6 + 3 * which + 1) * DM) + lane;
#pragma unroll
            for (int j = 0; j < 8; ++j) { ma[j] = pa[64 * j]; mb[j] = pb[64 * j]; } }
        const float* xr = row < NCTX ? xc + (size_t)row * DM : xl + (size_t)(row - NCTX) * DM;
        norm_row(xr, ma, mb, HB + (size_t)row * DM, lane); }
}
__device__ __forceinline__ void ph_qkv(const Args& A, int layer, LAS unsigned char* L) {
    ENV_PTRS
    const int G = gridDim.x, bx = blockIdx.x; const bool is_ax = (layer % 3) == 2; const int jx = layer / 3;
    const bf16* W = (const bf16*)(ws + (is_ax ? WS_WQKVA : (jx == 0 ? WS_WQKV0 : WS_WQKV1)));
    pg8::Gemm g{(const bf16*)(ws + WS_H), W, NTOK, QKVD, DM}; pg8::StaticOrder S; S.init(NTOK, QKVD, G, bx);
    pg8::EpiQKV E{(bf16*)(ws + WS_BIG), is_ax ? nullptr : out + OUT_WK + (size_t)jx * 256 * 512, is_ax ? out + OUT_AV : out + OUT_WV + (size_t)jx * 256 * 512, is_ax ? 0 : 256};
    pg8::gemm_phase<pg8::EpiQKV, pg8::StaticOrder, true, true>(L, g, S, E);
}
__device__ __forceinline__ void ph_qkpost(const Args& A, int layer) {
    ENV_IDS ENV_PTRS
    const bool is_ax = (layer % 3) == 2; bf16* QKVB = (bf16*)(ws + WS_BIG);
    for (int row = (is_ax ? 0 : NCTX) + gw; row < NTOK; row += NGW)
        qkpost_row(QKVB + (size_t)row * QKVD, row, is_ax, GIN(27), GIN(28), out + OUT_AK, lane);
}
__device__ __forceinline__ void ph_attn(const Args& A, int layer, LAS char* lds) {
    ENV_PTRS
    const int G = gridDim.x, bx = blockIdx.x; const bool is_ax = (layer % 3) == 2; const int jx = layer / 3;
    const att::bf16* QK = (const att::bf16*)(ws + WS_BIG); att::bf16* OB = (att::bf16*)(ws + WS_H);
    const att::bf16* CK = (const att::bf16*)(ws + (is_ax ? WS_CAK : WS_CWK));
    const att::bf16* CV = (const att::bf16*)(ws + (is_ax ? WS_CAV : WS_CWV));
    const int ncl = is_ax ? 1 : 2;
#pragma unroll 1
    for (int u = bx; u < 1536; u += G) {
        att::Unit U;
        if (u < 1024) { const int b = u >> 7, qb = (u >> 4) & 7, h = u & 15, kvh = h >> 2;
            const size_t r0 = (size_t)NCTX + (size_t)b * 2048 + (size_t)qb * 256;
            U.Q = QK + r0 * QKVD + h * 128; U.ldq = QKVD;
            const size_t coff = ((size_t)(b * ncl + (is_ax ? 0 : jx)) * 512) * 512 + kvh * 128;
            U.KA = CK + coff; U.VA = CV + coff; U.ldA = 512; U.nA = 8;
            const int klo = is_ax ? 0 : (qb * 256 - 128 < 0 ? 0 : qb * 256 - 128), khi = is_ax ? 2048 : (qb * 256 + 384 > 2048 ? 2048 : qb * 256 + 384);
            const size_t kr0 = (size_t)NCTX + (size_t)b * 2048 + klo;
            U.KB = QK + kr0 * QKVD + 2048 + kvh * 128; U.VB = QK + kr0 * QKVD + 2560 + kvh * 128; U.ldB = QKVD;
            U.NT = 8 + (khi - klo) / 64; U.win = is_ax ? 0 : 1; U.dq0 = qb * 256 - klo;
            U.O = OB + r0 * DM + h * 128; U.ldo = DM;
            U.has_sink = is_ax ? 0 : 1; U.sink = is_ax ? 0.f : GIN(14)[jx * 16 + h];
        } else { const int uc = u - 1024, b = uc >> 4, h = uc & 15, kvh = h >> 2; const size_t r0 = (size_t)b * 256;
            U.Q = QK + r0 * QKVD + h * 128; U.ldq = QKVD;
            U.KA = QK + r0 * QKVD + 2048 + kvh * 128; U.VA = QK + r0 * QKVD + 2560 + kvh * 128; U.ldA = QKVD; U.nA = 4;
            U.KB = U.KA; U.VB = U.VA; U.ldB = QKVD; U.NT = 4; U.win = 0; U.dq0 = 0;
            U.O = OB + r0 * DM + h * 128; U.ldo = DM;
            U.has_sink = is_ax ? 0 : 1; U.sink = is_ax ? 0.f : GIN(14)[jx * 16 + h];
        }
        att::attn_unit(U, lds);
    }
}
__device__ __forceinline__ void ph_hyin(const Args& A, LAS unsigned char* L) {
    ENV_PTRS
    const int G = gridDim.x, bx = blockIdx.x;
    pg8::Gemm g{(const bf16*)(ws + WS_WHI), (const bf16*)(ws + WS_H), 6144, NTOK, DM}; pg8::StaticOrder S; S.init(6144, NTOK, G, bx);
    pg8::EpiBf16 E{(bf16*)(ws + WS_BIG), NTOK};
    pg8::gemm_phase<pg8::EpiBf16, pg8::StaticOrder, true, true>(L, g, S, E);
}
__device__ __forceinline__ void ph_hyconv(const Args& A, LAS unsigned char* L) {
    ENV_IDS ENV_PTRS
    const bf16* UT = (const bf16*)(ws + WS_BIG); bf16* ZT = (bf16*)(ws + WS_ZT);
    const float* cw = GIN(16); const float* cbv = GIN(17); const float* skp = GIN(24); const float* INV = (const float*)(ws + WS_INV);
    LAS unsigned char* ush = L + hy::U_OFF; LAS unsigned char* ubw = L + hy::U_OFF + wave * hy::U_BYTES;
    const bf16* FTL = (const bf16*)(ws + WS_FT); const bf16* FTC = (const bf16*)(ws + WS_FT_CTX);
    hy::FPre fl[4]; unsigned tl0[8];
#pragma unroll 1
    for (int d = bx; d < DM; d += G) {
        float w0[3], w1[3], w2[3], cb[3];
#pragma unroll
        for (int p = 0; p < 3; ++p) { const int ch = p * DM + d; w0[p] = cw[ch]; w1[p] = cw[6144 + ch]; w2[p] = cw[2 * 6144 + ch]; cb[p] = cbv[ch]; }
        const float inl0 = INV[d], inl1 = INV[2048 + d], inc0 = INV[4096 + d], inc1 = INV[6144 + d];
        const float sk0 = skp[d], sk1 = skp[DM + d];
        const bf16* ftl = FTL + (size_t)d * 2 * 2048; const bf16* ftc = FTC + (size_t)d * 2 * 256;
        const size_t cb0 = (size_t)wave * 1024;
        hy::fill_coop_load(fl, UT + (size_t)d * NTOK + NCTX, tid); hy::taps_load<8>(tl0, ftl, 2048, tid);
        hy::fill_coop_write(ush, fl, w0[0], w1[0], w2[0], cb[0], tid); hy::copies_write<8>(L, tl0, 2048, hy::ZTOP_L, tid); __syncthreads();
        hy::GPre g0[8]; unsigned tl1[8];
        hy::taps_load<8>(tl1, ftl + (size_t)2048 * 2 * 2048, 2048, tid);
        f32x4 acc[8];
#pragma unroll
        for (int k = 0; k < 8; ++k) acc[k] = (f32x4){0.f, 0.f, 0.f, 0.f};
        hy::toeplitz_coop(L, ush, acc, wave, lane); __syncthreads();
        hy::gate_coop_load(g0, UT + (size_t)(DM + d) * NTOK + NCTX, wave, lane);
        hy::gate_coop_apply(acc, g0, ush, w0[1], w1[1], w2[1], cb[1], inl0, sk0, wave, lane, false, nullptr); hy::copies_write<8>(L, tl1, 2048, hy::ZTOP_L, tid); __syncthreads();
        hy::GPre g1[8]; hy::FPre fc[2]; unsigned tc0[1];
        hy::fill_ctx_load(fc, UT + (size_t)d * NTOK + cb0, lane); hy::taps_load<1>(tc0, ftc, 256, tid);
#pragma unroll
        for (int k = 0; k < 8; ++k) acc[k] = (f32x4){0.f, 0.f, 0.f, 0.f};
        hy::toeplitz_coop(L, ush, acc, wave, lane);
        hy::gate_coop_load(g1, UT + (size_t)(2 * DM + d) * NTOK + NCTX, wave, lane);
        hy::gate_coop_apply(acc, g1, ush, w0[2], w1[2], w2[2], cb[2], inl1, sk1, wave, lane, true, ZT + (size_t)d * NTOK + NCTX); __syncthreads();
        hy::fill_ctx_write(ubw, fc, w0[0], w1[0], w2[0], cb[0], lane); hy::copies_write<1>(L, tc0, 256, hy::ZTOP_C, tid); __syncthreads();
        hy::GPre h0[4]; unsigned tc1[1];
        hy::gate_ctx_load(h0, UT + (size_t)(DM + d) * NTOK + cb0, lane); hy::taps_load<1>(tc1, ftc + (size_t)2048 * 2 * 256, 256, tid);
        f32x4 ac4[4];
#pragma unroll
        for (int q = 0; q < 4; ++q) ac4[q] = (f32x4){0.f, 0.f, 0.f, 0.f};
        hy::toeplitz_ctx4(L, ubw, ac4, lane);
        hy::gate_ctx_apply(ac4, h0, ubw, w0[1], w1[1], w2[1], cb[1], inc0, sk0, lane, false, nullptr); __syncthreads();
        hy::copies_write<1>(L, tc1, 256, hy::ZTOP_C, tid); __syncthreads();
        hy::GPre h1[4];
        hy::gate_ctx_load(h1, UT + (size_t)(2 * DM + d) * NTOK + cb0, lane);
#pragma unroll
        for (int q = 0; q < 4; ++q) ac4[q] = (f32x4){0.f, 0.f, 0.f, 0.f};
        hy::toeplitz_ctx4(L, ubw, ac4, lane);
        hy::gate_ctx_apply(ac4, h1, ubw, w0[2], w1[2], w2[2], cb[2], inc1, sk1, lane, true, ZT + (size_t)d * NTOK + cb0); __syncthreads();
    }
}
__device__ __forceinline__ void ph_hytr(const Args& A, LAS unsigned char* L) {
    ENV_IDS ENV_PTRS
    const bf16* ZT = (const bf16*)(ws + WS_ZT); bf16* HB = (bf16*)(ws + WS_H);
    LAS unsigned char* scr = L + wave * 16384;
    for (int tile = gw; tile < 32 * 384; tile += NGW) { const int d0 = (tile & 31) * 64, r0 = (tile >> 5) * 64;
#pragma unroll
        for (int j = 0; j < 8; ++j) { const int idx = j * 64 + lane, dl = idx >> 3, ch = idx & 7;
            *(LAS v4u*)(scr + dl * 144 + ch * 16) = *(const GAS v4u*)(ZT + (size_t)(d0 + dl) * NTOK + r0 + ch * 8); }
        LDS_WAIT(); asm volatile("" ::: "memory");
#pragma unroll
        for (int j = 0; j < 8; ++j) { unsigned e[8];
#pragma unroll
            for (int q = 0; q < 8; ++q) e[q] = *(const LAS unsigned short*)(scr + (j * 8 + q) * 144 + lane * 2);
            v4u o; o.x = e[0] | (e[1] << 16); o.y = e[2] | (e[3] << 16); o.z = e[4] | (e[5] << 16); o.w = e[6] | (e[7] << 16);
            *(GAS v4u*)(HB + (size_t)(r0 + lane) * DM + d0 + j * 8) = o; }
        LDS_WAIT(); asm volatile("" ::: "memory"); }
}
__device__ __forceinline__ void ph_mixout(const Args& A, int layer, LAS unsigned char* L, float gs) {
    ENV_PTRS
    const int G = gridDim.x, bx = blockIdx.x; const int kind = layer % 3, jx = layer / 3;
    const float* modf = (const float*)(ws + WS_MODF) + (size_t)layer * 9 * 6 * DM;
    const float* xc = layer == 0 ? GIN(0) : out; const float* xl = layer == 0 ? GIN(1) : out + (size_t)NCTX * DM;
    const bf16* W = (const bf16*)(ws + (kind == 1 ? WS_WHO : (kind == 2 ? WS_WOA : (jx == 0 ? WS_WO0 : WS_WO1))));
    pg8::Gemm g{(const bf16*)(ws + WS_H), W, NTOK, DM, DM}; pg8::StaticOrder S; S.init(NTOK, DM, G, bx);
    pg8::EpiResid E{xc, xl, out, modf + 2 * DM, gs};
    pg8::gemm_phase<pg8::EpiResid, pg8::StaticOrder, true, true>(L, g, S, E);
}
__device__ __forceinline__ void ph_gu(const Args& A, int layer, LAS unsigned char* L) {
    ENV_PTRS
    const int G = gridDim.x, bx = blockIdx.x;
    pg8::Gemm g{(const bf16*)(ws + WS_H), (const bf16*)(ws + WS_WGU + (size_t)layer * W_GU), NTOK, NGU, DM}; pg8::StaticOrder S; S.init(NTOK, NGU, G, bx);
    pg8::EpiSwiglu E{(bf16*)(ws + WS_BIG)};
    pg8::gemm_phase<pg8::EpiSwiglu, pg8::StaticOrder, true, true>(L, g, S, E);
}
__device__ __forceinline__ void ph_down(const Args& A, int layer, LAS unsigned char* L, float gs) {
    ENV_PTRS
    const int G = gridDim.x, bx = blockIdx.x;
    const float* modf = (const float*)(ws + WS_MODF) + (size_t)layer * 9 * 6 * DM;
    pg8::Gemm g{(const bf16*)(ws + WS_BIG), (const bf16*)(ws + WS_WDN + (size_t)layer * W_DN), NTOK, DM, DFF}; pg8::StaticOrder S; S.init(NTOK, DM, G, bx);
    pg8::EpiResid E{out, out + (size_t)NCTX * DM, out, modf + 5 * DM, gs};
    pg8::gemm_phase<pg8::EpiResid, pg8::StaticOrder, true, true>(L, g, S, E);
}
__device__ __forceinline__ void ph_final(const Args& A) {
    ENV_IDS ENV_PTRS
    for (int row = gw; row < NTOK; row += NGW) final_norm_row(out + (size_t)row * DM, GIN(32), lane);
}

__global__ void __launch_bounds__(NWAVES * 64, 2) hybrid_fwd(Args A) {
    extern __shared__ __attribute__((aligned(16))) unsigned char lds[];
    LAS unsigned char* L = (LAS unsigned char*)lds;
    for (int u = threadIdx.x; u < (LDS_BYTES - LDSCTL_OFF) / 4; u += NWAVES * 64) ((LAS unsigned*)(L + LDSCTL_OFF))[u] = 0u;
    __syncthreads();
    XcdBarrier bar; bar.bar = (unsigned*)(A.ws + WS_CTL) + CW_BAR; bar.x = 0; bar.st = nullptr;
    if (!MK_PER_PHASE) bar = xcd_barrier_post((unsigned*)(A.ws + WS_CTL) + CW_BAR, (volatile LAS unsigned*)(L + MISC_OFF) + 8);
    const int lo = A.ph_lo, hi = A.ph_hi;
#define IN(k) (lo <= (k) && (k) < hi)
#define SEAM(k) do { if (IN(k) && IN((k) + 1)) xcd_barrier(bar); } while (0)
    if (PHON(0) && IN(0)) RUN(0, ph_prologue_a(A, L));
    SEAM(0);
    if (PHON(1) && IN(1)) RUN(1, ph_prologue_b(A, L));
    SEAM(1);
#pragma unroll 1
    for (int layer = 0; layer < DEPTH; ++layer) {
        const int pb = 2 + 8 * layer;
        if (PHON(2) && IN(pb + 0)) RUN(2, ph_norm(A, layer, 0));
        SEAM(pb + 0);
        if ((layer % 3) != 1) {
            if (PHON(3) && IN(pb + 1)) RUN(3, ph_qkv(A, layer, L));
            SEAM(pb + 1);
            if (PHON(4) && IN(pb + 2)) RUN(4, ph_qkpost(A, layer));
            SEAM(pb + 2);
            if (PHON(5) && IN(pb + 3)) RUN(5, ph_attn(A, layer, (LAS char*)L));
            SEAM(pb + 3);
        } else {
            if (PHON(6) && IN(pb + 1)) RUN(6, ph_hyin(A, L));
            SEAM(pb + 1);
            if (PHON(7) && IN(pb + 2)) RUN(7, ph_hyconv(A, L));
            SEAM(pb + 2);
            if (PHON(8) && IN(pb + 3)) RUN(8, ph_hytr(A, L));
            SEAM(pb + 3);
        }
        if (PHON(9) && IN(pb + 4)) RUN(9, ph_mixout(A, layer, L, RSCALE));
        SEAM(pb + 4);
        if (PHON(10) && IN(pb + 5)) RUN(10, ph_norm(A, layer, 1));
        SEAM(pb + 5);
        if (PHON(11) && IN(pb + 6)) RUN(11, ph_gu(A, layer, L));
        SEAM(pb + 6);
        if (PHON(12) && IN(pb + 7)) RUN(12, ph_down(A, layer, L, RSCALE));
        SEAM(pb + 7);
    }
    if (PHON(13) && IN(34)) RUN(13, ph_final(A));
#undef IN
#undef SEAM
}

extern "C" void kernel_launch(void* const* d_in, const int* in_sizes, int n_in, void* d_out, int out_size, void* d_ws, size_t ws_size, hipStream_t stream) {
    static int grid = 0;
    if (grid == 0) {
        if (n_in != 33 || (size_t)out_size != OUT_END || ws_size < WS_END) { fprintf(stderr, "kernel_launch: unexpected shapes: n_in %d out %d ws %zu (need %zu)\n", n_in, out_size, ws_size, (size_t)WS_END); grid = -1; return; }
        int dev = 0, cus = 0, per_cu = 0;
        if (hipGetDevice(&dev) != hipSuccess || hipDeviceGetAttribute(&cus, hipDeviceAttributeMultiprocessorCount, dev) != hipSuccess) { grid = -1; return; }
        if (hipFuncSetAttribute((const void*)hybrid_fwd, hipFuncAttributeMaxDynamicSharedMemorySize, LDS_BYTES) != hipSuccess) { fprintf(stderr, "kernel_launch: hipFuncSetAttribute failed\n"); grid = -1; return; }
        if (hipOccupancyMaxActiveBlocksPerMultiprocessor(&per_cu, (const void*)hybrid_fwd, NWAVES * 64, LDS_BYTES) != hipSuccess || per_cu < 1)
            fprintf(stderr, "kernel_launch: occupancy query reports %d workgroups per CU\n", per_cu);
        (void)hipGetLastError();
        grid = cus;
    }
    if (grid < 0) return;
    if (hipMemsetAsync((char*)d_ws + WS_CTL, 0, CTL_ZERO_BYTES, stream) != hipSuccess) { fprintf(stderr, "kernel_launch: memset failed\n"); return; }
    Args a{};
    for (int i = 0; i < 33; ++i) a.in[i] = (const float*)d_in[i];
    a.out = (float*)d_out; a.ws = (unsigned char*)d_ws;
#if MK_PER_PHASE
    for (int ph = 0; ph < NPHASE; ++ph) { a.ph_lo = ph; a.ph_hi = ph + 1; hipLaunchKernelGGL(hybrid_fwd, dim3(grid), dim3(NWAVES * 64), LDS_BYTES, stream, a); }
#else
    a.ph_lo = 0; a.ph_hi = NPHASE; hipLaunchKernelGGL(hybrid_fwd, dim3(grid), dim3(NWAVES * 64), LDS_BYTES, stream, a);
#endif
    const hipError_t le = hipPeekAtLastError();
    if (le != hipSuccess) fprintf(stderr, "kernel_launch: launch failed: %s\n", hipGetErrorName(le));
}
```

```cpp
#include <hip/hip_runtime.h>
#include <cstdio>
#include <cstdint>
#include <hip/hip_bf16.h>
#include <cmath>
namespace pg8 {
#define PG8_LAS __attribute__((address_space(3)))
typedef unsigned short bf16_t;
typedef short bf16x8 __attribute__((ext_vector_type(8)));
typedef float f32x4 __attribute__((ext_vector_type(4)));
typedef unsigned u32x4 __attribute__((ext_vector_type(4)));
constexpr int BM = 256, BK = 64, HALF = 128, HTB = HALF * BK * 2  , STAGE_BYTES = 8 * HTB, NXCD = 8;

__host__ __device__ __forceinline__ int lds_byte(int r, int c) { const int st = (r >> 4) * 2 + (c >> 5), rr = r & 15, cc = c & 31, ob = rr * 64 + cc * 2; return st * 1024 + (ob ^ (((ob >> 9) & 1) << 5)); }
__host__ __device__ __forceinline__ void stage_rc(int b, int& R, int& C) { const int st = b / 1024, sb = b % 1024, swz = sb ^ (((sb >> 9) & 1) << 5); R = (st >> 1) * 16 + swz / 64; C = (st & 1) * 32 + (swz % 64) / 2; }
__host__ __device__ __forceinline__ int perm32(int rho) { const int n = rho >> 4, i = rho & 15; return 8 * (i >> 2) + 4 * n + (i & 3); }

struct Unit { int pm, pn, k0, nk, part, slot; };
struct Gemm { const bf16_t* A; const bf16_t* Bt; int M, N, K; };

struct StaticOrder {
    int nM, nN, nwg, G, c, WGM, SPL, full, T, ntk, i0; float* pbuf; unsigned* pcnt;
    __host__ __device__ void init(int M, int N, int G_, int c_, int wgm = 4) { nM = M / BM; nN = N / BM; nwg = nM * nN; G = G_; c = c_; WGM = wgm; SPL = 1; full = nwg; T = 0; ntk = 0; i0 = 0; pbuf = nullptr; pcnt = nullptr; }
    __host__ __device__ void split(int spl, int ktiles, float* pb, unsigned* pc) { T = nwg % G; full = nwg - T; SPL = (T > 0 && T * spl <= G) ? spl : 1; if (SPL == 1) { full = nwg; T = 0; } ntk = ktiles; pbuf = pb; pcnt = pc; }
    __host__ __device__ bool next(int i, Unit& u) const {
        long L = (long)(i + i0) * G + c; u.part = -1; u.k0 = 0; u.nk = ntk; u.slot = 0;
        if (L >= full && SPL > 1) { const int j = (int)(L - full); if (j >= T * SPL) return false; u.part = j / T; u.slot = j % T; L = full + u.slot; u.nk = ntk / SPL; u.k0 = u.part * u.nk; }
        else if (L >= nwg) return false;
        int wgid = (int)L; { const int q = nwg / NXCD, r = nwg % NXCD, xcd = wgid % NXCD, off = wgid / NXCD; wgid = (xcd < r ? xcd * (q + 1) : r * (q + 1) + (xcd - r) * q) + off; }
        const int nig = WGM * nN, gid = wgid / nig, fm = gid * WGM, gsz = (nM - fm) < WGM ? (nM - fm) : WGM;
        u.pm = fm + ((wgid % nig) % gsz); u.pn = (wgid % nig) / gsz; return true;
    }
    __device__ __forceinline__ void a_ready(const Unit&) const {}
    __device__ __forceinline__ void done(const Unit&) const {}
};

__device__ __forceinline__ unsigned cvt_pk_bf16(float lo, float hi) { unsigned r; asm("v_cvt_pk_bf16_f32 %0, %1, %2" : "=v"(r) : "v"(lo), "v"(hi)); return r; }
typedef float f32x2 __attribute__((ext_vector_type(2)));
struct EpiBf16 {
    static constexpr bool PERM = true, AFTER_DRAIN = false;
    bf16_t* O; int ldc;
    __device__ __forceinline__ void operator()(const f32x4 (&acc)[2][2][4][2], const Unit& u, int wr, int wc, int fr, int fq) const {
        const int row0 = u.pm * BM + wr * 64 + fr; const int col0 = u.pn * BM + wc * 32 + 8 * fq;
#pragma unroll
        for (int ai = 0; ai < 2; ++ai)
#pragma unroll
            for (int m = 0; m < 4; ++m) { bf16_t* rowp = O + (size_t)(row0 + ai * HALF + m * 16) * ldc + col0;
#pragma unroll
                for (int bj = 0; bj < 2; ++bj) { const f32x4 v0 = acc[ai][bj][m][0], v1 = acc[ai][bj][m][1];
                    u32x4 w; w.x = cvt_pk_bf16(v0[0], v0[1]); w.y = cvt_pk_bf16(v0[2], v0[3]); w.z = cvt_pk_bf16(v1[0], v1[1]); w.w = cvt_pk_bf16(v1[2], v1[3]);
                    *(u32x4*)(rowp + bj * HALF) = w; } }
    }
};
struct EpiQKV {
    static constexpr bool PERM = true, AFTER_DRAIN = false;
    bf16_t* O; float* sk; float* sv; int extra;
    __device__ __forceinline__ void operator()(const f32x4 (&acc)[2][2][4][2], const Unit& u, int wr, int wc, int fr, int fq) const {
        const int row0 = u.pm * BM + wr * 64 + fr; const int col0 = u.pn * BM + wc * 32 + 8 * fq;
        float* sb = nullptr; int scol = 0;
        if (u.pm < 32 && u.pn >= 8) { if (u.pn < 10) { sb = sk; scol = col0 - 2048; } else { sb = sv; scol = col0 - 2560; } }
#pragma unroll
        for (int ai = 0; ai < 2; ++ai)
#pragma unroll
            for (int m = 0; m < 4; ++m) { const int row = row0 + ai * HALF + m * 16; bf16_t* rowp = O + (size_t)row * 3072 + col0;
#pragma unroll
                for (int bj = 0; bj < 2; ++bj) { const f32x4 v0 = acc[ai][bj][m][0], v1 = acc[ai][bj][m][1];
                    u32x4 w; w.x = cvt_pk_bf16(v0[0], v0[1]); w.y = cvt_pk_bf16(v0[2], v0[3]); w.z = cvt_pk_bf16(v1[0], v1[1]); w.w = cvt_pk_bf16(v1[2], v1[3]);
                    *(u32x4*)(rowp + bj * HALF) = w;
                    if (sb) { float* sp = sb + (size_t)(row + (row >> 8) * extra) * 512 + scol + bj * HALF; *(f32x4*)sp = v0; *(f32x4*)(sp + 4) = v1; } } }
    }
};
struct EpiResid {
    static constexpr bool PERM = true, AFTER_DRAIN = false;
    bf16_t* xb; const float* gate; float gs;
    __device__ __forceinline__ void operator()(const f32x4 (&acc)[2][2][4][2], const Unit& u, int wr, int wc, int fr, int fq) const {
        const int row0 = u.pm * BM + wr * 64 + fr; const int col0 = u.pn * BM + wc * 32 + 8 * fq;
        const int cv = u.pm < 32 ? 0 : 1 + ((u.pm - 32) >> 3);
        const float* gp = gate + (size_t)cv * (6 * 2048) + col0;
        f32x4 gv[2][2];
#pragma unroll
        for (int bj = 0; bj < 2; ++bj)
#pragma unroll
            for (int n = 0; n < 2; ++n) gv[bj][n] = *(const f32x4*)(gp + bj * HALF + n * 4) * gs;
#pragma unroll
        for (int ai = 0; ai < 2; ++ai) { u32x4 xw[4][2];
#pragma unroll
            for (int m = 0; m < 4; ++m)
#pragma unroll
                for (int bj = 0; bj < 2; ++bj) xw[m][bj] = *(const u32x4*)(xb + (size_t)(row0 + ai * HALF + m * 16) * 2048 + col0 + bj * HALF);
#pragma unroll
            for (int m = 0; m < 4; ++m)
#pragma unroll
                for (int bj = 0; bj < 2; ++bj) { const u32x4 w = xw[m][bj];
                    const f32x4 x0 = {__builtin_bit_cast(float, w.x << 16), __builtin_bit_cast(float, w.x & 0xffff0000u), __builtin_bit_cast(float, w.y << 16), __builtin_bit_cast(float, w.y & 0xffff0000u)};
                    const f32x4 x1 = {__builtin_bit_cast(float, w.z << 16), __builtin_bit_cast(float, w.z & 0xffff0000u), __builtin_bit_cast(float, w.w << 16), __builtin_bit_cast(float, w.w & 0xffff0000u)};
                    const f32x4 y0 = x0 + gv[bj][0] * acc[ai][bj][m][0], y1 = x1 + gv[bj][1] * acc[ai][bj][m][1];
                    u32x4 o; o.x = cvt_pk_bf16(y0[0], y0[1]); o.y = cvt_pk_bf16(y0[2], y0[3]); o.z = cvt_pk_bf16(y1[0], y1[1]); o.w = cvt_pk_bf16(y1[2], y1[3]);
                    *(u32x4*)(xb + (size_t)(row0 + ai * HALF + m * 16) * 2048 + col0 + bj * HALF) = o; }
            asm volatile("" ::: "memory"); }
    }
};
struct EpiSwiglu {
    static constexpr bool PERM = true, AFTER_DRAIN = false;
    bf16_t* O;
    __device__ __forceinline__ float sw(float g, float uu) const { return g * __builtin_amdgcn_rcpf(1.0f + __builtin_amdgcn_exp2f(-1.4426950408889634f * g)) * uu; }
    __device__ __forceinline__ f32x4 sw4(const f32x4 g, const f32x4 uu) const {
        const f32x4 t = g * -1.4426950408889634f;
        f32x4 e; e[0] = __builtin_amdgcn_exp2f(t[0]); e[1] = __builtin_amdgcn_exp2f(t[1]); e[2] = __builtin_amdgcn_exp2f(t[2]); e[3] = __builtin_amdgcn_exp2f(t[3]);
        const f32x4 d = e + 1.0f;
        f32x4 r; r[0] = __builtin_amdgcn_rcpf(d[0]); r[1] = __builtin_amdgcn_rcpf(d[1]); r[2] = __builtin_amdgcn_rcpf(d[2]); r[3] = __builtin_amdgcn_rcpf(d[3]);
        return (g * uu) * r;
    }
    __device__ __forceinline__ void operator()(const f32x4 (&acc)[2][2][4][2], const Unit& u, int wr, int wc, int fr, int fq) const {
        const int row0 = u.pm * BM + wr * 64 + fr; const int col0 = u.pn * HALF + wc * 32 + 8 * fq;
#pragma unroll
        for (int ai = 0; ai < 2; ++ai)
#pragma unroll
            for (int m = 0; m < 4; ++m) {
                bf16_t* rowp = O + ((size_t)(u.pm * 88 + u.pn * 2 + (wc >> 1)) * 256 + (wr * 64 + fr + ai * HALF + m * 16)) * 64 + (wc & 1) * 32 + 8 * fq;
                const f32x4 g0 = acc[ai][0][m][0], g1 = acc[ai][0][m][1], u0 = acc[ai][1][m][0], u1 = acc[ai][1][m][1];
                const f32x4 y0 = sw4(g0, u0), y1 = sw4(g1, u1);
                u32x4 w; w.x = cvt_pk_bf16(y0[0], y0[1]); w.y = cvt_pk_bf16(y0[2], y0[3]); w.z = cvt_pk_bf16(y1[0], y1[1]); w.w = cvt_pk_bf16(y1[2], y1[3]);
                *(u32x4*)rowp = w; }
    }
};

typedef short s16x4 __attribute__((ext_vector_type(4)));
template <int OFF> __device__ __forceinline__ s16x4 tr_read(int vb) { s16x4 r; asm volatile("ds_read_b64_tr_b16 %0, %1 offset:%2" : "=&v"(r) : "v"(vb), "i"(OFF) : "memory"); return r; }
template <class Epi, class Sched, bool ALIGN_EPI = false, bool SP2 = false, bool SPLITK = false, bool ABLK = false, bool ATR = false>
__device__ __forceinline__ void gemm_phase(PG8_LAS unsigned char* lds, const Gemm g, const Sched& S, const Epi& E) {
    int tid_ = threadIdx.x; asm volatile("" : "+v"(tid_));
    const int tid = tid_, wid = __builtin_amdgcn_readfirstlane(tid >> 6), lane = tid & 63, wr = wid >> 2, wc = wid & 3, fr = lane & 15, fq = lane >> 4;
    const int K = g.K, nt = K / BK;
    unsigned voffA[2], voffB[2];
#pragma unroll
    for (int i = 0; i < 2; ++i) { int R, C; stage_rc(tid * 16 + i * 8192, R, C); const int Rb = Epi::PERM ? ((R & ~31) + perm32(R & 31)) : R;
        voffA[i] = ABLK ? (unsigned)(R * BK + C) * 2u : (unsigned)(R * K + C) * 2u; voffB[i] = (unsigned)(Rb * K + C) * 2u;
        if constexpr (ATR) { const int P = tid * 16 + i * 8192, kl = P >> 8, cs = (P >> 4) & 15, c = cs ^ (((kl & 3) << 2) | ((kl >> 2) & 3));
            voffA[i] = (unsigned)kl * (unsigned)(g.M * 2) + (unsigned)c * 16u; } }
    const size_t kstep = (size_t)(BK * 2);
    const size_t hstep = (size_t)HALF * K * 2;
    const size_t tstep = 2 * hstep;
    const size_t kstepA = ATR ? (size_t)BK * g.M * 2 : ABLK ? (size_t)BM * BK * 2 : kstep, hstepA = ATR ? (size_t)HALF * 2 : ABLK ? (size_t)HALF * BK * 2 : hstep, tstepA = ATR ? (size_t)BM * 2 : ABLK ? (size_t)nt * BM * BK * 2 : tstep;
    const unsigned ldsw = (unsigned)wid * 1024u;
    const int aoff = lds_byte(wr * 64 + fr, fq * 8), boff = lds_byte(wc * 32 + fr, fq * 8);
#define PG8_SA(b, h) (((b) * 2 + (h)) * HTB)
#define PG8_SB(b, h) ((4 + (b) * 2 + (h)) * HTB)
#define PG8_STAGE(bufoff, gbase, voff) do { _Pragma("unroll") for (int _i = 0; _i < 2; ++_i) \
        __builtin_amdgcn_global_load_lds((const unsigned*)((const char*)(gbase) + (voff)[_i]), (PG8_LAS unsigned*)(lds + (bufoff) + ldsw + _i * 8192), 16, 0, 0); } while (0)
#define PG8_LDA_ROW(dst, b, h) do { _Pragma("unroll") for (int m = 0; m < 4; ++m) _Pragma("unroll") for (int k = 0; k < 2; ++k) dst[m][k] = *(const PG8_LAS bf16x8*)(lds + PG8_SA(b, h) + aoff + m * 2048 + k * 1024); } while (0)
    int atr[4][2];
    if constexpr (ATR) { const int fq_ = lane >> 4, q_ = (lane & 15) >> 2, p_ = lane & 3;
#pragma unroll
        for (int m = 0; m < 4; ++m)
#pragma unroll
            for (int hf = 0; hf < 2; ++hf) { const int kl = 8 * fq_ + 4 * hf + q_, c = 8 * wr + 2 * m + (p_ >> 1), f = ((kl & 3) << 2) | ((kl >> 2) & 3);
                atr[m][hf] = (int)(unsigned)(uintptr_t)lds + kl * 256 + 16 * (c ^ f) + 8 * (p_ & 1); } }
#define PG8_TR1(dst, m, k, b, h) do { const s16x4 l_ = tr_read<PG8_SA(b, h) + (k) * 8192>(atr[m][0]), h_ = tr_read<PG8_SA(b, h) + (k) * 8192>(atr[m][1]); dst[m][k] = __builtin_shufflevector(l_, h_, 0, 1, 2, 3, 4, 5, 6, 7); } while (0)
#define PG8_LDA(dst, b, h) do { if constexpr (ATR) { PG8_TR1(dst, 0, 0, b, h); PG8_TR1(dst, 0, 1, b, h); PG8_TR1(dst, 1, 0, b, h); PG8_TR1(dst, 1, 1, b, h); PG8_TR1(dst, 2, 0, b, h); PG8_TR1(dst, 2, 1, b, h); PG8_TR1(dst, 3, 0, b, h); PG8_TR1(dst, 3, 1, b, h); } \
    else PG8_LDA_ROW(dst, b, h); } while (0)
#define PG8_LDB(dst, b, h) do { _Pragma("unroll") for (int n = 0; n < 2; ++n) _Pragma("unroll") for (int k = 0; k < 2; ++k) dst[n][k] = *(const PG8_LAS bf16x8*)(lds + PG8_SB(b, h) + boff + n * 2048 + k * 1024); } while (0)
#define PG8_MMA(ai, bj, At, Bt) do { __builtin_amdgcn_s_setprio(1); _Pragma("unroll") for (int m = 0; m < 4; ++m) _Pragma("unroll") for (int n = 0; n < 2; ++n) _Pragma("unroll") for (int k = 0; k < 2; ++k) \
        acc[ai][bj][m][n] = __builtin_amdgcn_mfma_f32_16x16x32_bf16(Bt[n][k], At[m][k], acc[ai][bj][m][n], 0, 0, 0); __builtin_amdgcn_s_setprio(0); } while (0)
#define PG8_WAIT_V(n) asm volatile("s_waitcnt vmcnt(" #n ")" ::: "memory")
#define PG8_WAIT_L(n) asm volatile("s_waitcnt lgkmcnt(" #n ")" ::: "memory")
#define PG8_BAR __builtin_amdgcn_s_barrier()
#define PG8_SCHED __builtin_amdgcn_sched_barrier(0)
    Unit cur, nxt; int ui = 0;
    if (!S.next(0, cur)) return;
    f32x4 acc[2][2][4][2];
#pragma unroll
    for (int a = 0; a < 2; ++a)
#pragma unroll
        for (int b = 0; b < 2; ++b)
#pragma unroll
            for (int m = 0; m < 4; ++m)
#pragma unroll
                for (int n = 0; n < 2; ++n) acc[a][b][m][n] = (f32x4){0.f, 0.f, 0.f, 0.f};
    bf16x8 At[4][2], B0[2][2], B1[2][2];
    const char* cA = (const char*)g.A + (size_t)cur.pm * tstepA; const char* cB = (const char*)g.Bt + (size_t)cur.pn * tstep;
    if constexpr (SPLITK) { cA += (size_t)cur.k0 * kstepA; cB += (size_t)cur.k0 * kstep; }
    S.a_ready(cur);
    if constexpr (SP2) {
        PG8_STAGE(PG8_SB(0, 0), cB, voffB); PG8_STAGE(PG8_SB(0, 1), cB + hstep, voffB); PG8_STAGE(PG8_SA(0, 0), cA, voffA); PG8_STAGE(PG8_SA(0, 1), cA + hstepA, voffA);
        if (wr == 1) PG8_BAR;
        PG8_WAIT_V(2); PG8_BAR;
        PG8_STAGE(PG8_SB(1, 0), cB + kstep, voffB); PG8_STAGE(PG8_SA(1, 0), cA + kstepA, voffA); PG8_STAGE(PG8_SB(1, 1), cB + hstep + kstep, voffB);
        PG8_WAIT_V(6); PG8_BAR;
    } else {
        PG8_STAGE(PG8_SB(0, 0), cB, voffB); PG8_STAGE(PG8_SA(0, 0), cA, voffA); PG8_STAGE(PG8_SB(0, 1), cB + hstep, voffB); PG8_STAGE(PG8_SA(0, 1), cA + hstepA, voffA);
        if (wr == 1) PG8_BAR;
        PG8_WAIT_V(4); PG8_BAR;
        PG8_STAGE(PG8_SB(1, 0), cB + kstep, voffB); PG8_STAGE(PG8_SA(1, 0), cA + kstepA, voffA); PG8_STAGE(PG8_SB(1, 1), cB + hstep + kstep, voffB);
        PG8_WAIT_V(6); PG8_BAR;
    }
    for (;;) {
        const bool has_next = S.next(ui + 1, nxt);
        const char* nA = has_next ? (const char*)g.A + (size_t)nxt.pm * tstepA : cA; const char* nB = has_next ? (const char*)g.Bt + (size_t)nxt.pn * tstep : cB;
        if constexpr (SPLITK) { if (has_next) { nA += (size_t)nxt.k0 * kstepA; nB += (size_t)nxt.k0 * kstep; } }
        const int unt = SPLITK ? cur.nk : nt;
        for (int t = 0; t < unt; t += 2) {
            const bool last = (t == unt - 2);
            const char* a1 = cA + (size_t)(t + 1) * kstepA;
            const char* a2 = last ? nA : cA + (size_t)(t + 2) * kstepA; const char* b2 = last ? nB : cB + (size_t)(t + 2) * kstep;
            const char* a3 = a2 + kstepA; const char* b3 = b2 + kstep;
            if (last && has_next) S.a_ready(nxt);
            if constexpr (SP2) {
            PG8_LDB(B0, 0, 0); PG8_LDB(B1, 0, 1); PG8_SCHED; PG8_LDA(At, 0, 0); PG8_STAGE(PG8_SA(1, 1), a1 + hstepA, voffA);
            PG8_WAIT_V(8); PG8_WAIT_L(0); PG8_BAR; PG8_MMA(0, 0, At, B0); PG8_MMA(0, 1, At, B1); PG8_BAR; PG8_SCHED;
            PG8_LDA(At, 0, 1); PG8_STAGE(PG8_SB(0, 0), b2, voffB); PG8_STAGE(PG8_SB(0, 1), b2 + hstep, voffB); PG8_STAGE(PG8_SA(0, 0), a2, voffA);
            PG8_WAIT_V(8); PG8_WAIT_L(0); PG8_BAR; PG8_MMA(1, 0, At, B0); PG8_MMA(1, 1, At, B1); PG8_BAR; PG8_SCHED;
            PG8_LDB(B0, 1, 0); PG8_LDB(B1, 1, 1); PG8_SCHED; PG8_LDA(At, 1, 0); PG8_STAGE(PG8_SA(0, 1), a2 + hstepA, voffA);
            PG8_WAIT_V(8); PG8_WAIT_L(0); PG8_BAR; PG8_MMA(0, 0, At, B0); PG8_MMA(0, 1, At, B1); PG8_BAR; PG8_SCHED;
            PG8_LDA(At, 1, 1); PG8_STAGE(PG8_SB(1, 0), b3, voffB); PG8_STAGE(PG8_SB(1, 1), b3 + hstep, voffB); PG8_STAGE(PG8_SA(1, 0), a3, voffA);
            PG8_WAIT_V(8); PG8_WAIT_L(0); PG8_BAR; PG8_MMA(1, 0, At, B0); PG8_MMA(1, 1, At, B1); PG8_BAR; PG8_SCHED;
            } else {
            PG8_LDB(B0, 0, 0); PG8_SCHED; PG8_LDA(At, 0, 0); PG8_STAGE(PG8_SA(1, 1), a1 + hstepA, voffA);
            PG8_WAIT_L(8); PG8_BAR; PG8_WAIT_L(0); PG8_MMA(0, 0, At, B0); PG8_BAR; PG8_SCHED;
            PG8_LDB(B1, 0, 1); PG8_STAGE(PG8_SB(0, 0), b2, voffB);
            PG8_BAR; PG8_WAIT_L(0); PG8_MMA(0, 1, At, B1); PG8_BAR;
            PG8_LDA(At, 0, 1); PG8_STAGE(PG8_SA(0, 0), a2, voffA);
            PG8_BAR; PG8_WAIT_L(0); PG8_MMA(1, 0, At, B0); PG8_BAR; PG8_SCHED;
            PG8_STAGE(PG8_SB(0, 1), b2 + hstep, voffB);
            PG8_WAIT_V(6); PG8_BAR; PG8_MMA(1, 1, At, B1); PG8_BAR;
            PG8_LDB(B0, 1, 0); PG8_SCHED; PG8_LDA(At, 1, 0); PG8_STAGE(PG8_SA(0, 1), a2 + hstepA, voffA);
            PG8_WAIT_L(8); PG8_BAR; PG8_WAIT_L(0); PG8_MMA(0, 0, At, B0); PG8_BAR; PG8_SCHED;
            PG8_LDB(B1, 1, 1); PG8_STAGE(PG8_SB(1, 0), b3, voffB);
            PG8_BAR; PG8_WAIT_L(0); PG8_MMA(0, 1, At, B1); PG8_BAR;
            PG8_LDA(At, 1, 1); PG8_STAGE(PG8_SA(1, 0), a3, voffA);
            PG8_BAR; PG8_WAIT_L(0); PG8_MMA(1, 0, At, B0); PG8_BAR; PG8_SCHED;
            PG8_STAGE(PG8_SB(1, 1), b3 + hstep, voffB);
            PG8_WAIT_V(6); PG8_BAR; PG8_MMA(1, 1, At, B1); PG8_BAR;
            }
        }
        if constexpr (ALIGN_EPI) { if (wr == 0) PG8_BAR; }
        if constexpr (SPLITK) {
            static_assert(ALIGN_EPI, "split-K tail units need both halves at the same barrier");
            if (cur.part >= 0) {
                const __amdgpu_buffer_rsrc_t prs = __builtin_amdgcn_make_buffer_rsrc((void*)S.pbuf, 0, 0x7fffffff, 0x00020000);
                unsigned po = (unsigned)(cur.slot * (S.SPL - 1)) * (32u * 512u * 16u) + (unsigned)tid * 16u;
                const bool writer = cur.part > 0;
#ifdef PROBE_SKIPX
                if (E.gs == 0.f) { if (writer) break; } else
#endif
                if (writer) {
                    po += (unsigned)(cur.part - 1) * (32u * 512u * 16u);
#pragma unroll
                    for (int a = 0; a < 2; ++a)
#pragma unroll
                        for (int b = 0; b < 2; ++b)
#pragma unroll
                            for (int m = 0; m < 4; ++m)
#pragma unroll
                                for (int n = 0; n < 2; ++n) __builtin_amdgcn_raw_buffer_store_b128(__builtin_bit_cast(u32x4, acc[a][b][m][n]), prs, po + (unsigned)((((a * 2 + b) * 4 + m) * 2 + n) * 8192), 0, 16);
                }
                PG8_WAIT_V(0); PG8_BAR;
                if (tid == 0) {
                    if (writer) __hip_atomic_fetch_add(S.pcnt + cur.slot, 1u, __ATOMIC_RELAXED, __HIP_MEMORY_SCOPE_AGENT);
                    else { unsigned sp = 0; while (__hip_atomic_load(S.pcnt + cur.slot, __ATOMIC_RELAXED, __HIP_MEMORY_SCOPE_AGENT) < (unsigned)(S.SPL - 1)) { __builtin_amdgcn_s_sleep(2); if (++sp > (1u << 22)) break; } }
                }
                PG8_BAR;
                if (writer) break;
#ifdef PROBE_SKIPX
                if (E.gs != 0.f)
#endif
#pragma unroll 1
                for (int p = 0; p < S.SPL - 1; ++p, po += 32u * 512u * 16u) {
#pragma unroll
                    for (int a = 0; a < 2; ++a)
#pragma unroll
                        for (int b = 0; b < 2; ++b) {
#pragma unroll
                            for (int m = 0; m < 4; ++m) {
                                const u32x4 q0 = __builtin_amdgcn_raw_buffer_load_b128(prs, po + (unsigned)((((a * 2 + b) * 4 + m) * 2 + 0) * 8192), 0, 16), q1 = __builtin_amdgcn_raw_buffer_load_b128(prs, po + (unsigned)((((a * 2 + b) * 4 + m) * 2 + 1) * 8192), 0, 16);
                                acc[a][b][m][0] += __builtin_bit_cast(f32x4, q0); acc[a][b][m][1] += __builtin_bit_cast(f32x4, q1); }
                            PG8_SCHED; } }
            }
        }
        if constexpr (!Epi::AFTER_DRAIN) { E(acc, cur, wr, wc, fr, fq); S.done(cur); }
        if (!has_next) break;
#pragma unroll
        for (int a = 0; a < 2; ++a)
#pragma unroll
            for (int b = 0; b < 2; ++b)
#pragma unroll
                for (int m = 0; m < 4; ++m)
#pragma unroll
                    for (int n = 0; n < 2; ++n) acc[a][b][m][n] = (f32x4){0.f, 0.f, 0.f, 0.f};
        cur = nxt; cA = nA; cB = nB; ++ui;
        if constexpr (ALIGN_EPI) { if (wr == 1) PG8_BAR; }
    }
    PG8_WAIT_V(0);
    if constexpr (!ALIGN_EPI) { if (wr == 0) PG8_BAR; }
    PG8_BAR;
    if constexpr (Epi::AFTER_DRAIN) { E.fused(acc, cur, wr, wc, fr, fq, lds, wid, lane); S.done(cur); }
#undef PG8_SA
#undef PG8_SB
#undef PG8_STAGE
#undef PG8_LDA
#undef PG8_LDA_ROW
#undef PG8_TR1
#undef PG8_LDB
#undef PG8_MMA
#undef PG8_WAIT_V
#undef PG8_WAIT_L
#undef PG8_BAR
#undef PG8_SCHED
}
}

namespace att {
using bf16 = unsigned short;
#define AG __attribute__((address_space(1)))
#define AL __attribute__((address_space(3)))
constexpr int D = 128, NW = 8, QBLK = 32, KVBLK = 64;
constexpr float SCALE = 0.088388347648318440f;
constexpr float THR = 8.f;
using bf16x8 = __attribute__((ext_vector_type(8))) short;
using s16x4  = __attribute__((ext_vector_type(4))) short;
using f32x16 = __attribute__((ext_vector_type(16))) float;
using u32x4  = __attribute__((ext_vector_type(4))) unsigned;
constexpr size_t SHM_V = KVBLK * D * 2, SHM_K = KVBLK * D * 2, SHM_ATTN = 2 * SHM_V + 2 * SHM_K + NW * 64 * 4;
#define KSWZ(row, colB) ((row) * 256 + ((colB) ^ (((row) & 7) << 4)))
#define SBAR() __builtin_amdgcn_sched_barrier(0)
__device__ __forceinline__ int crow(int r, int hi) { return (r & 3) + 8 * (r >> 2) + 4 * hi; }
__device__ __forceinline__ unsigned cvtpk(float lo, float hi) { unsigned r; asm("v_cvt_pk_bf16_f32 %0, %1, %2" : "=v"(r) : "v"(lo), "v"(hi)); return r; }
__device__ __forceinline__ bf16x8 ld8(const bf16* p) { return *(const AG bf16x8*)p; }

__device__ __forceinline__ void partialSM(f32x16& p0, f32x16& p1, float& m_reg, float& mn, float& alpha) {
  constexpr float C = SCALE * 1.4426950408889634f;
  float pmax = p0[0]; for (int r = 1; r < 16; ++r) pmax = fmaxf(pmax, p0[r]); for (int r = 0; r < 16; ++r) pmax = fmaxf(pmax, p1[r]);
  { auto rr = __builtin_amdgcn_permlane32_swap(__float_as_uint(pmax), __float_as_uint(pmax), false, false);
    pmax = fmaxf(__uint_as_float(rr[0]), __uint_as_float(rr[1])); }
  if (__builtin_expect(__all(pmax - m_reg <= THR / SCALE), 1)) { mn = m_reg; alpha = 1.f; }
  else { mn = fmaxf(m_reg, pmax); alpha = __builtin_amdgcn_exp2f((m_reg - mn) * C); m_reg = mn; }
  float mnC = -mn * C;
  for (int r = 0; r < 16; ++r) p0[r] = fmaf(p0[r], C, mnC); for (int r = 0; r < 16; ++r) p1[r] = fmaf(p1[r], C, mnC);
  for (int r = 0; r < 16; ++r) p0[r] = __builtin_amdgcn_exp2f(p0[r]);
}
__device__ __forceinline__ void finishSM(f32x16& p0, f32x16& p1, float alpha, float& l_reg, bf16x8& pa0, bf16x8& pa1, bf16x8& pa2, bf16x8& pa3) {
  for (int r = 0; r < 16; ++r) p1[r] = __builtin_amdgcn_exp2f(p1[r]);
  float ps = 0; for (int r = 0; r < 16; ++r) ps += p0[r]; for (int r = 0; r < 16; ++r) ps += p1[r];
  { auto rr = __builtin_amdgcn_permlane32_swap(__float_as_uint(ps), __float_as_uint(ps), false, false);
    ps = __uint_as_float(rr[0]) + __uint_as_float(rr[1]); }
  l_reg = l_reg * alpha + ps;
#define PK4(P, BASE, OUT) do { unsigned a0 = cvtpk(P[BASE + 0], P[BASE + 1]), a1 = cvtpk(P[BASE + 2], P[BASE + 3]);   \
    unsigned b0 = cvtpk(P[BASE + 4], P[BASE + 5]), b1 = cvtpk(P[BASE + 6], P[BASE + 7]);                              \
    auto r0 = __builtin_amdgcn_permlane32_swap(a0, b0, false, false); auto r1 = __builtin_amdgcn_permlane32_swap(a1, b1, false, false); \
    u32x4 w = {r0[0], r1[0], r0[1], r1[1]}; OUT = *reinterpret_cast<bf16x8*>(&w); } while (0)
  PK4(p0, 0, pa0); PK4(p0, 8, pa1); PK4(p1, 0, pa2); PK4(p1, 8, pa3);
#undef PK4
}
__device__ __forceinline__ void qkt(f32x16& p0, f32x16& p1, const AL char* Ks, const bf16x8* qr, int r32, int hi) {
  p0 = f32x16{}; p1 = f32x16{};
  for (int d0 = 0; d0 < 8; ++d0) { int cb = (d0 * 16 + hi * 8) * 2;
    bf16x8 b0 = *(const AL bf16x8*)(Ks + KSWZ(r32, cb));
    bf16x8 b1 = *(const AL bf16x8*)(Ks + KSWZ(32 + r32, cb));
    p0 = __builtin_amdgcn_mfma_f32_32x32x16_bf16(b0, qr[d0], p0, 0, 0, 0);
    p1 = __builtin_amdgcn_mfma_f32_32x32x16_bf16(b1, qr[d0], p1, 0, 0, 0); }
}
__device__ __forceinline__ void wmask(f32x16& p0, f32x16& p1, int dq, int hi) {
#pragma unroll
  for (int r = 0; r < 16; ++r) { const int df = dq - crow(r, hi);
    if (df > 128 || df < -128) p0[r] = -1e30f;
    if (df - 32 > 128 || df - 32 < -128) p1[r] = -1e30f; }
}
__device__ __forceinline__ int v_st(int k, int c) { const int kk = (k & ~0xC) | ((k & 4) << 1) | ((k & 8) >> 1); return ((kk >> 3) * 4 + (c >> 5)) * 512 + ((kk & 7) * 32 + (c & 31)) * 2; }
__device__ __forceinline__ int v_rd_base(int lane) { return ((lane & 3) << 3) | (((lane >> 2) & 3) << 6) | (((lane >> 4) & 1) << 5) | (((lane >> 5) & 1) << 8); }
constexpr int v_rd_off(int d0, int ks, int half) { return d0 * 512 + ks * 4096 + half * 2048; }
template <int OFF> __device__ __forceinline__ s16x4 tr_read(int vb) {
  s16x4 r; asm volatile("ds_read_b64_tr_b16 %0, %1 offset:%2" : "=&v"(r) : "v"(vb), "i"(OFF) : "memory"); return r;
}
template <int D0> __device__ __forceinline__ void pv_one(f32x16& od, int vb, bf16x8 pa0, bf16x8 pa1, bf16x8 pa2, bf16x8 pa3) {
  const s16x4 l0 = tr_read<v_rd_off(D0, 0, 0)>(vb), h0 = tr_read<v_rd_off(D0, 0, 1)>(vb), l1 = tr_read<v_rd_off(D0, 1, 0)>(vb), h1 = tr_read<v_rd_off(D0, 1, 1)>(vb);
  const s16x4 l2 = tr_read<v_rd_off(D0, 2, 0)>(vb), h2 = tr_read<v_rd_off(D0, 2, 1)>(vb), l3 = tr_read<v_rd_off(D0, 3, 0)>(vb), h3 = tr_read<v_rd_off(D0, 3, 1)>(vb);
  asm volatile("s_waitcnt lgkmcnt(0)" ::: "memory"); SBAR();
#define PK(L, H) (bf16x8){L[0], L[1], L[2], L[3], H[0], H[1], H[2], H[3]}
  od = __builtin_amdgcn_mfma_f32_32x32x16_bf16(pa0, PK(l0, h0), od, 0, 0, 0);
  od = __builtin_amdgcn_mfma_f32_32x32x16_bf16(pa1, PK(l1, h1), od, 0, 0, 0);
  od = __builtin_amdgcn_mfma_f32_32x32x16_bf16(pa2, PK(l2, h2), od, 0, 0, 0);
  od = __builtin_amdgcn_mfma_f32_32x32x16_bf16(pa3, PK(l3, h3), od, 0, 0, 0);
#undef PK
}
__device__ __forceinline__ void pv_d0(f32x16* o, int vb, bf16x8 pa0, bf16x8 pa1, bf16x8 pa2, bf16x8 pa3) {
  pv_one<0>(o[0], vb, pa0, pa1, pa2, pa3); pv_one<1>(o[1], vb, pa0, pa1, pa2, pa3); pv_one<2>(o[2], vb, pa0, pa1, pa2, pa3); pv_one<3>(o[3], vb, pa0, pa1, pa2, pa3);
}

struct Unit {
  const bf16* Q; int ldq;
  const bf16* KA; const bf16* VA; int ldA; int nA;
  const bf16* KB; const bf16* VB; int ldB;
  int NT;
  int win;
  int dq0;
  int has_sink; float sink;
  int qmode; int qt0; const float* qg; const float* rope;
  bf16* O; int ldo;
};

__device__ __forceinline__ void attn_unit(const Unit& U, AL char* lds) {
  int tid_ = threadIdx.x; asm volatile("" : "+v"(tid_));
  const int tid = tid_, wid = __builtin_amdgcn_readfirstlane(tid >> 6), lane = tid & 63, r32 = lane & 31, hi = lane >> 5;
  AL char* V_lds = lds; AL char* K_lds = lds + 2 * SHM_V;
  AL float* ws = (AL float*)(lds + 2 * SHM_V + 2 * SHM_K) + wid * 64; AL float* li_l = ws; AL float* al_l = ws + 32;
  float m_reg = -1e30f, l_reg = 0; f32x16 o[4] = {}; bf16x8 qr[8];
  const int sr = tid >> 4, sc = (tid & 15) * 8, vst0 = v_st(sr, sc), vst1 = v_st(32 + sr, sc);
  const int vb0 = (int)(unsigned)(uintptr_t)V_lds + v_rd_base(lane);
  const int nA = U.nA, NT = U.NT;
  const int dqw = U.dq0 + wid * QBLK + r32;
  struct { bf16x8 vs0, vs1, ks0, ks1; } sr_[2];
#define SLOAD(i, jt) do { const int jj_ = (jt); const bf16 *kp_, *vp_; long ld_; \
    if (jj_ < nA) { ld_ = U.ldA; kp_ = U.KA + (long)jj_ * 64 * ld_; vp_ = U.VA + (long)jj_ * 64 * ld_; } \
    else { ld_ = U.ldB; kp_ = U.KB + (long)(jj_ - nA) * 64 * ld_; vp_ = U.VB + (long)(jj_ - nA) * 64 * ld_; } \
    sr_[i].vs0 = ld8(vp_ + (long)sr * ld_ + sc); sr_[i].vs1 = ld8(vp_ + (long)(32 + sr) * ld_ + sc); \
    sr_[i].ks0 = ld8(kp_ + (long)sr * ld_ + sc); sr_[i].ks1 = ld8(kp_ + (long)(32 + sr) * ld_ + sc); } while (0)
#define SWRITE(b, i) do { *(AL bf16x8*)(V_lds + (b) * SHM_V + vst0) = sr_[i].vs0;          \
    *(AL bf16x8*)(V_lds + (b) * SHM_V + vst1) = sr_[i].vs1; int kc = sc * 2;               \
    *(AL bf16x8*)(K_lds + (b) * SHM_K + KSWZ(sr, kc)) = sr_[i].ks0;                       \
    *(AL bf16x8*)(K_lds + (b) * SHM_K + KSWZ(32 + sr, kc)) = sr_[i].ks1; } while (0)
  constexpr int SE = 0, SO = 1;
  SLOAD(SE, 0);
  const bf16* Qw = U.Q + (long)(wid * QBLK + r32) * U.ldq + hi * 8;
#pragma unroll
  for (int d0 = 0; d0 < 8; ++d0) qr[d0] = ld8(Qw + d0 * 16);
  if (U.qmode) {
#define BF2F(sv) __builtin_bit_cast(float, (unsigned)(unsigned short)(sv) << 16)
    float rstd = 1.f;
    if (U.qmode & 1) { float ss = 0.f;
#pragma unroll
      for (int d0 = 0; d0 < 8; ++d0)
#pragma unroll
        for (int e = 0; e < 8; ++e) { const float v = BF2F(qr[d0][e]); ss += v * v; }
      ss += __shfl_xor(ss, 32); rstd = 1.0f / sqrtf(ss * (1.0f / 128.0f) + 1e-6f); }
    const int tq = (U.qt0 + wid * QBLK + r32) & 2047;
#pragma unroll
    for (int p = 0; p < 4; ++p) { const int d0 = (p & 1) + 4 * (p >> 1), d1 = d0 + 2, ax = p >> 1;
      float x1[8], x2[8];
#pragma unroll
      for (int e = 0; e < 8; ++e) { x1[e] = BF2F(qr[d0][e]); x2[e] = BF2F(qr[d1][e]); }
      if (U.qmode & 1) { const float* g1 = U.qg + d0 * 16 + hi * 8; const float* g2 = U.qg + d1 * 16 + hi * 8;
#pragma unroll
        for (int e = 0; e < 8; ++e) { x1[e] *= rstd * *(const AG float*)(g1 + e); x2[e] *= rstd * *(const AG float*)(g2 + e); } }
      if (U.qmode & 2) { const float* cp = U.rope + tq * 64 + ax * 32 + (d0 & 1) * 16 + hi * 8; const float* sp = cp + 2048 * 64;
#pragma unroll
        for (int e = 0; e < 8; ++e) { const float c = *(const AG float*)(cp + e), s = *(const AG float*)(sp + e); const float y1 = x1[e] * c - x2[e] * s, y2 = x2[e] * c + x1[e] * s; x1[e] = y1; x2[e] = y2; } }
      u32x4 w1 = {cvtpk(x1[0], x1[1]), cvtpk(x1[2], x1[3]), cvtpk(x1[4], x1[5]), cvtpk(x1[6], x1[7])}, w2 = {cvtpk(x2[0], x2[1]), cvtpk(x2[2], x2[3]), cvtpk(x2[4], x2[5]), cvtpk(x2[6], x2[7])};
      qr[d0] = *reinterpret_cast<bf16x8*>(&w1); qr[d1] = *reinterpret_cast<bf16x8*>(&w2); }
#undef BF2F
  }
#define RESC(a) do { if (__any((a) < 1.f)) { if (hi == 0) al_l[r32] = (a); asm volatile("s_waitcnt lgkmcnt(0)" ::: "memory"); \
    for (int d = 0; d < 4; ++d) for (int r = 0; r < 16; ++r) o[d][r] *= al_l[crow(r, hi)]; } } while (0)
#define MASK(P0, P1, jt) do { if (U.win && (jt) >= nA) { const int dq_ = dqw - ((jt) - nA) * 64; \
    if (__any(dq_ > 128 || dq_ - 63 < -128)) wmask(P0, P1, dq_, hi); } } while (0)
  f32x16 pA0, pA1, pB0, pB1; float mnA, mnB, alA, alB; bf16x8 pa0, pa1, pa2, pa3;
#define LBAR() asm volatile("s_waitcnt lgkmcnt(0)\n\ts_barrier" ::: "memory")
#define SWAIT() asm volatile("s_waitcnt vmcnt(4)" ::: "memory")
#define TCL(t) ((t) < NT ? (t) : NT - 1)
  asm volatile("s_waitcnt vmcnt(0)" ::: "memory"); SWRITE(0, SE); SLOAD(SO, 1); SLOAD(SE, (2 < U.NT ? 2 : U.NT - 1)); LBAR();
  qkt(pA0, pA1, K_lds, qr, r32, hi); MASK(pA0, pA1, 0); partialSM(pA0, pA1, m_reg, mnA, alA);
  SWAIT(); SWRITE(1, SO); LBAR();
#pragma unroll 1
  for (int j = 1; j + 1 < NT; j += 2) {
    SBAR(); qkt(pB0, pB1, K_lds + SHM_K, qr, r32, hi); MASK(pB0, pB1, j);
    finishSM(pA0, pA1, alA, l_reg, pa0, pa1, pa2, pa3); SBAR();
    SLOAD(SO, TCL(j + 2)); SBAR();
    pv_d0(o, vb0, pa0, pa1, pa2, pa3); partialSM(pB0, pB1, m_reg, mnB, alB);
    LBAR(); SWAIT(); SWRITE(0, SE);
    RESC(alB); LBAR();
    SBAR(); qkt(pA0, pA1, K_lds, qr, r32, hi); MASK(pA0, pA1, j + 1);
    finishSM(pB0, pB1, alB, l_reg, pa0, pa1, pa2, pa3); SBAR();
    SLOAD(SE, TCL(j + 3)); SBAR();
    pv_d0(o, vb0 + (int)SHM_V, pa0, pa1, pa2, pa3); partialSM(pA0, pA1, m_reg, mnA, alA);
    LBAR(); SWAIT(); SWRITE(1, SO);
    RESC(alA); LBAR();
  }
  SBAR(); qkt(pB0, pB1, K_lds + SHM_K, qr, r32, hi); MASK(pB0, pB1, NT - 1);
  finishSM(pA0, pA1, alA, l_reg, pa0, pa1, pa2, pa3); SBAR();
  pv_d0(o, vb0, pa0, pa1, pa2, pa3); partialSM(pB0, pB1, m_reg, mnB, alB);
  LBAR(); RESC(alB);
  finishSM(pB0, pB1, alB, l_reg, pa0, pa1, pa2, pa3); SBAR();
  pv_d0(o, vb0 + (int)SHM_V, pa0, pa1, pa2, pa3);
  LBAR();
#undef SWAIT
#undef TCL
  if (U.has_sink) { constexpr float C = SCALE * 1.4426950408889634f; l_reg += __builtin_amdgcn_exp2f(fminf(U.sink * 1.4426950408889634f - m_reg * C, 120.f)); }
  if (hi == 0) li_l[r32] = l_reg; asm volatile("s_waitcnt lgkmcnt(0)" ::: "memory");
  float rli[16];
#pragma unroll
  for (int r = 0; r < 16; ++r) rli[r] = __builtin_amdgcn_rcpf(li_l[crow(r, hi)]);
  AL char* ost = lds + wid * 8192;
#pragma unroll
  for (int r = 0; r < 16; ++r) { const int orow = crow(r, hi);
#pragma unroll
    for (int d0 = 0; d0 < 4; ++d0) { const float v = o[d0][r] * rli[r]; const unsigned pk = cvtpk(v, v);
      *(AL unsigned short*)(ost + orow * 256 + (d0 * 32 + r32) * 2) = (unsigned short)(pk & 0xffffu); } }
  asm volatile("s_waitcnt lgkmcnt(0)" ::: "memory");
  bf16* Ow = U.O + (long)(wid * QBLK) * U.ldo;
#pragma unroll
  for (int k = 0; k < 8; ++k) { const int c = lane + 64 * k, row = c >> 4, cc = c & 15;
    const u32x4 v = *(const AL u32x4*)(ost + row * 256 + cc * 16);
    *(AG u32x4*)(Ow + (long)row * U.ldo + cc * 8) = v; }
  LBAR();
#undef SLOAD
#undef SWRITE
#undef RESC
#undef MASK
#undef LBAR
}
}

constexpr int DM = 2048, NCTX = 8192, NLAT = 16384, NTOK = 24576, QKVD = 3072, DFF = 5632, NGU = 11264, DEPTH = 4;
constexpr int NWAVES = 8;
constexpr size_t MiB = 1u << 20;
constexpr size_t OUT_YP = 0, OUT_YS = (size_t)NCTX * DM, OUT_WK = (size_t)NTOK * DM, OUT_WV = OUT_WK + (size_t)32 * 2 * 256 * 512,
                 OUT_AK = OUT_WV + (size_t)32 * 2 * 256 * 512, OUT_AV = OUT_AK + (size_t)32 * 256 * 512, OUT_END = OUT_AV + (size_t)32 * 256 * 512;
constexpr size_t WS_CTL = 0, CTL_ZERO_BYTES = 1 * MiB;
constexpr size_t WS_MODP = 1 * MiB;
constexpr size_t WS_MODF = 16 * MiB;
constexpr size_t WS_A2 = 18 * MiB;
constexpr size_t WS_ROPE = 19 * MiB;
constexpr size_t WS_CKV = 20 * MiB;
constexpr size_t WS_CWK = WS_CKV, WS_CWV = WS_CKV + 8 * MiB, WS_CAK = WS_CKV + 16 * MiB, WS_CAV = WS_CKV + 20 * MiB;
constexpr size_t WS_FT = 44 * MiB;
constexpr size_t WS_FT_CTX = WS_FT + 32 * MiB;
constexpr size_t WS_W = 80 * MiB;
constexpr size_t W_QKV = (size_t)QKVD * DM * 2, W_SQ = (size_t)DM * DM * 2, W_IN = (size_t)6144 * DM * 2, W_GU = (size_t)NGU * DM * 2, W_DN = (size_t)DM * DFF * 2;
constexpr size_t WS_WQKV0 = WS_W, WS_WQKV1 = WS_WQKV0 + W_QKV, WS_WQKVA = WS_WQKV1 + W_QKV, WS_WO0 = WS_WQKVA + W_QKV, WS_WO1 = WS_WO0 + W_SQ, WS_WOA = WS_WO1 + W_SQ,
                 WS_WHO = WS_WOA + W_SQ, WS_WHI = WS_WHO + W_SQ, WS_WGU = WS_WHI + W_IN, WS_WDN = WS_WGU + 4 * W_GU, WS_WEND = WS_WDN + 4 * W_DN;
constexpr size_t WS_H = 448 * MiB;
constexpr size_t WS_BIG = 544 * MiB;
constexpr size_t WS_ZT = WS_BIG + 288 * MiB;
constexpr size_t WS_XB = WS_BIG + 384 * MiB;
constexpr size_t WS_NP = WS_XB + 96 * MiB;
constexpr size_t WS_INV = WS_NP + (size_t)48 * 8192 * 4;
constexpr size_t WS_END = WS_NP + 2 * MiB;
static_assert(WS_WEND <= WS_H && WS_FT_CTX + 4 * MiB <= WS_W && WS_CAV + 4 * MiB <= WS_FT, "ws map");
static_assert(WS_MODP + (size_t)4 * 8 * 9 * 12288 * 4 <= WS_MODF && WS_MODF + (size_t)4 * 9 * 6 * 2048 * 4 <= WS_A2 && WS_A2 + (size_t)2304 * 64 * 4 <= WS_CKV && WS_INV + (size_t)4 * 2048 * 4 <= WS_END, "small buffers");
constexpr int CW_TMO = 0;
constexpr int CW_BAR = 4096;
constexpr int CW_SPLIT = 16384;
constexpr int RING_BYTES = 131072;
constexpr int LDSCTL_OFF = RING_BYTES, MISC_OFF = LDSCTL_OFF + 320;
constexpr int LDS_BYTES = 147456;

#define GAS __attribute__((address_space(1)))
#define LAS __attribute__((address_space(3)))
typedef unsigned short bf16;
typedef unsigned v4u __attribute__((ext_vector_type(4)));
typedef unsigned v2u __attribute__((ext_vector_type(2)));
typedef float f32x4 __attribute__((ext_vector_type(4)));
typedef short bf16x8 __attribute__((ext_vector_type(8)));
typedef short bf16x4 __attribute__((ext_vector_type(4)));
typedef GAS unsigned gu32;
#define RLX_AGENT __ATOMIC_RELAXED, __HIP_MEMORY_SCOPE_AGENT
#define LDS_WAIT() asm volatile("s_waitcnt lgkmcnt(0)" ::: "memory")
#define VM_WAIT() asm volatile("s_waitcnt vmcnt(0)" ::: "memory")
__device__ __forceinline__ unsigned f2bf(float f) { unsigned u = __builtin_bit_cast(unsigned, f); return (u + 0x7fffu + ((u >> 16) & 1u)) >> 16; }
__device__ __forceinline__ unsigned pk2(float lo, float hi) { unsigned r; asm("v_cvt_pk_bf16_f32 %0, %1, %2" : "=v"(r) : "v"(lo), "v"(hi)); return r; }
__device__ __forceinline__ float bf2f(unsigned short b) { return __builtin_bit_cast(float, (unsigned)b << 16); }
__device__ __forceinline__ float bflo(unsigned w) { return __builtin_bit_cast(float, w << 16); }
__device__ __forceinline__ float bfhi(unsigned w) { return __builtin_bit_cast(float, w & 0xffff0000u); }
__device__ __forceinline__ float wave_sum(float v) {
#pragma unroll
    for (int o = 1; o < 64; o <<= 1) v += __shfl_xor(v, o);
    return v;
}
#define XB_TMO      128
#define XB_XCNT(j)  (256  + 64 * (j))
#define XB_XSUB(j)  (1280 + 64 * (j))
#define XB_XGEN(j)  (2304 + 64 * (j))
#define XB_TOP      3328
#define XB_TOPGEN   3392
#define XCD_BAR_WORDS 3456
#define XB_SPIN_CAP (1u << 18)

__device__ __forceinline__ unsigned xb_ld(unsigned* p)              { return __hip_atomic_load(p, __ATOMIC_RELAXED, __HIP_MEMORY_SCOPE_AGENT); }
__device__ __forceinline__ unsigned xb_add(unsigned* p, unsigned v) { return __hip_atomic_fetch_add(p, v, __ATOMIC_RELAXED, __HIP_MEMORY_SCOPE_AGENT); }
__device__ __forceinline__ unsigned xb_xcc_id() { return (unsigned)__builtin_amdgcn_s_getreg((3 << 11) | 20) & 0xFu; }
#define XB_SPIN(cond, bar) do { unsigned _sp = 0; while (cond) { __builtin_amdgcn_s_sleep(1); \
    if ((++_sp & 255u) == 0u) { if (xb_ld(&(bar)[XB_TMO])) break; if (_sp > XB_SPIN_CAP) { atomicAdd(&(bar)[XB_TMO], 1u); break; } } } } while (0)

struct XcdBarrier {
    unsigned* bar; unsigned x;
    volatile LAS unsigned* st;
};

__device__ __forceinline__ XcdBarrier xcd_barrier_post(unsigned* bar, volatile LAS unsigned* st) {
    XcdBarrier b; b.bar = bar; b.x = xb_xcc_id(); b.st = st;
    if (threadIdx.x == 0) (void)xb_add(&bar[XB_XCNT(b.x)], 1u);
    return b;
}
__device__ __forceinline__ void xcd_barrier_complete(unsigned* bar, unsigned x, unsigned& nloc, unsigned& nx) {
    const unsigned G = gridDim.x * gridDim.y * gridDim.z;
    unsigned sum, cnt, mine, sp = 0u;
    for (;;) {
        sum = 0u; cnt = 0u; mine = 0u;
#pragma unroll
        for (unsigned j = 0; j < 16; ++j) { const unsigned c = xb_ld(&bar[XB_XCNT(j)]); sum += c; cnt += (c > 0u) ? 1u : 0u; mine = (j == x) ? c : mine; }
        if (sum == G) break;
        __builtin_amdgcn_s_sleep(1);
        if ((++sp & 255u) == 0u) { if (xb_ld(&bar[XB_TMO])) break; if (sp > XB_SPIN_CAP) { atomicAdd(&bar[XB_TMO], 1u); break; } }
    }
    nloc = mine > 0u ? mine : 1u; nx = cnt > 0u ? cnt : 1u;
}

__device__ __forceinline__ void xcd_barrier(const XcdBarrier& b) {
    asm volatile("s_waitcnt vmcnt(0)" ::: "memory");
    __syncthreads();
    if (threadIdx.x == 0) {
        unsigned* bar = b.bar;
        __builtin_amdgcn_s_waitcnt(0);
        unsigned nloc = b.st[0], nx = b.st[1];
        if (nloc == 0u) { xcd_barrier_complete(bar, b.x, nloc, nx); b.st[0] = nloc; b.st[1] = nx; }
        const unsigned old = xb_add(&bar[XB_XSUB(b.x)], 1u);
        const unsigned gen = old / nloc;
        if (old + 1u == (gen + 1u) * nloc) {
            __builtin_amdgcn_fence(__ATOMIC_RELEASE, "agent");
            asm volatile("s_waitcnt vmcnt(0)" ::: "memory");
            const unsigned og = xb_add(&bar[XB_TOP], 1u);
            const unsigned tg = og / nx;
            if (og + 1u == (tg + 1u) * nx) xb_add(&bar[XB_TOPGEN], 1u);
            else XB_SPIN(xb_ld(&bar[XB_TOPGEN]) == tg, bar);
            __builtin_amdgcn_fence(__ATOMIC_ACQUIRE, "agent");
            xb_add(&bar[XB_XGEN(b.x)], 1u);
            asm volatile("s_waitcnt vmcnt(0)" ::: "memory");
        } else {
            XB_SPIN(xb_ld(&bar[XB_XGEN(b.x)]) == gen, bar);
            __builtin_amdgcn_fence(__ATOMIC_ACQUIRE, "agent");
            asm volatile("s_waitcnt vmcnt(0)" ::: "memory");
        }
    }
    __syncthreads();
}

struct TItem { const float* src; bf16* dst; int K, N, k0, n0, drow0; };
__device__ __forceinline__ void titem_load(const TItem& t, f32x4 (&v)[8], int lane) {
#pragma unroll
    for (int i = 0; i < 8; ++i) v[i] = *(const GAS f32x4*)(t.src + (size_t)(t.k0 + 8 * i + (lane >> 3)) * t.N + t.n0 + 4 * (lane & 7));
}
__device__ __forceinline__ void titem_finish(const TItem& t, const f32x4 (&v)[8], LAS float* scr, int lane) {
#pragma unroll
    for (int i = 0; i < 8; ++i) { LAS float* d = scr + (8 * i + (lane >> 3)) * 33 + 4 * (lane & 7); d[0] = v[i].x; d[1] = v[i].y; d[2] = v[i].z; d[3] = v[i].w; }
    LDS_WAIT(); asm volatile("" ::: "memory");
    const int c = lane & 7;
#pragma unroll
    for (int j = 0; j < 4; ++j) { const int n = (lane >> 3) + 8 * j; const LAS float* s = scr + (8 * c) * 33 + n;
        v4u o; o.x = pk2(s[0 * 33], s[1 * 33]); o.y = pk2(s[2 * 33], s[3 * 33]); o.z = pk2(s[4 * 33], s[5 * 33]); o.w = pk2(s[6 * 33], s[7 * 33]);
        *(GAS v4u*)(t.dst + (size_t)(t.drow0 + n) * t.K + t.k0 + 8 * c) = o; }
    LDS_WAIT(); asm volatile("" ::: "memory");
}
constexpr int IT_QKV = (DM / 64) * (QKVD / 32), IT_SQ = (DM / 64) * (DM / 32), IT_IN = (DM / 64) * (6144 / 32), IT_GU = (DM / 64) * (NGU / 32), IT_DN = (DFF / 64) * (DM / 32);
constexpr int IT_TOTAL = 3 * IT_QKV + 4 * IT_SQ + IT_IN + 4 * IT_GU + 4 * IT_DN;

struct Args { const float* in[33]; float* out; unsigned char* ws; int ph_lo, ph_hi; };
#define GIN(k) ((const float*)(const GAS float*)A.in[k])

__device__ __forceinline__ TItem titem_decode(const Args& A, int it) {
    unsigned char* ws = A.ws;
    const float* src; bf16* dst; int K = DM, N; bool gu = false; int r = it;
    if (r < 3 * IT_QKV) { const int m = r / IT_QKV; r -= m * IT_QKV; N = QKVD;
        src = (m < 2) ? GIN(12) + (size_t)m * DM * QKVD : GIN(26); dst = (bf16*)(ws + WS_WQKV0 + (size_t)m * W_QKV); }
    else if ((r -= 3 * IT_QKV) < 4 * IT_SQ) { const int m = r / IT_SQ; r -= m * IT_SQ; N = DM;
        src = (m < 2) ? GIN(13) + (size_t)m * DM * DM : (m == 2 ? GIN(29) : GIN(25)); dst = (bf16*)(ws + WS_WO0 + (size_t)m * W_SQ); }
    else if ((r -= 4 * IT_SQ) < IT_IN) { N = 6144; src = GIN(15); dst = (bf16*)(ws + WS_WHI); }
    else if ((r -= IT_IN) < 4 * IT_GU) { const int m = r / IT_GU; r -= m * IT_GU; N = NGU; gu = true;
        src = GIN(30) + (size_t)m * DM * NGU; dst = (bf16*)(ws + WS_WGU + (size_t)m * W_GU); }
    else { r -= 4 * IT_GU; const int m = r / IT_DN; r -= m * IT_DN; N = DM; K = DFF;
        src = GIN(31) + (size_t)m * DFF * DM; dst = (bf16*)(ws + WS_WDN + (size_t)m * W_DN); }
    const int nblk = N / 32, kb = r / nblk, nb = r % nblk, k0 = 64 * kb, n0 = 32 * nb;
    int drow0 = n0;
    if (gu) { const int isu = n0 >= DFF ? 1 : 0; const int j = n0 - isu * DFF; drow0 = (j >> 7) * 256 + isu * 128 + (j & 127); }
    TItem t; t.src = src; t.dst = dst; t.K = K; t.N = N; t.k0 = k0; t.n0 = n0; t.drow0 = drow0; return t;
}

__device__ __forceinline__ void adaln_partial_unit(const Args& A, int u, LAS float* scr, int lane) {
    const int layer = u / 384, kc = (u / 48) % 8, cg = u % 48;
    const float* cctx = GIN(7); const float* cin = GIN(6);
    for (int idx = lane; idx < 9 * 256; idx += 64) { const int c = idx >> 8, kk = idx & 255, k = kc * 256 + kk;
        const float v = (c == 0) ? cctx[k] : cin[(size_t)(c - 1) * DM + k]; scr[idx] = v / (1.0f + expf(-v)); }
    LDS_WAIT(); asm volatile("" ::: "memory");
    f32x4 acc[9];
#pragma unroll
    for (int c = 0; c < 9; ++c) acc[c] = (f32x4){0.f, 0.f, 0.f, 0.f};
    const float* wp = GIN(10) + (size_t)layer * DM * 12288 + (size_t)(kc * 256) * 12288 + cg * 256 + lane * 4;
#pragma unroll 8
    for (int kk = 0; kk < 256; ++kk) { const f32x4 w = *(const GAS f32x4*)(wp + (size_t)kk * 12288);
#pragma unroll
        for (int c = 0; c < 9; ++c) acc[c] += scr[c * 256 + kk] * w; }
    float* mp = (float*)(A.ws + WS_MODP) + (size_t)((layer * 8 + kc) * 9) * 12288 + cg * 256 + lane * 4;
#pragma unroll
    for (int c = 0; c < 9; ++c) *(f32x4*)(mp + (size_t)c * 12288) = acc[c];
    LDS_WAIT(); asm volatile("" ::: "memory");
}

__device__ __forceinline__ void filter_a2_row(const Args& A, int rr, int lane) {
    const int L = rr < 2048 ? 2048 : 256, t = rr < 2048 ? rr : rr - 2048;
    const float tn = (float)t / (float)(L - 1), w = 6.283185307179586f * (float)t / (float)L;
    float feat = 0.f;
    if (lane == 0) feat = tn;
    else if (lane <= 16) feat = cosf(w * (1e-4f + (float)(lane - 1) * ((15.0f - 1e-4f) / 15.0f)));
    else if (lane <= 32) feat = -sinf(w * (1e-4f + (float)(lane - 17) * ((15.0f - 1e-4f) / 15.0f)));
    const float* w1 = GIN(18); const float* b1 = GIN(19); const float* w2 = GIN(20); const float* b2 = GIN(21); const float* fq = GIN(23);
    float s = b1[lane];
    for (int f = 0; f < 33; ++f) s += __shfl(feat, f) * w1[f * 64 + lane];
    const float a1 = sinf(fq[lane] * s);
    float s2 = b2[lane];
    for (int k = 0; k < 64; ++k) s2 += __shfl(a1, k) * w2[k * 64 + lane];
    ((float*)(A.ws + WS_A2))[(size_t)rr * 64 + lane] = sinf(fq[64 + lane] * s2);
}

__device__ __forceinline__ void split_bf16x8(const f32x4 x0, const f32x4 x1, bf16x8& hi, bf16x8& lo) {
    const float v[8] = {x0.x, x0.y, x0.z, x0.w, x1.x, x1.y, x1.z, x1.w};
    unsigned ph[4], pl[4];
#pragma unroll
    for (int j = 0; j < 4; ++j) { ph[j] = pk2(v[2 * j], v[2 * j + 1]);
        pl[j] = pk2(v[2 * j] - __builtin_bit_cast(float, ph[j] << 16), v[2 * j + 1] - __builtin_bit_cast(float, ph[j] & 0xffff0000u)); }
    const v4u qh = {ph[0], ph[1], ph[2], ph[3]}, ql = {pl[0], pl[1], pl[2], pl[3]};
    hi = __builtin_bit_cast(bf16x8, qh); lo = __builtin_bit_cast(bf16x8, ql);
}
__device__ __forceinline__ void filter_hf_unit(const Args& A, int u, int lane) {
    const int variant = u < 8192 ? 0 : 1; const int uu = variant ? u - 8192 : u; const int tch = uu >> 9, cb = uu & 511;
    const int L = variant ? 256 : 2048; const int n = lane & 15, g = lane >> 4;
    const int col = cb * 16 + n, side = col >> 12, order = (col >> 11) & 1, d = col & 2047;
    const float* w3 = GIN(22) + col;
    bf16x8 bh[2], bl[2];
#pragma unroll
    for (int s = 0; s < 2; ++s) { const float* wp = w3 + (size_t)(32 * s + 8 * g) * 8192;
        const f32x4 x0 = {wp[0], wp[8192], wp[2 * 8192], wp[3 * 8192]}, x1 = {wp[4 * 8192], wp[5 * 8192], wp[6 * 8192], wp[7 * 8192]};
        split_bf16x8(x0, x1, bh[s], bl[s]); }
    constexpr float MIND = -3.0701134573253944f, MAXD = -15.350567286626972f;
    const float delta = fabsf(MIND + (MAXD - MIND) * ((float)d / 2047.0f)), rl1 = 1.0f / (float)(L - 1);
    const float* a2 = (const float*)(A.ws + WS_A2) + (size_t)(variant ? 2048 : 0) * 64;
    bf16* ft = (bf16*)(A.ws + (variant ? WS_FT_CTX : WS_FT)) + ((size_t)(order * 2048 + d) * 2 + side) * L;
    float asum = 0.f;
    f32x4 av[8][4];
#pragma unroll
    for (int tile = 0; tile < 8; ++tile) { const float* ar = a2 + (size_t)(tch * 128 + tile * 16 + n) * 64 + 8 * g;
#pragma unroll
        for (int s = 0; s < 2; ++s) { av[tile][2 * s] = *(const GAS f32x4*)(ar + 32 * s); av[tile][2 * s + 1] = *(const GAS f32x4*)(ar + 32 * s + 4); } }
    asm volatile("" ::: "memory");
#pragma unroll
    for (int tile = 0; tile < 8; ++tile) { const int t0 = tch * 128 + tile * 16;
        f32x4 acc = {0.f, 0.f, 0.f, 0.f};
#pragma unroll
        for (int s = 0; s < 2; ++s) { bf16x8 ah, al; split_bf16x8(av[tile][2 * s], av[tile][2 * s + 1], ah, al);
            acc = __builtin_amdgcn_mfma_f32_16x16x32_bf16(ah, bh[s], acc, 0, 0, 0);
            acc = __builtin_amdgcn_mfma_f32_16x16x32_bf16(ah, bl[s], acc, 0, 0, 0);
            acc = __builtin_amdgcn_mfma_f32_16x16x32_bf16(al, bh[s], acc, 0, 0, 0); }
        float hv[4];
#pragma unroll
        for (int r = 0; r < 4; ++r) { const int t = t0 + 4 * g + r; const float v = acc[r] * expf(-((float)t * rl1) * delta); hv[r] = v;
            if (!(side == 1 && t == 0)) asum += fabsf(v); }
        v2u o; o.x = pk2(hv[0], hv[1]); o.y = pk2(hv[2], hv[3]);
        *(GAS v2u*)(ft + t0 + 4 * g) = o; }
    asum += __shfl_xor(asum, 16); asum += __shfl_xor(asum, 32);
    if (g == 0) ((float*)(A.ws + WS_NP))[(size_t)(variant ? 32 + tch : tch) * 8192 + col] = asum;
}

__device__ __forceinline__ void norm_store(const f32x4 (&v)[4][2], float ssq, const f32x4 (&a)[4][2], const f32x4 (&b)[4][2], bf16* orow, int lane) {
    const float rstd = 1.0f / sqrtf(wave_sum(ssq) * (1.0f / DM) + 1e-6f);
#pragma unroll
    for (int j = 0; j < 4; ++j) { const f32x4 y0 = v[j][0] * rstd * a[j][0] + b[j][0], y1 = v[j][1] * rstd * a[j][1] + b[j][1];
        v4u w; w.x = pk2(y0.x, y0.y); w.y = pk2(y0.z, y0.w); w.z = pk2(y1.x, y1.y); w.w = pk2(y1.z, y1.w); *((GAS v4u*)orow + lane + 64 * j) = w; }
}
__device__ __forceinline__ void norm_row_f32(const float* xrow, const f32x4 (&a)[4][2], const f32x4 (&b)[4][2], bf16* orow, bf16* xbrow, int lane) {
    f32x4 v[4][2]; float s = 0.f;
#pragma unroll
    for (int j = 0; j < 4; ++j) { const GAS f32x4* p = (const GAS f32x4*)(xrow + 8 * lane + 512 * j); v[j][0] = p[0]; v[j][1] = p[1];
        s += (v[j][0].x * v[j][0].x + v[j][0].y * v[j][0].y) + (v[j][0].z * v[j][0].z + v[j][0].w * v[j][0].w) + (v[j][1].x * v[j][1].x + v[j][1].y * v[j][1].y) + (v[j][1].z * v[j][1].z + v[j][1].w * v[j][1].w); }
#pragma unroll
    for (int j = 0; j < 4; ++j) { v4u w; w.x = pk2(v[j][0].x, v[j][0].y); w.y = pk2(v[j][0].z, v[j][0].w); w.z = pk2(v[j][1].x, v[j][1].y); w.w = pk2(v[j][1].z, v[j][1].w); *((GAS v4u*)xbrow + lane + 64 * j) = w; }
    norm_store(v, s, a, b, orow, lane);
}
__device__ __forceinline__ void load_row_bf16(const bf16* xbrow, f32x4 (&v)[4][2], float& s, int lane) {
    s = 0.f;
#pragma unroll
    for (int j = 0; j < 4; ++j) { const v4u w = *((const GAS v4u*)xbrow + lane + 64 * j);
        v[j][0] = (f32x4){bflo(w.x), bfhi(w.x), bflo(w.y), bfhi(w.y)}; v[j][1] = (f32x4){bflo(w.z), bfhi(w.z), bflo(w.w), bfhi(w.w)};
        s += (v[j][0].x * v[j][0].x + v[j][0].y * v[j][0].y) + (v[j][0].z * v[j][0].z + v[j][0].w * v[j][0].w) + (v[j][1].x * v[j][1].x + v[j][1].y * v[j][1].y) + (v[j][1].z * v[j][1].z + v[j][1].w * v[j][1].w); }
}
__device__ __forceinline__ void norm_row_bf16(const bf16* xbrow, const f32x4 (&a)[4][2], const f32x4 (&b)[4][2], bf16* orow, int lane) {
    f32x4 v[4][2]; float s; load_row_bf16(xbrow, v, s, lane); norm_store(v, s, a, b, orow, lane);
}
__device__ __forceinline__ void final_norm_row(const bf16* xbrow, float* yrow, const float* g, int lane) {
    f32x4 v[4][2]; float s; load_row_bf16(xbrow, v, s, lane);
    const float rstd = 1.0f / sqrtf(wave_sum(s) * (1.0f / DM) + 1e-6f);
#pragma unroll
    for (int j = 0; j < 4; ++j) { const GAS f32x4* gp = (const GAS f32x4*)(g + 8 * lane + 512 * j); GAS f32x4* yp = (GAS f32x4*)(yrow + 8 * lane + 512 * j);
        yp[0] = v[j][0] * rstd * gp[0]; yp[1] = v[j][1] * rstd * gp[1]; }
}

__device__ __forceinline__ void rope_table_entry(float* rope, int e) {
    const int t = e >> 6, a = (e >> 5) & 1, i = e & 31; const float pos = (float)(a == 0 ? (t >> 6) : (t & 63));
    const float ang = pos * expf(-(float)i * (9.210340371976184f / 32.0f));
    rope[e] = cosf(ang); rope[2048 * 64 + e] = sinf(ang);
}
__device__ __forceinline__ void qkpost_row(bf16* qkv_row, int row, bool is_ax, const float* kg, const float* rope, float* state_k, int lane) {
    const bool is_lat = row >= NCTX;
    const int hsub = lane >> 4, a = (lane >> 3) & 1, i0 = (lane & 7) * 4;
    f32x4 cs = (f32x4){1.f, 1.f, 1.f, 1.f}, sn = (f32x4){0.f, 0.f, 0.f, 0.f};
    if (is_lat) { const int t = (row - NCTX) & 2047; cs = *(const GAS f32x4*)(rope + t * 64 + a * 32 + i0); sn = *(const GAS f32x4*)(rope + 2048 * 64 + t * 64 + a * 32 + i0); }
    bf16* base = qkv_row + 2048 + hsub * 128 + a * 64 + i0;
    const v2u r1 = *(const GAS v2u*)base, r2 = *(const GAS v2u*)(base + 32);
    float x1[4] = {bflo(r1.x), bfhi(r1.x), bflo(r1.y), bfhi(r1.y)}, x2[4] = {bflo(r2.x), bfhi(r2.x), bflo(r2.y), bfhi(r2.y)};
    if (is_ax) {
        float ss = 0.f;
#pragma unroll
        for (int e = 0; e < 4; ++e) ss += x1[e] * x1[e] + x2[e] * x2[e];
        ss += __shfl_xor(ss, 1); ss += __shfl_xor(ss, 2); ss += __shfl_xor(ss, 4); ss += __shfl_xor(ss, 8);
        const float rstd = 1.0f / sqrtf(ss * (1.0f / 128.0f) + 1e-6f);
        const float* G = kg + a * 64 + i0;
#pragma unroll
        for (int e = 0; e < 4; ++e) { x1[e] = x1[e] * rstd * G[e]; x2[e] = x2[e] * rstd * G[32 + e]; }
    }
    if (is_lat) {
#pragma unroll
        for (int e = 0; e < 4; ++e) { const float y1 = x1[e] * cs[e] - x2[e] * sn[e], y2 = x2[e] * cs[e] + x1[e] * sn[e]; x1[e] = y1; x2[e] = y2; }
    }
    if (is_ax || is_lat) { v2u w1, w2; w1.x = pk2(x1[0], x1[1]); w1.y = pk2(x1[2], x1[3]); w2.x = pk2(x2[0], x2[1]); w2.y = pk2(x2[2], x2[3]);
        *(GAS v2u*)base = w1; *(GAS v2u*)(base + 32) = w2; }
    if (is_ax && !is_lat) { float* sp = state_k + (size_t)row * 512 + hsub * 128 + a * 64 + i0;
        *(GAS f32x4*)sp = (f32x4){x1[0], x1[1], x1[2], x1[3]}; *(GAS f32x4*)(sp + 32) = (f32x4){x2[0], x2[1], x2[2], x2[3]}; }
}

namespace hy {
constexpr int CPY_STRIDE = 8480;
constexpr int U_OFF = 8 * CPY_STRIDE;
constexpr int U_BYTES = 6144;
static_assert(U_OFF + 8 * U_BYTES <= RING_BYTES, "hyena LDS map");

__device__ __forceinline__ void build_copies(LAS unsigned char* lds, const bf16* ft, int L, int tid) {
    if (tid < 264) { const int c = tid / 33, e = tid % 33; const int qq = (e < 17 - c) ? e : 2 * L + 16 - c + (e - (17 - c));
        *(LAS unsigned short*)(lds + c * CPY_STRIDE + qq * 2) = 0; }
    if (tid < 2 * L / 8) { const int side = tid / (L / 8), t8 = (tid % (L / 8)) * 8;
        const v4u raw = *(const GAS v4u*)(ft + (size_t)side * L + t8);
        const unsigned wds[4] = {raw.x, raw.y, raw.z, raw.w};
#pragma unroll
        for (int e = 0; e < 8; ++e) { const int t = t8 + e; const unsigned short val = (unsigned short)((e & 1) ? (wds[e >> 1] >> 16) : (wds[e >> 1] & 0xffffu));
            if (!(side == 1 && t == 0)) { const int p = side == 0 ? L - t : L + t;
#pragma unroll
                for (int c = 0; c < 8; ++c) *(LAS unsigned short*)(lds + c * CPY_STRIDE + (p + 16 - c) * 2) = val; } } }
}
__device__ __forceinline__ void fill_u(LAS unsigned char* ub, const bf16* urow, int L, float w0, float w1, float w2, float bb, int lane) {
    { const int e0 = lane < 32 ? lane * 8 : L + 256 + (lane - 32) * 8; *(LAS v4u*)(ub + e0 * 2) = (v4u){0u, 0u, 0u, 0u}; }
    for (int q = lane; q < L / 8; q += 64) { const int s0 = 8 * q;
        const v4u raw = *(const GAS v4u*)(urow + s0);
        const float prev = s0 > 0 ? bf2f(urow[s0 - 1]) : 0.f, next = s0 + 8 < L ? bf2f(urow[s0 + 8]) : 0.f;
        const float x[10] = {prev, bflo(raw.x), bfhi(raw.x), bflo(raw.y), bfhi(raw.y), bflo(raw.z), bfhi(raw.z), bflo(raw.w), bfhi(raw.w), next};
        float y[8];
#pragma unroll
        for (int j = 0; j < 8; ++j) y[j] = w0 * x[j] + w1 * x[j + 1] + w2 * x[j + 2] + bb;
        v4u o; o.x = pk2(y[0], y[1]); o.y = pk2(y[2], y[3]); o.z = pk2(y[4], y[5]); o.w = pk2(y[6], y[7]);
        *(LAS v4u*)(ub + (256 + s0) * 2) = o; }
}
template <int NT>
__device__ __forceinline__ void toeplitz(const LAS unsigned char* cpy, const LAS unsigned char* ub, f32x4 (&acc)[NT], int lane) {
    constexpr int L = 256 * NT;
    const int i = lane & 15, g = lane >> 4, c = (-i) & 7;
    const LAS unsigned char* ap = cpy + c * CPY_STRIDE + 2 * (L + 8 * g + 16 - i - c);
    const LAS unsigned char* bp = ub + 2 * (256 + 8 * g + 16 * i);
#pragma unroll 2
    for (int S = -256; S <= L - 32; S += 32) {
        const bf16x8 b = *(const LAS bf16x8*)(bp + 2 * S);
        bf16x8 a[NT];
#pragma unroll
        for (int k = 0; k < NT; ++k) a[k] = *(const LAS bf16x8*)(ap + 2 * S - 512 * k);
#pragma unroll
        for (int k = 0; k < NT; ++k) acc[k] = __builtin_amdgcn_mfma_f32_16x16x32_bf16(a[k], b, acc[k], 0, 0, 0);
    }
}
template <int NT>
__device__ __forceinline__ void gate(const f32x4 (&acc)[NT], LAS unsigned char* ub, const bf16* xg, float cw0, float cw1, float cw2, float cb, float invn, float skip, int lane, bool last, bf16* zt) {
    constexpr int L = 256 * NT;
    const int sg = lane & 15, g = lane >> 4;
#pragma unroll
    for (int k = 0; k < NT; ++k) { const int t0 = 256 * k + 16 * sg + 4 * g;
        const v2u ur = *(const LAS v2u*)(ub + (256 + t0) * 2);
        const v2u xr = *(const GAS v2u*)(xg + t0);
        const float prev = t0 > 0 ? bf2f(xg[t0 - 1]) : 0.f, next = t0 + 4 < L ? bf2f(xg[t0 + 4]) : 0.f;
        const float x[6] = {prev, bflo(xr.x), bfhi(xr.x), bflo(xr.y), bfhi(xr.y), next};
        const float uu[4] = {bflo(ur.x), bfhi(ur.x), bflo(ur.y), bfhi(ur.y)};
        float z[4];
#pragma unroll
        for (int r = 0; r < 4; ++r) { const float xc = cw0 * x[r] + cw1 * x[r + 1] + cw2 * x[r + 2] + cb; z[r] = xc * (acc[k][r] * invn + skip * uu[r]); }
        v2u o; o.x = pk2(z[0], z[1]); o.y = pk2(z[2], z[3]);
        if (last) *(GAS v2u*)(zt + t0) = o; else *(LAS v2u*)(ub + (256 + t0) * 2) = o; }
}

constexpr int USH_STR = 4416;
__device__ __forceinline__ int ush_base(int b) { return b * USH_STR + (b >> 2) * 16; }
static_assert(U_OFF + 8 * USH_STR + 64 <= RING_BYTES, "hyena LDS map (shared u)");

__device__ __forceinline__ void build_copies2(LAS unsigned char* lds, const bf16* ft, int L, int ztop, int tid) {
    const int nz = ztop - 2 * L + 1;
    for (int z = tid; z < 8 * nz; z += 512) { const int c = z / nz, e = z % nz; const int qq = (e < 17 - c) ? e : 2 * L + 16 - c + (e - (17 - c));
        *(LAS unsigned short*)(lds + c * CPY_STRIDE + qq * 2) = 0; }
    for (int idx = tid; idx < 2 * L; idx += 512) { const int side = idx >= L ? 1 : 0, t = idx - side * L;
        if (!(side == 1 && t == 0)) { const unsigned short val = *(const GAS unsigned short*)(ft + idx); const int p = side ? L + t : L - t;
#pragma unroll
            for (int c = 0; c < 8; ++c) *(LAS unsigned short*)(lds + c * CPY_STRIDE + (p + 16 - c) * 2) = val; } }
}
__device__ __forceinline__ void fill_coop(LAS unsigned char* ush, const bf16* urow_ch, float w0, float w1, float w2, float bb, int tid) {
    for (int z = tid; z < 160; z += 512) { const int b = z / 20, e = z % 20; const int el = e < 4 ? e * 8 : 2080 + (e - 4) * 8;
        *(LAS v4u*)(ush + ush_base(b) + el * 2) = (v4u){0u, 0u, 0u, 0u}; }
#pragma unroll 1
    for (int ch = tid; ch < 2048; ch += 512) { const int b = ch >> 8, s0 = (ch & 255) * 8; const bf16* urow = urow_ch + b * 2048;
        const v4u raw = *(const GAS v4u*)(urow + s0);
        const float prev = s0 > 0 ? bf2f(*(const GAS bf16*)(urow + s0 - 1)) : 0.f, next = s0 + 8 < 2048 ? bf2f(*(const GAS bf16*)(urow + s0 + 8)) : 0.f;
        const float x[10] = {prev, bflo(raw.x), bfhi(raw.x), bflo(raw.y), bfhi(raw.y), bflo(raw.z), bfhi(raw.z), bflo(raw.w), bfhi(raw.w), next};
        float y[8];
#pragma unroll
        for (int j = 0; j < 8; ++j) y[j] = w0 * x[j] + w1 * x[j + 1] + w2 * x[j + 2] + bb;
        v4u o; o.x = pk2(y[0], y[1]); o.y = pk2(y[2], y[3]); o.z = pk2(y[4], y[5]); o.w = pk2(y[6], y[7]);
        *(LAS v4u*)(ush + ush_base(b) + 2 * (32 + s0)) = o; }
}
__device__ __forceinline__ void toeplitz_coop(const LAS unsigned char* cpy, const LAS unsigned char* ush, f32x4 (&acc)[8], int wave, int lane) {
    constexpr int L = 2048;
    const int i = lane & 15, g = lane >> 4, c = (-i) & 7, bb = i & 7, sg = i >> 3;
    const LAS unsigned char* aq = cpy + c * CPY_STRIDE + 2 * (L + 8 * g + 16 - i - c) - 64 * (8 * wave - 2);
    const LAS unsigned char* bq = ush + ush_base(bb) + 2 * (32 + 8 * g + 16 * sg) - 64;
#pragma unroll 1
    for (int q = 0; q < 17; ++q) {
        bf16x8 A[11], Bf[4];
#pragma unroll
        for (int m = 0; m < 11; ++m) A[m] = *(const LAS bf16x8*)(aq - 64 * m);
#pragma unroll
        for (int b4 = 0; b4 < 4; ++b4) Bf[b4] = *(const LAS bf16x8*)(bq + 64 * b4);
#pragma unroll
        for (int b4 = 0; b4 < 4; ++b4)
#pragma unroll
            for (int a = 0; a < 8; ++a) acc[a] = __builtin_amdgcn_mfma_f32_16x16x32_bf16(A[a - b4 + 3], Bf[b4], acc[a], 0, 0, 0);
        aq += 256; bq += 256;
    }
}
__device__ __forceinline__ void gate_coop(const f32x4 (&acc)[8], LAS unsigned char* ush, const bf16* xg_ch, float cw0, float cw1, float cw2, float cb, float invn, float skip, int wave, int lane, bool last, bf16* zt_ch) {
    const int i = lane & 15, g = lane >> 4, bb = i & 7, sg = i >> 3;
    const bf16* xg = xg_ch + bb * 2048; bf16* zt = zt_ch + bb * 2048; LAS unsigned char* ub = ush + ush_base(bb);
#pragma unroll
    for (int a = 0; a < 8; ++a) { const int t0 = 32 * (8 * wave + a) + 16 * sg + 4 * g;
        const v2u ur = *(const LAS v2u*)(ub + (32 + t0) * 2);
        const v2u xr = *(const GAS v2u*)(xg + t0);
        const float prev = t0 > 0 ? bf2f(*(const GAS bf16*)(xg + t0 - 1)) : 0.f, next = t0 + 4 < 2048 ? bf2f(*(const GAS bf16*)(xg + t0 + 4)) : 0.f;
        const float x[6] = {prev, bflo(xr.x), bfhi(xr.x), bflo(xr.y), bfhi(xr.y), next};
        const float uu[4] = {bflo(ur.x), bfhi(ur.x), bflo(ur.y), bfhi(ur.y)};
        float z[4];
#pragma unroll
        for (int r = 0; r < 4; ++r) { const float xc = cw0 * x[r] + cw1 * x[r + 1] + cw2 * x[r + 2] + cb; z[r] = xc * (acc[a][r] * invn + skip * uu[r]); }
        v2u o; o.x = pk2(z[0], z[1]); o.y = pk2(z[2], z[3]);
        if (last) *(GAS v2u*)(zt + t0) = o; else *(LAS v2u*)(ub + (32 + t0) * 2) = o; }
}

struct GPre { v2u xr; unsigned pn; };
struct FPre { v4u raw; unsigned pn; };
constexpr int ZTOP_L = 2 * 2048 + 136, ZTOP_C = 2 * 256 + 32;

template <int NTAP> __device__ __forceinline__ void taps_load(unsigned (&tp)[(NTAP + 1) / 2], const bf16* ft, int L, int tid) {
#pragma unroll
    for (int w = 0; w < (NTAP + 1) / 2; ++w) tp[w] = 0u;
#pragma unroll
    for (int e = 0; e < NTAP; ++e) { const int idx = tid + 512 * e; const unsigned v = idx < 2 * L ? (unsigned)*(const GAS unsigned short*)(ft + idx) : 0u; tp[e >> 1] |= v << (16 * (e & 1)); }
}
template <int NTAP> __device__ __forceinline__ void copies_write(LAS unsigned char* lds, const unsigned (&tp)[(NTAP + 1) / 2], int L, int ztop, int tid) {
    const int nz = ztop - 2 * L + 1;
    for (int z = tid; z < 8 * nz; z += 512) { const int c = z / nz, e = z % nz; const int qq = (e < 17 - c) ? e : 2 * L + 16 - c + (e - (17 - c));
        *(LAS unsigned short*)(lds + c * CPY_STRIDE + qq * 2) = 0; }
#pragma unroll
    for (int e = 0; e < NTAP; ++e) { const int idx = tid + 512 * e;
        if (idx < 2 * L) { const int side = idx >= L ? 1 : 0, t = idx - side * L;
            if (!(side == 1 && t == 0)) { const int p = side ? L + t : L - t; const unsigned short val = (unsigned short)(tp[e >> 1] >> (16 * (e & 1)));
#pragma unroll
                for (int c = 0; c < 8; ++c) *(LAS unsigned short*)(lds + c * CPY_STRIDE + (p + 16 - c) * 2) = val; } } }
}
__device__ __forceinline__ void conv8_store(LAS unsigned char* dst, const FPre& f, float w0, float w1, float w2, float bb) {
    const float x[10] = {bflo(f.pn), bflo(f.raw.x), bfhi(f.raw.x), bflo(f.raw.y), bfhi(f.raw.y), bflo(f.raw.z), bfhi(f.raw.z), bflo(f.raw.w), bfhi(f.raw.w), bfhi(f.pn)};
    float y[8];
#pragma unroll
    for (int j = 0; j < 8; ++j) y[j] = w0 * x[j] + w1 * x[j + 1] + w2 * x[j + 2] + bb;
    v4u o; o.x = pk2(y[0], y[1]); o.y = pk2(y[2], y[3]); o.z = pk2(y[4], y[5]); o.w = pk2(y[6], y[7]);
    *(LAS v4u*)dst = o;
}
__device__ __forceinline__ void fpre_load(FPre& f, const bf16* urow, int s0, int L) {
    f.raw = *(const GAS v4u*)(urow + s0);
    const unsigned p = s0 > 0 ? (unsigned)*(const GAS unsigned short*)(urow + s0 - 1) : 0u, n = s0 + 8 < L ? (unsigned)*(const GAS unsigned short*)(urow + s0 + 8) : 0u;
    f.pn = p | (n << 16);
}
__device__ __forceinline__ void fill_coop_load(FPre (&fp)[4], const bf16* urow_ch, int tid) {
#pragma unroll
    for (int q = 0; q < 4; ++q) { const int ch = tid + 512 * q, b = ch >> 8, s0 = (ch & 255) * 8; fpre_load(fp[q], urow_ch + b * 2048, s0, 2048); }
}
__device__ __forceinline__ void fill_coop_write(LAS unsigned char* ush, const FPre (&fp)[4], float w0, float w1, float w2, float bb, int tid) {
    for (int z = tid; z < 160; z += 512) { const int b = z / 20, e = z % 20; const int el = e < 4 ? e * 8 : 2080 + (e - 4) * 8;
        *(LAS v4u*)(ush + ush_base(b) + el * 2) = (v4u){0u, 0u, 0u, 0u}; }
#pragma unroll
    for (int q = 0; q < 4; ++q) { const int ch = tid + 512 * q, b = ch >> 8, s0 = (ch & 255) * 8; conv8_store(ush + ush_base(b) + 2 * (32 + s0), fp[q], w0, w1, w2, bb); }
}
__device__ __forceinline__ void fill_ctx_load(FPre (&fp)[2], const bf16* urow_wave, int lane) {
#pragma unroll
    for (int j = 0; j < 2; ++j) { const int q = 2 * (lane >> 5) + j, s0 = (lane & 31) * 8; fpre_load(fp[j], urow_wave + q * 256, s0, 256); }
}
__device__ __forceinline__ void fill_ctx_write(LAS unsigned char* ubw, const FPre (&fp)[2], float w0, float w1, float w2, float bb, int lane) {
    const int e0 = lane < 32 ? lane * 8 : 512 + (lane - 32) * 8;
#pragma unroll
    for (int q = 0; q < 4; ++q) *(LAS v4u*)(ubw + q * 1536 + e0 * 2) = (v4u){0u, 0u, 0u, 0u};
#pragma unroll
    for (int j = 0; j < 2; ++j) { const int q = 2 * (lane >> 5) + j, s0 = (lane & 31) * 8; conv8_store(ubw + q * 1536 + (256 + s0) * 2, fp[j], w0, w1, w2, bb); }
}
__device__ __forceinline__ void gpre_load(GPre& p, const bf16* xg, int t0, int L) {
    p.xr = *(const GAS v2u*)(xg + t0);
    const unsigned a = t0 > 0 ? (unsigned)*(const GAS unsigned short*)(xg + t0 - 1) : 0u, n = t0 + 4 < L ? (unsigned)*(const GAS unsigned short*)(xg + t0 + 4) : 0u;
    p.pn = a | (n << 16);
}
__device__ __forceinline__ void gate4(const f32x4& y, const GPre& p, LAS unsigned char* up, float cw0, float cw1, float cw2, float cb, float invn, float skip, bool last, bf16* zp) {
    const v2u ur = *(const LAS v2u*)up;
    const float x[6] = {bflo(p.pn), bflo(p.xr.x), bfhi(p.xr.x), bflo(p.xr.y), bfhi(p.xr.y), bfhi(p.pn)};
    const float uu[4] = {bflo(ur.x), bfhi(ur.x), bflo(ur.y), bfhi(ur.y)};
    float z[4];
#pragma unroll
    for (int r = 0; r < 4; ++r) { const float xc = cw0 * x[r] + cw1 * x[r + 1] + cw2 * x[r + 2] + cb; z[r] = xc * (y[r] * invn + skip * uu[r]); }
    v2u o; o.x = pk2(z[0], z[1]); o.y = pk2(z[2], z[3]);
    if (last) *(GAS v2u*)zp = o; else *(LAS v2u*)up = o;
}
__device__ __forceinline__ void gate_coop_load(GPre (&pre)[8], const bf16* xg_ch, int wave, int lane) {
    const int i = lane & 15, g = lane >> 4, bb = i & 7, sg = i >> 3;
#pragma unroll
    for (int a = 0; a < 8; ++a) gpre_load(pre[a], xg_ch + bb * 2048, 32 * (8 * wave + a) + 16 * sg + 4 * g, 2048);
}
__device__ __forceinline__ void gate_coop_apply(const f32x4 (&acc)[8], const GPre (&pre)[8], LAS unsigned char* ush, float cw0, float cw1, float cw2, float cb, float invn, float skip, int wave, int lane, bool last, bf16* zt_ch) {
    const int i = lane & 15, g = lane >> 4, bb = i & 7, sg = i >> 3;
#pragma unroll
    for (int a = 0; a < 8; ++a) { const int t0 = 32 * (8 * wave + a) + 16 * sg + 4 * g;
        gate4(acc[a], pre[a], ush + ush_base(bb) + (32 + t0) * 2, cw0, cw1, cw2, cb, invn, skip, last, zt_ch + bb * 2048 + t0);
        __builtin_amdgcn_sched_barrier(0); }
}
__device__ __forceinline__ void toeplitz_ctx4(const LAS unsigned char* cpy, const LAS unsigned char* ubw, f32x4 (&acc)[4], int lane) {
    const int i = lane & 15, g = lane >> 4, c = (-i) & 7;
    const LAS unsigned char* ap = cpy + c * CPY_STRIDE + 2 * (256 + 8 * g + 16 - i - c);
    const LAS unsigned char* bp = ubw + 2 * (256 + 8 * g + 16 * i);
#pragma unroll 2
    for (int S = -256; S <= 224; S += 32) {
        const bf16x8 a = *(const LAS bf16x8*)(ap + 2 * S);
        bf16x8 b[4];
#pragma unroll
        for (int q = 0; q < 4; ++q) b[q] = *(const LAS bf16x8*)(bp + 1536 * q + 2 * S);
#pragma unroll
        for (int q = 0; q < 4; ++q) acc[q] = __builtin_amdgcn_mfma_f32_16x16x32_bf16(a, b[q], acc[q], 0, 0, 0);
    }
}
__device__ __forceinline__ void gate_ctx_load(GPre (&pre)[4], const bf16* xg_wave, int lane) {
    const int t0 = 16 * (lane & 15) + 4 * (lane >> 4);
#pragma unroll
    for (int q = 0; q < 4; ++q) gpre_load(pre[q], xg_wave + q * 256, t0, 256);
}
__device__ __forceinline__ void gate_ctx_apply(const f32x4 (&acc)[4], const GPre (&pre)[4], LAS unsigned char* ubw, float cw0, float cw1, float cw2, float cb, float invn, float skip, int lane, bool last, bf16* zt_wave) {
    const int t0 = 16 * (lane & 15) + 4 * (lane >> 4);
#pragma unroll
    for (int q = 0; q < 4; ++q) { gate4(acc[q], pre[q], ubw + q * 1536 + (256 + t0) * 2, cw0, cw1, cw2, cb, invn, skip, last, zt_wave + q * 256 + t0); __builtin_amdgcn_sched_barrier(0); }
}
}

constexpr int NPHASE = 35;
#ifndef PHMASK
#define PHMASK 0xFFFF
#endif
#define PHON(b) ((PHMASK >> (b)) & 1)
#ifndef REPMASK
#define REPMASK 0
#endif
#ifndef REPN
#define REPN 2
#endif
#define RSCALE (r_ == 0 ? 1.0f : 0.0f)
#define RUN(b, call) do { _Pragma("unroll 1") for (int r_ = 0; r_ < (((REPMASK >> (b)) & 1) ? REPN : 1); ++r_) { call; } } while (0)
#ifndef MK_PER_PHASE
#define MK_PER_PHASE 0
#endif


#ifndef STAGGER_TICKS
#define STAGGER_TICKS 800
#endif
__device__ __forceinline__ void stagger_start() {
    if (STAGGER_TICKS > 0 && (blockIdx.x & 1)) { const unsigned long long t0 = __builtin_amdgcn_s_memrealtime(); while (__builtin_amdgcn_s_memrealtime() - t0 < (unsigned long long)STAGGER_TICKS) __builtin_amdgcn_s_sleep(8); }
}
template <class T> __device__ __forceinline__ T* launder(T* p) { GAS T* q = (GAS T*)p; asm volatile("" : "+s"(q)); return (T*)q; }
#define ENV_IDS int tid_ = threadIdx.x; asm volatile("" : "+v"(tid_)); const int tid = tid_, lane = tid & 63, wave = __builtin_amdgcn_readfirstlane(tid >> 6); const int G = gridDim.x, bx = blockIdx.x; \
    const int vcu = (G % 8 == 0) ? (bx % 8) * (G / 8) + bx / 8 : bx; const int gw = vcu * NWAVES + wave, NGW = G * NWAVES; (void)tid; (void)lane; (void)gw; (void)NGW; (void)bx;
#ifndef SPL_DN
#define SPL_DN 4
#endif
#ifndef WGM_QKV
#define WGM_QKV 4
#endif
#ifndef WGM_IN
#define WGM_IN 4
#endif
#ifndef WGM_MIX
#define WGM_MIX 4
#endif
#ifndef WGM_GU
#define WGM_GU 8
#endif
#ifndef WGM_DN
#define WGM_DN 4
#endif
#define ENV_PTRS unsigned char* ws = launder(A.ws); float* out = launder(A.out); (void)out; (void)ws;

__device__ __forceinline__ void ph_prologue_a(const Args& A, LAS unsigned char* L) {
    ENV_IDS ENV_PTRS
    LAS float* wscr = (LAS float*)(L + wave * 16384);
    { int it = gw; TItem t; f32x4 tv[8];
      if (it < IT_TOTAL) { t = titem_decode(A, it); titem_load(t, tv, lane); }
#pragma unroll 1
      while (it < IT_TOTAL) { const int nit = it + NGW; TItem tn = t; f32x4 tn_v[8];
#pragma unroll
          for (int i = 0; i < 8; ++i) tn_v[i] = tv[i];
          if (nit < IT_TOTAL) { tn = titem_decode(A, nit); titem_load(tn, tn_v, lane); }
          titem_finish(t, tv, wscr, lane);
          t = tn;
#pragma unroll
          for (int i = 0; i < 8; ++i) tv[i] = tn_v[i];
          it = nit; } }
    { const size_t NCH = (size_t)2 * 524288 + 2 * 262144;
      for (size_t ch = (size_t)gw * 64 + lane; ch < NCH; ch += (size_t)NGW * 64) {
          int ten; size_t off; unsigned char* dstb;
          if (ch < 524288) { ten = 0; off = ch * 8; dstb = ws + WS_CWK; } else if (ch < 1048576) { ten = 1; off = (ch - 524288) * 8; dstb = ws + WS_CWV; }
          else if (ch < 1310720) { ten = 2; off = (ch - 1048576) * 8; dstb = ws + WS_CAK; } else { ten = 3; off = (ch - 1310720) * 8; dstb = ws + WS_CAV; }
          const float* src = GIN(2 + ten) + off; const f32x4 a = *(const GAS f32x4*)src, b = *(const GAS f32x4*)(src + 4);
          v4u o; o.x = pk2(a.x, a.y); o.y = pk2(a.z, a.w); o.z = pk2(b.x, b.y); o.w = pk2(b.z, b.w);
          *(GAS v4u*)((bf16*)dstb + off) = o; } }
    for (int e = gw * 64 + lane; e < 2048 * 64; e += NGW * 64) rope_table_entry((float*)(ws + WS_ROPE), e);
    for (int u = gw; u < 1536; u += NGW) adaln_partial_unit(A, __builtin_amdgcn_readfirstlane(u), wscr, lane);
    for (int rr = gw; rr < 2304; rr += NGW) filter_a2_row(A, __builtin_amdgcn_readfirstlane(rr), lane);
}
__device__ __forceinline__ void ph_prologue_b(const Args& A, LAS unsigned char* L) {
    ENV_IDS ENV_PTRS
    LAS float* wscr = (LAS float*)(L + wave * 16384);
    float* MODF = (float*)(ws + WS_MODF);
    for (int e = gw * 64 + lane; e < DEPTH * 9 * DM; e += NGW * 64) { const int layer = e / (9 * DM), c = (e / DM) % 9, col = e % DM;
        float m[6];
#pragma unroll
        for (int q = 0; q < 6; ++q) { float s = GIN(11)[(size_t)layer * 12288 + q * DM + col];
#pragma unroll
            for (int kc = 0; kc < 8; ++kc) s += ((const float*)(ws + WS_MODP))[(size_t)((layer * 8 + kc) * 9 + c) * 12288 + q * DM + col];
            m[q] = s; }
        float* mf = MODF + (size_t)((layer * 9 + c) * 6) * DM + col;
        mf[0 * DM] = GIN(8)[layer * DM + col] * (1.0f + m[1]); mf[1 * DM] = m[0]; mf[2 * DM] = m[2];
        mf[3 * DM] = GIN(9)[layer * DM + col] * (1.0f + m[4]); mf[4 * DM] = m[3]; mf[5 * DM] = m[5]; }
    for (int u = gw; u < 9216; u += NGW) filter_hf_unit(A, __builtin_amdgcn_readfirstlane(u), lane);
}
__device__ __forceinline__ void ph_norm(const Args& A, int layer, int which) {
    ENV_IDS ENV_PTRS
    const float* modf = (const float*)(ws + WS_MODF) + (size_t)layer * 9 * 6 * DM; bf16* HB = (bf16*)(ws + WS_H);
    if (layer == 0 && which == 0) {
        const float* NP = (const float*)(ws + WS_NP); float* INV = (float*)(ws + WS_INV);
        for (int e = gw * 64 + lane; e < 4 * DM; e += NGW * 64) { const int variant = e >> 12, o = (e >> 11) & 1, d = e & 2047; float s = 0.f;
            const int c0 = variant ? 32 : 0, c1 = variant ? 34 : 16;
            for (int ch = c0; ch < c1; ++ch) s += NP[(size_t)ch * 8192 + o * 2048 + d] + NP[(size_t)ch * 8192 + 4096 + o * 2048 + d];
            INV[e] = 1.0f / (s + 1e-6f); } }
    bf16* XB = (bf16*)(ws + WS_XB);
    const int per = (NTOK + NGW - 1) / NGW, r0 = gw * per, r1 = (r0 + per < NTOK) ? r0 + per : NTOK;
    int cur = -1; f32x4 ma[4][2], mb[4][2];
#pragma unroll 1
    for (int row = r0; row < r1; ++row) { const int cv = row < NCTX ? 0 : 1 + ((row - NCTX) >> 11);
        if (cv != cur) { cur = cv; const float* pa = modf + (size_t)(cv * 6 + 3 * which) * DM + 8 * lane; const float* pb = modf + (size_t)(cv * 6 + 3 * which + 1) * DM + 8 * lane;
#pragma unroll
            for (int j = 0; j < 4; ++j) { ma[j][0] = *(const GAS f32x4*)(pa + 512 * j); ma[j][1] = *(const GAS f32x4*)(pa + 512 * j + 4); mb[j][0] = *(const GAS f32x4*)(pb + 512 * j); mb[j][1] = *(const GAS f32x4*)(pb + 512 * j + 4); } }
        if (layer == 0 && which == 0) { const float* xr = row < NCTX ? GIN(0) + (size_t)row * DM : GIN(1) + (size_t)(row - NCTX) * DM;
            norm_row_f32(xr, ma, mb, HB + (size_t)row * DM, XB + (size_t)row * DM, lane); }
        else norm_row_bf16(XB + (size_t)row * DM, ma, mb, HB + (size_t)row * DM, lane); }
}
__device__ __forceinline__ void ph_qkv(const Args& A, int layer, LAS unsigned char* L) {
    ENV_PTRS
    const int G = gridDim.x, bx = blockIdx.x; const bool is_ax = (layer % 3) == 2; const int jx = layer / 3;
    const bf16* W = (const bf16*)(ws + (is_ax ? WS_WQKVA : (jx == 0 ? WS_WQKV0 : WS_WQKV1)));
    pg8::Gemm g{(const bf16*)(ws + WS_H), W, NTOK, QKVD, DM}; pg8::StaticOrder S; S.init(NTOK, QKVD, G, bx, WGM_QKV);
    pg8::EpiQKV E{(bf16*)(ws + WS_BIG), is_ax ? nullptr : out + OUT_WK + (size_t)jx * 256 * 512, is_ax ? out + OUT_AV : out + OUT_WV + (size_t)jx * 256 * 512, is_ax ? 0 : 256};
    pg8::gemm_phase<pg8::EpiQKV, pg8::StaticOrder, true, true>(L, g, S, E);
}
__device__ __forceinline__ void ph_qkpost(const Args& A, int layer) {
    ENV_IDS ENV_PTRS
    const bool is_ax = (layer % 3) == 2; bf16* QKVB = (bf16*)(ws + WS_BIG);
    for (int row = (is_ax ? 0 : NCTX) + gw; row < NTOK; row += NGW)
        qkpost_row(QKVB + (size_t)row * QKVD, row, is_ax, GIN(28), (const float*)(ws + WS_ROPE), out + OUT_AK, lane);
}
__device__ __forceinline__ void ph_attn(const Args& A, int layer, LAS char* lds) {
    ENV_PTRS
    const int G = gridDim.x, bx = blockIdx.x; const bool is_ax = (layer % 3) == 2; const int jx = layer / 3;
    const att::bf16* QK = (const att::bf16*)(ws + WS_BIG); att::bf16* OB = (att::bf16*)(ws + WS_H);
    const att::bf16* CK = (const att::bf16*)(ws + (is_ax ? WS_CAK : WS_CWK));
    const att::bf16* CV = (const att::bf16*)(ws + (is_ax ? WS_CAV : WS_CWV));
    const int ncl = is_ax ? 1 : 2;
#pragma unroll 1
    for (int u = bx; u < 1536; u += G) {
        att::Unit U;
        if (u < 1024) { const int b = u >> 7, qb = ((u >> 4) + 2 * (u >> 8)) & 7, h = u & 15, kvh = h >> 2;
            const size_t r0 = (size_t)NCTX + (size_t)b * 2048 + (size_t)qb * 256;
            U.Q = QK + r0 * QKVD + h * 128; U.ldq = QKVD;
            const size_t coff = ((size_t)(b * ncl + (is_ax ? 0 : jx)) * 512) * 512 + kvh * 128;
            U.KA = CK + coff; U.VA = CV + coff; U.ldA = 512; U.nA = 8;
            const int klo = is_ax ? 0 : (qb * 256 - 128 < 0 ? 0 : qb * 256 - 128), khi = is_ax ? 2048 : (qb * 256 + 384 > 2048 ? 2048 : qb * 256 + 384);
            const size_t kr0 = (size_t)NCTX + (size_t)b * 2048 + klo;
            U.KB = QK + kr0 * QKVD + 2048 + kvh * 128; U.VB = QK + kr0 * QKVD + 2560 + kvh * 128; U.ldB = QKVD;
            U.NT = 8 + (khi - klo) / 64; U.win = is_ax ? 0 : 1; U.dq0 = qb * 256 - klo;
            U.O = OB + r0 * DM + h * 128; U.ldo = DM;
            U.has_sink = is_ax ? 0 : 1; U.sink = is_ax ? 0.f : GIN(14)[jx * 16 + h];
            U.qmode = is_ax ? 3 : 2; U.qt0 = qb * 256;
        } else { const int uc = u - 1024, b = uc >> 4, h = uc & 15, kvh = h >> 2; const size_t r0 = (size_t)b * 256;
            U.Q = QK + r0 * QKVD + h * 128; U.ldq = QKVD;
            U.KA = QK + r0 * QKVD + 2048 + kvh * 128; U.VA = QK + r0 * QKVD + 2560 + kvh * 128; U.ldA = QKVD; U.nA = 4;
            U.KB = U.KA; U.VB = U.VA; U.ldB = QKVD; U.NT = 4; U.win = 0; U.dq0 = 0;
            U.O = OB + r0 * DM + h * 128; U.ldo = DM;
            U.has_sink = is_ax ? 0 : 1; U.sink = is_ax ? 0.f : GIN(14)[jx * 16 + h];
            U.qmode = is_ax ? 1 : 0; U.qt0 = 0;
        }
        U.qg = GIN(27); U.rope = (const float*)(ws + WS_ROPE);
        att::attn_unit(U, lds);
    }
}
__device__ __forceinline__ void ph_hyin(const Args& A, LAS unsigned char* L) {
    ENV_PTRS
    const int G = gridDim.x, bx = blockIdx.x;
    pg8::Gemm g{(const bf16*)(ws + WS_WHI), (const bf16*)(ws + WS_H), 6144, NTOK, DM}; pg8::StaticOrder S; S.init(6144, NTOK, G, bx, WGM_IN);
    pg8::EpiBf16 E{(bf16*)(ws + WS_BIG), NTOK};
    pg8::gemm_phase<pg8::EpiBf16, pg8::StaticOrder, true, true>(L, g, S, E);
}
__device__ __forceinline__ void ph_hyconv(const Args& A, LAS unsigned char* L) {
    ENV_IDS ENV_PTRS
    const bf16* UT = (const bf16*)(ws + WS_BIG); bf16* ZT = (bf16*)(ws + WS_ZT);
    const float* cw = GIN(16); const float* cbv = GIN(17); const float* skp = GIN(24); const float* INV = (const float*)(ws + WS_INV);
    LAS unsigned char* ush = L + hy::U_OFF; LAS unsigned char* ubw = L + hy::U_OFF + wave * hy::U_BYTES;
    const bf16* FTL = (const bf16*)(ws + WS_FT); const bf16* FTC = (const bf16*)(ws + WS_FT_CTX);
    hy::FPre fl[4]; unsigned tl0[4];
#pragma unroll 1
    for (int d = bx; d < DM; d += G) {
        float w0[3], w1[3], w2[3], cb[3];
#pragma unroll
        for (int p = 0; p < 3; ++p) { const int ch = p * DM + d; w0[p] = cw[ch]; w1[p] = cw[6144 + ch]; w2[p] = cw[2 * 6144 + ch]; cb[p] = cbv[ch]; }
        const float inl0 = INV[d], inl1 = INV[2048 + d], inc0 = INV[4096 + d], inc1 = INV[6144 + d];
        const float sk0 = skp[d], sk1 = skp[DM + d];
        const bf16* ftl = FTL + (size_t)d * 2 * 2048; const bf16* ftc = FTC + (size_t)d * 2 * 256;
        const size_t cb0 = (size_t)wave * 1024;
        hy::fill_coop_load(fl, UT + (size_t)d * NTOK + NCTX, tid); hy::taps_load<8>(tl0, ftl, 2048, tid);
        hy::fill_coop_write(ush, fl, w0[0], w1[0], w2[0], cb[0], tid); hy::copies_write<8>(L, tl0, 2048, hy::ZTOP_L, tid); __syncthreads();
        hy::GPre g0[8]; unsigned tl1[4];
        hy::taps_load<8>(tl1, ftl + (size_t)2048 * 2 * 2048, 2048, tid);
        f32x4 acc[8];
#pragma unroll
        for (int k = 0; k < 8; ++k) acc[k] = (f32x4){0.f, 0.f, 0.f, 0.f};
        hy::toeplitz_coop(L, ush, acc, wave, lane); __syncthreads();
        hy::gate_coop_load(g0, UT + (size_t)(DM + d) * NTOK + NCTX, wave, lane);
        hy::gate_coop_apply(acc, g0, ush, w0[1], w1[1], w2[1], cb[1], inl0, sk0, wave, lane, false, nullptr); hy::copies_write<8>(L, tl1, 2048, hy::ZTOP_L, tid); __syncthreads();
        hy::GPre g1[8]; hy::FPre fc[2]; unsigned tc0[1], tc1[1];
        hy::fill_ctx_load(fc, UT + (size_t)d * NTOK + cb0, lane); hy::taps_load<1>(tc0, ftc, 256, tid); hy::taps_load<1>(tc1, ftc + (size_t)2048 * 2 * 256, 256, tid);
#pragma unroll
        for (int k = 0; k < 8; ++k) acc[k] = (f32x4){0.f, 0.f, 0.f, 0.f};
        hy::toeplitz_coop(L, ush, acc, wave, lane);
        hy::gate_coop_load(g1, UT + (size_t)(2 * DM + d) * NTOK + NCTX, wave, lane);
        hy::gate_coop_apply(acc, g1, ush, w0[2], w1[2], w2[2], cb[2], inl1, sk1, wave, lane, true, ZT + (size_t)d * NTOK + NCTX); __syncthreads();
        hy::fill_ctx_write(ubw, fc, w0[0], w1[0], w2[0], cb[0], lane); hy::copies_write<1>(L, tc0, 256, hy::ZTOP_C, tid); hy::copies_write<1>(L + 2048, tc1, 256, hy::ZTOP_C, tid); __syncthreads();
        hy::GPre h0[4];
        hy::gate_ctx_load(h0, UT + (size_t)(DM + d) * NTOK + cb0, lane);
        f32x4 ac4[4];
#pragma unroll
        for (int q = 0; q < 4; ++q) ac4[q] = (f32x4){0.f, 0.f, 0.f, 0.f};
        hy::toeplitz_ctx4(L, ubw, ac4, lane);
        hy::GPre h1[4];
        hy::gate_ctx_load(h1, UT + (size_t)(2 * DM + d) * NTOK + cb0, lane);
        hy::gate_ctx_apply(ac4, h0, ubw, w0[1], w1[1], w2[1], cb[1], inc0, sk0, lane, false, nullptr);
        LDS_WAIT(); asm volatile("" ::: "memory");
#pragma unroll
        for (int q = 0; q < 4; ++q) ac4[q] = (f32x4){0.f, 0.f, 0.f, 0.f};
        hy::toeplitz_ctx4(L + 2048, ubw, ac4, lane);
        hy::gate_ctx_apply(ac4, h1, ubw, w0[2], w1[2], w2[2], cb[2], inc1, sk1, lane, true, ZT + (size_t)d * NTOK + cb0); __syncthreads();
    }
}
__device__ __forceinline__ void ph_hytr(const Args& A, LAS unsigned char* L) {
    ENV_IDS ENV_PTRS
    const bf16* ZT = (const bf16*)(ws + WS_ZT); bf16* HB = (bf16*)(ws + WS_H);
    LAS unsigned char* scr = L + wave * 16384;
    for (int tile = gw; tile < 32 * 384; tile += NGW) { const int d0 = (tile & 31) * 64, r0 = (tile >> 5) * 64;
#pragma unroll
        for (int j = 0; j < 8; ++j) { const int idx = j * 64 + lane, dl = idx >> 3, ch = idx & 7;
            *(LAS v4u*)(scr + dl * 144 + ch * 16) = *(const GAS v4u*)(ZT + (size_t)(d0 + dl) * NTOK + r0 + ch * 8); }
        LDS_WAIT(); asm volatile("" ::: "memory");
#pragma unroll
        for (int j = 0; j < 8; ++j) { unsigned e[8];
#pragma unroll
            for (int q = 0; q < 8; ++q) e[q] = *(const LAS unsigned short*)(scr + (j * 8 + q) * 144 + lane * 2);
            v4u o; o.x = e[0] | (e[1] << 16); o.y = e[2] | (e[3] << 16); o.z = e[4] | (e[5] << 16); o.w = e[6] | (e[7] << 16);
            *(GAS v4u*)(HB + (size_t)(r0 + lane) * DM + d0 + j * 8) = o; }
        LDS_WAIT(); asm volatile("" ::: "memory"); }
}
__device__ __forceinline__ void ph_mixout(const Args& A, int layer, LAS unsigned char* L, float gs) {
    ENV_PTRS
    const int G = gridDim.x, bx = blockIdx.x; const int kind = layer % 3, jx = layer / 3;
    const float* modf = (const float*)(ws + WS_MODF) + (size_t)layer * 9 * 6 * DM;
    const bf16* W = (const bf16*)(ws + (kind == 1 ? WS_WHO : (kind == 2 ? WS_WOA : (jx == 0 ? WS_WO0 : WS_WO1))));
    pg8::StaticOrder S; S.init(NTOK, DM, G, bx, WGM_MIX);
    pg8::EpiResid E{(bf16*)(ws + WS_XB), modf + 2 * DM, gs};
    if (kind == 1) {
        pg8::Gemm g{(const bf16*)(ws + WS_ZT), W, NTOK, DM, DM};
        pg8::gemm_phase<pg8::EpiResid, pg8::StaticOrder, true, true, false, false, true>(L, g, S, E);
    } else {
        pg8::Gemm g{(const bf16*)(ws + WS_H), W, NTOK, DM, DM};
        pg8::gemm_phase<pg8::EpiResid, pg8::StaticOrder, true, true>(L, g, S, E);
    }
}
__device__ __forceinline__ void ph_gu(const Args& A, int layer, LAS unsigned char* L) {
    ENV_PTRS
    const int G = gridDim.x, bx = blockIdx.x;
    pg8::Gemm g{(const bf16*)(ws + WS_H), (const bf16*)(ws + WS_WGU + (size_t)layer * W_GU), NTOK, NGU, DM}; pg8::StaticOrder S; S.init(NTOK, NGU, G, bx, WGM_GU);
    pg8::EpiSwiglu E{(bf16*)(ws + WS_BIG)};
    pg8::gemm_phase<pg8::EpiSwiglu, pg8::StaticOrder, true, true>(L, g, S, E);
}
__device__ __forceinline__ void ph_down(const Args& A, int layer, LAS unsigned char* L, float gs) {
    ENV_PTRS
    const int G = gridDim.x, bx = blockIdx.x;
    const float* modf = (const float*)(ws + WS_MODF) + (size_t)layer * 9 * 6 * DM;
    pg8::Gemm g{(const bf16*)(ws + WS_BIG), (const bf16*)(ws + WS_WDN + (size_t)layer * W_DN), NTOK, DM, DFF}; pg8::StaticOrder S; S.init(NTOK, DM, G, bx, WGM_DN);
    int spl_ = SPL_DN; asm volatile("" : "+s"(spl_));
    S.split(spl_, DFF / 64, (float*)(ws + WS_H), (unsigned*)(ws + WS_CTL) + CW_SPLIT + (layer * 4 + 3) * 256);
#ifdef PROBE_I0
    if (gs == 0.f) S.i0 = PROBE_I0;
#endif
    pg8::EpiResid E{(bf16*)(ws + WS_XB), modf + 5 * DM, gs};
    pg8::gemm_phase<pg8::EpiResid, pg8::StaticOrder, true, true, true, true>(L, g, S, E);
}
__device__ __forceinline__ void ph_final(const Args& A) {
    ENV_IDS ENV_PTRS
    for (int row = gw; row < NTOK; row += NGW) final_norm_row((const bf16*)(ws + WS_XB) + (size_t)row * DM, out + (size_t)row * DM, GIN(32), lane);
}

__global__ void __launch_bounds__(NWAVES * 64, 2) hybrid_fwd(Args A) {
    extern __shared__ __attribute__((aligned(16))) unsigned char lds[];
    LAS unsigned char* L = (LAS unsigned char*)lds;
    for (int u = threadIdx.x; u < (LDS_BYTES - LDSCTL_OFF) / 4; u += NWAVES * 64) ((LAS unsigned*)(L + LDSCTL_OFF))[u] = 0u;
    __syncthreads();
    XcdBarrier bar; bar.bar = (unsigned*)(A.ws + WS_CTL) + CW_BAR; bar.x = 0; bar.st = nullptr;
    if (!MK_PER_PHASE) bar = xcd_barrier_post((unsigned*)(A.ws + WS_CTL) + CW_BAR, (volatile LAS unsigned*)(L + MISC_OFF) + 8);
    const int lo = A.ph_lo, hi = A.ph_hi;
#define IN(k) (lo <= (k) && (k) < hi)
#define SEAM(k) do { if (IN(k) && IN((k) + 1)) xcd_barrier(bar); } while (0)
    if (PHON(0) && IN(0)) RUN(0, ph_prologue_a(A, L));
    SEAM(0);
    if (PHON(1) && IN(1)) RUN(1, ph_prologue_b(A, L));
    SEAM(1);
#pragma unroll 1
    for (int layer = 0; layer < DEPTH; ++layer) {
        const int pb = 2 + 8 * layer;
        if (PHON(2) && IN(pb + 0)) RUN(2, ph_norm(A, layer, 0));
        SEAM(pb + 0);
        if ((layer % 3) != 1) {
            if (PHON(3) && IN(pb + 1)) RUN(3, ph_qkv(A, layer, L));
            SEAM(pb + 1);
            if (PHON(4) && IN(pb + 2)) RUN(4, ph_qkpost(A, layer));
            SEAM(pb + 2);
            if (PHON(5) && IN(pb + 3)) RUN(5, ph_attn(A, layer, (LAS char*)L));
            SEAM(pb + 3);
        } else {
            if (PHON(6) && IN(pb + 1)) RUN(6, ph_hyin(A, L));
            SEAM(pb + 1);
            if (PHON(7) && IN(pb + 2)) RUN(7, ph_hyconv(A, L));
            SEAM(pb + 2);
        }
        if (PHON(9) && IN(pb + 4)) RUN(9, ph_mixout(A, layer, L, RSCALE));
        SEAM(pb + 4);
        if (PHON(10) && IN(pb + 5)) RUN(10, ph_norm(A, layer, 1));
        SEAM(pb + 5);
        if (PHON(11) && IN(pb + 6)) RUN(11, ph_gu(A, layer, L));
        SEAM(pb + 6);
        if (PHON(12) && IN(pb + 7)) RUN(12, ph_down(A, layer, L, RSCALE));
        SEAM(pb + 7);
    }
    if (PHON(13) && IN(34)) RUN(13, ph_final(A));
#undef IN
#undef SEAM
}

extern "C" void kernel_launch(void* const* d_in, const int* in_sizes, int n_in, void* d_out, int out_size, void* d_ws, size_t ws_size, hipStream_t stream) {
    static int grid = 0;
    if (grid == 0) {
        if (n_in != 33 || (size_t)out_size != OUT_END || ws_size < WS_END) { fprintf(stderr, "kernel_launch: unexpected shapes: n_in %d out %d ws %zu (need %zu)\n", n_in, out_size, ws_size, (size_t)WS_END); grid = -1; return; }
        int dev = 0, cus = 0, per_cu = 0;
        if (hipGetDevice(&dev) != hipSuccess || hipDeviceGetAttribute(&cus, hipDeviceAttributeMultiprocessorCount, dev) != hipSuccess) { grid = -1; return; }
        if (hipFuncSetAttribute((const void*)hybrid_fwd, hipFuncAttributeMaxDynamicSharedMemorySize, LDS_BYTES) != hipSuccess) { fprintf(stderr, "kernel_launch: hipFuncSetAttribute failed\n"); grid = -1; return; }
        if (hipOccupancyMaxActiveBlocksPerMultiprocessor(&per_cu, (const void*)hybrid_fwd, NWAVES * 64, LDS_BYTES) != hipSuccess || per_cu < 1)
            fprintf(stderr, "kernel_launch: occupancy query reports %d workgroups per CU\n", per_cu);
        (void)hipGetLastError();
        grid = cus;
    }
    if (grid < 0) return;
    if (hipMemsetAsync((char*)d_ws + WS_CTL, 0, CTL_ZERO_BYTES, stream) != hipSuccess) { fprintf(stderr, "kernel_launch: memset failed\n"); return; }
    Args a{};
    for (int i = 0; i < 33; ++i) a.in[i] = (const float*)d_in[i];
    a.out = (float*)d_out; a.ws = (unsigned char*)d_ws;
#if MK_PER_PHASE
    for (int ph = 0; ph < NPHASE; ++ph) { a.ph_lo = ph; a.ph_hi = ph + 1; hipLaunchKernelGGL(hybrid_fwd, dim3(grid), dim3(NWAVES * 64), LDS_BYTES, stream, a); }
#else
    a.ph_lo = 0; a.ph_hi = NPHASE; hipLaunchKernelGGL(hybrid_fwd, dim3(grid), dim3(NWAVES * 64), LDS_BYTES, stream, a);
#endif
    const hipError_t le = hipPeekAtLastError();
    if (le != hipSuccess) fprintf(stderr, "kernel_launch: launch failed: %s\n", hipGetErrorName(le));
}
```

```cpp
#include <hip/hip_runtime.h>
#include <cstdio>
#include <cstdint>
#include <hip/hip_bf16.h>
#include <cmath>
namespace pg8 {
#define PG8_LAS __attribute__((address_space(3)))
typedef unsigned short bf16_t;
typedef short bf16x8 __attribute__((ext_vector_type(8)));
typedef float f32x4 __attribute__((ext_vector_type(4)));
typedef unsigned u32x4 __attribute__((ext_vector_type(4)));
constexpr int BM = 256, BK = 64, HALF = 128, HTB = HALF * BK * 2  , STAGE_BYTES = 8 * HTB, NXCD = 8;

__host__ __device__ __forceinline__ int lds_byte(int r, int c) { const int st = (r >> 4) * 2 + (c >> 5), rr = r & 15, cc = c & 31, ob = rr * 64 + cc * 2; return st * 1024 + (ob ^ (((ob >> 9) & 1) << 5)); }
__host__ __device__ __forceinline__ void stage_rc(int b, int& R, int& C) { const int st = b / 1024, sb = b % 1024, swz = sb ^ (((sb >> 9) & 1) << 5); R = (st >> 1) * 16 + swz / 64; C = (st & 1) * 32 + (swz % 64) / 2; }
__host__ __device__ __forceinline__ int perm32(int rho) { const int n = rho >> 4, i = rho & 15; return 8 * (i >> 2) + 4 * n + (i & 3); }

struct Unit { int pm, pn, k0, nk, part, slot; };
struct Gemm { const bf16_t* A; const bf16_t* Bt; int M, N, K; };

struct StaticOrder {
    int nM, nN, nwg, G, c, WGM, SPL, full, T, ntk, i0; float* pbuf; unsigned* pcnt;
    __host__ __device__ void init(int M, int N, int G_, int c_, int wgm = 4) { nM = M / BM; nN = N / BM; nwg = nM * nN; G = G_; c = c_; WGM = wgm; SPL = 1; full = nwg; T = 0; ntk = 0; i0 = 0; pbuf = nullptr; pcnt = nullptr; }
    __host__ __device__ void split(int spl, int ktiles, float* pb, unsigned* pc) { T = nwg % G; full = nwg - T; SPL = (T > 0 && T * spl <= G) ? spl : 1; if (SPL == 1) { full = nwg; T = 0; } ntk = ktiles; pbuf = pb; pcnt = pc; }
    __host__ __device__ bool next(int i, Unit& u) const {
        long L = (long)(i + i0) * G + c; u.part = -1; u.k0 = 0; u.nk = ntk; u.slot = 0;
        if (L >= full && SPL > 1) { const int j = (int)(L - full); if (j >= T * SPL) return false; u.part = j / T; u.slot = j % T; L = full + u.slot; u.nk = ntk / SPL; u.k0 = u.part * u.nk; }
        else if (L >= nwg) return false;
        int wgid = (int)L; { const int q = nwg / NXCD, r = nwg % NXCD, xcd = wgid % NXCD, off = wgid / NXCD; wgid = (xcd < r ? xcd * (q + 1) : r * (q + 1) + (xcd - r) * q) + off; }
        const int nig = WGM * nN, gid = wgid / nig, fm = gid * WGM, gsz = (nM - fm) < WGM ? (nM - fm) : WGM;
        u.pm = fm + ((wgid % nig) % gsz); u.pn = (wgid % nig) / gsz; return true;
    }
    __device__ __forceinline__ void a_ready(const Unit&) const {}
    __device__ __forceinline__ void done(const Unit&) const {}
};

__device__ __forceinline__ unsigned cvt_pk_bf16(float lo, float hi) { unsigned r; asm("v_cvt_pk_bf16_f32 %0, %1, %2" : "=v"(r) : "v"(lo), "v"(hi)); return r; }
typedef float f32x2 __attribute__((ext_vector_type(2)));
struct EpiBf16 {
    static constexpr bool PERM = true, AFTER_DRAIN = false;
    bf16_t* O; int ldc;
    __device__ __forceinline__ void operator()(const f32x4 (&acc)[2][2][4][2], const Unit& u, int wr, int wc, int fr, int fq) const {
        const int row0 = u.pm * BM + wr * 64 + fr; const int col0 = u.pn * BM + wc * 32 + 8 * fq;
#pragma unroll
        for (int ai = 0; ai < 2; ++ai)
#pragma unroll
            for (int m = 0; m < 4; ++m) { bf16_t* rowp = O + (size_t)(row0 + ai * HALF + m * 16) * ldc + col0;
#pragma unroll
                for (int bj = 0; bj < 2; ++bj) { const f32x4 v0 = acc[ai][bj][m][0], v1 = acc[ai][bj][m][1];
                    u32x4 w; w.x = cvt_pk_bf16(v0[0], v0[1]); w.y = cvt_pk_bf16(v0[2], v0[3]); w.z = cvt_pk_bf16(v1[0], v1[1]); w.w = cvt_pk_bf16(v1[2], v1[3]);
                    *(u32x4*)(rowp + bj * HALF) = w; } }
    }
};
struct EpiQKV {
    static constexpr bool PERM = true, AFTER_DRAIN = false;
    bf16_t* O; float* sk; float* sv; int extra;
    __device__ __forceinline__ void operator()(const f32x4 (&acc)[2][2][4][2], const Unit& u, int wr, int wc, int fr, int fq) const {
        const int row0 = u.pm * BM + wr * 64 + fr; const int col0 = u.pn * BM + wc * 32 + 8 * fq;
        float* sb = nullptr; int scol = 0;
        if (u.pm < 32 && u.pn >= 8) { if (u.pn < 10) { sb = sk; scol = col0 - 2048; } else { sb = sv; scol = col0 - 2560; } }
#pragma unroll
        for (int ai = 0; ai < 2; ++ai)
#pragma unroll
            for (int m = 0; m < 4; ++m) { const int row = row0 + ai * HALF + m * 16; bf16_t* rowp = O + (size_t)row * 3072 + col0;
#pragma unroll
                for (int bj = 0; bj < 2; ++bj) { const f32x4 v0 = acc[ai][bj][m][0], v1 = acc[ai][bj][m][1];
                    u32x4 w; w.x = cvt_pk_bf16(v0[0], v0[1]); w.y = cvt_pk_bf16(v0[2], v0[3]); w.z = cvt_pk_bf16(v1[0], v1[1]); w.w = cvt_pk_bf16(v1[2], v1[3]);
                    *(u32x4*)(rowp + bj * HALF) = w;
                    if (sb) { float* sp = sb + (size_t)(row + (row >> 8) * extra) * 512 + scol + bj * HALF; *(f32x4*)sp = v0; *(f32x4*)(sp + 4) = v1; } } }
    }
};
struct EpiResid {
    static constexpr bool PERM = true, AFTER_DRAIN = false;
    bf16_t* xb; const float* gate; float gs;
    __device__ __forceinline__ void operator()(const f32x4 (&acc)[2][2][4][2], const Unit& u, int wr, int wc, int fr, int fq) const {
        const int row0 = u.pm * BM + wr * 64 + fr; const int col0 = u.pn * BM + wc * 32 + 8 * fq;
        const int cv = u.pm < 32 ? 0 : 1 + ((u.pm - 32) >> 3);
        const float* gp = gate + (size_t)cv * (6 * 2048) + col0;
        f32x4 gv[2][2];
#pragma unroll
        for (int bj = 0; bj < 2; ++bj)
#pragma unroll
            for (int n = 0; n < 2; ++n) gv[bj][n] = *(const f32x4*)(gp + bj * HALF + n * 4) * gs;
#pragma unroll
        for (int ai = 0; ai < 2; ++ai) { u32x4 xw[4][2];
#pragma unroll
            for (int m = 0; m < 4; ++m)
#pragma unroll
                for (int bj = 0; bj < 2; ++bj) xw[m][bj] = *(const u32x4*)(xb + (size_t)(row0 + ai * HALF + m * 16) * 2048 + col0 + bj * HALF);
#pragma unroll
            for (int m = 0; m < 4; ++m)
#pragma unroll
                for (int bj = 0; bj < 2; ++bj) { const u32x4 w = xw[m][bj];
                    const f32x4 x0 = {__builtin_bit_cast(float, w.x << 16), __builtin_bit_cast(float, w.x & 0xffff0000u), __builtin_bit_cast(float, w.y << 16), __builtin_bit_cast(float, w.y & 0xffff0000u)};
                    const f32x4 x1 = {__builtin_bit_cast(float, w.z << 16), __builtin_bit_cast(float, w.z & 0xffff0000u), __builtin_bit_cast(float, w.w << 16), __builtin_bit_cast(float, w.w & 0xffff0000u)};
                    const f32x4 y0 = x0 + gv[bj][0] * acc[ai][bj][m][0], y1 = x1 + gv[bj][1] * acc[ai][bj][m][1];
                    u32x4 o; o.x = cvt_pk_bf16(y0[0], y0[1]); o.y = cvt_pk_bf16(y0[2], y0[3]); o.z = cvt_pk_bf16(y1[0], y1[1]); o.w = cvt_pk_bf16(y1[2], y1[3]);
                    *(u32x4*)(xb + (size_t)(row0 + ai * HALF + m * 16) * 2048 + col0 + bj * HALF) = o; }
            asm volatile("" ::: "memory"); }
    }
};
struct EpiSwiglu {
    static constexpr bool PERM = true, AFTER_DRAIN = false;
    bf16_t* O;
    __device__ __forceinline__ float sw(float g, float uu) const { return g * __builtin_amdgcn_rcpf(1.0f + __builtin_amdgcn_exp2f(-1.4426950408889634f * g)) * uu; }
    __device__ __forceinline__ f32x4 sw4(const f32x4 g, const f32x4 uu) const {
        const f32x4 t = g * -1.4426950408889634f;
        f32x4 e; e[0] = __builtin_amdgcn_exp2f(t[0]); e[1] = __builtin_amdgcn_exp2f(t[1]); e[2] = __builtin_amdgcn_exp2f(t[2]); e[3] = __builtin_amdgcn_exp2f(t[3]);
        const f32x4 d = e + 1.0f;
        f32x4 r; r[0] = __builtin_amdgcn_rcpf(d[0]); r[1] = __builtin_amdgcn_rcpf(d[1]); r[2] = __builtin_amdgcn_rcpf(d[2]); r[3] = __builtin_amdgcn_rcpf(d[3]);
        return (g * uu) * r;
    }
    __device__ __forceinline__ void operator()(const f32x4 (&acc)[2][2][4][2], const Unit& u, int wr, int wc, int fr, int fq) const {
        const int row0 = u.pm * BM + wr * 64 + fr; const int col0 = u.pn * HALF + wc * 32 + 8 * fq;
#pragma unroll
        for (int ai = 0; ai < 2; ++ai)
#pragma unroll
            for (int m = 0; m < 4; ++m) {
                bf16_t* rowp = O + ((size_t)(u.pm * 88 + u.pn * 2 + (wc >> 1)) * 256 + (wr * 64 + fr + ai * HALF + m * 16)) * 64 + (wc & 1) * 32 + 8 * fq;
                const f32x4 g0 = acc[ai][0][m][0], g1 = acc[ai][0][m][1], u0 = acc[ai][1][m][0], u1 = acc[ai][1][m][1];
                const f32x4 y0 = sw4(g0, u0), y1 = sw4(g1, u1);
                u32x4 w; w.x = cvt_pk_bf16(y0[0], y0[1]); w.y = cvt_pk_bf16(y0[2], y0[3]); w.z = cvt_pk_bf16(y1[0], y1[1]); w.w = cvt_pk_bf16(y1[2], y1[3]);
                *(u32x4*)rowp = w; }
    }
};

typedef short s16x4 __attribute__((ext_vector_type(4)));
template <int OFF> __device__ __forceinline__ s16x4 tr_read(int vb) { s16x4 r; asm volatile("ds_read_b64_tr_b16 %0, %1 offset:%2" : "=&v"(r) : "v"(vb), "i"(OFF) : "memory"); return r; }
template <class Epi, class Sched, bool ALIGN_EPI = false, bool SP2 = false, bool SPLITK = false, bool ABLK = false, bool ATR = false>
__device__ __forceinline__ void gemm_phase(PG8_LAS unsigned char* lds, const Gemm g, const Sched& S, const Epi& E) {
    int tid_ = threadIdx.x; asm volatile("" : "+v"(tid_));
    const int tid = tid_, wid = __builtin_amdgcn_readfirstlane(tid >> 6), lane = tid & 63, wr = wid >> 2, wc = wid & 3, fr = lane & 15, fq = lane >> 4;
    const int K = g.K, nt = K / BK;
    unsigned voffA[2], voffB[2];
#pragma unroll
    for (int i = 0; i < 2; ++i) { int R, C; stage_rc(tid * 16 + i * 8192, R, C); const int Rb = Epi::PERM ? ((R & ~31) + perm32(R & 31)) : R;
        voffA[i] = ABLK ? (unsigned)(R * BK + C) * 2u : (unsigned)(R * K + C) * 2u; voffB[i] = (unsigned)(Rb * K + C) * 2u;
        if constexpr (ATR) { const int P = tid * 16 + i * 8192, kl = P >> 8, cs = (P >> 4) & 15, c = cs ^ (((kl & 3) << 2) | ((kl >> 2) & 3));
            voffA[i] = (unsigned)kl * (unsigned)(g.M * 2) + (unsigned)c * 16u; } }
    const size_t kstep = (size_t)(BK * 2);
    const size_t hstep = (size_t)HALF * K * 2;
    const size_t tstep = 2 * hstep;
    const size_t kstepA = ATR ? (size_t)BK * g.M * 2 : ABLK ? (size_t)BM * BK * 2 : kstep, hstepA = ATR ? (size_t)HALF * 2 : ABLK ? (size_t)HALF * BK * 2 : hstep, tstepA = ATR ? (size_t)BM * 2 : ABLK ? (size_t)nt * BM * BK * 2 : tstep;
    const unsigned ldsw = (unsigned)wid * 1024u;
    const int aoff = lds_byte(wr * 64 + fr, fq * 8), boff = lds_byte(wc * 32 + fr, fq * 8);
#define PG8_SA(b, h) (((b) * 2 + (h)) * HTB)
#define PG8_SB(b, h) ((4 + (b) * 2 + (h)) * HTB)
#define PG8_STAGE(bufoff, gbase, voff) do { _Pragma("unroll") for (int _i = 0; _i < 2; ++_i) \
        __builtin_amdgcn_global_load_lds((const unsigned*)((const char*)(gbase) + (voff)[_i]), (PG8_LAS unsigned*)(lds + (bufoff) + ldsw + _i * 8192), 16, 0, 0); } while (0)
#define PG8_LDA_ROW(dst, b, h) do { _Pragma("unroll") for (int m = 0; m < 4; ++m) _Pragma("unroll") for (int k = 0; k < 2; ++k) dst[m][k] = *(const PG8_LAS bf16x8*)(lds + PG8_SA(b, h) + aoff + m * 2048 + k * 1024); } while (0)
    int atr[4][2];
    if constexpr (ATR) { const int fq_ = lane >> 4, q_ = (lane & 15) >> 2, p_ = lane & 3;
#pragma unroll
        for (int m = 0; m < 4; ++m)
#pragma unroll
            for (int hf = 0; hf < 2; ++hf) { const int kl = 8 * fq_ + 4 * hf + q_, c = 8 * wr + 2 * m + (p_ >> 1), f = ((kl & 3) << 2) | ((kl >> 2) & 3);
                atr[m][hf] = (int)(unsigned)(uintptr_t)lds + kl * 256 + 16 * (c ^ f) + 8 * (p_ & 1); } }
#define PG8_TR1(dst, m, k, b, h) do { const s16x4 l_ = tr_read<PG8_SA(b, h) + (k) * 8192>(atr[m][0]), h_ = tr_read<PG8_SA(b, h) + (k) * 8192>(atr[m][1]); dst[m][k] = __builtin_shufflevector(l_, h_, 0, 1, 2, 3, 4, 5, 6, 7); } while (0)
#define PG8_LDA(dst, b, h) do { if constexpr (ATR) { PG8_TR1(dst, 0, 0, b, h); PG8_TR1(dst, 0, 1, b, h); PG8_TR1(dst, 1, 0, b, h); PG8_TR1(dst, 1, 1, b, h); PG8_TR1(dst, 2, 0, b, h); PG8_TR1(dst, 2, 1, b, h); PG8_TR1(dst, 3, 0, b, h); PG8_TR1(dst, 3, 1, b, h); } \
    else PG8_LDA_ROW(dst, b, h); } while (0)
#define PG8_LDB(dst, b, h) do { _Pragma("unroll") for (int n = 0; n < 2; ++n) _Pragma("unroll") for (int k = 0; k < 2; ++k) dst[n][k] = *(const PG8_LAS bf16x8*)(lds + PG8_SB(b, h) + boff + n * 2048 + k * 1024); } while (0)
#define PG8_MMA(ai, bj, At, Bt) do { __builtin_amdgcn_s_setprio(1); _Pragma("unroll") for (int m = 0; m < 4; ++m) _Pragma("unroll") for (int n = 0; n < 2; ++n) _Pragma("unroll") for (int k = 0; k < 2; ++k) \
        acc[ai][bj][m][n] = __builtin_amdgcn_mfma_f32_16x16x32_bf16(Bt[n][k], At[m][k], acc[ai][bj][m][n], 0, 0, 0); __builtin_amdgcn_s_setprio(0); } while (0)
#define PG8_WAIT_V(n) asm volatile("s_waitcnt vmcnt(" #n ")" ::: "memory")
#define PG8_WAIT_L(n) asm volatile("s_waitcnt lgkmcnt(" #n ")" ::: "memory")
#define PG8_BAR __builtin_amdgcn_s_barrier()
#define PG8_SCHED __builtin_amdgcn_sched_barrier(0)
    Unit cur, nxt; int ui = 0;
    if (!S.next(0, cur)) return;
    f32x4 acc[2][2][4][2];
#pragma unroll
    for (int a = 0; a < 2; ++a)
#pragma unroll
        for (int b = 0; b < 2; ++b)
#pragma unroll
            for (int m = 0; m < 4; ++m)
#pragma unroll
                for (int n = 0; n < 2; ++n) acc[a][b][m][n] = (f32x4){0.f, 0.f, 0.f, 0.f};
    bf16x8 At[4][2], B0[2][2], B1[2][2];
    const char* cA = (const char*)g.A + (size_t)cur.pm * tstepA; const char* cB = (const char*)g.Bt + (size_t)cur.pn * tstep;
    if constexpr (SPLITK) { cA += (size_t)cur.k0 * kstepA; cB += (size_t)cur.k0 * kstep; }
    S.a_ready(cur);
    if constexpr (SP2) {
        PG8_STAGE(PG8_SB(0, 0), cB, voffB); PG8_STAGE(PG8_SB(0, 1), cB + hstep, voffB); PG8_STAGE(PG8_SA(0, 0), cA, voffA); PG8_STAGE(PG8_SA(0, 1), cA + hstepA, voffA);
        if (wr == 1) PG8_BAR;
        PG8_WAIT_V(2); PG8_BAR;
        PG8_STAGE(PG8_SB(1, 0), cB + kstep, voffB); PG8_STAGE(PG8_SA(1, 0), cA + kstepA, voffA); PG8_STAGE(PG8_SB(1, 1), cB + hstep + kstep, voffB);
        PG8_WAIT_V(6); PG8_BAR;
    } else {
        PG8_STAGE(PG8_SB(0, 0), cB, voffB); PG8_STAGE(PG8_SA(0, 0), cA, voffA); PG8_STAGE(PG8_SB(0, 1), cB + hstep, voffB); PG8_STAGE(PG8_SA(0, 1), cA + hstepA, voffA);
        if (wr == 1) PG8_BAR;
        PG8_WAIT_V(4); PG8_BAR;
        PG8_STAGE(PG8_SB(1, 0), cB + kstep, voffB); PG8_STAGE(PG8_SA(1, 0), cA + kstepA, voffA); PG8_STAGE(PG8_SB(1, 1), cB + hstep + kstep, voffB);
        PG8_WAIT_V(6); PG8_BAR;
    }
    for (;;) {
        const bool has_next = S.next(ui + 1, nxt);
        const char* nA = has_next ? (const char*)g.A + (size_t)nxt.pm * tstepA : cA; const char* nB = has_next ? (const char*)g.Bt + (size_t)nxt.pn * tstep : cB;
        if constexpr (SPLITK) { if (has_next) { nA += (size_t)nxt.k0 * kstepA; nB += (size_t)nxt.k0 * kstep; } }
        const int unt = SPLITK ? cur.nk : nt;
        for (int t = 0; t < unt; t += 2) {
            const bool last = (t == unt - 2);
            const char* a1 = cA + (size_t)(t + 1) * kstepA;
            const char* a2 = last ? nA : cA + (size_t)(t + 2) * kstepA; const char* b2 = last ? nB : cB + (size_t)(t + 2) * kstep;
            const char* a3 = a2 + kstepA; const char* b3 = b2 + kstep;
            if (last && has_next) S.a_ready(nxt);
            if constexpr (SP2) {
            PG8_LDB(B0, 0, 0); PG8_LDB(B1, 0, 1); PG8_SCHED; PG8_LDA(At, 0, 0); PG8_STAGE(PG8_SA(1, 1), a1 + hstepA, voffA);
            PG8_WAIT_V(8); PG8_WAIT_L(0); PG8_BAR; PG8_MMA(0, 0, At, B0); PG8_MMA(0, 1, At, B1); PG8_BAR; PG8_SCHED;
            PG8_LDA(At, 0, 1); PG8_STAGE(PG8_SB(0, 0), b2, voffB); PG8_STAGE(PG8_SB(0, 1), b2 + hstep, voffB); PG8_STAGE(PG8_SA(0, 0), a2, voffA);
            PG8_WAIT_V(8); PG8_WAIT_L(0); PG8_BAR; PG8_MMA(1, 0, At, B0); PG8_MMA(1, 1, At, B1); PG8_BAR; PG8_SCHED;
            PG8_LDB(B0, 1, 0); PG8_LDB(B1, 1, 1); PG8_SCHED; PG8_LDA(At, 1, 0); PG8_STAGE(PG8_SA(0, 1), a2 + hstepA, voffA);
            PG8_WAIT_V(8); PG8_WAIT_L(0); PG8_BAR; PG8_MMA(0, 0, At, B0); PG8_MMA(0, 1, At, B1); PG8_BAR; PG8_SCHED;
            PG8_LDA(At, 1, 1); PG8_STAGE(PG8_SB(1, 0), b3, voffB); PG8_STAGE(PG8_SB(1, 1), b3 + hstep, voffB); PG8_STAGE(PG8_SA(1, 0), a3, voffA);
            PG8_WAIT_V(8); PG8_WAIT_L(0); PG8_BAR; PG8_MMA(1, 0, At, B0); PG8_MMA(1, 1, At, B1); PG8_BAR; PG8_SCHED;
            } else {
            PG8_LDB(B0, 0, 0); PG8_SCHED; PG8_LDA(At, 0, 0); PG8_STAGE(PG8_SA(1, 1), a1 + hstepA, voffA);
            PG8_WAIT_L(8); PG8_BAR; PG8_WAIT_L(0); PG8_MMA(0, 0, At, B0); PG8_BAR; PG8_SCHED;
            PG8_LDB(B1, 0, 1); PG8_STAGE(PG8_SB(0, 0), b2, voffB);
            PG8_BAR; PG8_WAIT_L(0); PG8_MMA(0, 1, At, B1); PG8_BAR;
            PG8_LDA(At, 0, 1); PG8_STAGE(PG8_SA(0, 0), a2, voffA);
            PG8_BAR; PG8_WAIT_L(0); PG8_MMA(1, 0, At, B0); PG8_BAR; PG8_SCHED;
            PG8_STAGE(PG8_SB(0, 1), b2 + hstep, voffB);
            PG8_WAIT_V(6); PG8_BAR; PG8_MMA(1, 1, At, B1); PG8_BAR;
            PG8_LDB(B0, 1, 0); PG8_SCHED; PG8_LDA(At, 1, 0); PG8_STAGE(PG8_SA(0, 1), a2 + hstepA, voffA);
            PG8_WAIT_L(8); PG8_BAR; PG8_WAIT_L(0); PG8_MMA(0, 0, At, B0); PG8_BAR; PG8_SCHED;
            PG8_LDB(B1, 1, 1); PG8_STAGE(PG8_SB(1, 0), b3, voffB);
            PG8_BAR; PG8_WAIT_L(0); PG8_MMA(0, 1, At, B1); PG8_BAR;
            PG8_LDA(At, 1, 1); PG8_STAGE(PG8_SA(1, 0), a3, voffA);
            PG8_BAR; PG8_WAIT_L(0); PG8_MMA(1, 0, At, B0); PG8_BAR; PG8_SCHED;
            PG8_STAGE(PG8_SB(1, 1), b3 + hstep, voffB);
            PG8_WAIT_V(6); PG8_BAR; PG8_MMA(1, 1, At, B1); PG8_BAR;
            }
        }
        if constexpr (ALIGN_EPI) { if (wr == 0) PG8_BAR; }
        if constexpr (SPLITK) {
            static_assert(ALIGN_EPI, "split-K tail units need both halves at the same barrier");
            if (cur.part >= 0) {
                const __amdgpu_buffer_rsrc_t prs = __builtin_amdgcn_make_buffer_rsrc((void*)S.pbuf, 0, 0x7fffffff, 0x00020000);
                unsigned po = (unsigned)(cur.slot * (S.SPL - 1)) * (32u * 512u * 16u) + (unsigned)tid * 16u;
                const bool writer = cur.part > 0;
#ifdef PROBE_SKIPX
                if (E.gs == 0.f) { if (writer) break; } else
#endif
                if (writer) {
                    po += (unsigned)(cur.part - 1) * (32u * 512u * 16u);
#pragma unroll
                    for (int a = 0; a < 2; ++a)
#pragma unroll
                        for (int b = 0; b < 2; ++b)
#pragma unroll
                            for (int m = 0; m < 4; ++m)
#pragma unroll
                                for (int n = 0; n < 2; ++n) __builtin_amdgcn_raw_buffer_store_b128(__builtin_bit_cast(u32x4, acc[a][b][m][n]), prs, po + (unsigned)((((a * 2 + b) * 4 + m) * 2 + n) * 8192), 0, 16);
                }
                PG8_WAIT_V(0); PG8_BAR;
                if (tid == 0) {
                    if (writer) __hip_atomic_fetch_add(S.pcnt + cur.slot, 1u, __ATOMIC_RELAXED, __HIP_MEMORY_SCOPE_AGENT);
                    else { unsigned sp = 0; while (__hip_atomic_load(S.pcnt + cur.slot, __ATOMIC_RELAXED, __HIP_MEMORY_SCOPE_AGENT) < (unsigned)(S.SPL - 1)) { __builtin_amdgcn_s_sleep(2); if (++sp > (1u << 22)) break; } }
                }
                PG8_BAR;
                if (writer) break;
#ifdef PROBE_SKIPX
                if (E.gs != 0.f)
#endif
#pragma unroll 1
                for (int p = 0; p < S.SPL - 1; ++p, po += 32u * 512u * 16u) {
#pragma unroll
                    for (int a = 0; a < 2; ++a)
#pragma unroll
                        for (int b = 0; b < 2; ++b) {
#pragma unroll
                            for (int m = 0; m < 4; ++m) {
                                const u32x4 q0 = __builtin_amdgcn_raw_buffer_load_b128(prs, po + (unsigned)((((a * 2 + b) * 4 + m) * 2 + 0) * 8192), 0, 16), q1 = __builtin_amdgcn_raw_buffer_load_b128(prs, po + (unsigned)((((a * 2 + b) * 4 + m) * 2 + 1) * 8192), 0, 16);
                                acc[a][b][m][0] += __builtin_bit_cast(f32x4, q0); acc[a][b][m][1] += __builtin_bit_cast(f32x4, q1); }
                            PG8_SCHED; } }
            }
        }
        if constexpr (!Epi::AFTER_DRAIN) { E(acc, cur, wr, wc, fr, fq); S.done(cur); }
        if (!has_next) break;
#pragma unroll
        for (int a = 0; a < 2; ++a)
#pragma unroll
            for (int b = 0; b < 2; ++b)
#pragma unroll
                for (int m = 0; m < 4; ++m)
#pragma unroll
                    for (int n = 0; n < 2; ++n) acc[a][b][m][n] = (f32x4){0.f, 0.f, 0.f, 0.f};
        cur = nxt; cA = nA; cB = nB; ++ui;
        if constexpr (ALIGN_EPI) { if (wr == 1) PG8_BAR; }
    }
    PG8_WAIT_V(0);
    if constexpr (!ALIGN_EPI) { if (wr == 0) PG8_BAR; }
    PG8_BAR;
    if constexpr (Epi::AFTER_DRAIN) { E.fused(acc, cur, wr, wc, fr, fq, lds, wid, lane); S.done(cur); }
#undef PG8_SA
#undef PG8_SB
#undef PG8_STAGE
#undef PG8_LDA
#undef PG8_LDA_ROW
#undef PG8_TR1
#undef PG8_LDB
#undef PG8_MMA
#undef PG8_WAIT_V
#undef PG8_WAIT_L
#undef PG8_BAR
#undef PG8_SCHED
}
}

namespace att {
using bf16 = unsigned short;
#define AG __attribute__((address_space(1)))
#define AL __attribute__((address_space(3)))
constexpr int D = 128, NW = 8, QBLK = 32, KVBLK = 64;
constexpr float SCALE = 0.088388347648318440f;
constexpr float THR = 8.f;
using bf16x8 = __attribute__((ext_vector_type(8))) short;
using s16x4  = __attribute__((ext_vector_type(4))) short;
using f32x16 = __attribute__((ext_vector_type(16))) float;
using u32x4  = __attribute__((ext_vector_type(4))) unsigned;
constexpr size_t SHM_V = KVBLK * D * 2, SHM_K = KVBLK * D * 2, SHM_ATTN = 2 * SHM_V + 2 * SHM_K + NW * 64 * 4;
#define KSWZ(row, colB) ((row) * 256 + ((colB) ^ (((row) & 7) << 4)))
#define SBAR() __builtin_amdgcn_sched_barrier(0)
__device__ __forceinline__ int crow(int r, int hi) { return (r & 3) + 8 * (r >> 2) + 4 * hi; }
__device__ __forceinline__ unsigned cvtpk(float lo, float hi) { unsigned r; asm("v_cvt_pk_bf16_f32 %0, %1, %2" : "=v"(r) : "v"(lo), "v"(hi)); return r; }
__device__ __forceinline__ bf16x8 ld8(const bf16* p) { return *(const AG bf16x8*)p; }

__device__ __forceinline__ void partialSM(f32x16& p0, f32x16& p1, float& m_reg, float& mn, float& alpha) {
  constexpr float C = SCALE * 1.4426950408889634f;
  float pmax = p0[0]; for (int r = 1; r < 16; ++r) pmax = fmaxf(pmax, p0[r]); for (int r = 0; r < 16; ++r) pmax = fmaxf(pmax, p1[r]);
  { auto rr = __builtin_amdgcn_permlane32_swap(__float_as_uint(pmax), __float_as_uint(pmax), false, false);
    pmax = fmaxf(__uint_as_float(rr[0]), __uint_as_float(rr[1])); }
  if (__builtin_expect(__all(pmax - m_reg <= THR / SCALE), 1)) { mn = m_reg; alpha = 1.f; }
  else { mn = fmaxf(m_reg, pmax); alpha = __builtin_amdgcn_exp2f((m_reg - mn) * C); m_reg = mn; }
  float mnC = -mn * C;
  for (int r = 0; r < 16; ++r) p0[r] = fmaf(p0[r], C, mnC); for (int r = 0; r < 16; ++r) p1[r] = fmaf(p1[r], C, mnC);
  for (int r = 0; r < 16; ++r) p0[r] = __builtin_amdgcn_exp2f(p0[r]);
}
__device__ __forceinline__ void finishSM(f32x16& p0, f32x16& p1, float alpha, float& l_reg, bf16x8& pa0, bf16x8& pa1, bf16x8& pa2, bf16x8& pa3) {
  for (int r = 0; r < 16; ++r) p1[r] = __builtin_amdgcn_exp2f(p1[r]);
  float ps = 0; for (int r = 0; r < 16; ++r) ps += p0[r]; for (int r = 0; r < 16; ++r) ps += p1[r];
  { auto rr = __builtin_amdgcn_permlane32_swap(__float_as_uint(ps), __float_as_uint(ps), false, false);
    ps = __uint_as_float(rr[0]) + __uint_as_float(rr[1]); }
  l_reg = l_reg * alpha + ps;
#define PK4(P, BASE, OUT) do { unsigned a0 = cvtpk(P[BASE + 0], P[BASE + 1]), a1 = cvtpk(P[BASE + 2], P[BASE + 3]);   \
    unsigned b0 = cvtpk(P[BASE + 4], P[BASE + 5]), b1 = cvtpk(P[BASE + 6], P[BASE + 7]);                              \
    auto r0 = __builtin_amdgcn_permlane32_swap(a0, b0, false, false); auto r1 = __builtin_amdgcn_permlane32_swap(a1, b1, false, false); \
    u32x4 w = {r0[0], r1[0], r0[1], r1[1]}; OUT = *reinterpret_cast<bf16x8*>(&w); } while (0)
  PK4(p0, 0, pa0); PK4(p0, 8, pa1); PK4(p1, 0, pa2); PK4(p1, 8, pa3);
#undef PK4
}
__device__ __forceinline__ void qkt(f32x16& p0, f32x16& p1, const AL char* Ks, const bf16x8* qr, int r32, int hi) {
  p0 = f32x16{}; p1 = f32x16{};
  for (int d0 = 0; d0 < 8; ++d0) { int cb = (d0 * 16 + hi * 8) * 2;
    bf16x8 b0 = *(const AL bf16x8*)(Ks + KSWZ(r32, cb));
    bf16x8 b1 = *(const AL bf16x8*)(Ks + KSWZ(32 + r32, cb));
    p0 = __builtin_amdgcn_mfma_f32_32x32x16_bf16(b0, qr[d0], p0, 0, 0, 0);
    p1 = __builtin_amdgcn_mfma_f32_32x32x16_bf16(b1, qr[d0], p1, 0, 0, 0); }
}
__device__ __forceinline__ void wmask(f32x16& p0, f32x16& p1, int dq, int hi) {
#pragma unroll
  for (int r = 0; r < 16; ++r) { const int df = dq - crow(r, hi);
    if (df > 128 || df < -128) p0[r] = -1e30f;
    if (df - 32 > 128 || df - 32 < -128) p1[r] = -1e30f; }
}
__device__ __forceinline__ int v_st(int k, int c) { const int kk = (k & ~0xC) | ((k & 4) << 1) | ((k & 8) >> 1); return ((kk >> 3) * 4 + (c >> 5)) * 512 + ((kk & 7) * 32 + (c & 31)) * 2; }
__device__ __forceinline__ int v_rd_base(int lane) { return ((lane & 3) << 3) | (((lane >> 2) & 3) << 6) | (((lane >> 4) & 1) << 5) | (((lane >> 5) & 1) << 8); }
constexpr int v_rd_off(int d0, int ks, int half) { return d0 * 512 + ks * 4096 + half * 2048; }
template <int OFF> __device__ __forceinline__ s16x4 tr_read(int vb) {
  s16x4 r; asm volatile("ds_read_b64_tr_b16 %0, %1 offset:%2" : "=&v"(r) : "v"(vb), "i"(OFF) : "memory"); return r;
}
template <int D0> __device__ __forceinline__ void pv_one(f32x16& od, int vb, bf16x8 pa0, bf16x8 pa1, bf16x8 pa2, bf16x8 pa3) {
  const s16x4 l0 = tr_read<v_rd_off(D0, 0, 0)>(vb), h0 = tr_read<v_rd_off(D0, 0, 1)>(vb), l1 = tr_read<v_rd_off(D0, 1, 0)>(vb), h1 = tr_read<v_rd_off(D0, 1, 1)>(vb);
  const s16x4 l2 = tr_read<v_rd_off(D0, 2, 0)>(vb), h2 = tr_read<v_rd_off(D0, 2, 1)>(vb), l3 = tr_read<v_rd_off(D0, 3, 0)>(vb), h3 = tr_read<v_rd_off(D0, 3, 1)>(vb);
  asm volatile("s_waitcnt lgkmcnt(0)" ::: "memory"); SBAR();
#define PK(L, H) (bf16x8){L[0], L[1], L[2], L[3], H[0], H[1], H[2], H[3]}
  od = __builtin_amdgcn_mfma_f32_32x32x16_bf16(pa0, PK(l0, h0), od, 0, 0, 0);
  od = __builtin_amdgcn_mfma_f32_32x32x16_bf16(pa1, PK(l1, h1), od, 0, 0, 0);
  od = __builtin_amdgcn_mfma_f32_32x32x16_bf16(pa2, PK(l2, h2), od, 0, 0, 0);
  od = __builtin_amdgcn_mfma_f32_32x32x16_bf16(pa3, PK(l3, h3), od, 0, 0, 0);
#undef PK
}
__device__ __forceinline__ void pv_d0(f32x16* o, int vb, bf16x8 pa0, bf16x8 pa1, bf16x8 pa2, bf16x8 pa3) {
  pv_one<0>(o[0], vb, pa0, pa1, pa2, pa3); pv_one<1>(o[1], vb, pa0, pa1, pa2, pa3); pv_one<2>(o[2], vb, pa0, pa1, pa2, pa3); pv_one<3>(o[3], vb, pa0, pa1, pa2, pa3);
}

struct Unit {
  const bf16* Q; int ldq;
  const bf16* KA; const bf16* VA; int ldA; int nA;
  const bf16* KB; const bf16* VB; int ldB;
  int NT;
  int win;
  int dq0;
  int has_sink; float sink;
  int qmode; int qt0; const float* qg; const float* rope;
  bf16* O; int ldo;
};

__device__ __forceinline__ void attn_unit(const Unit& U, AL char* lds) {
  int tid_ = threadIdx.x; asm volatile("" : "+v"(tid_));
  const int tid = tid_, wid = __builtin_amdgcn_readfirstlane(tid >> 6), lane = tid & 63, r32 = lane & 31, hi = lane >> 5;
  AL char* V_lds = lds; AL char* K_lds = lds + 2 * SHM_V;
  AL float* ws = (AL float*)(lds + 2 * SHM_V + 2 * SHM_K) + wid * 64; AL float* li_l = ws; AL float* al_l = ws + 32;
  float m_reg = -1e30f, l_reg = 0; f32x16 o[4] = {}; bf16x8 qr[8];
  const bf16* Qw = U.Q + (long)(wid * QBLK + r32) * U.ldq + hi * 8;
#pragma unroll
  for (int d0 = 0; d0 < 8; ++d0) qr[d0] = ld8(Qw + d0 * 16);
  if (U.qmode) {
#define BF2F(sv) __builtin_bit_cast(float, (unsigned)(unsigned short)(sv) << 16)
    float rstd = 1.f;
    if (U.qmode & 1) { float ss = 0.f;
#pragma unroll
      for (int d0 = 0; d0 < 8; ++d0)
#pragma unroll
        for (int e = 0; e < 8; ++e) { const float v = BF2F(qr[d0][e]); ss += v * v; }
      ss += __shfl_xor(ss, 32); rstd = 1.0f / sqrtf(ss * (1.0f / 128.0f) + 1e-6f); }
    const int tq = (U.qt0 + wid * QBLK + r32) & 2047;
#pragma unroll
    for (int p = 0; p < 4; ++p) { const int d0 = (p & 1) + 4 * (p >> 1), d1 = d0 + 2, ax = p >> 1;
      float x1[8], x2[8];
#pragma unroll
      for (int e = 0; e < 8; ++e) { x1[e] = BF2F(qr[d0][e]); x2[e] = BF2F(qr[d1][e]); }
      if (U.qmode & 1) { const float* g1 = U.qg + d0 * 16 + hi * 8; const float* g2 = U.qg + d1 * 16 + hi * 8;
#pragma unroll
        for (int e = 0; e < 8; ++e) { x1[e] *= rstd * *(const AG float*)(g1 + e); x2[e] *= rstd * *(const AG float*)(g2 + e); } }
      if (U.qmode & 2) { const float* cp = U.rope + tq * 64 + ax * 32 + (d0 & 1) * 16 + hi * 8; const float* sp = cp + 2048 * 64;
#pragma unroll
        for (int e = 0; e < 8; ++e) { const float c = *(const AG float*)(cp + e), s = *(const AG float*)(sp + e); const float y1 = x1[e] * c - x2[e] * s, y2 = x2[e] * c + x1[e] * s; x1[e] = y1; x2[e] = y2; } }
      u32x4 w1 = {cvtpk(x1[0], x1[1]), cvtpk(x1[2], x1[3]), cvtpk(x1[4], x1[5]), cvtpk(x1[6], x1[7])}, w2 = {cvtpk(x2[0], x2[1]), cvtpk(x2[2], x2[3]), cvtpk(x2[4], x2[5]), cvtpk(x2[6], x2[7])};
      qr[d0] = *reinterpret_cast<bf16x8*>(&w1); qr[d1] = *reinterpret_cast<bf16x8*>(&w2); }
#undef BF2F
  }
  const int sr = tid >> 4, sc = (tid & 15) * 8, vst0 = v_st(sr, sc), vst1 = v_st(32 + sr, sc);
  const int vb0 = (int)(unsigned)(uintptr_t)V_lds + v_rd_base(lane);
  const int nA = U.nA, NT = U.NT;
  const int dqw = U.dq0 + wid * QBLK + r32;
  struct { bf16x8 vs0, vs1, ks0, ks1; } sr_[1];
#define SLOAD(i, jt) do { const int jj_ = (jt); const bf16 *kp_, *vp_; long ld_; \
    if (jj_ < nA) { ld_ = U.ldA; kp_ = U.KA + (long)jj_ * 64 * ld_; vp_ = U.VA + (long)jj_ * 64 * ld_; } \
    else { ld_ = U.ldB; kp_ = U.KB + (long)(jj_ - nA) * 64 * ld_; vp_ = U.VB + (long)(jj_ - nA) * 64 * ld_; } \
    sr_[i].vs0 = ld8(vp_ + (long)sr * ld_ + sc); sr_[i].vs1 = ld8(vp_ + (long)(32 + sr) * ld_ + sc); \
    sr_[i].ks0 = ld8(kp_ + (long)sr * ld_ + sc); sr_[i].ks1 = ld8(kp_ + (long)(32 + sr) * ld_ + sc); } while (0)
#define SWRITE(b, i) do { *(AL bf16x8*)(V_lds + (b) * SHM_V + vst0) = sr_[i].vs0;          \
    *(AL bf16x8*)(V_lds + (b) * SHM_V + vst1) = sr_[i].vs1; int kc = sc * 2;               \
    *(AL bf16x8*)(K_lds + (b) * SHM_K + KSWZ(sr, kc)) = sr_[i].ks0;                       \
    *(AL bf16x8*)(K_lds + (b) * SHM_K + KSWZ(32 + sr, kc)) = sr_[i].ks1; } while (0)
#define RESC(a) do { if (__any((a) < 1.f)) { if (hi == 0) al_l[r32] = (a); asm volatile("s_waitcnt lgkmcnt(0)" ::: "memory"); \
    for (int d = 0; d < 4; ++d) for (int r = 0; r < 16; ++r) o[d][r] *= al_l[crow(r, hi)]; } } while (0)
#define MASK(P0, P1, jt) do { if (U.win && (jt) >= nA) { const int dq_ = dqw - ((jt) - nA) * 64; \
    if (__any(dq_ > 128 || dq_ - 63 < -128)) wmask(P0, P1, dq_, hi); } } while (0)
  f32x16 pA0, pA1, pB0, pB1; float mnA, mnB, alA, alB; bf16x8 pa0, pa1, pa2, pa3;
#define LBAR() asm volatile("s_waitcnt lgkmcnt(0)\n\ts_barrier" ::: "memory")
#define SWAIT() asm volatile("s_waitcnt vmcnt(0)" ::: "memory")
  constexpr int SE = 0, SO = 0;
  SLOAD(SE, 0); asm volatile("s_waitcnt vmcnt(0)" ::: "memory"); SWRITE(0, SE); LBAR();
  qkt(pA0, pA1, K_lds, qr, r32, hi); MASK(pA0, pA1, 0); partialSM(pA0, pA1, m_reg, mnA, alA);
  SLOAD(SO, 1);
  SWAIT(); SWRITE(1, SO); LBAR();
#pragma unroll 1
  for (int j = 1; j + 1 < NT; j += 2) {
    SBAR(); qkt(pB0, pB1, K_lds + SHM_K, qr, r32, hi); MASK(pB0, pB1, j);
    finishSM(pA0, pA1, alA, l_reg, pa0, pa1, pa2, pa3); SBAR();
    SLOAD(SO, j + 1); SBAR();
    pv_d0(o, vb0, pa0, pa1, pa2, pa3); partialSM(pB0, pB1, m_reg, mnB, alB);
    LBAR(); SWAIT(); SWRITE(0, SE);
    RESC(alB); LBAR();
    SBAR(); qkt(pA0, pA1, K_lds, qr, r32, hi); MASK(pA0, pA1, j + 1);
    finishSM(pB0, pB1, alB, l_reg, pa0, pa1, pa2, pa3); SBAR();
    SLOAD(SE, j + 2); SBAR();
    pv_d0(o, vb0 + (int)SHM_V, pa0, pa1, pa2, pa3); partialSM(pA0, pA1, m_reg, mnA, alA);
    LBAR(); SWAIT(); SWRITE(1, SO);
    RESC(alA); LBAR();
  }
  SBAR(); qkt(pB0, pB1, K_lds + SHM_K, qr, r32, hi); MASK(pB0, pB1, NT - 1);
  finishSM(pA0, pA1, alA, l_reg, pa0, pa1, pa2, pa3); SBAR();
  pv_d0(o, vb0, pa0, pa1, pa2, pa3); partialSM(pB0, pB1, m_reg, mnB, alB);
  LBAR(); RESC(alB);
  finishSM(pB0, pB1, alB, l_reg, pa0, pa1, pa2, pa3); SBAR();
  pv_d0(o, vb0 + (int)SHM_V, pa0, pa1, pa2, pa3);
  LBAR();
#undef SWAIT
  if (U.has_sink) { constexpr float C = SCALE * 1.4426950408889634f; l_reg += __builtin_amdgcn_exp2f(fminf(U.sink * 1.4426950408889634f - m_reg * C, 120.f)); }
  if (hi == 0) li_l[r32] = l_reg; asm volatile("s_waitcnt lgkmcnt(0)" ::: "memory");
  float rli[16];
#pragma unroll
  for (int r = 0; r < 16; ++r) rli[r] = __builtin_amdgcn_rcpf(li_l[crow(r, hi)]);
  AL char* ost = lds + wid * 8192;
#pragma unroll
  for (int r = 0; r < 16; ++r) { const int orow = crow(r, hi);
#pragma unroll
    for (int d0 = 0; d0 < 4; ++d0) { const float v = o[d0][r] * rli[r]; const unsigned pk = cvtpk(v, v);
      *(AL unsigned short*)(ost + orow * 256 + (d0 * 32 + r32) * 2) = (unsigned short)(pk & 0xffffu); } }
  asm volatile("s_waitcnt lgkmcnt(0)" ::: "memory");
  bf16* Ow = U.O + (long)(wid * QBLK) * U.ldo;
#pragma unroll
  for (int k = 0; k < 8; ++k) { const int c = lane + 64 * k, row = c >> 4, cc = c & 15;
    const u32x4 v = *(const AL u32x4*)(ost + row * 256 + cc * 16);
    *(AG u32x4*)(Ow + (long)row * U.ldo + cc * 8) = v; }
  LBAR();
#undef SLOAD
#undef SWRITE
#undef RESC
#undef MASK
#undef LBAR
}
}

constexpr int DM = 2048, NCTX = 8192, NLAT = 16384, NTOK = 24576, QKVD = 3072, DFF = 5632, NGU = 11264, DEPTH = 4;
constexpr int NWAVES = 8;
constexpr size_t MiB = 1u << 20;
constexpr size_t OUT_YP = 0, OUT_YS = (size_t)NCTX * DM, OUT_WK = (size_t)NTOK * DM, OUT_WV = OUT_WK + (size_t)32 * 2 * 256 * 512,
                 OUT_AK = OUT_WV + (size_t)32 * 2 * 256 * 512, OUT_AV = OUT_AK + (size_t)32 * 256 * 512, OUT_END = OUT_AV + (size_t)32 * 256 * 512;
constexpr size_t WS_CTL = 0, CTL_ZERO_BYTES = 1 * MiB;
constexpr size_t WS_MODP = 1 * MiB;
constexpr size_t WS_MODF = 16 * MiB;
constexpr size_t WS_A2 = 18 * MiB;
constexpr size_t WS_ROPE = 19 * MiB;
constexpr size_t WS_CKV = 20 * MiB;
constexpr size_t WS_CWK = WS_CKV, WS_CWV = WS_CKV + 8 * MiB, WS_CAK = WS_CKV + 16 * MiB, WS_CAV = WS_CKV + 20 * MiB;
constexpr size_t WS_FT = 44 * MiB;
constexpr size_t WS_FT_CTX = WS_FT + 32 * MiB;
constexpr size_t WS_W = 80 * MiB;
constexpr size_t W_QKV = (size_t)QKVD * DM * 2, W_SQ = (size_t)DM * DM * 2, W_IN = (size_t)6144 * DM * 2, W_GU = (size_t)NGU * DM * 2, W_DN = (size_t)DM * DFF * 2;
constexpr size_t WS_WQKV0 = WS_W, WS_WQKV1 = WS_WQKV0 + W_QKV, WS_WQKVA = WS_WQKV1 + W_QKV, WS_WO0 = WS_WQKVA + W_QKV, WS_WO1 = WS_WO0 + W_SQ, WS_WOA = WS_WO1 + W_SQ,
                 WS_WHO = WS_WOA + W_SQ, WS_WHI = WS_WHO + W_SQ, WS_WGU = WS_WHI + W_IN, WS_WDN = WS_WGU + 4 * W_GU, WS_WEND = WS_WDN + 4 * W_DN;
constexpr size_t WS_H = 448 * MiB;
constexpr size_t WS_BIG = 544 * MiB;
constexpr size_t WS_ZT = WS_BIG + 288 * MiB;
constexpr size_t WS_XB = WS_BIG + 384 * MiB;
constexpr size_t WS_NP = WS_XB + 96 * MiB;
constexpr size_t WS_INV = WS_NP + (size_t)48 * 8192 * 4;
constexpr size_t WS_END = WS_NP + 2 * MiB;
static_assert(WS_WEND <= WS_H && WS_FT_CTX + 4 * MiB <= WS_W && WS_CAV + 4 * MiB <= WS_FT, "ws map");
static_assert(WS_MODP + (size_t)4 * 8 * 9 * 12288 * 4 <= WS_MODF && WS_MODF + (size_t)4 * 9 * 6 * 2048 * 4 <= WS_A2 && WS_A2 + (size_t)2304 * 64 * 4 <= WS_CKV && WS_INV + (size_t)4 * 2048 * 4 <= WS_END, "small buffers");
constexpr int CW_TMO = 0;
constexpr int CW_BAR = 4096;
constexpr int CW_SPLIT = 16384;
constexpr int RING_BYTES = 131072;
constexpr int LDSCTL_OFF = RING_BYTES, MISC_OFF = LDSCTL_OFF + 320;
constexpr int LDS_BYTES = 147456;

#define GAS __attribute__((address_space(1)))
#define LAS __attribute__((address_space(3)))
typedef unsigned short bf16;
typedef unsigned v4u __attribute__((ext_vector_type(4)));
typedef unsigned v2u __attribute__((ext_vector_type(2)));
typedef float f32x4 __attribute__((ext_vector_type(4)));
typedef short bf16x8 __attribute__((ext_vector_type(8)));
typedef short bf16x4 __attribute__((ext_vector_type(4)));
typedef GAS unsigned gu32;
#define RLX_AGENT __ATOMIC_RELAXED, __HIP_MEMORY_SCOPE_AGENT
#define LDS_WAIT() asm volatile("s_waitcnt lgkmcnt(0)" ::: "memory")
#define VM_WAIT() asm volatile("s_waitcnt vmcnt(0)" ::: "memory")
__device__ __forceinline__ unsigned f2bf(float f) { unsigned u = __builtin_bit_cast(unsigned, f); return (u + 0x7fffu + ((u >> 16) & 1u)) >> 16; }
__device__ __forceinline__ unsigned pk2(float lo, float hi) { unsigned r; asm("v_cvt_pk_bf16_f32 %0, %1, %2" : "=v"(r) : "v"(lo), "v"(hi)); return r; }
__device__ __forceinline__ float bf2f(unsigned short b) { return __builtin_bit_cast(float, (unsigned)b << 16); }
__device__ __forceinline__ float bflo(unsigned w) { return __builtin_bit_cast(float, w << 16); }
__device__ __forceinline__ float bfhi(unsigned w) { return __builtin_bit_cast(float, w & 0xffff0000u); }
__device__ __forceinline__ float wave_sum(float v) {
#pragma unroll
    for (int o = 1; o < 64; o <<= 1) v += __shfl_xor(v, o);
    return v;
}
#define XB_TMO      128
#define XB_XCNT(j)  (256  + 64 * (j))
#define XB_XSUB(j)  (1280 + 64 * (j))
#define XB_XGEN(j)  (2304 + 64 * (j))
#define XB_TOP      3328
#define XB_TOPGEN   3392
#define XCD_BAR_WORDS 3456
#define XB_SPIN_CAP (1u << 18)

__device__ __forceinline__ unsigned xb_ld(unsigned* p)              { return __hip_atomic_load(p, __ATOMIC_RELAXED, __HIP_MEMORY_SCOPE_AGENT); }
__device__ __forceinline__ unsigned xb_add(unsigned* p, unsigned v) { return __hip_atomic_fetch_add(p, v, __ATOMIC_RELAXED, __HIP_MEMORY_SCOPE_AGENT); }
__device__ __forceinline__ unsigned xb_xcc_id() { return (unsigned)__builtin_amdgcn_s_getreg((3 << 11) | 20) & 0xFu; }
#define XB_SPIN(cond, bar) do { unsigned _sp = 0; while (cond) { __builtin_amdgcn_s_sleep(1); \
    if ((++_sp & 255u) == 0u) { if (xb_ld(&(bar)[XB_TMO])) break; if (_sp > XB_SPIN_CAP) { atomicAdd(&(bar)[XB_TMO], 1u); break; } } } } while (0)

struct XcdBarrier {
    unsigned* bar; unsigned x;
    volatile LAS unsigned* st;
};

__device__ __forceinline__ XcdBarrier xcd_barrier_post(unsigned* bar, volatile LAS unsigned* st) {
    XcdBarrier b; b.bar = bar; b.x = xb_xcc_id(); b.st = st;
    if (threadIdx.x == 0) (void)xb_add(&bar[XB_XCNT(b.x)], 1u);
    return b;
}
__device__ __forceinline__ void xcd_barrier_complete(unsigned* bar, unsigned x, unsigned& nloc, unsigned& nx) {
    const unsigned G = gridDim.x * gridDim.y * gridDim.z;
    unsigned sum, cnt, mine, sp = 0u;
    for (;;) {
        sum = 0u; cnt = 0u; mine = 0u;
#pragma unroll
        for (unsigned j = 0; j < 16; ++j) { const unsigned c = xb_ld(&bar[XB_XCNT(j)]); sum += c; cnt += (c > 0u) ? 1u : 0u; mine = (j == x) ? c : mine; }
        if (sum == G) break;
        __builtin_amdgcn_s_sleep(1);
        if ((++sp & 255u) == 0u) { if (xb_ld(&bar[XB_TMO])) break; if (sp > XB_SPIN_CAP) { atomicAdd(&bar[XB_TMO], 1u); break; } }
    }
    nloc = mine > 0u ? mine : 1u; nx = cnt > 0u ? cnt : 1u;
}

__device__ __forceinline__ void xcd_barrier(const XcdBarrier& b) {
    asm volatile("s_waitcnt vmcnt(0)" ::: "memory");
    __syncthreads();
    if (threadIdx.x == 0) {
        unsigned* bar = b.bar;
        __builtin_amdgcn_s_waitcnt(0);
        unsigned nloc = b.st[0], nx = b.st[1];
        if (nloc == 0u) { xcd_barrier_complete(bar, b.x, nloc, nx); b.st[0] = nloc; b.st[1] = nx; }
        const unsigned old = xb_add(&bar[XB_XSUB(b.x)], 1u);
        const unsigned gen = old / nloc;
        if (old + 1u == (gen + 1u) * nloc) {
            __builtin_amdgcn_fence(__ATOMIC_RELEASE, "agent");
            asm volatile("s_waitcnt vmcnt(0)" ::: "memory");
            const unsigned og = xb_add(&bar[XB_TOP], 1u);
            const unsigned tg = og / nx;
            if (og + 1u == (tg + 1u) * nx) xb_add(&bar[XB_TOPGEN], 1u);
            else XB_SPIN(xb_ld(&bar[XB_TOPGEN]) == tg, bar);
            __builtin_amdgcn_fence(__ATOMIC_ACQUIRE, "agent");
            xb_add(&bar[XB_XGEN(b.x)], 1u);
            asm volatile("s_waitcnt vmcnt(0)" ::: "memory");
        } else {
            XB_SPIN(xb_ld(&bar[XB_XGEN(b.x)]) == gen, bar);
            __builtin_amdgcn_fence(__ATOMIC_ACQUIRE, "agent");
            asm volatile("s_waitcnt vmcnt(0)" ::: "memory");
        }
    }
    __syncthreads();
}

struct TItem { const float* src; bf16* dst; int K, N, k0, n0, drow0; };
__device__ __forceinline__ void titem_load(const TItem& t, f32x4 (&v)[8], int lane) {
#pragma unroll
    for (int i = 0; i < 8; ++i) v[i] = *(const GAS f32x4*)(t.src + (size_t)(t.k0 + 8 * i + (lane >> 3)) * t.N + t.n0 + 4 * (lane & 7));
}
__device__ __forceinline__ void titem_finish(const TItem& t, const f32x4 (&v)[8], LAS float* scr, int lane) {
#pragma unroll
    for (int i = 0; i < 8; ++i) { LAS float* d = scr + (8 * i + (lane >> 3)) * 33 + 4 * (lane & 7); d[0] = v[i].x; d[1] = v[i].y; d[2] = v[i].z; d[3] = v[i].w; }
    LDS_WAIT(); asm volatile("" ::: "memory");
    const int c = lane & 7;
#pragma unroll
    for (int j = 0; j < 4; ++j) { const int n = (lane >> 3) + 8 * j; const LAS float* s = scr + (8 * c) * 33 + n;
        v4u o; o.x = pk2(s[0 * 33], s[1 * 33]); o.y = pk2(s[2 * 33], s[3 * 33]); o.z = pk2(s[4 * 33], s[5 * 33]); o.w = pk2(s[6 * 33], s[7 * 33]);
        *(GAS v4u*)(t.dst + (size_t)(t.drow0 + n) * t.K + t.k0 + 8 * c) = o; }
    LDS_WAIT(); asm volatile("" ::: "memory");
}
constexpr int IT_QKV = (DM / 64) * (QKVD / 32), IT_SQ = (DM / 64) * (DM / 32), IT_IN = (DM / 64) * (6144 / 32), IT_GU = (DM / 64) * (NGU / 32), IT_DN = (DFF / 64) * (DM / 32);
constexpr int IT_TOTAL = 3 * IT_QKV + 4 * IT_SQ + IT_IN + 4 * IT_GU + 4 * IT_DN;

struct Args { const float* in[33]; float* out; unsigned char* ws; int ph_lo, ph_hi; };
#define GIN(k) ((const float*)(const GAS float*)A.in[k])

__device__ __forceinline__ TItem titem_decode(const Args& A, int it) {
    unsigned char* ws = A.ws;
    const float* src; bf16* dst; int K = DM, N; bool gu = false; int r = it;
    if (r < 3 * IT_QKV) { const int m = r / IT_QKV; r -= m * IT_QKV; N = QKVD;
        src = (m < 2) ? GIN(12) + (size_t)m * DM * QKVD : GIN(26); dst = (bf16*)(ws + WS_WQKV0 + (size_t)m * W_QKV); }
    else if ((r -= 3 * IT_QKV) < 4 * IT_SQ) { const int m = r / IT_SQ; r -= m * IT_SQ; N = DM;
        src = (m < 2) ? GIN(13) + (size_t)m * DM * DM : (m == 2 ? GIN(29) : GIN(25)); dst = (bf16*)(ws + WS_WO0 + (size_t)m * W_SQ); }
    else if ((r -= 4 * IT_SQ) < IT_IN) { N = 6144; src = GIN(15); dst = (bf16*)(ws + WS_WHI); }
    else if ((r -= IT_IN) < 4 * IT_GU) { const int m = r / IT_GU; r -= m * IT_GU; N = NGU; gu = true;
        src = GIN(30) + (size_t)m * DM * NGU; dst = (bf16*)(ws + WS_WGU + (size_t)m * W_GU); }
    else { r -= 4 * IT_GU; const int m = r / IT_DN; r -= m * IT_DN; N = DM; K = DFF;
        src = GIN(31) + (size_t)m * DFF * DM; dst = (bf16*)(ws + WS_WDN + (size_t)m * W_DN); }
    const int nblk = N / 32, kb = r / nblk, nb = r % nblk, k0 = 64 * kb, n0 = 32 * nb;
    int drow0 = n0;
    if (gu) { const int isu = n0 >= DFF ? 1 : 0; const int j = n0 - isu * DFF; drow0 = (j >> 7) * 256 + isu * 128 + (j & 127); }
    TItem t; t.src = src; t.dst = dst; t.K = K; t.N = N; t.k0 = k0; t.n0 = n0; t.drow0 = drow0; return t;
}

__device__ __forceinline__ void adaln_partial_unit(const Args& A, int u, LAS float* scr, int lane) {
    const int layer = u / 384, kc = (u / 48) % 8, cg = u % 48;
    const float* cctx = GIN(7); const float* cin = GIN(6);
    for (int idx = lane; idx < 9 * 256; idx += 64) { const int c = idx >> 8, kk = idx & 255, k = kc * 256 + kk;
        const float v = (c == 0) ? cctx[k] : cin[(size_t)(c - 1) * DM + k]; scr[idx] = v / (1.0f + expf(-v)); }
    LDS_WAIT(); asm volatile("" ::: "memory");
    f32x4 acc[9];
#pragma unroll
    for (int c = 0; c < 9; ++c) acc[c] = (f32x4){0.f, 0.f, 0.f, 0.f};
    const float* wp = GIN(10) + (size_t)layer * DM * 12288 + (size_t)(kc * 256) * 12288 + cg * 256 + lane * 4;
#pragma unroll 8
    for (int kk = 0; kk < 256; ++kk) { const f32x4 w = *(const GAS f32x4*)(wp + (size_t)kk * 12288);
#pragma unroll
        for (int c = 0; c < 9; ++c) acc[c] += scr[c * 256 + kk] * w; }
    float* mp = (float*)(A.ws + WS_MODP) + (size_t)((layer * 8 + kc) * 9) * 12288 + cg * 256 + lane * 4;
#pragma unroll
    for (int c = 0; c < 9; ++c) *(f32x4*)(mp + (size_t)c * 12288) = acc[c];
    LDS_WAIT(); asm volatile("" ::: "memory");
}

__device__ __forceinline__ void filter_a2_row(const Args& A, int rr, int lane) {
    const int L = rr < 2048 ? 2048 : 256, t = rr < 2048 ? rr : rr - 2048;
    const float tn = (float)t / (float)(L - 1), w = 6.283185307179586f * (float)t / (float)L;
    float feat = 0.f;
    if (lane == 0) feat = tn;
    else if (lane <= 16) feat = cosf(w * (1e-4f + (float)(lane - 1) * ((15.0f - 1e-4f) / 15.0f)));
    else if (lane <= 32) feat = -sinf(w * (1e-4f + (float)(lane - 17) * ((15.0f - 1e-4f) / 15.0f)));
    const float* w1 = GIN(18); const float* b1 = GIN(19); const float* w2 = GIN(20); const float* b2 = GIN(21); const float* fq = GIN(23);
    float s = b1[lane];
    for (int f = 0; f < 33; ++f) s += __shfl(feat, f) * w1[f * 64 + lane];
    const float a1 = sinf(fq[lane] * s);
    float s2 = b2[lane];
    for (int k = 0; k < 64; ++k) s2 += __shfl(a1, k) * w2[k * 64 + lane];
    ((float*)(A.ws + WS_A2))[(size_t)rr * 64 + lane] = sinf(fq[64 + lane] * s2);
}

__device__ __forceinline__ void split_bf16x8(const f32x4 x0, const f32x4 x1, bf16x8& hi, bf16x8& lo) {
    const float v[8] = {x0.x, x0.y, x0.z, x0.w, x1.x, x1.y, x1.z, x1.w};
    unsigned ph[4], pl[4];
#pragma unroll
    for (int j = 0; j < 4; ++j) { ph[j] = pk2(v[2 * j], v[2 * j + 1]);
        pl[j] = pk2(v[2 * j] - __builtin_bit_cast(float, ph[j] << 16), v[2 * j + 1] - __builtin_bit_cast(float, ph[j] & 0xffff0000u)); }
    const v4u qh = {ph[0], ph[1], ph[2], ph[3]}, ql = {pl[0], pl[1], pl[2], pl[3]};
    hi = __builtin_bit_cast(bf16x8, qh); lo = __builtin_bit_cast(bf16x8, ql);
}
__device__ __forceinline__ void filter_hf_unit(const Args& A, int u, int lane) {
    const int variant = u < 8192 ? 0 : 1; const int uu = variant ? u - 8192 : u; const int tch = uu >> 9, cb = uu & 511;
    const int L = variant ? 256 : 2048; const int n = lane & 15, g = lane >> 4;
    const int col = cb * 16 + n, side = col >> 12, order = (col >> 11) & 1, d = col & 2047;
    const float* w3 = GIN(22) + col;
    bf16x8 bh[2], bl[2];
#pragma unroll
    for (int s = 0; s < 2; ++s) { const float* wp = w3 + (size_t)(32 * s + 8 * g) * 8192;
        const f32x4 x0 = {wp[0], wp[8192], wp[2 * 8192], wp[3 * 8192]}, x1 = {wp[4 * 8192], wp[5 * 8192], wp[6 * 8192], wp[7 * 8192]};
        split_bf16x8(x0, x1, bh[s], bl[s]); }
    constexpr float MIND = -3.0701134573253944f, MAXD = -15.350567286626972f;
    const float delta = fabsf(MIND + (MAXD - MIND) * ((float)d / 2047.0f)), rl1 = 1.0f / (float)(L - 1);
    const float* a2 = (const float*)(A.ws + WS_A2) + (size_t)(variant ? 2048 : 0) * 64;
    bf16* ft = (bf16*)(A.ws + (variant ? WS_FT_CTX : WS_FT)) + ((size_t)(order * 2048 + d) * 2 + side) * L;
    float asum = 0.f;
    f32x4 av[8][4];
#pragma unroll
    for (int tile = 0; tile < 8; ++tile) { const float* ar = a2 + (size_t)(tch * 128 + tile * 16 + n) * 64 + 8 * g;
#pragma unroll
        for (int s = 0; s < 2; ++s) { av[tile][2 * s] = *(const GAS f32x4*)(ar + 32 * s); av[tile][2 * s + 1] = *(const GAS f32x4*)(ar + 32 * s + 4); } }
    asm volatile("" ::: "memory");
#pragma unroll
    for (int tile = 0; tile < 8; ++tile) { const int t0 = tch * 128 + tile * 16;
        f32x4 acc = {0.f, 0.f, 0.f, 0.f};
#pragma unroll
        for (int s = 0; s < 2; ++s) { bf16x8 ah, al; split_bf16x8(av[tile][2 * s], av[tile][2 * s + 1], ah, al);
            acc = __builtin_amdgcn_mfma_f32_16x16x32_bf16(ah, bh[s], acc, 0, 0, 0);
            acc = __builtin_amdgcn_mfma_f32_16x16x32_bf16(ah, bl[s], acc, 0, 0, 0);
            acc = __builtin_amdgcn_mfma_f32_16x16x32_bf16(al, bh[s], acc, 0, 0, 0); }
        float hv[4];
#pragma unroll
        for (int r = 0; r < 4; ++r) { const int t = t0 + 4 * g + r; const float v = acc[r] * expf(-((float)t * rl1) * delta); hv[r] = v;
            if (!(side == 1 && t == 0)) asum += fabsf(v); }
        v2u o; o.x = pk2(hv[0], hv[1]); o.y = pk2(hv[2], hv[3]);
        *(GAS v2u*)(ft + t0 + 4 * g) = o; }
    asum += __shfl_xor(asum, 16); asum += __shfl_xor(asum, 32);
    if (g == 0) ((float*)(A.ws + WS_NP))[(size_t)(variant ? 32 + tch : tch) * 8192 + col] = asum;
}

__device__ __forceinline__ void norm_store(const f32x4 (&v)[4][2], float ssq, const f32x4 (&a)[4][2], const f32x4 (&b)[4][2], bf16* orow, int lane) {
    const float rstd = 1.0f / sqrtf(wave_sum(ssq) * (1.0f / DM) + 1e-6f);
#pragma unroll
    for (int j = 0; j < 4; ++j) { const f32x4 y0 = v[j][0] * rstd * a[j][0] + b[j][0], y1 = v[j][1] * rstd * a[j][1] + b[j][1];
        v4u w; w.x = pk2(y0.x, y0.y); w.y = pk2(y0.z, y0.w); w.z = pk2(y1.x, y1.y); w.w = pk2(y1.z, y1.w); *((GAS v4u*)orow + lane + 64 * j) = w; }
}
__device__ __forceinline__ void norm_row_f32(const float* xrow, const f32x4 (&a)[4][2], const f32x4 (&b)[4][2], bf16* orow, bf16* xbrow, int lane) {
    f32x4 v[4][2]; float s = 0.f;
#pragma unroll
    for (int j = 0; j < 4; ++j) { const GAS f32x4* p = (const GAS f32x4*)(xrow + 8 * lane + 512 * j); v[j][0] = p[0]; v[j][1] = p[1];
        s += (v[j][0].x * v[j][0].x + v[j][0].y * v[j][0].y) + (v[j][0].z * v[j][0].z + v[j][0].w * v[j][0].w) + (v[j][1].x * v[j][1].x + v[j][1].y * v[j][1].y) + (v[j][1].z * v[j][1].z + v[j][1].w * v[j][1].w); }
#pragma unroll
    for (int j = 0; j < 4; ++j) { v4u w; w.x = pk2(v[j][0].x, v[j][0].y); w.y = pk2(v[j][0].z, v[j][0].w); w.z = pk2(v[j][1].x, v[j][1].y); w.w = pk2(v[j][1].z, v[j][1].w); *((GAS v4u*)xbrow + lane + 64 * j) = w; }
    norm_store(v, s, a, b, orow, lane);
}
__device__ __forceinline__ void load_row_bf16(const bf16* xbrow, f32x4 (&v)[4][2], float& s, int lane) {
    s = 0.f;
#pragma unroll
    for (int j = 0; j < 4; ++j) { const v4u w = *((const GAS v4u*)xbrow + lane + 64 * j);
        v[j][0] = (f32x4){bflo(w.x), bfhi(w.x), bflo(w.y), bfhi(w.y)}; v[j][1] = (f32x4){bflo(w.z), bfhi(w.z), bflo(w.w), bfhi(w.w)};
        s += (v[j][0].x * v[j][0].x + v[j][0].y * v[j][0].y) + (v[j][0].z * v[j][0].z + v[j][0].w * v[j][0].w) + (v[j][1].x * v[j][1].x + v[j][1].y * v[j][1].y) + (v[j][1].z * v[j][1].z + v[j][1].w * v[j][1].w); }
}
__device__ __forceinline__ void norm_row_bf16(const bf16* xbrow, const f32x4 (&a)[4][2], const f32x4 (&b)[4][2], bf16* orow, int lane) {
    f32x4 v[4][2]; float s; load_row_bf16(xbrow, v, s, lane); norm_store(v, s, a, b, orow, lane);
}
__device__ __forceinline__ void final_norm_row(const bf16* xbrow, float* yrow, const float* g, int lane) {
    f32x4 v[4][2]; float s; load_row_bf16(xbrow, v, s, lane);
    const float rstd = 1.0f / sqrtf(wave_sum(s) * (1.0f / DM) + 1e-6f);
#pragma unroll
    for (int j = 0; j < 4; ++j) { const GAS f32x4* gp = (const GAS f32x4*)(g + 8 * lane + 512 * j); GAS f32x4* yp = (GAS f32x4*)(yrow + 8 * lane + 512 * j);
        yp[0] = v[j][0] * rstd * gp[0]; yp[1] = v[j][1] * rstd * gp[1]; }
}

__device__ __forceinline__ void rope_table_entry(float* rope, int e) {
    const int t = e >> 6, a = (e >> 5) & 1, i = e & 31; const float pos = (float)(a == 0 ? (t >> 6) : (t & 63));
    const float ang = pos * expf(-(float)i * (9.210340371976184f / 32.0f));
    rope[e] = cosf(ang); rope[2048 * 64 + e] = sinf(ang);
}
__device__ __forceinline__ void qkpost_row(bf16* qkv_row, int row, bool is_ax, const float* kg, const float* rope, float* state_k, int lane) {
    const bool is_lat = row >= NCTX;
    const int hsub = lane >> 4, a = (lane >> 3) & 1, i0 = (lane & 7) * 4;
    f32x4 cs = (f32x4){1.f, 1.f, 1.f, 1.f}, sn = (f32x4){0.f, 0.f, 0.f, 0.f};
    if (is_lat) { const int t = (row - NCTX) & 2047; cs = *(const GAS f32x4*)(rope + t * 64 + a * 32 + i0); sn = *(const GAS f32x4*)(rope + 2048 * 64 + t * 64 + a * 32 + i0); }
    bf16* base = qkv_row + 2048 + hsub * 128 + a * 64 + i0;
    const v2u r1 = *(const GAS v2u*)base, r2 = *(const GAS v2u*)(base + 32);
    float x1[4] = {bflo(r1.x), bfhi(r1.x), bflo(r1.y), bfhi(r1.y)}, x2[4] = {bflo(r2.x), bfhi(r2.x), bflo(r2.y), bfhi(r2.y)};
    if (is_ax) {
        float ss = 0.f;
#pragma unroll
        for (int e = 0; e < 4; ++e) ss += x1[e] * x1[e] + x2[e] * x2[e];
        ss += __shfl_xor(ss, 1); ss += __shfl_xor(ss, 2); ss += __shfl_xor(ss, 4); ss += __shfl_xor(ss, 8);
        const float rstd = 1.0f / sqrtf(ss * (1.0f / 128.0f) + 1e-6f);
        const float* G = kg + a * 64 + i0;
#pragma unroll
        for (int e = 0; e < 4; ++e) { x1[e] = x1[e] * rstd * G[e]; x2[e] = x2[e] * rstd * G[32 + e]; }
    }
    if (is_lat) {
#pragma unroll
        for (int e = 0; e < 4; ++e) { const float y1 = x1[e] * cs[e] - x2[e] * sn[e], y2 = x2[e] * cs[e] + x1[e] * sn[e]; x1[e] = y1; x2[e] = y2; }
    }
    if (is_ax || is_lat) { v2u w1, w2; w1.x = pk2(x1[0], x1[1]); w1.y = pk2(x1[2], x1[3]); w2.x = pk2(x2[0], x2[1]); w2.y = pk2(x2[2], x2[3]);
        *(GAS v2u*)base = w1; *(GAS v2u*)(base + 32) = w2; }
    if (is_ax && !is_lat) { float* sp = state_k + (size_t)row * 512 + hsub * 128 + a * 64 + i0;
        *(GAS f32x4*)sp = (f32x4){x1[0], x1[1], x1[2], x1[3]}; *(GAS f32x4*)(sp + 32) = (f32x4){x2[0], x2[1], x2[2], x2[3]}; }
}

namespace hy {
constexpr int CPY_STRIDE = 8480;
constexpr int U_OFF = 8 * CPY_STRIDE;
constexpr int U_BYTES = 6144;
static_assert(U_OFF + 8 * U_BYTES <= RING_BYTES, "hyena LDS map");

__device__ __forceinline__ void build_copies(LAS unsigned char* lds, const bf16* ft, int L, int tid) {
    if (tid < 264) { const int c = tid / 33, e = tid % 33; const int qq = (e < 17 - c) ? e : 2 * L + 16 - c + (e - (17 - c));
        *(LAS unsigned short*)(lds + c * CPY_STRIDE + qq * 2) = 0; }
    if (tid < 2 * L / 8) { const int side = tid / (L / 8), t8 = (tid % (L / 8)) * 8;
        const v4u raw = *(const GAS v4u*)(ft + (size_t)side * L + t8);
        const unsigned wds[4] = {raw.x, raw.y, raw.z, raw.w};
#pragma unroll
        for (int e = 0; e < 8; ++e) { const int t = t8 + e; const unsigned short val = (unsigned short)((e & 1) ? (wds[e >> 1] >> 16) : (wds[e >> 1] & 0xffffu));
            if (!(side == 1 && t == 0)) { const int p = side == 0 ? L - t : L + t;
#pragma unroll
                for (int c = 0; c < 8; ++c) *(LAS unsigned short*)(lds + c * CPY_STRIDE + (p + 16 - c) * 2) = val; } } }
}
__device__ __forceinline__ void fill_u(LAS unsigned char* ub, const bf16* urow, int L, float w0, float w1, float w2, float bb, int lane) {
    { const int e0 = lane < 32 ? lane * 8 : L + 256 + (lane - 32) * 8; *(LAS v4u*)(ub + e0 * 2) = (v4u){0u, 0u, 0u, 0u}; }
    for (int q = lane; q < L / 8; q += 64) { const int s0 = 8 * q;
        const v4u raw = *(const GAS v4u*)(urow + s0);
        const float prev = s0 > 0 ? bf2f(urow[s0 - 1]) : 0.f, next = s0 + 8 < L ? bf2f(urow[s0 + 8]) : 0.f;
        const float x[10] = {prev, bflo(raw.x), bfhi(raw.x), bflo(raw.y), bfhi(raw.y), bflo(raw.z), bfhi(raw.z), bflo(raw.w), bfhi(raw.w), next};
        float y[8];
#pragma unroll
        for (int j = 0; j < 8; ++j) y[j] = w0 * x[j] + w1 * x[j + 1] + w2 * x[j + 2] + bb;
        v4u o; o.x = pk2(y[0], y[1]); o.y = pk2(y[2], y[3]); o.z = pk2(y[4], y[5]); o.w = pk2(y[6], y[7]);
        *(LAS v4u*)(ub + (256 + s0) * 2) = o; }
}
template <int NT>
__device__ __forceinline__ void toeplitz(const LAS unsigned char* cpy, const LAS unsigned char* ub, f32x4 (&acc)[NT], int lane) {
    constexpr int L = 256 * NT;
    const int i = lane & 15, g = lane >> 4, c = (-i) & 7;
    const LAS unsigned char* ap = cpy + c * CPY_STRIDE + 2 * (L + 8 * g + 16 - i - c);
    const LAS unsigned char* bp = ub + 2 * (256 + 8 * g + 16 * i);
#pragma unroll 2
    for (int S = -256; S <= L - 32; S += 32) {
        const bf16x8 b = *(const LAS bf16x8*)(bp + 2 * S);
        bf16x8 a[NT];
#pragma unroll
        for (int k = 0; k < NT; ++k) a[k] = *(const LAS bf16x8*)(ap + 2 * S - 512 * k);
#pragma unroll
        for (int k = 0; k < NT; ++k) acc[k] = __builtin_amdgcn_mfma_f32_16x16x32_bf16(a[k], b, acc[k], 0, 0, 0);
    }
}
template <int NT>
__device__ __forceinline__ void gate(const f32x4 (&acc)[NT], LAS unsigned char* ub, const bf16* xg, float cw0, float cw1, float cw2, float cb, float invn, float skip, int lane, bool last, bf16* zt) {
    constexpr int L = 256 * NT;
    const int sg = lane & 15, g = lane >> 4;
#pragma unroll
    for (int k = 0; k < NT; ++k) { const int t0 = 256 * k + 16 * sg + 4 * g;
        const v2u ur = *(const LAS v2u*)(ub + (256 + t0) * 2);
        const v2u xr = *(const GAS v2u*)(xg + t0);
        const float prev = t0 > 0 ? bf2f(xg[t0 - 1]) : 0.f, next = t0 + 4 < L ? bf2f(xg[t0 + 4]) : 0.f;
        const float x[6] = {prev, bflo(xr.x), bfhi(xr.x), bflo(xr.y), bfhi(xr.y), next};
        const float uu[4] = {bflo(ur.x), bfhi(ur.x), bflo(ur.y), bfhi(ur.y)};
        float z[4];
#pragma unroll
        for (int r = 0; r < 4; ++r) { const float xc = cw0 * x[r] + cw1 * x[r + 1] + cw2 * x[r + 2] + cb; z[r] = xc * (acc[k][r] * invn + skip * uu[r]); }
        v2u o; o.x = pk2(z[0], z[1]); o.y = pk2(z[2], z[3]);
        if (last) *(GAS v2u*)(zt + t0) = o; else *(LAS v2u*)(ub + (256 + t0) * 2) = o; }
}

constexpr int USH_STR = 4416;
__device__ __forceinline__ int ush_base(int b) { return b * USH_STR + (b >> 2) * 16; }
static_assert(U_OFF + 8 * USH_STR + 64 <= RING_BYTES, "hyena LDS map (shared u)");

__device__ __forceinline__ void build_copies2(LAS unsigned char* lds, const bf16* ft, int L, int ztop, int tid) {
    const int nz = ztop - 2 * L + 1;
    for (int z = tid; z < 8 * nz; z += 512) { const int c = z / nz, e = z % nz; const int qq = (e < 17 - c) ? e : 2 * L + 16 - c + (e - (17 - c));
        *(LAS unsigned short*)(lds + c * CPY_STRIDE + qq * 2) = 0; }
    for (int idx = tid; idx < 2 * L; idx += 512) { const int side = idx >= L ? 1 : 0, t = idx - side * L;
        if (!(side == 1 && t == 0)) { const unsigned short val = *(const GAS unsigned short*)(ft + idx); const int p = side ? L + t : L - t;
#pragma unroll
            for (int c = 0; c < 8; ++c) *(LAS unsigned short*)(lds + c * CPY_STRIDE + (p + 16 - c) * 2) = val; } }
}
__device__ __forceinline__ void fill_coop(LAS unsigned char* ush, const bf16* urow_ch, float w0, float w1, float w2, float bb, int tid) {
    for (int z = tid; z < 160; z += 512) { const int b = z / 20, e = z % 20; const int el = e < 4 ? e * 8 : 2080 + (e - 4) * 8;
        *(LAS v4u*)(ush + ush_base(b) + el * 2) = (v4u){0u, 0u, 0u, 0u}; }
#pragma unroll 1
    for (int ch = tid; ch < 2048; ch += 512) { const int b = ch >> 8, s0 = (ch & 255) * 8; const bf16* urow = urow_ch + b * 2048;
        const v4u raw = *(const GAS v4u*)(urow + s0);
        const float prev = s0 > 0 ? bf2f(*(const GAS bf16*)(urow + s0 - 1)) : 0.f, next = s0 + 8 < 2048 ? bf2f(*(const GAS bf16*)(urow + s0 + 8)) : 0.f;
        const float x[10] = {prev, bflo(raw.x), bfhi(raw.x), bflo(raw.y), bfhi(raw.y), bflo(raw.z), bfhi(raw.z), bflo(raw.w), bfhi(raw.w), next};
        float y[8];
#pragma unroll
        for (int j = 0; j < 8; ++j) y[j] = w0 * x[j] + w1 * x[j + 1] + w2 * x[j + 2] + bb;
        v4u o; o.x = pk2(y[0], y[1]); o.y = pk2(y[2], y[3]); o.z = pk2(y[4], y[5]); o.w = pk2(y[6], y[7]);
        *(LAS v4u*)(ush + ush_base(b) + 2 * (32 + s0)) = o; }
}
__device__ __forceinline__ void toeplitz_coop(const LAS unsigned char* cpy, const LAS unsigned char* ush, f32x4 (&acc)[8], int wave, int lane) {
    constexpr int L = 2048;
    const int i = lane & 15, g = lane >> 4, c = (-i) & 7, bb = i & 7, sg = i >> 3;
    const LAS unsigned char* aq = cpy + c * CPY_STRIDE + 2 * (L + 8 * g + 16 - i - c) - 64 * (8 * wave - 2);
    const LAS unsigned char* bq = ush + ush_base(bb) + 2 * (32 + 8 * g + 16 * sg) - 64;
#pragma unroll
    for (int q = 0; q < 17; ++q) {
        bf16x8 A[11], Bf[4];
#pragma unroll
        for (int m = 0; m < 11; ++m) A[m] = *(const LAS bf16x8*)(aq - 64 * m);
#pragma unroll
        for (int b4 = 0; b4 < 4; ++b4) Bf[b4] = *(const LAS bf16x8*)(bq + 64 * b4);
#pragma unroll
        for (int b4 = 0; b4 < 4; ++b4)
#pragma unroll
            for (int a = 0; a < 8; ++a) acc[a] = __builtin_amdgcn_mfma_f32_16x16x32_bf16(A[a - b4 + 3], Bf[b4], acc[a], 0, 0, 0);
        aq += 256; bq += 256;
    }
}
__device__ __forceinline__ void gate_coop(const f32x4 (&acc)[8], LAS unsigned char* ush, const bf16* xg_ch, float cw0, float cw1, float cw2, float cb, float invn, float skip, int wave, int lane, bool last, bf16* zt_ch) {
    const int i = lane & 15, g = lane >> 4, bb = i & 7, sg = i >> 3;
    const bf16* xg = xg_ch + bb * 2048; bf16* zt = zt_ch + bb * 2048; LAS unsigned char* ub = ush + ush_base(bb);
#pragma unroll
    for (int a = 0; a < 8; ++a) { const int t0 = 32 * (8 * wave + a) + 16 * sg + 4 * g;
        const v2u ur = *(const LAS v2u*)(ub + (32 + t0) * 2);
        const v2u xr = *(const GAS v2u*)(xg + t0);
        const float prev = t0 > 0 ? bf2f(*(const GAS bf16*)(xg + t0 - 1)) : 0.f, next = t0 + 4 < 2048 ? bf2f(*(const GAS bf16*)(xg + t0 + 4)) : 0.f;
        const float x[6] = {prev, bflo(xr.x), bfhi(xr.x), bflo(xr.y), bfhi(xr.y), next};
        const float uu[4] = {bflo(ur.x), bfhi(ur.x), bflo(ur.y), bfhi(ur.y)};
        float z[4];
#pragma unroll
        for (int r = 0; r < 4; ++r) { const float xc = cw0 * x[r] + cw1 * x[r + 1] + cw2 * x[r + 2] + cb; z[r] = xc * (acc[a][r] * invn + skip * uu[r]); }
        v2u o; o.x = pk2(z[0], z[1]); o.y = pk2(z[2], z[3]);
        if (last) *(GAS v2u*)(zt + t0) = o; else *(LAS v2u*)(ub + (32 + t0) * 2) = o; }
}

struct GPre { v2u xr; unsigned pn; };
struct FPre { v4u raw; unsigned pn; };
constexpr int ZTOP_L = 2 * 2048 + 136, ZTOP_C = 2 * 256 + 32;

template <int NTAP> __device__ __forceinline__ void taps_load(unsigned (&tp)[(NTAP + 1) / 2], const bf16* ft, int L, int tid) {
#pragma unroll
    for (int w = 0; w < (NTAP + 1) / 2; ++w) tp[w] = 0u;
#pragma unroll
    for (int e = 0; e < NTAP; ++e) { const int idx = tid + 512 * e; const unsigned v = idx < 2 * L ? (unsigned)*(const GAS unsigned short*)(ft + idx) : 0u; tp[e >> 1] |= v << (16 * (e & 1)); }
}
template <int NTAP> __device__ __forceinline__ void copies_write(LAS unsigned char* lds, const unsigned (&tp)[(NTAP + 1) / 2], int L, int ztop, int tid) {
    const int nz = ztop - 2 * L + 1;
    for (int z = tid; z < 8 * nz; z += 512) { const int c = z / nz, e = z % nz; const int qq = (e < 17 - c) ? e : 2 * L + 16 - c + (e - (17 - c));
        *(LAS unsigned short*)(lds + c * CPY_STRIDE + qq * 2) = 0; }
#pragma unroll
    for (int e = 0; e < NTAP; ++e) { const int idx = tid + 512 * e;
        if (idx < 2 * L) { const int side = idx >= L ? 1 : 0, t = idx - side * L;
            if (!(side == 1 && t == 0)) { const int p = side ? L + t : L - t; const unsigned short val = (unsigned short)(tp[e >> 1] >> (16 * (e & 1)));
#pragma unroll
                for (int c = 0; c < 8; ++c) *(LAS unsigned short*)(lds + c * CPY_STRIDE + (p + 16 - c) * 2) = val; } } }
}
__device__ __forceinline__ void conv8_store(LAS unsigned char* dst, const FPre& f, float w0, float w1, float w2, float bb) {
    const float x[10] = {bflo(f.pn), bflo(f.raw.x), bfhi(f.raw.x), bflo(f.raw.y), bfhi(f.raw.y), bflo(f.raw.z), bfhi(f.raw.z), bflo(f.raw.w), bfhi(f.raw.w), bfhi(f.pn)};
    float y[8];
#pragma unroll
    for (int j = 0; j < 8; ++j) y[j] = w0 * x[j] + w1 * x[j + 1] + w2 * x[j + 2] + bb;
    v4u o; o.x = pk2(y[0], y[1]); o.y = pk2(y[2], y[3]); o.z = pk2(y[4], y[5]); o.w = pk2(y[6], y[7]);
    *(LAS v4u*)dst = o;
}
__device__ __forceinline__ void fpre_load(FPre& f, const bf16* urow, int s0, int L) {
    f.raw = *(const GAS v4u*)(urow + s0);
    const unsigned p = s0 > 0 ? (unsigned)*(const GAS unsigned short*)(urow + s0 - 1) : 0u, n = s0 + 8 < L ? (unsigned)*(const GAS unsigned short*)(urow + s0 + 8) : 0u;
    f.pn = p | (n << 16);
}
__device__ __forceinline__ void fill_coop_load(FPre (&fp)[4], const bf16* urow_ch, int tid) {
#pragma unroll
    for (int q = 0; q < 4; ++q) { const int ch = tid + 512 * q, b = ch >> 8, s0 = (ch & 255) * 8; fpre_load(fp[q], urow_ch + b * 2048, s0, 2048); }
}
__device__ __forceinline__ void fill_coop_write(LAS unsigned char* ush, const FPre (&fp)[4], float w0, float w1, float w2, float bb, int tid) {
    for (int z = tid; z < 160; z += 512) { const int b = z / 20, e = z % 20; const int el = e < 4 ? e * 8 : 2080 + (e - 4) * 8;
        *(LAS v4u*)(ush + ush_base(b) + el * 2) = (v4u){0u, 0u, 0u, 0u}; }
#pragma unroll
    for (int q = 0; q < 4; ++q) { const int ch = tid + 512 * q, b = ch >> 8, s0 = (ch & 255) * 8; conv8_store(ush + ush_base(b) + 2 * (32 + s0), fp[q], w0, w1, w2, bb); }
}
__device__ __forceinline__ void fill_ctx_load(FPre (&fp)[2], const bf16* urow_wave, int lane) {
#pragma unroll
    for (int j = 0; j < 2; ++j) { const int q = 2 * (lane >> 5) + j, s0 = (lane & 31) * 8; fpre_load(fp[j], urow_wave + q * 256, s0, 256); }
}
__device__ __forceinline__ void fill_ctx_write(LAS unsigned char* ubw, const FPre (&fp)[2], float w0, float w1, float w2, float bb, int lane) {
    const int e0 = lane < 32 ? lane * 8 : 512 + (lane - 32) * 8;
#pragma unroll
    for (int q = 0; q < 4; ++q) *(LAS v4u*)(ubw + q * 1536 + e0 * 2) = (v4u){0u, 0u, 0u, 0u};
#pragma unroll
    for (int j = 0; j < 2; ++j) { const int q = 2 * (lane >> 5) + j, s0 = (lane & 31) * 8; conv8_store(ubw + q * 1536 + (256 + s0) * 2, fp[j], w0, w1, w2, bb); }
}
__device__ __forceinline__ void gpre_load(GPre& p, const bf16* xg, int t0, int L) {
    p.xr = *(const GAS v2u*)(xg + t0);
    const unsigned a = t0 > 0 ? (unsigned)*(const GAS unsigned short*)(xg + t0 - 1) : 0u, n = t0 + 4 < L ? (unsigned)*(const GAS unsigned short*)(xg + t0 + 4) : 0u;
    p.pn = a | (n << 16);
}
__device__ __forceinline__ void gate4(const f32x4& y, const GPre& p, LAS unsigned char* up, float cw0, float cw1, float cw2, float cb, float invn, float skip, bool last, bf16* zp) {
    const v2u ur = *(const LAS v2u*)up;
    const float x[6] = {bflo(p.pn), bflo(p.xr.x), bfhi(p.xr.x), bflo(p.xr.y), bfhi(p.xr.y), bfhi(p.pn)};
    const float uu[4] = {bflo(ur.x), bfhi(ur.x), bflo(ur.y), bfhi(ur.y)};
    float z[4];
#pragma unroll
    for (int r = 0; r < 4; ++r) { const float xc = cw0 * x[r] + cw1 * x[r + 1] + cw2 * x[r + 2] + cb; z[r] = xc * (y[r] * invn + skip * uu[r]); }
    v2u o; o.x = pk2(z[0], z[1]); o.y = pk2(z[2], z[3]);
    if (last) *(GAS v2u*)zp = o; else *(LAS v2u*)up = o;
}
__device__ __forceinline__ void gate_coop_load(GPre (&pre)[8], const bf16* xg_ch, int wave, int lane) {
    const int i = lane & 15, g = lane >> 4, bb = i & 7, sg = i >> 3;
#pragma unroll
    for (int a = 0; a < 8; ++a) gpre_load(pre[a], xg_ch + bb * 2048, 32 * (8 * wave + a) + 16 * sg + 4 * g, 2048);
}
__device__ __forceinline__ void gate_coop_apply(const f32x4 (&acc)[8], const GPre (&pre)[8], LAS unsigned char* ush, float cw0, float cw1, float cw2, float cb, float invn, float skip, int wave, int lane, bool last, bf16* zt_ch) {
    const int i = lane & 15, g = lane >> 4, bb = i & 7, sg = i >> 3;
#pragma unroll
    for (int a = 0; a < 8; ++a) { const int t0 = 32 * (8 * wave + a) + 16 * sg + 4 * g;
        gate4(acc[a], pre[a], ush + ush_base(bb) + (32 + t0) * 2, cw0, cw1, cw2, cb, invn, skip, last, zt_ch + bb * 2048 + t0);
        __builtin_amdgcn_sched_barrier(0); }
}
__device__ __forceinline__ void toeplitz_ctx4(const LAS unsigned char* cpy, const LAS unsigned char* ubw, f32x4 (&acc)[4], int lane) {
    const int i = lane & 15, g = lane >> 4, c = (-i) & 7;
    const LAS unsigned char* ap = cpy + c * CPY_STRIDE + 2 * (256 + 8 * g + 16 - i - c);
    const LAS unsigned char* bp = ubw + 2 * (256 + 8 * g + 16 * i);
#pragma unroll 2
    for (int S = -256; S <= 224; S += 32) {
        const bf16x8 a = *(const LAS bf16x8*)(ap + 2 * S);
        bf16x8 b[4];
#pragma unroll
        for (int q = 0; q < 4; ++q) b[q] = *(const LAS bf16x8*)(bp + 1536 * q + 2 * S);
#pragma unroll
        for (int q = 0; q < 4; ++q) acc[q] = __builtin_amdgcn_mfma_f32_16x16x32_bf16(a, b[q], acc[q], 0, 0, 0);
    }
}
__device__ __forceinline__ void gate_ctx_load(GPre (&pre)[4], const bf16* xg_wave, int lane) {
    const int t0 = 16 * (lane & 15) + 4 * (lane >> 4);
#pragma unroll
    for (int q = 0; q < 4; ++q) gpre_load(pre[q], xg_wave + q * 256, t0, 256);
}
__device__ __forceinline__ void gate_ctx_apply(const f32x4 (&acc)[4], const GPre (&pre)[4], LAS unsigned char* ubw, float cw0, float cw1, float cw2, float cb, float invn, float skip, int lane, bool last, bf16* zt_wave) {
    const int t0 = 16 * (lane & 15) + 4 * (lane >> 4);
#pragma unroll
    for (int q = 0; q < 4; ++q) { gate4(acc[q], pre[q], ubw + q * 1536 + (256 + t0) * 2, cw0, cw1, cw2, cb, invn, skip, last, zt_wave + q * 256 + t0); __builtin_amdgcn_sched_barrier(0); }
}
}

constexpr int NPHASE = 35;
#ifndef PHMASK
#define PHMASK 0xFFFF
#endif
#define PHON(b) ((PHMASK >> (b)) & 1)
#ifndef REPMASK
#define REPMASK 0
#endif
#ifndef REPN
#define REPN 2
#endif
#define RSCALE (r_ == 0 ? 1.0f : 0.0f)
#define RUN(b, call) do { _Pragma("unroll 1") for (int r_ = 0; r_ < (((REPMASK >> (b)) & 1) ? REPN : 1); ++r_) { call; } } while (0)
#ifndef MK_PER_PHASE
#define MK_PER_PHASE 0
#endif


#ifndef STAGGER_TICKS
#define STAGGER_TICKS 800
#endif
__device__ __forceinline__ void stagger_start() {
    if (STAGGER_TICKS > 0 && (blockIdx.x & 1)) { const unsigned long long t0 = __builtin_amdgcn_s_memrealtime(); while (__builtin_amdgcn_s_memrealtime() - t0 < (unsigned long long)STAGGER_TICKS) __builtin_amdgcn_s_sleep(8); }
}
template <class T> __device__ __forceinline__ T* launder(T* p) { GAS T* q = (GAS T*)p; asm volatile("" : "+s"(q)); return (T*)q; }
#define ENV_IDS int tid_ = threadIdx.x; asm volatile("" : "+v"(tid_)); const int tid = tid_, lane = tid & 63, wave = __builtin_amdgcn_readfirstlane(tid >> 6); const int G = gridDim.x, bx = blockIdx.x; \
    const int vcu = (G % 8 == 0) ? (bx % 8) * (G / 8) + bx / 8 : bx; const int gw = vcu * NWAVES + wave, NGW = G * NWAVES; (void)tid; (void)lane; (void)gw; (void)NGW; (void)bx;
#ifndef SPL_DN
#define SPL_DN 4
#endif
#ifndef WGM_QKV
#define WGM_QKV 4
#endif
#ifndef WGM_IN
#define WGM_IN 4
#endif
#ifndef WGM_MIX
#define WGM_MIX 4
#endif
#ifndef WGM_GU
#define WGM_GU 8
#endif
#ifndef WGM_DN
#define WGM_DN 4
#endif
#define ENV_PTRS unsigned char* ws = launder(A.ws); float* out = launder(A.out); (void)out; (void)ws;

__device__ __forceinline__ void ph_prologue_a(const Args& A, LAS unsigned char* L) {
    ENV_IDS ENV_PTRS
    LAS float* wscr = (LAS float*)(L + wave * 16384);
    { int it = gw; TItem t; f32x4 tv[8];
      if (it < IT_TOTAL) { t = titem_decode(A, it); titem_load(t, tv, lane); }
#pragma unroll 1
      while (it < IT_TOTAL) { const int nit = it + NGW; TItem tn = t; f32x4 tn_v[8];
#pragma unroll
          for (int i = 0; i < 8; ++i) tn_v[i] = tv[i];
          if (nit < IT_TOTAL) { tn = titem_decode(A, nit); titem_load(tn, tn_v, lane); }
          titem_finish(t, tv, wscr, lane);
          t = tn;
#pragma unroll
          for (int i = 0; i < 8; ++i) tv[i] = tn_v[i];
          it = nit; } }
    { const size_t NCH = (size_t)2 * 524288 + 2 * 262144;
      for (size_t ch = (size_t)gw * 64 + lane; ch < NCH; ch += (size_t)NGW * 64) {
          int ten; size_t off; unsigned char* dstb;
          if (ch < 524288) { ten = 0; off = ch * 8; dstb = ws + WS_CWK; } else if (ch < 1048576) { ten = 1; off = (ch - 524288) * 8; dstb = ws + WS_CWV; }
          else if (ch < 1310720) { ten = 2; off = (ch - 1048576) * 8; dstb = ws + WS_CAK; } else { ten = 3; off = (ch - 1310720) * 8; dstb = ws + WS_CAV; }
          const float* src = GIN(2 + ten) + off; const f32x4 a = *(const GAS f32x4*)src, b = *(const GAS f32x4*)(src + 4);
          v4u o; o.x = pk2(a.x, a.y); o.y = pk2(a.z, a.w); o.z = pk2(b.x, b.y); o.w = pk2(b.z, b.w);
          *(GAS v4u*)((bf16*)dstb + off) = o; } }
    for (int e = gw * 64 + lane; e < 2048 * 64; e += NGW * 64) rope_table_entry((float*)(ws + WS_ROPE), e);
    for (int u = gw; u < 1536; u += NGW) adaln_partial_unit(A, __builtin_amdgcn_readfirstlane(u), wscr, lane);
    for (int rr = gw; rr < 2304; rr += NGW) filter_a2_row(A, __builtin_amdgcn_readfirstlane(rr), lane);
}
__device__ __forceinline__ void ph_prologue_b(const Args& A, LAS unsigned char* L) {
    ENV_IDS ENV_PTRS
    LAS float* wscr = (LAS float*)(L + wave * 16384);
    float* MODF = (float*)(ws + WS_MODF);
    for (int e = gw * 64 + lane; e < DEPTH * 9 * DM; e += NGW * 64) { const int layer = e / (9 * DM), c = (e / DM) % 9, col = e % DM;
        float m[6];
#pragma unroll
        for (int q = 0; q < 6; ++q) { float s = GIN(11)[(size_t)layer * 12288 + q * DM + col];
#pragma unroll
            for (int kc = 0; kc < 8; ++kc) s += ((const float*)(ws + WS_MODP))[(size_t)((layer * 8 + kc) * 9 + c) * 12288 + q * DM + col];
            m[q] = s; }
        float* mf = MODF + (size_t)((layer * 9 + c) * 6) * DM + col;
        mf[0 * DM] = GIN(8)[layer * DM + col] * (1.0f + m[1]); mf[1 * DM] = m[0]; mf[2 * DM] = m[2];
        mf[3 * DM] = GIN(9)[layer * DM + col] * (1.0f + m[4]); mf[4 * DM] = m[3]; mf[5 * DM] = m[5]; }
    for (int u = gw; u < 9216; u += NGW) filter_hf_unit(A, __builtin_amdgcn_readfirstlane(u), lane);
}
__device__ __forceinline__ void ph_norm(const Args& A, int layer, int which) {
    ENV_IDS ENV_PTRS
    const float* modf = (const float*)(ws + WS_MODF) + (size_t)layer * 9 * 6 * DM; bf16* HB = (bf16*)(ws + WS_H);
    if (layer == 0 && which == 0) {
        const float* NP = (const float*)(ws + WS_NP); float* INV = (float*)(ws + WS_INV);
        for (int e = gw * 64 + lane; e < 4 * DM; e += NGW * 64) { const int variant = e >> 12, o = (e >> 11) & 1, d = e & 2047; float s = 0.f;
            const int c0 = variant ? 32 : 0, c1 = variant ? 34 : 16;
            for (int ch = c0; ch < c1; ++ch) s += NP[(size_t)ch * 8192 + o * 2048 + d] + NP[(size_t)ch * 8192 + 4096 + o * 2048 + d];
            INV[e] = 1.0f / (s + 1e-6f); } }
    bf16* XB = (bf16*)(ws + WS_XB);
    const int per = (NTOK + NGW - 1) / NGW, r0 = gw * per, r1 = (r0 + per < NTOK) ? r0 + per : NTOK;
    int cur = -1; f32x4 ma[4][2], mb[4][2];
#pragma unroll 1
    for (int row = r0; row < r1; ++row) { const int cv = row < NCTX ? 0 : 1 + ((row - NCTX) >> 11);
        if (cv != cur) { cur = cv; const float* pa = modf + (size_t)(cv * 6 + 3 * which) * DM + 8 * lane; const float* pb = modf + (size_t)(cv * 6 + 3 * which + 1) * DM + 8 * lane;
#pragma unroll
            for (int j = 0; j < 4; ++j) { ma[j][0] = *(const GAS f32x4*)(pa + 512 * j); ma[j][1] = *(const GAS f32x4*)(pa + 512 * j + 4); mb[j][0] = *(const GAS f32x4*)(pb + 512 * j); mb[j][1] = *(const GAS f32x4*)(pb + 512 * j + 4); } }
        if (layer == 0 && which == 0) { const float* xr = row < NCTX ? GIN(0) + (size_t)row * DM : GIN(1) + (size_t)(row - NCTX) * DM;
            norm_row_f32(xr, ma, mb, HB + (size_t)row * DM, XB + (size_t)row * DM, lane); }
        else norm_row_bf16(XB + (size_t)row * DM, ma, mb, HB + (size_t)row * DM, lane); }
}
__device__ __forceinline__ void ph_qkv(const Args& A, int layer, LAS unsigned char* L) {
    ENV_PTRS
    const int G = gridDim.x, bx = blockIdx.x; const bool is_ax = (layer % 3) == 2; const int jx = layer / 3;
    const bf16* W = (const bf16*)(ws + (is_ax ? WS_WQKVA : (jx == 0 ? WS_WQKV0 : WS_WQKV1)));
    pg8::Gemm g{(const bf16*)(ws + WS_H), W, NTOK, QKVD, DM}; pg8::StaticOrder S; S.init(NTOK, QKVD, G, bx, WGM_QKV);
    pg8::EpiQKV E{(bf16*)(ws + WS_BIG), is_ax ? nullptr : out + OUT_WK + (size_t)jx * 256 * 512, is_ax ? out + OUT_AV : out + OUT_WV + (size_t)jx * 256 * 512, is_ax ? 0 : 256};
    pg8::gemm_phase<pg8::EpiQKV, pg8::StaticOrder, true, true>(L, g, S, E);
}
__device__ __forceinline__ void ph_qkpost(const Args& A, int layer) {
    ENV_IDS ENV_PTRS
    const bool is_ax = (layer % 3) == 2; bf16* QKVB = (bf16*)(ws + WS_BIG);
    for (int row = (is_ax ? 0 : NCTX) + gw; row < NTOK; row += NGW)
        qkpost_row(QKVB + (size_t)row * QKVD, row, is_ax, GIN(28), (const float*)(ws + WS_ROPE), out + OUT_AK, lane);
}
__device__ __forceinline__ void ph_attn(const Args& A, int layer, LAS char* lds) {
    ENV_PTRS
    const int G = gridDim.x, bx = blockIdx.x; const bool is_ax = (layer % 3) == 2; const int jx = layer / 3;
    const att::bf16* QK = (const att::bf16*)(ws + WS_BIG); att::bf16* OB = (att::bf16*)(ws + WS_H);
    const att::bf16* CK = (const att::bf16*)(ws + (is_ax ? WS_CAK : WS_CWK));
    const att::bf16* CV = (const att::bf16*)(ws + (is_ax ? WS_CAV : WS_CWV));
    const int ncl = is_ax ? 1 : 2;
#pragma unroll 1
    for (int u = bx; u < 1536; u += G) {
        att::Unit U;
        if (u < 1024) { const int b = u >> 7, qb = (u >> 4) & 7, h = u & 15, kvh = h >> 2;
            const size_t r0 = (size_t)NCTX + (size_t)b * 2048 + (size_t)qb * 256;
            U.Q = QK + r0 * QKVD + h * 128; U.ldq = QKVD;
            const size_t coff = ((size_t)(b * ncl + (is_ax ? 0 : jx)) * 512) * 512 + kvh * 128;
            U.KA = CK + coff; U.VA = CV + coff; U.ldA = 512; U.nA = 8;
            const int klo = is_ax ? 0 : (qb * 256 - 128 < 0 ? 0 : qb * 256 - 128), khi = is_ax ? 2048 : (qb * 256 + 384 > 2048 ? 2048 : qb * 256 + 384);
            const size_t kr0 = (size_t)NCTX + (size_t)b * 2048 + klo;
            U.KB = QK + kr0 * QKVD + 2048 + kvh * 128; U.VB = QK + kr0 * QKVD + 2560 + kvh * 128; U.ldB = QKVD;
            U.NT = 8 + (khi - klo) / 64; U.win = is_ax ? 0 : 1; U.dq0 = qb * 256 - klo;
            U.O = OB + r0 * DM + h * 128; U.ldo = DM;
            U.has_sink = is_ax ? 0 : 1; U.sink = is_ax ? 0.f : GIN(14)[jx * 16 + h];
            U.qmode = is_ax ? 3 : 2; U.qt0 = qb * 256;
        } else { const int uc = u - 1024, b = uc >> 4, h = uc & 15, kvh = h >> 2; const size_t r0 = (size_t)b * 256;
            U.Q = QK + r0 * QKVD + h * 128; U.ldq = QKVD;
            U.KA = QK + r0 * QKVD + 2048 + kvh * 128; U.VA = QK + r0 * QKVD + 2560 + kvh * 128; U.ldA = QKVD; U.nA = 4;
            U.KB = U.KA; U.VB = U.VA; U.ldB = QKVD; U.NT = 4; U.win = 0; U.dq0 = 0;
            U.O = OB + r0 * DM + h * 128; U.ldo = DM;
            U.has_sink = is_ax ? 0 : 1; U.sink = is_ax ? 0.f : GIN(14)[jx * 16 + h];
            U.qmode = is_ax ? 1 : 0; U.qt0 = 0;
        }
        U.qg = GIN(27); U.rope = (const float*)(ws + WS_ROPE);
        att::attn_unit(U, lds);
    }
}
__device__ __forceinline__ void ph_hyin(const Args& A, LAS unsigned char* L) {
    ENV_PTRS
    const int G = gridDim.x, bx = blockIdx.x;
    pg8::Gemm g{(const bf16*)(ws + WS_WHI), (const bf16*)(ws + WS_H), 6144, NTOK, DM}; pg8::StaticOrder S; S.init(6144, NTOK, G, bx, WGM_IN);
    pg8::EpiBf16 E{(bf16*)(ws + WS_BIG), NTOK};
    pg8::gemm_phase<pg8::EpiBf16, pg8::StaticOrder, true, true>(L, g, S, E);
}
__device__ __forceinline__ void ph_hyconv(const Args& A, LAS unsigned char* L) {
    ENV_IDS ENV_PTRS
    const bf16* UT = (const bf16*)(ws + WS_BIG); bf16* ZT = (bf16*)(ws + WS_ZT);
    const float* cw = GIN(16); const float* cbv = GIN(17); const float* skp = GIN(24); const float* INV = (const float*)(ws + WS_INV);
    LAS unsigned char* ush = L + hy::U_OFF; LAS unsigned char* ubw = L + hy::U_OFF + wave * hy::U_BYTES;
    const bf16* FTL = (const bf16*)(ws + WS_FT); const bf16* FTC = (const bf16*)(ws + WS_FT_CTX);
    hy::FPre fl[4]; unsigned tl0[4];
#pragma unroll 1
    for (int d = bx; d < DM; d += G) {
        float w0[3], w1[3], w2[3], cb[3];
#pragma unroll
        for (int p = 0; p < 3; ++p) { const int ch = p * DM + d; w0[p] = cw[ch]; w1[p] = cw[6144 + ch]; w2[p] = cw[2 * 6144 + ch]; cb[p] = cbv[ch]; }
        const float inl0 = INV[d], inl1 = INV[2048 + d], inc0 = INV[4096 + d], inc1 = INV[6144 + d];
        const float sk0 = skp[d], sk1 = skp[DM + d];
        const bf16* ftl = FTL + (size_t)d * 2 * 2048; const bf16* ftc = FTC + (size_t)d * 2 * 256;
        const size_t cb0 = (size_t)wave * 1024;
        hy::fill_coop_load(fl, UT + (size_t)d * NTOK + NCTX, tid); hy::taps_load<8>(tl0, ftl, 2048, tid);
        hy::fill_coop_write(ush, fl, w0[0], w1[0], w2[0], cb[0], tid); hy::copies_write<8>(L, tl0, 2048, hy::ZTOP_L, tid); __syncthreads();
        hy::GPre g0[8]; unsigned tl1[4];
        hy::taps_load<8>(tl1, ftl + (size_t)2048 * 2 * 2048, 2048, tid);
        f32x4 acc[8];
#pragma unroll
        for (int k = 0; k < 8; ++k) acc[k] = (f32x4){0.f, 0.f, 0.f, 0.f};
        hy::toeplitz_coop(L, ush, acc, wave, lane); __syncthreads();
        hy::gate_coop_load(g0, UT + (size_t)(DM + d) * NTOK + NCTX, wave, lane);
        hy::gate_coop_apply(acc, g0, ush, w0[1], w1[1], w2[1], cb[1], inl0, sk0, wave, lane, false, nullptr); hy::copies_write<8>(L, tl1, 2048, hy::ZTOP_L, tid); __syncthreads();
        hy::GPre g1[8]; hy::FPre fc[2]; unsigned tc0[1], tc1[1];
        hy::fill_ctx_load(fc, UT + (size_t)d * NTOK + cb0, lane); hy::taps_load<1>(tc0, ftc, 256, tid); hy::taps_load<1>(tc1, ftc + (size_t)2048 * 2 * 256, 256, tid);
#pragma unroll
        for (int k = 0; k < 8; ++k) acc[k] = (f32x4){0.f, 0.f, 0.f, 0.f};
        hy::toeplitz_coop(L, ush, acc, wave, lane);
        hy::gate_coop_load(g1, UT + (size_t)(2 * DM + d) * NTOK + NCTX, wave, lane);
        hy::gate_coop_apply(acc, g1, ush, w0[2], w1[2], w2[2], cb[2], inl1, sk1, wave, lane, true, ZT + (size_t)d * NTOK + NCTX); __syncthreads();
        hy::fill_ctx_write(ubw, fc, w0[0], w1[0], w2[0], cb[0], lane); hy::copies_write<1>(L, tc0, 256, hy::ZTOP_C, tid); hy::copies_write<1>(L + 2048, tc1, 256, hy::ZTOP_C, tid); __syncthreads();
        hy::GPre h0[4];
        hy::gate_ctx_load(h0, UT + (size_t)(DM + d) * NTOK + cb0, lane);
        f32x4 ac4[4];
#pragma unroll
        for (int q = 0; q < 4; ++q) ac4[q] = (f32x4){0.f, 0.f, 0.f, 0.f};
        hy::toeplitz_ctx4(L, ubw, ac4, lane);
        hy::GPre h1[4];
        hy::gate_ctx_load(h1, UT + (size_t)(2 * DM + d) * NTOK + cb0, lane);
        hy::gate_ctx_apply(ac4, h0, ubw, w0[1], w1[1], w2[1], cb[1], inc0, sk0, lane, false, nullptr);
        LDS_WAIT(); asm volatile("" ::: "memory");
#pragma unroll
        for (int q = 0; q < 4; ++q) ac4[q] = (f32x4){0.f, 0.f, 0.f, 0.f};
        hy::toeplitz_ctx4(L + 2048, ubw, ac4, lane);
        hy::gate_ctx_apply(ac4, h1, ubw, w0[2], w1[2], w2[2], cb[2], inc1, sk1, lane, true, ZT + (size_t)d * NTOK + cb0); __syncthreads();
    }
}
__device__ __forceinline__ void ph_hytr(const Args& A, LAS unsigned char* L) {
    ENV_IDS ENV_PTRS
    const bf16* ZT = (const bf16*)(ws + WS_ZT); bf16* HB = (bf16*)(ws + WS_H);
    LAS unsigned char* scr = L + wave * 16384;
    for (int tile = gw; tile < 32 * 384; tile += NGW) { const int d0 = (tile & 31) * 64, r0 = (tile >> 5) * 64;
#pragma unroll
        for (int j = 0; j < 8; ++j) { const int idx = j * 64 + lane, dl = idx >> 3, ch = idx & 7;
            *(LAS v4u*)(scr + dl * 144 + ch * 16) = *(const GAS v4u*)(ZT + (size_t)(d0 + dl) * NTOK + r0 + ch * 8); }
        LDS_WAIT(); asm volatile("" ::: "memory");
#pragma unroll
        for (int j = 0; j < 8; ++j) { unsigned e[8];
#pragma unroll
            for (int q = 0; q < 8; ++q) e[q] = *(const LAS unsigned short*)(scr + (j * 8 + q) * 144 + lane * 2);
            v4u o; o.x = e[0] | (e[1] << 16); o.y = e[2] | (e[3] << 16); o.z = e[4] | (e[5] << 16); o.w = e[6] | (e[7] << 16);
            *(GAS v4u*)(HB + (size_t)(r0 + lane) * DM + d0 + j * 8) = o; }
        LDS_WAIT(); asm volatile("" ::: "memory"); }
}
__device__ __forceinline__ void ph_mixout(const Args& A, int layer, LAS unsigned char* L, float gs) {
    ENV_PTRS
    const int G = gridDim.x, bx = blockIdx.x; const int kind = layer % 3, jx = layer / 3;
    const float* modf = (const float*)(ws + WS_MODF) + (size_t)layer * 9 * 6 * DM;
    const bf16* W = (const bf16*)(ws + (kind == 1 ? WS_WHO : (kind == 2 ? WS_WOA : (jx == 0 ? WS_WO0 : WS_WO1))));
    pg8::StaticOrder S; S.init(NTOK, DM, G, bx, WGM_MIX);
    pg8::EpiResid E{(bf16*)(ws + WS_XB), modf + 2 * DM, gs};
    if (kind == 1) {
        pg8::Gemm g{(const bf16*)(ws + WS_ZT), W, NTOK, DM, DM};
        pg8::gemm_phase<pg8::EpiResid, pg8::StaticOrder, true, true, false, false, true>(L, g, S, E);
    } else {
        pg8::Gemm g{(const bf16*)(ws + WS_H), W, NTOK, DM, DM};
        pg8::gemm_phase<pg8::EpiResid, pg8::StaticOrder, true, true>(L, g, S, E);
    }
}
__device__ __forceinline__ void ph_gu(const Args& A, int layer, LAS unsigned char* L) {
    ENV_PTRS
    const int G = gridDim.x, bx = blockIdx.x;
    pg8::Gemm g{(const bf16*)(ws + WS_H), (const bf16*)(ws + WS_WGU + (size_t)layer * W_GU), NTOK, NGU, DM}; pg8::StaticOrder S; S.init(NTOK, NGU, G, bx, WGM_GU);
    pg8::EpiSwiglu E{(bf16*)(ws + WS_BIG)};
    pg8::gemm_phase<pg8::EpiSwiglu, pg8::StaticOrder, true, true>(L, g, S, E);
}
__device__ __forceinline__ void ph_down(const Args& A, int layer, LAS unsigned char* L, float gs) {
    ENV_PTRS
    const int G = gridDim.x, bx = blockIdx.x;
    const float* modf = (const float*)(ws + WS_MODF) + (size_t)layer * 9 * 6 * DM;
    pg8::Gemm g{(const bf16*)(ws + WS_BIG), (const bf16*)(ws + WS_WDN + (size_t)layer * W_DN), NTOK, DM, DFF}; pg8::StaticOrder S; S.init(NTOK, DM, G, bx, WGM_DN);
    int spl_ = SPL_DN; asm volatile("" : "+s"(spl_));
    S.split(spl_, DFF / 64, (float*)(ws + WS_H), (unsigned*)(ws + WS_CTL) + CW_SPLIT + (layer * 4 + 3) * 256);
#ifdef PROBE_I0
    if (gs == 0.f) S.i0 = PROBE_I0;
#endif
    pg8::EpiResid E{(bf16*)(ws + WS_XB), modf + 5 * DM, gs};
    pg8::gemm_phase<pg8::EpiResid, pg8::StaticOrder, true, true, true, true>(L, g, S, E);
}
__device__ __forceinline__ void ph_final(const Args& A) {
    ENV_IDS ENV_PTRS
    for (int row = gw; row < NTOK; row += NGW) final_norm_row((const bf16*)(ws + WS_XB) + (size_t)row * DM, out + (size_t)row * DM, GIN(32), lane);
}

__global__ void __launch_bounds__(NWAVES * 64, 2) hybrid_fwd(Args A) {
    extern __shared__ __attribute__((aligned(16))) unsigned char lds[];
    LAS unsigned char* L = (LAS unsigned char*)lds;
    for (int u = threadIdx.x; u < (LDS_BYTES - LDSCTL_OFF) / 4; u += NWAVES * 64) ((LAS unsigned*)(L + LDSCTL_OFF))[u] = 0u;
    __syncthreads();
    XcdBarrier bar; bar.bar = (unsigned*)(A.ws + WS_CTL) + CW_BAR; bar.x = 0; bar.st = nullptr;
    if (!MK_PER_PHASE) bar = xcd_barrier_post((unsigned*)(A.ws + WS_CTL) + CW_BAR, (volatile LAS unsigned*)(L + MISC_OFF) + 8);
    const int lo = A.ph_lo, hi = A.ph_hi;
#define IN(k) (lo <= (k) && (k) < hi)
#define SEAM(k) do { if (IN(k) && IN((k) + 1)) xcd_barrier(bar); } while (0)
    if (PHON(0) && IN(0)) RUN(0, ph_prologue_a(A, L));
    SEAM(0);
    if (PHON(1) && IN(1)) RUN(1, ph_prologue_b(A, L));
    SEAM(1);
#pragma unroll 1
    for (int layer = 0; layer < DEPTH; ++layer) {
        const int pb = 2 + 8 * layer;
        if (PHON(2) && IN(pb + 0)) RUN(2, ph_norm(A, layer, 0));
        SEAM(pb + 0);
        if ((layer % 3) != 1) {
            if (PHON(3) && IN(pb + 1)) RUN(3, ph_qkv(A, layer, L));
            SEAM(pb + 1);
            if (PHON(4) && IN(pb + 2)) RUN(4, ph_qkpost(A, layer));
            SEAM(pb + 2);
            if (PHON(5) && IN(pb + 3)) RUN(5, ph_attn(A, layer, (LAS char*)L));
            SEAM(pb + 3);
        } else {
            if (PHON(6) && IN(pb + 1)) RUN(6, ph_hyin(A, L));
            SEAM(pb + 1);
            if (PHON(7) && IN(pb + 2)) RUN(7, ph_hyconv(A, L));
            SEAM(pb + 2);
        }
        if (PHON(9) && IN(pb + 4)) RUN(9, ph_mixout(A, layer, L, RSCALE));
        SEAM(pb + 4);
        if (PHON(10) && IN(pb + 5)) RUN(10, ph_norm(A, layer, 1));
        SEAM(pb + 5);
        if (PHON(11) && IN(pb + 6)) RUN(11, ph_gu(A, layer, L));
        SEAM(pb + 6);
        if (PHON(12) && IN(pb + 7)) RUN(12, ph_down(A, layer, L, RSCALE));
        SEAM(pb + 7);
    }
    if (PHON(13) && IN(34)) RUN(13, ph_final(A));
#undef IN
#undef SEAM
}

extern "C" void kernel_launch(void* const* d_in, const int* in_sizes, int n_in, void* d_out, int out_size, void* d_ws, size_t ws_size, hipStream_t stream) {
    static int grid = 0;
    if (grid == 0) {
        if (n_in != 33 || (size_t)out_size != OUT_END || ws_size < WS_END) { fprintf(stderr, "kernel_launch: unexpected shapes: n_in %d out %d ws %zu (need %zu)\n", n_in, out_size, ws_size, (size_t)WS_END); grid = -1; return; }
        int dev = 0, cus = 0, per_cu = 0;
        if (hipGetDevice(&dev) != hipSuccess || hipDeviceGetAttribute(&cus, hipDeviceAttributeMultiprocessorCount, dev) != hipSuccess) { grid = -1; return; }
        if (hipFuncSetAttribute((const void*)hybrid_fwd, hipFuncAttributeMaxDynamicSharedMemorySize, LDS_BYTES) != hipSuccess) { fprintf(stderr, "kernel_launch: hipFuncSetAttribute failed\n"); grid = -1; return; }
        if (hipOccupancyMaxActiveBlocksPerMultiprocessor(&per_cu, (const void*)hybrid_fwd, NWAVES * 64, LDS_BYTES) != hipSuccess || per_cu < 1)
            fprintf(stderr, "kernel_launch: occupancy query reports %d workgroups per CU\n", per_cu);
        (void)hipGetLastError();
        grid = cus;
    }
    if (grid < 0) return;
    if (hipMemsetAsync((char*)d_ws + WS_CTL, 0, CTL_ZERO_BYTES, stream) != hipSuccess) { fprintf(stderr, "kernel_launch: memset failed\n"); return; }
    Args a{};
    for (int i = 0; i < 33; ++i) a.in[i] = (const float*)d_in[i];
    a.out = (float*)d_out; a.ws = (unsigned char*)d_ws;
#if MK_PER_PHASE
    for (int ph = 0; ph < NPHASE; ++ph) { a.ph_lo = ph; a.ph_hi = ph + 1; hipLaunchKernelGGL(hybrid_fwd, dim3(grid), dim3(NWAVES * 64), LDS_BYTES, stream, a); }
#else
    a.ph_lo = 0; a.ph_hi = NPHASE; hipLaunchKernelGGL(hybrid_fwd, dim3(grid), dim3(NWAVES * 64), LDS_BYTES, stream, a);
#endif
    const hipError_t le = hipPeekAtLastError();
    if (le != hipSuccess) fprintf(stderr, "kernel_launch: launch failed: %s\n", hipGetErrorName(le));
}
```
